# Optimizing an MI355X kernel written in HIP

```python
import math
import jax, jax.numpy as jnp
from jax import lax
import numpy as np


D_MODEL = 2048
BATCH = 8
SEQ = 2048
DEPTH = 1

MEM_TOKENS = 256
RET_HEADS = 8
RET_QK_DIM = 128
RET_V_DIM = 128
RET_CHUNK = 128
DIL_PATTERNS = ((128, 1), (512, 4), (2048, 16))
DIL_HEADS_PER_GROUP = 4
DIL_HEAD_DIM = 128
DIL_BLOCK = 128
ROPE_THETA = 10000.0
MEM_HEADS = 4
MEM_HEAD_DIM = D_MODEL // MEM_HEADS
PEER_HEADS = 8
PEER_N_KEYS = 128
PEER_N_EXPERTS = PEER_N_KEYS * PEER_N_KEYS
PEER_QUERY_DIM = 256
PEER_TOPK = 16
PEER_TOKEN_BLOCK = 128
NORM_EPS = 1e-6

RET_QK_W = RET_HEADS * RET_QK_DIM
RET_V_W = RET_HEADS * RET_V_DIM
DIL_N_GROUPS = len(DIL_PATTERNS)
DIL_QKV_W = DIL_N_GROUPS * DIL_HEADS_PER_GROUP * DIL_HEAD_DIM
DIL_OUT_W = DIL_HEADS_PER_GROUP * DIL_HEAD_DIM
IN_SPLIT_SIZES = (RET_QK_W, RET_QK_W, RET_V_W, RET_V_W, DIL_QKV_W, DIL_QKV_W, DIL_QKV_W, D_MODEL, D_MODEL)
IN_WIDTH = sum(IN_SPLIT_SIZES)
IN_SPLIT_POINTS = tuple(int(c) for c in np.cumsum(IN_SPLIT_SIZES)[:-1])

kernel_name = 'hybrid_retention_dilated_peer_block'


def rms_norm(x, g):
    xf = x.astype(jnp.float32)
    y = xf * lax.rsqrt(jnp.mean(xf * xf, axis=-1, keepdims=True) + NORM_EPS)
    return (y * g.astype(jnp.float32)).astype(x.dtype)


def rotary(x, pos):
    dh = x.shape[-1]
    half = dh // 2
    inv = 1.0 / (ROPE_THETA ** (jnp.arange(half, dtype=jnp.float32) / half))
    ang = pos.astype(jnp.float32)[..., None] * inv
    cos = jnp.cos(ang)[:, :, None, :]
    sin = jnp.sin(ang)[:, :, None, :]
    xf = x.astype(jnp.float32)
    x1, x2 = xf[..., :half], xf[..., half:]
    return jnp.concatenate([x1 * cos - x2 * sin, x2 * cos + x1 * sin], axis=-1).astype(x.dtype)


def retnet_rotate(x, pos):
    dh = x.shape[-1]
    angle = 1.0 / (10000.0 ** jnp.linspace(0.0, 1.0, dh // 2, dtype=jnp.float32))
    angle = jnp.repeat(angle, 2)
    ang = pos.astype(jnp.float32)[..., None] * angle
    cos = jnp.cos(ang)[:, :, None, :]
    sin = jnp.sin(ang)[:, :, None, :]
    xf = x.astype(jnp.float32)
    rot = jnp.stack([-xf[..., 1::2], xf[..., 0::2]], axis=-1).reshape(xf.shape)
    return xf * cos + rot * sin


def retention(q, k, v, pos):
    b, s, h, dk = q.shape
    dv = v.shape[-1]
    c = RET_CHUNK
    n = s // c
    q = retnet_rotate(q, pos)
    k = retnet_rotate(k, pos) * (dk ** -0.5)
    v = v.astype(jnp.float32)
    to_chunks = lambda t: t.reshape(b, n, c, h, t.shape[-1]).transpose(0, 3, 1, 2, 4)
    qc, kc, vc = to_chunks(q), to_chunks(k), to_chunks(v)
    log_g = jnp.log1p(-jnp.exp2(-5.0 - jnp.arange(h, dtype=jnp.float32)))
    i = jnp.arange(c, dtype=jnp.float32)
    diff = i[:, None] - i[None, :]
    dmat = jnp.where(diff >= 0, jnp.exp(log_g[:, None, None] * jnp.maximum(diff, 0.0)), 0.0)
    scores = jnp.einsum('bhncd,bhnjd->bhncj', qc, kc) * dmat[None, :, None]
    inner = jnp.einsum('bhncj,bhnje->bhnce', scores, vc)
    k_w = jnp.exp(log_g[:, None] * (c - 1 - i))
    kv = jnp.einsum('bhncd,bhnce->bhnde', kc * k_w[None, :, None, :, None], vc)
    chunk_decay = jnp.exp(log_g * c)[None, :, None, None]

    def step(state, kv_n):
        return chunk_decay * state + kv_n, state

    init = jnp.zeros((b, h, dk, dv), kv.dtype)
    _, prev = lax.scan(step, init, jnp.moveaxis(kv, 2, 0))
    prev = jnp.moveaxis(prev, 0, 2)
    q_w = jnp.exp(log_g[:, None] * (i + 1.0))
    cross = jnp.einsum('bhncd,bhnde->bhnce', qc * q_w[None, :, None, :, None], prev)
    out = (inner + cross).transpose(0, 2, 3, 1, 4).reshape(b, s, h, dv)
    out = out * lax.rsqrt(jnp.mean(out * out, axis=-1, keepdims=True) + NORM_EPS)
    return out


def banded_attention(q, k, v, window):
    *lead, L, dh = q.shape
    blk = DIL_BLOCK
    nb = -(-L // blk)
    pad = nb * blk - L
    padw = [(0, 0)] * len(lead) + [(0, pad), (0, 0)]
    qb = jnp.pad(q, padw).reshape(*lead, nb, blk, dh)
    kb = jnp.pad(k, padw).reshape(*lead, nb, blk, dh)
    vb = jnp.pad(v, padw).reshape(*lead, nb, blk, dh)
    shift = lambda t: jnp.concatenate([jnp.zeros_like(t[..., :1, :, :]), t[..., :-1, :, :]], axis=-3)
    kcat = jnp.concatenate([shift(kb), kb], axis=-2)
    vcat = jnp.concatenate([shift(vb), vb], axis=-2)
    s = jnp.einsum('...nqd,...nkd->...nqk', qb, kcat).astype(jnp.float32) * (dh ** -0.5)
    nidx = jnp.arange(nb)[:, None, None]
    qpos = nidx * blk + jnp.arange(blk)[None, :, None]
    kpos = (nidx - 1) * blk + jnp.arange(2 * blk)[None, None, :]
    dist = qpos - kpos
    mask = (dist >= 0) & (dist <= window) & (kpos >= 0)
    s = jnp.where(mask, s, -jnp.inf)
    lse = jax.nn.logsumexp(s, axis=-1, keepdims=True)
    p = jnp.exp(s - lse)
    out = jnp.einsum('...nqk,...nkd->...nqd', p.astype(vcat.dtype), vcat)
    out = out.reshape(*lead, nb * blk, dh)[..., :L, :]
    lse = lse[..., 0].reshape(*lead, nb * blk)[..., :L]
    return out, lse


def dilated_attention(q, k, v):
    b, s, _, dh = q.shape
    hg = DIL_HEADS_PER_GROUP
    outs, lses = [], []
    for g, (w, r) in enumerate(DIL_PATTERNS):
        sl = slice(g * hg, (g + 1) * hg)
        sub = lambda t: t[:, :, sl].reshape(b, s // r, r, hg, dh).transpose(0, 2, 3, 1, 4)
        o, l = banded_attention(sub(q), sub(k), sub(v), w // r)
        outs.append(o.transpose(0, 3, 1, 2, 4).reshape(b, s, hg, dh))
        lses.append(l.transpose(0, 3, 1, 2).reshape(b, s, hg))
    outs = jnp.stack(outs, axis=0)
    wts = jax.nn.softmax(jnp.stack(lses, axis=0), axis=0)
    return jnp.sum(wts[..., None] * outs.astype(jnp.float32), axis=0)


def memory_cross_attention(h, memn, w_q, w_kv, w_o):
    b, s, d = h.shape
    m = memn.shape[1]
    q = (h @ w_q).reshape(b, s, MEM_HEADS, MEM_HEAD_DIM)
    k, v = jnp.split(memn @ w_kv, 2, axis=-1)
    k = k.reshape(b, m, MEM_HEADS, MEM_HEAD_DIM)
    v = v.reshape(b, m, MEM_HEADS, MEM_HEAD_DIM)
    sc = jnp.einsum('bshd,bmhd->bhsm', q, k).astype(jnp.float32) * (MEM_HEAD_DIM ** -0.5)
    p = jax.nn.softmax(sc, axis=-1)
    o = jnp.einsum('bhsm,bmhd->bshd', p.astype(v.dtype), v).reshape(b, s, d)
    return o @ w_o


def peer_ffn(h, w_q, subkeys, u_tab, v_tab):
    b, s, d = h.shape
    t = b * s
    ht = h.reshape(t, d)
    qh = (ht @ w_q).reshape(t, PEER_HEADS, 2, PEER_QUERY_DIM // 2)
    sc = jnp.einsum('thpd,hpnd->thpn', qh, subkeys).astype(jnp.float32)
    v_top, i_top = lax.top_k(sc, PEER_TOPK)
    combo = (v_top[:, :, 0, :, None] + v_top[:, :, 1, None, :]).reshape(t, PEER_HEADS, PEER_TOPK * PEER_TOPK)
    c_val, c_idx = lax.top_k(combo, PEER_TOPK)
    i1 = jnp.take_along_axis(i_top[:, :, 0, :], c_idx // PEER_TOPK, axis=-1)
    i2 = jnp.take_along_axis(i_top[:, :, 1, :], c_idx % PEER_TOPK, axis=-1)
    e_idx = i1 * PEER_N_KEYS + i2
    gates = jax.nn.softmax(c_val, axis=-1)
    nblk = t // PEER_TOKEN_BLOCK
    kk = PEER_HEADS * PEER_TOPK
    xb = ht.reshape(nblk, PEER_TOKEN_BLOCK, d)
    ib = e_idx.reshape(nblk, PEER_TOKEN_BLOCK, kk)
    gb = gates.reshape(nblk, PEER_TOKEN_BLOCK, kk).astype(h.dtype)

    def expert_block(args):
        x_, i_, g_ = args
        u = u_tab[i_]
        a = jax.nn.gelu(jnp.einsum('td,tkd->tk', x_, u), approximate=False)
        return jnp.einsum('tk,tkd->td', a * g_, v_tab[i_])

    return lax.map(expert_block, (xb, ib, gb)).reshape(b, s, d)


def setup_inputs(seed: int = 0) -> dict:
    key = jax.random.key(seed)
    ks = jax.random.split(key, 20)
    f32 = jnp.float32
    nrm = lambda k, shape, scale: jax.random.normal(k, shape, f32) * scale
    gain = lambda k, shape: 1.0 + 0.02 * jax.random.normal(k, shape, f32)
    x = nrm(ks[0], (BATCH, SEQ, D_MODEL), 1.0)
    mem = nrm(ks[1], (BATCH, MEM_TOKENS, D_MODEL), 1.0)
    offset = jax.random.randint(ks[2], (BATCH, 1), 0, 4096, dtype=jnp.int32)
    positions = offset + jnp.arange(SEQ, dtype=jnp.int32)[None, :]
    return {
        'x': x,
        'mem': mem,
        'positions': positions,
        'g_mix': gain(ks[3], (DEPTH, D_MODEL)),
        'w_in': nrm(ks[4], (DEPTH, D_MODEL, IN_WIDTH), D_MODEL ** -0.5),
        'w_br_ret': nrm(ks[5], (DEPTH, RET_V_W, D_MODEL), RET_V_W ** -0.5),
        'w_br_dil': nrm(ks[6], (DEPTH, DIL_OUT_W, D_MODEL), DIL_OUT_W ** -0.5),
        'w_out': nrm(ks[7], (DEPTH, D_MODEL, D_MODEL), D_MODEL ** -0.5),
        'g_cross': gain(ks[8], (DEPTH, D_MODEL)),
        'g_mem': gain(ks[9], (DEPTH, D_MODEL)),
        'w_q_mem': nrm(ks[10], (DEPTH, D_MODEL, D_MODEL), D_MODEL ** -0.5),
        'w_kv_mem': nrm(ks[11], (DEPTH, D_MODEL, 2 * D_MODEL), D_MODEL ** -0.5),
        'w_o_mem': nrm(ks[12], (DEPTH, D_MODEL, D_MODEL), D_MODEL ** -0.5),
        'g_ffn': gain(ks[13], (DEPTH, D_MODEL)),
        'w_peer_q': nrm(ks[14], (DEPTH, D_MODEL, PEER_HEADS * PEER_QUERY_DIM), D_MODEL ** -0.5),
        'peer_subkeys': nrm(ks[15], (DEPTH, PEER_HEADS, 2, PEER_N_KEYS, PEER_QUERY_DIM // 2), (PEER_QUERY_DIM // 2) ** -0.5),
        'peer_u': nrm(ks[16], (DEPTH, PEER_N_EXPERTS, D_MODEL), D_MODEL ** -0.5),
        'peer_v': nrm(ks[17], (DEPTH, PEER_N_EXPERTS, D_MODEL), PEER_HEADS ** -0.5),
        'g_final': gain(ks[18], (D_MODEL,)),
    }


def reference(x, mem, positions, g_mix, w_in, w_br_ret, w_br_dil, w_out, g_cross, g_mem, w_q_mem, w_kv_mem, w_o_mem, g_ffn, w_peer_q, peer_subkeys, peer_u, peer_v, g_final):
    b, s, d = x.shape
    for l in range(DEPTH):
        h = rms_norm(x, g_mix[l])
        proj = h @ w_in[l]
        rq, rk, rv, rg, dq, dk, dv, gate_ret, gate_dil = jnp.split(proj, IN_SPLIT_POINTS, axis=-1)
        ret = retention(rq.reshape(b, s, RET_HEADS, RET_QK_DIM), rk.reshape(b, s, RET_HEADS, RET_QK_DIM),
                        rv.reshape(b, s, RET_HEADS, RET_V_DIM), positions)
        ret = (ret.reshape(b, s, RET_V_W) * jax.nn.silu(rg.astype(jnp.float32))).astype(x.dtype)
        nh = DIL_N_GROUPS * DIL_HEADS_PER_GROUP
        dq = rotary(dq.reshape(b, s, nh, DIL_HEAD_DIM), positions)
        dk = rotary(dk.reshape(b, s, nh, DIL_HEAD_DIM), positions)
        dv = dv.reshape(b, s, nh, DIL_HEAD_DIM)
        dil = dilated_attention(dq, dk, dv).reshape(b, s, DIL_OUT_W).astype(x.dtype)
        merged = jax.nn.sigmoid(gate_ret) * (ret @ w_br_ret[l]) + jax.nn.sigmoid(gate_dil) * (dil @ w_br_dil[l])
        x = x + merged @ w_out[l]
        hc = rms_norm(x, g_cross[l])
        memn = rms_norm(mem, g_mem[l])
        x = x + memory_cross_attention(hc, memn, w_q_mem[l], w_kv_mem[l], w_o_mem[l])
        hf = rms_norm(x, g_ffn[l])
        x = x + peer_ffn(hf, w_peer_q[l], peer_subkeys[l], peer_u[l], peer_v[l])
    return rms_norm(x, g_final)
```

```cpp
#include <hip/hip_runtime.h>
#include <cstdio>
#include <cstdint>
#include <cmath>

#define LAS __attribute__((address_space(3)))
#define GAS __attribute__((address_space(1)))
#define DI __device__ __forceinline__
typedef unsigned short bf16_t;
typedef short bf16x8 __attribute__((ext_vector_type(8)));
typedef short s16x4 __attribute__((ext_vector_type(4)));
typedef short v4i16_t __attribute__((ext_vector_type(4)));
typedef float f32x2 __attribute__((ext_vector_type(2)));
typedef float f32x4 __attribute__((ext_vector_type(4)));
typedef float f32x16 __attribute__((ext_vector_type(16)));
typedef unsigned u32x2 __attribute__((ext_vector_type(2)));
typedef unsigned u32x4 __attribute__((ext_vector_type(4)));
typedef __bf16 bf16x2_t __attribute__((ext_vector_type(2)));

constexpr int NB = 8, SEQ = 2048, DM = 2048, MT = NB * SEQ;
constexpr int MEMT = 256, MROWS = NB * MEMT;
constexpr int INW = 12800;
constexpr float EPS = 1e-6f;
constexpr int NWAVES = 8, NTHREADS = 512;

constexpr size_t MiB = 1u << 20;
constexpr size_t WS_CTL = 0, CTL_ZERO_BYTES = 1 * MiB;
constexpr size_t WS_SSQ1 = 2 * MiB, WS_SSQ2 = 4 * MiB, WS_LSE = 6 * MiB, WS_EIDX = 8 * MiB, WS_GATE = 16 * MiB;
constexpr size_t WS_WIN_T = 24 * MiB, WS_WKV_T = 74 * MiB, WS_WBR_T = 90 * MiB, WS_WBD_T = 94 * MiB, WS_WOUT_T = 96 * MiB, WS_WQ_T = 104 * MiB, WS_WO_T = 112 * MiB, WS_WPQ_T = 120 * MiB;
constexpr size_t WS_SUBK = 128 * MiB, WS_KM = 130 * MiB, WS_VT = 138 * MiB;
constexpr size_t WS_RQ = 148 * MiB, WS_RK = 180 * MiB, WS_RV = 212 * MiB, WS_SG = 244 * MiB, WS_DQ = 276 * MiB, WS_DK = 324 * MiB, WS_DV = 372 * MiB, WS_GR = 420 * MiB, WS_GD = 484 * MiB;
constexpr size_t WS_END = 548 * MiB;
constexpr size_t WS_KVST = 24 * MiB;
constexpr size_t WS_XB = 24 * MiB;
constexpr size_t WS_QM = 180 * MiB;
constexpr size_t WS_PQ = 180 * MiB;
constexpr size_t WS_P = 244 * MiB;
constexpr size_t WS_O = 324 * MiB;
constexpr size_t WS_UTAB = 276 * MiB;
constexpr size_t WS_VTAB = 404 * MiB;
constexpr size_t DO_H1 = 0, DO_MEMN = 64 * MiB, DO_CSRET = 72 * MiB, DO_CSROT = 80 * MiB;

DI unsigned f2bf(float f) { unsigned u = __builtin_bit_cast(unsigned, f); return (u + 0x7fffu + ((u >> 16) & 1u)) >> 16; }
DI unsigned pk2(float lo, float hi) { f32x2 v = {lo, hi}; bf16x2_t b = __builtin_convertvector(v, bf16x2_t); return __builtin_bit_cast(unsigned, b); }
DI float bf_lo(unsigned w) { return __builtin_bit_cast(float, w << 16); }
DI float bf_hi(unsigned w) { return __builtin_bit_cast(float, w & 0xffff0000u); }
DI float wave_sum(float v) {
#pragma unroll
    for (int o = 1; o < 64; o <<= 1) v += __shfl_xor(v, o);
    return v;
}
#define LDS_WAIT() asm volatile("s_waitcnt lgkmcnt(0)" ::: "memory")
#define VM_WAIT() asm volatile("s_waitcnt vmcnt(0)" ::: "memory")
DI float fast_exp2(float x) { return __builtin_amdgcn_exp2f(x); }
DI float fast_rcp(float x) { return __builtin_amdgcn_rcpf(x); }
DI float sigmoid_f(float x) { return fast_rcp(1.f + fast_exp2(-1.4426950408889634f * x)); }

namespace pg8 {
constexpr int BM = 256, BK = 64, HALF = 128, HTB = HALF * BK * 2, STAGE_BYTES = 8 * HTB, NXCD = 8, WGM = 8;
__host__ __device__ __forceinline__ int lds_byte(int r, int c) { const int st = (r >> 4) * 2 + (c >> 5), rr = r & 15, cc = c & 31, ob = rr * 64 + cc * 2; return st * 1024 + (ob ^ (((ob >> 9) & 1) << 5)); }
__host__ __device__ __forceinline__ void stage_rc(int b, int& R, int& C) { const int st = b / 1024, sb = b % 1024, swz = sb ^ (((sb >> 9) & 1) << 5); R = (st >> 1) * 16 + swz / 64; C = (st & 1) * 32 + (swz % 64) / 2; }
__host__ __device__ __forceinline__ int perm32(int rho) { const int n = rho >> 4, i = rho & 15; return 8 * (i >> 2) + 4 * n + (i & 3); }

__device__ __forceinline__ void tile_of(int L, int nM, int nN, int& pm, int& pn) {
    const int nwg = nM * nN; int wgid = L;
    { const int q = nwg / NXCD, r = nwg % NXCD, xcd = wgid % NXCD, off = wgid / NXCD; wgid = (xcd < r ? xcd * (q + 1) : r * (q + 1) + (xcd - r) * q) + off; }
    const int nig = WGM * nN, gid = wgid / nig, fm = gid * WGM, gsz = (nM - fm) < WGM ? (nM - fm) : WGM;
    pm = fm + ((wgid % nig) % gsz); pn = (wgid % nig) / gsz;
}

template <class Epi, class Sched, bool ALIGN_EPI>
__device__ __forceinline__ void gemm_phase(LAS unsigned char* lds, const int K, const int lda, const int ldb, const Sched& S, const Epi& E) {
    typedef typename Sched::Unit Unit;
    const int tid = threadIdx.x, wid = __builtin_amdgcn_readfirstlane(tid >> 6), lane = tid & 63, wr = wid >> 2, wc = wid & 3, fr = lane & 15, fq = lane >> 4;
    const int nt = K / BK;
    unsigned voffA[2], voffB[2];
#pragma unroll
    for (int i = 0; i < 2; ++i) { int R, C; stage_rc(tid * 16 + i * 8192, R, C); const int Rb = (R & ~31) + perm32(R & 31);
        voffA[i] = (unsigned)(R * lda + C) * 2u; voffB[i] = (unsigned)(Rb * ldb + C) * 2u; }
    const size_t kstep = (size_t)(BK * 2);
    const size_t hstepA = (size_t)HALF * lda * 2, hstepB = (size_t)HALF * ldb * 2;
    const unsigned ldsw = (unsigned)wid * 1024u;
    const int aoff = lds_byte(wr * 64 + fr, fq * 8), boff = lds_byte(wc * 32 + fr, fq * 8);
#define PG8_SA(b, h) (((b) * 2 + (h)) * HTB)
#define PG8_SB(b, h) ((4 + (b) * 2 + (h)) * HTB)
#define PG8_STAGE(bufoff, gbase, voff) do { _Pragma("unroll") for (int _i = 0; _i < 2; ++_i) \
        __builtin_amdgcn_global_load_lds((const unsigned*)((const char*)(gbase) + (voff)[_i]), (LAS unsigned*)(lds + (bufoff) + ldsw + _i * 8192), 16, 0, 0); } while (0)
#define PG8_LDA(dst, b, h) do { _Pragma("unroll") for (int m = 0; m < 4; ++m) _Pragma("unroll") for (int k = 0; k < 2; ++k) dst[m][k] = *(const LAS bf16x8*)(lds + PG8_SA(b, h) + aoff + m * 2048 + k * 1024); } while (0)
#define PG8_LDB(dst, b, h) do { _Pragma("unroll") for (int n = 0; n < 2; ++n) _Pragma("unroll") for (int k = 0; k < 2; ++k) dst[n][k] = *(const LAS bf16x8*)(lds + PG8_SB(b, h) + boff + n * 2048 + k * 1024); } while (0)
#define PG8_MMA(ai, bj, At, Bt) do { __builtin_amdgcn_s_setprio(1); _Pragma("unroll") for (int m = 0; m < 4; ++m) _Pragma("unroll") for (int n = 0; n < 2; ++n) _Pragma("unroll") for (int k = 0; k < 2; ++k) \
        acc[ai][bj][m][n] = __builtin_amdgcn_mfma_f32_16x16x32_bf16(Bt[n][k], At[m][k], acc[ai][bj][m][n], 0, 0, 0); __builtin_amdgcn_s_setprio(0); } while (0)
#define PG8_WAIT_V(n) asm volatile("s_waitcnt vmcnt(" #n ")" ::: "memory")
#define PG8_WAIT_L(n) asm volatile("s_waitcnt lgkmcnt(" #n ")" ::: "memory")
#define PG8_BAR __builtin_amdgcn_s_barrier()
#define PG8_SCHED __builtin_amdgcn_sched_barrier(0)
    Unit cur, nxt; int ui = 0;
    if (!S.next(0, cur)) return;
    f32x4 acc[2][2][4][2];
#pragma unroll
    for (int a = 0; a < 2; ++a)
#pragma unroll
        for (int b = 0; b < 2; ++b)
#pragma unroll
            for (int m = 0; m < 4; ++m)
#pragma unroll
                for (int n = 0; n < 2; ++n) acc[a][b][m][n] = (f32x4){0.f, 0.f, 0.f, 0.f};
    bf16x8 At[4][2], B0[2][2], B1[2][2];
    const char* cA = cur.A; const char* cB = cur.B;
    PG8_STAGE(PG8_SB(0, 0), cB, voffB); PG8_STAGE(PG8_SB(0, 1), cB + hstepB, voffB); PG8_STAGE(PG8_SA(0, 0), cA, voffA); PG8_STAGE(PG8_SA(0, 1), cA + hstepA, voffA);
    if (wr == 1) PG8_BAR;
    PG8_WAIT_V(2); PG8_BAR;
    PG8_STAGE(PG8_SB(1, 0), cB + kstep, voffB); PG8_STAGE(PG8_SA(1, 0), cA + kstep, voffA); PG8_STAGE(PG8_SB(1, 1), cB + hstepB + kstep, voffB);
    PG8_WAIT_V(6); PG8_BAR;
    for (;;) {
        const bool has_next = S.next(ui + 1, nxt);
        const char* nA = has_next ? nxt.A : cA; const char* nB = has_next ? nxt.B : cB;
        for (int t = 0; t < nt; t += 2) {
            const bool last = (t == nt - 2);
            const char* a1 = cA + (size_t)(t + 1) * kstep;
            const char* a2 = last ? nA : cA + (size_t)(t + 2) * kstep; const char* b2 = last ? nB : cB + (size_t)(t + 2) * kstep;
            const char* a3 = a2 + kstep; const char* b3 = b2 + kstep;
            PG8_LDB(B0, 0, 0); PG8_LDB(B1, 0, 1); PG8_SCHED; PG8_LDA(At, 0, 0); PG8_STAGE(PG8_SA(1, 1), a1 + hstepA, voffA);
            PG8_WAIT_V(8); PG8_WAIT_L(0); PG8_BAR; PG8_MMA(0, 0, At, B0); PG8_MMA(0, 1, At, B1); PG8_BAR; PG8_SCHED;
            PG8_LDA(At, 0, 1); PG8_STAGE(PG8_SB(0, 0), b2, voffB); PG8_STAGE(PG8_SB(0, 1), b2 + hstepB, voffB); PG8_STAGE(PG8_SA(0, 0), a2, voffA);
            PG8_WAIT_V(8); PG8_WAIT_L(0); PG8_BAR; PG8_MMA(1, 0, At, B0); PG8_MMA(1, 1, At, B1); PG8_BAR; PG8_SCHED;
            PG8_LDB(B0, 1, 0); PG8_LDB(B1, 1, 1); PG8_SCHED; PG8_LDA(At, 1, 0); PG8_STAGE(PG8_SA(0, 1), a2 + hstepA, voffA);
            PG8_WAIT_V(8); PG8_WAIT_L(0); PG8_BAR; PG8_MMA(0, 0, At, B0); PG8_MMA(0, 1, At, B1); PG8_BAR; PG8_SCHED;
            PG8_LDA(At, 1, 1); PG8_STAGE(PG8_SB(1, 0), b3, voffB); PG8_STAGE(PG8_SB(1, 1), b3 + hstepB, voffB); PG8_STAGE(PG8_SA(1, 0), a3, voffA);
            PG8_WAIT_V(8); PG8_WAIT_L(0); PG8_BAR; PG8_MMA(1, 0, At, B0); PG8_MMA(1, 1, At, B1); PG8_BAR; PG8_SCHED;
        }
        if constexpr (ALIGN_EPI) { if (wr == 0) PG8_BAR; }
        E(acc, cur, wr, wc, fr, fq, wid, lane);
        if (!has_next) break;
#pragma unroll
        for (int a = 0; a < 2; ++a)
#pragma unroll
            for (int b = 0; b < 2; ++b)
#pragma unroll
                for (int m = 0; m < 4; ++m)
#pragma unroll
                    for (int n = 0; n < 2; ++n) acc[a][b][m][n] = (f32x4){0.f, 0.f, 0.f, 0.f};
        cur = nxt; cA = nA; cB = nB; ++ui;
        if constexpr (ALIGN_EPI) { if (wr == 1) PG8_BAR; }
    }
    PG8_WAIT_V(0);
    if constexpr (!ALIGN_EPI) { if (wr == 0) PG8_BAR; }
    PG8_BAR;
#undef PG8_SA
#undef PG8_SB
#undef PG8_STAGE
#undef PG8_LDA
#undef PG8_LDB
#undef PG8_MMA
#undef PG8_WAIT_V
#undef PG8_WAIT_L
#undef PG8_BAR
#undef PG8_SCHED
}
}

constexpr int RING_BYTES = 131072;
constexpr int LDSX_OFF = RING_BYTES;
constexpr int LDSCTL_OFF = RING_BYTES + 16384;
constexpr int LDS_BYTES = 163840;

typedef GAS unsigned gu32;
#define RLX_AGENT __ATOMIC_RELAXED, __HIP_MEMORY_SCOPE_AGENT

#define XB_TMO      128
#define XB_XCNT(j)  (256  + 64 * (j))
#define XB_XSUB(j)  (1280 + 64 * (j))
#define XB_XGEN(j)  (2304 + 64 * (j))
#define XB_TOP      3328
#define XB_TOPGEN   3392
#define XCD_BAR_WORDS 3456
#define XB_SPIN_CAP (1u << 20)
DI unsigned xb_ld(unsigned* p)              { return __hip_atomic_load(p, __ATOMIC_RELAXED, __HIP_MEMORY_SCOPE_AGENT); }
DI unsigned xb_add(unsigned* p, unsigned v) { return __hip_atomic_fetch_add(p, v, __ATOMIC_RELAXED, __HIP_MEMORY_SCOPE_AGENT); }
DI unsigned xb_xcc_id() { return (unsigned)__builtin_amdgcn_s_getreg((3 << 11) | 20) & 0xFu; }
#define XB_SPIN(cond, bar) do { unsigned _sp = 0; while (cond) { __builtin_amdgcn_s_sleep(1); \
    if ((++_sp & 255u) == 0u) { if (xb_ld(&(bar)[XB_TMO])) break; if (_sp > XB_SPIN_CAP) { atomicAdd(&(bar)[XB_TMO], 1u); break; } } } } while (0)
struct XcdBarrier { unsigned* bar; unsigned x; volatile LAS unsigned* st; };
DI XcdBarrier xcd_barrier_post(unsigned* bar, volatile LAS unsigned* st) {
    XcdBarrier b; b.bar = bar; b.x = xb_xcc_id(); b.st = st;
    if (threadIdx.x == 0) (void)xb_add(&bar[XB_XCNT(b.x)], 1u);
    return b;
}
DI void xcd_barrier_complete(unsigned* bar, unsigned x, unsigned& nloc, unsigned& nx) {
    const unsigned G = gridDim.x * gridDim.y * gridDim.z;
    unsigned sum, cnt, mine, sp = 0u;
    for (;;) {
        sum = 0u; cnt = 0u; mine = 0u;
#pragma unroll
        for (unsigned j = 0; j < 16; ++j) { const unsigned c = xb_ld(&bar[XB_XCNT(j)]); sum += c; cnt += (c > 0u) ? 1u : 0u; mine = (j == x) ? c : mine; }
        if (sum == G) break;
        __builtin_amdgcn_s_sleep(1);
        if ((++sp & 255u) == 0u) { if (xb_ld(&bar[XB_TMO])) break; if (sp > XB_SPIN_CAP) { atomicAdd(&bar[XB_TMO], 1u); break; } }
    }
    nloc = mine > 0u ? mine : 1u; nx = cnt > 0u ? cnt : 1u;
}
DI void xcd_barrier(const XcdBarrier& b) {
    asm volatile("s_waitcnt vmcnt(0)" ::: "memory");
    __syncthreads();
    if (threadIdx.x == 0) {
        unsigned* bar = b.bar;
        __builtin_amdgcn_s_waitcnt(0);
        unsigned nloc = b.st[0], nx = b.st[1];
        if (nloc == 0u) { xcd_barrier_complete(bar, b.x, nloc, nx); b.st[0] = nloc; b.st[1] = nx; }
        const unsigned old = xb_add(&bar[XB_XSUB(b.x)], 1u);
        const unsigned gen = old / nloc;
        if (old + 1u == (gen + 1u) * nloc) {
            __builtin_amdgcn_fence(__ATOMIC_RELEASE, "agent");
            asm volatile("s_waitcnt vmcnt(0)" ::: "memory");
            const unsigned og = xb_add(&bar[XB_TOP], 1u);
            const unsigned tg = og / nx;
            if (og + 1u == (tg + 1u) * nx) xb_add(&bar[XB_TOPGEN], 1u);
            else XB_SPIN(xb_ld(&bar[XB_TOPGEN]) == tg, bar);
            __builtin_amdgcn_fence(__ATOMIC_ACQUIRE, "agent");
            xb_add(&bar[XB_XGEN(b.x)], 1u);
            asm volatile("s_waitcnt vmcnt(0)" ::: "memory");
        } else {
            XB_SPIN(xb_ld(&bar[XB_XGEN(b.x)]) == gen, bar);
            __builtin_amdgcn_fence(__ATOMIC_ACQUIRE, "agent");
            asm volatile("s_waitcnt vmcnt(0)" ::: "memory");
        }
    }
    __syncthreads();
}

struct Args {
    const void* in[19]; float* out; unsigned char* ws; int ph_lo, ph_hi;
    double fret[64]; double frot[64];
};
struct Frame {
    LAS unsigned char* lds;
    int tid, lane, wave, G, bid;
    unsigned char* ws; unsigned char* dout;
};
enum { I_X = 0, I_MEM, I_POS, I_GMIX, I_WIN, I_WBR, I_WBD, I_WOUT, I_GCROSS, I_GMEM, I_WQ, I_WKV, I_WO, I_GFFN, I_WPQ, I_SUBK, I_PU, I_PV, I_GFINAL };

DI void tr_item(const float* W, int K, int N, bf16_t* WT, const float* scale, int rot_lo, int rot_hi, LAS float* scr, int item, int lane) {
    const int nblk = N / 32, kb = item / nblk, nb = item % nblk, k0 = 64 * kb, n0 = 32 * nb;
    const int nd = n0 + (lane & 31); int ns = nd;
    if (nd >= rot_lo && nd < rot_hi) { const int jj = nd & 127; ns = (nd - jj) + ((jj & 1) ? 64 : 0) + (jj >> 1); }
#pragma unroll 8
    for (int i = 0; i < 32; ++i) { const int kk = 2 * i + (lane >> 5); float w = W[(size_t)(k0 + kk) * N + ns]; if (scale) w *= scale[k0 + kk]; scr[kk * 33 + (lane & 31)] = w; }
    LDS_WAIT();
    const int c = lane & 7;
#pragma unroll
    for (int j = 0; j < 4; ++j) { const int n = (lane >> 3) + 8 * j; const LAS float* s = scr + (8 * c) * 33 + n;
        u32x4 o; o.x = pk2(s[0 * 33], s[1 * 33]); o.y = pk2(s[2 * 33], s[3 * 33]); o.z = pk2(s[4 * 33], s[5 * 33]); o.w = pk2(s[6 * 33], s[7 * 33]);
        *(GAS u32x4*)(WT + (size_t)(n0 + n) * K + k0 + 8 * c) = o; }
    LDS_WAIT();
}
DI void rms_row_bf16(const float* xrow, const float* g, bf16_t* orow, int lane) {
    const GAS f32x4* xr = (const GAS f32x4*)xrow + lane; const GAS f32x4* gr = (const GAS f32x4*)g + lane;
    f32x4 v[8]; float s = 0.f;
#pragma unroll
    for (int j = 0; j < 8; ++j) { v[j] = xr[64 * j]; s += (v[j].x * v[j].x + v[j].y * v[j].y) + (v[j].z * v[j].z + v[j].w * v[j].w); }
    const float rstd = 1.0f / sqrtf(wave_sum(s) * (1.f / DM) + EPS);
    GAS u32x2* o8 = (GAS u32x2*)orow + lane;
#pragma unroll
    for (int j = 0; j < 8; ++j) { const f32x4 gg = gr[64 * j]; u32x2 o; o.x = pk2(v[j].x * rstd * gg.x, v[j].y * rstd * gg.y); o.y = pk2(v[j].z * rstd * gg.z, v[j].w * rstd * gg.w); o8[64 * j] = o; }
}
DI void sincos_d(double a, float& c, float& s) {
    const double x = a * 0.63661977236758134308; const double q = __builtin_rint(x);
    double r = __builtin_fma(-q, 1.57079632679489655800, a); r = __builtin_fma(-q, 6.12323399573676603587e-17, r);
    const int qi = ((int)q) & 3; const double r2 = r * r;
    double sn = 1.0 / 6227020800.0; sn = sn * r2 - 1.0 / 39916800.0; sn = sn * r2 + 1.0 / 362880.0; sn = sn * r2 - 1.0 / 5040.0; sn = sn * r2 + 1.0 / 120.0; sn = sn * r2 - 1.0 / 6.0; sn = sn * r2 + 1.0; sn *= r;
    double cs = -1.0 / 87178291200.0; cs = cs * r2 + 1.0 / 479001600.0; cs = cs * r2 - 1.0 / 3628800.0; cs = cs * r2 + 1.0 / 40320.0; cs = cs * r2 - 1.0 / 720.0; cs = cs * r2 + 1.0 / 24.0; cs = cs * r2 - 0.5; cs = cs * r2 + 1.0;
    const double so = (qi == 0) ? sn : (qi == 1) ? cs : (qi == 2) ? -sn : -cs;
    const double co = (qi == 0) ? cs : (qi == 1) ? -sn : (qi == 2) ? -cs : sn;
    c = (float)co; s = (float)so;
}
DI void ph0_prologue(const Frame& F, const Args& a) {
    LAS float* scr = (LAS float*)(F.lds + F.wave * 8448);
    const int gw = F.bid * NWAVES + F.wave, NGW = F.G * NWAVES;
    unsigned char* ws = F.ws;
    constexpr int I_IN = (DM / 64) * (INW / 32), I_KV = (DM / 64) * (4096 / 32), I_BR = (1024 / 64) * (DM / 32), I_BD = (512 / 64) * (DM / 32), I_SQ = (DM / 64) * (DM / 32);
    constexpr int NITEMS = I_IN + I_KV + I_BR + I_BD + 4 * I_SQ;
    for (int it = gw; it < NITEMS; it += NGW) {
        int r = it;
        if (r < I_IN) { tr_item((const float*)a.in[I_WIN], DM, INW, (bf16_t*)(ws + WS_WIN_T), nullptr, 4096, 7168, scr, r, F.lane); continue; } r -= I_IN;
        if (r < I_KV) { tr_item((const float*)a.in[I_WKV], DM, 4096, (bf16_t*)(ws + WS_WKV_T), nullptr, 0, 0, scr, r, F.lane); continue; } r -= I_KV;
        if (r < I_BR) { tr_item((const float*)a.in[I_WBR], 1024, DM, (bf16_t*)(ws + WS_WBR_T), nullptr, 0, 0, scr, r, F.lane); continue; } r -= I_BR;
        if (r < I_BD) { tr_item((const float*)a.in[I_WBD], 512, DM, (bf16_t*)(ws + WS_WBD_T), nullptr, 0, 0, scr, r, F.lane); continue; } r -= I_BD;
        if (r < I_SQ) { tr_item((const float*)a.in[I_WOUT], DM, DM, (bf16_t*)(ws + WS_WOUT_T), nullptr, 0, 0, scr, r, F.lane); continue; } r -= I_SQ;
        if (r < I_SQ) { tr_item((const float*)a.in[I_WQ], DM, DM, (bf16_t*)(ws + WS_WQ_T), (const float*)a.in[I_GCROSS], 0, 0, scr, r, F.lane); continue; } r -= I_SQ;
        if (r < I_SQ) { tr_item((const float*)a.in[I_WO], DM, DM, (bf16_t*)(ws + WS_WO_T), nullptr, 0, 0, scr, r, F.lane); continue; } r -= I_SQ;
        tr_item((const float*)a.in[I_WPQ], DM, DM, (bf16_t*)(ws + WS_WPQ_T), (const float*)a.in[I_GFFN], 0, 0, scr, r, F.lane);
    }
    for (int m = gw; m < MT; m += NGW) rms_row_bf16((const float*)a.in[I_X] + (size_t)m * DM, (const float*)a.in[I_GMIX], (bf16_t*)(F.dout + DO_H1) + (size_t)m * DM, F.lane);
    for (int m = gw; m < MROWS; m += NGW) rms_row_bf16((const float*)a.in[I_MEM] + (size_t)m * DM, (const float*)a.in[I_GMEM], (bf16_t*)(F.dout + DO_MEMN) + (size_t)m * DM, F.lane);
    const int gt = F.bid * NTHREADS + F.tid, NGT = F.G * NTHREADS;
    for (int i = gt; i < 16 * 128 * 128 / 8; i += NGT) {
        const GAS f32x4* s = (const GAS f32x4*)a.in[I_SUBK] + 2 * (size_t)i; const f32x4 v0 = s[0], v1 = s[1];
        u32x4 o; o.x = pk2(v0.x, v0.y); o.y = pk2(v0.z, v0.w); o.z = pk2(v1.x, v1.y); o.w = pk2(v1.z, v1.w);
        ((GAS u32x4*)(ws + WS_SUBK))[i] = o;
    }
    for (int i = gt; i < MT * 64; i += NGT) {
        const int t = i >> 6, k = i & 63; const double pos = (double)((const int*)a.in[I_POS])[t];
        float c, s; sincos_d(pos * a.fret[k], c, s); ((GAS f32x2*)(F.dout + DO_CSRET))[i] = (f32x2){c, s};
        sincos_d(pos * a.frot[k], c, s); ((GAS f32x2*)(F.dout + DO_CSROT))[i] = (f32x2){c, s};
    }
}

struct Unit1 { const char* A; const char* B; int pm, pn; int mode; bf16_t* out; int ldo; float scale; const float* cs; };
struct Sched1 {
    typedef Unit1 Unit;
    int G, c; unsigned char* ws; unsigned char* dout;
    DI bool next(int i, Unit& u) const {
        const int L = i * G + c; if (L >= 3328) return false;
        if (L < 3200) {
            int pm, pn; pg8::tile_of(L, 64, 50, pm, pn); u.pm = pm; u.pn = pn;
            u.A = (const char*)(dout + DO_H1) + (size_t)pm * 256 * DM * 2; u.B = (const char*)(ws + WS_WIN_T) + (size_t)pn * 256 * DM * 2;
            u.scale = 1.f; u.cs = nullptr; u.mode = 0;
            const size_t rowoff = (size_t)pm * 256;
            if (pn < 4)       { u.mode = 1; u.out = (bf16_t*)(ws + WS_RQ) + rowoff * 1024 + (pn - 0) * 256; u.ldo = 1024; u.cs = (const float*)(dout + DO_CSRET); }
            else if (pn < 8)  { u.mode = 1; u.out = (bf16_t*)(ws + WS_RK) + rowoff * 1024 + (pn - 4) * 256; u.ldo = 1024; u.cs = (const float*)(dout + DO_CSRET); u.scale = 0.08838834764831845f; }
            else if (pn < 12) { u.out = (bf16_t*)(ws + WS_RV) + rowoff * 1024 + (pn - 8) * 256; u.ldo = 1024; }
            else if (pn < 16) { u.mode = 2; u.out = (bf16_t*)(ws + WS_SG) + rowoff * 1024 + (pn - 12) * 256; u.ldo = 1024; }
            else if (pn < 22) { u.mode = 1; u.out = (bf16_t*)(ws + WS_DQ) + rowoff * 1536 + (pn - 16) * 256; u.ldo = 1536; u.cs = (const float*)(dout + DO_CSROT); u.scale = 0.08838834764831845f * 1.4426950408889634f; }
            else if (pn < 28) { u.mode = 1; u.out = (bf16_t*)(ws + WS_DK) + rowoff * 1536 + (pn - 22) * 256; u.ldo = 1536; u.cs = (const float*)(dout + DO_CSROT); }
            else if (pn < 34) { u.out = (bf16_t*)(ws + WS_DV) + rowoff * 1536 + (pn - 28) * 256; u.ldo = 1536; }
            else if (pn < 42) { u.mode = 3; u.out = (bf16_t*)(ws + WS_GR) + rowoff * 2048 + (pn - 34) * 256; u.ldo = 2048; }
            else              { u.mode = 3; u.out = (bf16_t*)(ws + WS_GD) + rowoff * 2048 + (pn - 42) * 256; u.ldo = 2048; }
        } else {
            const int l = L - 3200; u.mode = 0; u.scale = 1.f; u.cs = nullptr; u.ldo = 2048;
            if (l < 64) { const int pm = l >> 3, pn = l & 7; u.pm = pm; u.pn = pn;
                u.A = (const char*)(dout + DO_MEMN) + (size_t)pm * 256 * DM * 2; u.B = (const char*)(ws + WS_WKV_T) + (size_t)pn * 256 * DM * 2;
                u.out = (bf16_t*)(ws + WS_KM) + (size_t)pm * 256 * 2048 + pn * 256; }
            else { const int l2 = l - 64, pm = l2 >> 3, pn = l2 & 7; u.pm = pm; u.pn = pn;
                u.A = (const char*)(ws + WS_WKV_T) + (size_t)(2048 + pm * 256) * DM * 2; u.B = (const char*)(dout + DO_MEMN) + (size_t)pn * 256 * DM * 2;
                u.out = (bf16_t*)(ws + WS_VT) + (size_t)pm * 256 * 2048 + pn * 256; }
        }
        return true;
    }
};
struct EpiProj {
    template <int MODE> DI void emit(const f32x4 (&acc)[2][2][4][2], const Unit1& u, int wr, int wc, int fr, int fq) const {
        const int rowl0 = wr * 64 + fr, colb = wc * 32 + 8 * fq;
#pragma unroll
        for (int ai = 0; ai < 2; ++ai)
#pragma unroll
            for (int m = 0; m < 4; ++m) {
                const int rl = ai * 128 + m * 16 + rowl0;
                f32x4 cs0 = {1.f, 0.f, 1.f, 0.f}, cs1 = cs0;
                if (MODE == 1) { const GAS f32x4* cp = (const GAS f32x4*)(u.cs + ((size_t)(u.pm * 256 + rl) * 64 + (colb >> 1)) * 2); cs0 = cp[0]; cs1 = cp[1]; }
                bf16_t* rowp = u.out + (size_t)rl * u.ldo + colb;
#pragma unroll
                for (int bj = 0; bj < 2; ++bj) {
                    f32x4 v0 = acc[ai][bj][m][0], v1 = acc[ai][bj][m][1];
                    if (MODE == 1) {
                        const f32x4 a0 = v0, a1 = v1; const float sc = u.scale;
                        v0.x = (a0.x * cs0.x - a0.y * cs0.y) * sc; v0.y = (a0.y * cs0.x + a0.x * cs0.y) * sc;
                        v0.z = (a0.z * cs0.z - a0.w * cs0.w) * sc; v0.w = (a0.w * cs0.z + a0.z * cs0.w) * sc;
                        v1.x = (a1.x * cs1.x - a1.y * cs1.y) * sc; v1.y = (a1.y * cs1.x + a1.x * cs1.y) * sc;
                        v1.z = (a1.z * cs1.z - a1.w * cs1.w) * sc; v1.w = (a1.w * cs1.z + a1.z * cs1.w) * sc;
                    } else if (MODE == 2) {
#pragma unroll
                        for (int e = 0; e < 4; ++e) { v0[e] = v0[e] * sigmoid_f(v0[e]); v1[e] = v1[e] * sigmoid_f(v1[e]); }
                    } else if (MODE == 3) {
#pragma unroll
                        for (int e = 0; e < 4; ++e) { v0[e] = sigmoid_f(v0[e]); v1[e] = sigmoid_f(v1[e]); }
                    }
                    u32x4 w; w.x = pk2(v0.x, v0.y); w.y = pk2(v0.z, v0.w); w.z = pk2(v1.x, v1.y); w.w = pk2(v1.z, v1.w);
                    *(GAS u32x4*)(rowp + bj * 128) = w;
                }
            }
    }
    DI void operator()(const f32x4 (&acc)[2][2][4][2], const Unit1& u, int wr, int wc, int fr, int fq, int wid, int lane) const {
        if (u.mode == 0) emit<0>(acc, u, wr, wc, fr, fq);
        else if (u.mode == 1) emit<1>(acc, u, wr, wc, fr, fq);
        else if (u.mode == 2) emit<2>(acc, u, wr, wc, fr, fq);
        else emit<3>(acc, u, wr, wc, fr, fq);
    }
};

#define MFMA32(a, b, c) __builtin_amdgcn_mfma_f32_32x32x16_bf16((a), (b), (c), 0, 0, 0)
DI int crow(int reg, int h) { return (reg & 3) + 8 * (reg >> 2) + 4 * h; }
DI s16x4 tr4(LAS const unsigned char* p) { return __builtin_bit_cast(s16x4, __builtin_amdgcn_ds_read_tr16_b64_v4i16((LAS v4i16_t*)p)); }
DI bf16x8 frag_tr(LAS const unsigned char* base, int pitch, int k0, int c0, int lane) {
    const int h = lane >> 5, blk = (lane >> 4) & 1, q = (lane & 15) >> 2, p = lane & 3;
    LAS const unsigned char* a = base + (k0 + 8 * h + q) * pitch + (c0 + 16 * blk + 4 * p) * 2;
    const s16x4 lo = tr4(a), hi = tr4(a + 4 * pitch);
    return __builtin_shufflevector(lo, hi, 0, 1, 2, 3, 4, 5, 6, 7);
}
DI bf16x8 frag_nt(LAS const unsigned char* base, int pitch, int r0, int k0, int lane) {
    return *(LAS const bf16x8*)(base + (r0 + (lane & 31)) * pitch + (k0 + 8 * (lane >> 5)) * 2);
}
DI f32x16 zero16() { f32x16 z;
#pragma unroll
    for (int i = 0; i < 16; ++i) z[i] = 0.f; return z; }
DI u32x4 scale_bf16x8(u32x4 v, float s) {
    u32x4 o; o.x = pk2(bf_lo(v.x) * s, bf_hi(v.x) * s); o.y = pk2(bf_lo(v.y) * s, bf_hi(v.y) * s); o.z = pk2(bf_lo(v.z) * s, bf_hi(v.z) * s); o.w = pk2(bf_lo(v.w) * s, bf_hi(v.w) * s); return o;
}
DI float ret_lg2gamma(int h) { return __builtin_log2f(1.0f - __builtin_exp2f(-5.0f - (float)h)); }

DI void ret_kv_item(const Frame& F, int bh, int n) {
    const int b = bh >> 3, h = bh & 7; const float lg = ret_lg2gamma(h);
    LAS unsigned char* VL = F.lds; LAS unsigned char* KL = F.lds + 128 * 320;
    const bf16_t* RK = (const bf16_t*)(F.ws + WS_RK); const bf16_t* RV = (const bf16_t*)(F.ws + WS_RV);
#pragma unroll
    for (int it = 0; it < 8; ++it) {
        const int idx = F.tid + NTHREADS * it, which = idx >> 11, rem = idx & 2047, row = rem >> 4, ch = rem & 15;
        const size_t tok = (size_t)b * SEQ + n * 128 + row;
        u32x4 v = *(const GAS u32x4*)((which ? RK : RV) + tok * 1024 + h * 128 + ch * 8);
        if (which) v = scale_bf16x8(v, fast_exp2(lg * (float)(127 - row)));
        *(LAS u32x4*)((which ? KL : VL) + row * 320 + ch * 16) = v;
    }
    __syncthreads();
    const int w = F.wave, lane = F.lane, eb = w >> 1, db0 = 2 * (w & 1);
    f32x16 acc0 = zero16(), acc1 = zero16();
#pragma unroll
    for (int s = 0; s < 8; ++s) {
        const bf16x8 a = frag_tr(VL, 320, 16 * s, 32 * eb, lane);
        const bf16x8 b0 = frag_tr(KL, 320, 16 * s, 32 * db0, lane), b1 = frag_tr(KL, 320, 16 * s, 32 * (db0 + 1), lane);
        acc0 = MFMA32(a, b0, acc0); acc1 = MFMA32(a, b1, acc1);
    }
    float* dst = (float*)(F.ws + WS_KVST) + ((size_t)(bh * 16 + n) * 128) * 128;
    const int r = lane & 31, hh = lane >> 5;
#pragma unroll
    for (int reg = 0; reg < 16; ++reg) { const int e = 32 * eb + crow(reg, hh);
        dst[(size_t)e * 128 + 32 * db0 + r] = acc0[reg]; dst[(size_t)e * 128 + 32 * (db0 + 1) + r] = acc1[reg]; }
    __syncthreads();
}

DI void dil_item(const Frame& F, int b, int head, int idx16) {
    const int g = head >> 2, r = (g == 0) ? 1 : (g == 1) ? 4 : 16, nbk = 16 / r, c = idx16 / nbk, n = idx16 % nbk;
    LAS unsigned char* VL = F.lds;
    LAS unsigned char* PL = F.lds + 256 * 320;
    LAS float* SMAX = (LAS float*)(F.lds + 256 * 320 + 128 * 528);
    LAS float* SSUM = SMAX + 256;
    bf16_t* DQ = (bf16_t*)(F.ws + WS_DQ); const bf16_t* DK = (const bf16_t*)(F.ws + WS_DK); const bf16_t* DV = (const bf16_t*)(F.ws + WS_DV);
    const size_t tb = (size_t)b * SEQ;
    const int kbmin = (n == 0) ? 4 : 0;
#pragma unroll
    for (int it = 0; it < 8; ++it) {
        const int idx = F.tid + NTHREADS * it, row = idx >> 4, ch = idx & 15;
        if (row >= 32 * kbmin) {
            const size_t tok = tb + (size_t)((128 * (n - 1) + row) * r + c);
            *(LAS u32x4*)(VL + row * 320 + ch * 16) = *(const GAS u32x4*)(DV + tok * 1536 + head * 128 + ch * 8);
        }
    }
    const int lane = F.lane, rr = lane & 31, hh = lane >> 5, wq = F.wave & 3, wd = F.wave >> 2;
    const int qi = 32 * wq + rr;
    const size_t tokq = tb + (size_t)((128 * n + qi) * r + c);
    bf16x8 qf[8];
    { const bf16_t* qp = DQ + tokq * 1536 + head * 128 + 8 * hh;
#pragma unroll
      for (int s = 0; s < 8; ++s) qf[s] = *(const GAS bf16x8*)(qp + 16 * s); }
    f32x16 st[3]; bool val[3]; float mloc = -INFINITY;
#pragma unroll
    for (int sl = 0; sl < 3; ++sl) {
        const int kb = wq + wd + 2 * sl; val[sl] = (kb <= wq + 4) && (kb >= kbmin);
        st[sl] = zero16();
        if (val[sl]) {
            const size_t tokk = tb + (size_t)((128 * (n - 1) + 32 * kb + rr) * r + c);
            const bf16_t* kp = DK + tokk * 1536 + head * 128 + 8 * hh;
            bf16x8 kf[8];
#pragma unroll
            for (int s = 0; s < 8; ++s) kf[s] = *(const GAS bf16x8*)(kp + 16 * s);
#pragma unroll
            for (int s = 0; s < 8; ++s) st[sl] = MFMA32(kf[s], qf[s], st[sl]);
#pragma unroll
            for (int reg = 0; reg < 16; ++reg) { const int jj = 32 * kb + crow(reg, hh); const bool ok = (jj >= qi) && (jj <= qi + 128);
                st[sl][reg] = ok ? st[sl][reg] : -INFINITY; mloc = fmaxf(mloc, st[sl][reg]); }
        }
    }
    mloc = fmaxf(mloc, __shfl_xor(mloc, 32));
    if (hh == 0) SMAX[wd * 128 + qi] = mloc;
    __syncthreads();
    const float mx = fmaxf(SMAX[qi], SMAX[128 + qi]);
    float lloc = 0.f;
#pragma unroll
    for (int sl = 0; sl < 3; ++sl) {
        if (val[sl]) { const int kb = wq + wd + 2 * sl;
#pragma unroll
            for (int reg = 0; reg < 16; ++reg) { const float p = fast_exp2(st[sl][reg] - mx); st[sl][reg] = p; lloc += p; }
#pragma unroll
            for (int g4 = 0; g4 < 4; ++g4) { u32x2 w; w.x = pk2(st[sl][4 * g4], st[sl][4 * g4 + 1]); w.y = pk2(st[sl][4 * g4 + 2], st[sl][4 * g4 + 3]);
                *(LAS u32x2*)(PL + qi * 528 + (32 * kb + 8 * g4 + 4 * hh) * 2) = w; }
        }
    }
    lloc += __shfl_xor(lloc, 32);
    if (hh == 0) SSUM[wd * 128 + qi] = lloc;
    __syncthreads();
    const float lsum = SSUM[qi] + SSUM[128 + qi];
    f32x16 o0 = zero16(), o1 = zero16();
    const int kb_lo = (wq > kbmin) ? wq : kbmin;
    for (int kb = kb_lo; kb <= wq + 4; ++kb) {
#pragma unroll
        for (int s = 0; s < 2; ++s) {
            const bf16x8 pb = frag_nt(PL, 528, 32 * wq, 32 * kb + 16 * s, lane);
            const bf16x8 a0 = frag_tr(VL, 320, 32 * kb + 16 * s, 64 * wd, lane), a1 = frag_tr(VL, 320, 32 * kb + 16 * s, 64 * wd + 32, lane);
            o0 = MFMA32(a0, pb, o0); o1 = MFMA32(a1, pb, o1);
        }
    }
    const float inv = 1.0f / lsum;
    bf16_t* op = DQ + tokq * 1536 + head * 128 + 64 * wd + 4 * hh;
#pragma unroll
    for (int g4 = 0; g4 < 4; ++g4) {
        u32x2 w0, w1; w0.x = pk2(o0[4 * g4] * inv, o0[4 * g4 + 1] * inv); w0.y = pk2(o0[4 * g4 + 2] * inv, o0[4 * g4 + 3] * inv);
        w1.x = pk2(o1[4 * g4] * inv, o1[4 * g4 + 1] * inv); w1.y = pk2(o1[4 * g4 + 2] * inv, o1[4 * g4 + 3] * inv);
        *(GAS u32x2*)(op + 8 * g4) = w0; *(GAS u32x2*)(op + 32 + 8 * g4) = w1;
    }
    if (wd == 0 && hh == 0) ((float*)(F.ws + WS_LSE))[(size_t)head * MT + tokq] = mx + __builtin_log2f(lsum);
    __syncthreads();
}

DI void ph2_mixers_a(const Frame& F) {
    for (int it = F.bid; it < 1024; it += F.G) ret_kv_item(F, it >> 4, it & 15);
    for (int it = F.bid; it < 1536; it += F.G) { const int b = it / 192, rem = it % 192; dil_item(F, b, rem >> 4, rem & 15); }
}

DI void ret_out_item(const Frame& F, int bh, int n) {
    const int b = bh >> 3, h = bh & 7; const float lg = ret_lg2gamma(h);
    LAS unsigned char* VL = F.lds;
    LAS unsigned char* PL = F.lds + 128 * 320;
    LAS unsigned char* PT = PL + 128 * 272;
    LAS float* SQ = (LAS float*)(PT + 128 * 272);
    bf16_t* RQ = (bf16_t*)(F.ws + WS_RQ); const bf16_t* RK = (const bf16_t*)(F.ws + WS_RK); const bf16_t* RV = (const bf16_t*)(F.ws + WS_RV); const bf16_t* SG = (const bf16_t*)(F.ws + WS_SG);
    const size_t tb = (size_t)b * SEQ + n * 128;
#pragma unroll
    for (int it = 0; it < 4; ++it) { const int idx = F.tid + NTHREADS * it, row = idx >> 4, ch = idx & 15;
        *(LAS u32x4*)(VL + row * 320 + ch * 16) = *(const GAS u32x4*)(RV + (tb + row) * 1024 + h * 128 + ch * 8); }
    { const float* kv = (const float*)(F.ws + WS_KVST) + (size_t)(bh * 16) * 16384;
#pragma unroll
      for (int it = 0; it < 8; ++it) { const int idx = F.tid + NTHREADS * it, e = idx >> 5, c4 = idx & 31;
          f32x4 acc = {0.f, 0.f, 0.f, 0.f};
          for (int m = 0; m < n; ++m) { const float wgt = fast_exp2(lg * 128.0f * (float)(n - 1 - m)); const f32x4 v = *(const GAS f32x4*)(kv + (size_t)m * 16384 + e * 128 + c4 * 4); acc += v * wgt; }
          u32x2 w; w.x = pk2(acc.x, acc.y); w.y = pk2(acc.z, acc.w);
          *(LAS u32x2*)(PT + e * 272 + c4 * 8) = w; } }
    const int lane = F.lane, rr = lane & 31, hh = lane >> 5, wq = F.wave & 3, we = F.wave >> 2;
    const int qi = 32 * wq + rr;
    bf16x8 qf[8];
    { const bf16_t* qp = RQ + (tb + qi) * 1024 + h * 128 + 8 * hh;
#pragma unroll
      for (int s = 0; s < 8; ++s) qf[s] = *(const GAS bf16x8*)(qp + 16 * s); }
#pragma unroll
    for (int sl = 0; sl < 2; ++sl) {
        const int kb = we + 2 * sl;
        if (kb <= wq) {
            const bf16_t* kp = RK + (tb + 32 * kb + rr) * 1024 + h * 128 + 8 * hh;
            bf16x8 kf[8];
#pragma unroll
            for (int s = 0; s < 8; ++s) kf[s] = *(const GAS bf16x8*)(kp + 16 * s);
            f32x16 st = zero16();
#pragma unroll
            for (int s = 0; s < 8; ++s) st = MFMA32(kf[s], qf[s], st);
#pragma unroll
            for (int reg = 0; reg < 16; ++reg) { const int j = 32 * kb + crow(reg, hh); st[reg] = (j <= qi) ? st[reg] * fast_exp2(lg * (float)(qi - j)) : 0.f; }
#pragma unroll
            for (int g4 = 0; g4 < 4; ++g4) { u32x2 w; w.x = pk2(st[4 * g4], st[4 * g4 + 1]); w.y = pk2(st[4 * g4 + 2], st[4 * g4 + 3]);
                *(LAS u32x2*)(PL + qi * 272 + (32 * kb + 8 * g4 + 4 * hh) * 2) = w; }
        }
    }
    __syncthreads();
    f32x16 in0 = zero16(), in1 = zero16(), cr0 = zero16(), cr1 = zero16();
    for (int kb = 0; kb <= wq; ++kb) {
#pragma unroll
        for (int s = 0; s < 2; ++s) {
            const bf16x8 pb = frag_nt(PL, 272, 32 * wq, 32 * kb + 16 * s, lane);
            const bf16x8 a0 = frag_tr(VL, 320, 32 * kb + 16 * s, 64 * we, lane), a1 = frag_tr(VL, 320, 32 * kb + 16 * s, 64 * we + 32, lane);
            in0 = MFMA32(a0, pb, in0); in1 = MFMA32(a1, pb, in1);
        }
    }
#pragma unroll
    for (int s = 0; s < 8; ++s) {
        const bf16x8 a0 = frag_nt(PT, 272, 64 * we, 16 * s, lane), a1 = frag_nt(PT, 272, 64 * we + 32, 16 * s, lane);
        cr0 = MFMA32(a0, qf[s], cr0); cr1 = MFMA32(a1, qf[s], cr1);
    }
    const float qw = fast_exp2(lg * (float)(qi + 1));
    float ss = 0.f;
#pragma unroll
    for (int reg = 0; reg < 16; ++reg) { in0[reg] += qw * cr0[reg]; in1[reg] += qw * cr1[reg]; ss += in0[reg] * in0[reg] + in1[reg] * in1[reg]; }
    ss += __shfl_xor(ss, 32);
    if (hh == 0) SQ[we * 128 + qi] = ss;
    __syncthreads();
    const float rstd = 1.0f / sqrtf((SQ[qi] + SQ[128 + qi]) * (1.0f / 128.0f) + EPS);
    const size_t off = (tb + qi) * 1024 + h * 128 + 64 * we + 4 * hh;
#pragma unroll
    for (int g4 = 0; g4 < 4; ++g4) {
        const u32x2 g0 = *(const GAS u32x2*)(SG + off + 8 * g4), g1 = *(const GAS u32x2*)(SG + off + 32 + 8 * g4);
        u32x2 w0, w1;
        w0.x = pk2(in0[4 * g4] * rstd * bf_lo(g0.x), in0[4 * g4 + 1] * rstd * bf_hi(g0.x)); w0.y = pk2(in0[4 * g4 + 2] * rstd * bf_lo(g0.y), in0[4 * g4 + 3] * rstd * bf_hi(g0.y));
        w1.x = pk2(in1[4 * g4] * rstd * bf_lo(g1.x), in1[4 * g4 + 1] * rstd * bf_hi(g1.x)); w1.y = pk2(in1[4 * g4 + 2] * rstd * bf_lo(g1.y), in1[4 * g4 + 3] * rstd * bf_hi(g1.y));
        *(GAS u32x2*)(RQ + off + 8 * g4) = w0; *(GAS u32x2*)(RQ + off + 32 + 8 * g4) = w1;
    }
    __syncthreads();
}
DI void ph3_mixers_b(const Frame& F) {
    for (int it = F.bid; it < 1024; it += F.G) ret_out_item(F, it >> 4, it & 15);
    bf16_t* DQ = (bf16_t*)(F.ws + WS_DQ); const float* LSE = (const float*)(F.ws + WS_LSE);
    const int gt = F.bid * NTHREADS + F.tid, NGT = F.G * NTHREADS;
    for (int i = gt; i < MT * 64; i += NGT) {
        const int t = i >> 6, hg = (i >> 4) & 3, ch = i & 15;
        const float l0 = LSE[(size_t)hg * MT + t], l1 = LSE[(size_t)(4 + hg) * MT + t], l2 = LSE[(size_t)(8 + hg) * MT + t];
        const float mx = fmaxf(l0, fmaxf(l1, l2)); float w0 = fast_exp2(l0 - mx), w1 = fast_exp2(l1 - mx), w2 = fast_exp2(l2 - mx);
        const float inv = 1.0f / (w0 + w1 + w2); w0 *= inv; w1 *= inv; w2 *= inv;
        bf16_t* p = DQ + (size_t)t * 1536 + hg * 128 + ch * 8;
        const u32x4 a = *(const GAS u32x4*)p, bq = *(const GAS u32x4*)(p + 512), cq = *(const GAS u32x4*)(p + 1024);
        u32x4 o;
        o.x = pk2(w0 * bf_lo(a.x) + w1 * bf_lo(bq.x) + w2 * bf_lo(cq.x), w0 * bf_hi(a.x) + w1 * bf_hi(bq.x) + w2 * bf_hi(cq.x));
        o.y = pk2(w0 * bf_lo(a.y) + w1 * bf_lo(bq.y) + w2 * bf_lo(cq.y), w0 * bf_hi(a.y) + w1 * bf_hi(bq.y) + w2 * bf_hi(cq.y));
        o.z = pk2(w0 * bf_lo(a.z) + w1 * bf_lo(bq.z) + w2 * bf_lo(cq.z), w0 * bf_hi(a.z) + w1 * bf_hi(bq.z) + w2 * bf_hi(cq.z));
        o.w = pk2(w0 * bf_lo(a.w) + w1 * bf_lo(bq.w) + w2 * bf_lo(cq.w), w0 * bf_hi(a.w) + w1 * bf_hi(bq.w) + w2 * bf_hi(cq.w));
        *(GAS u32x4*)p = o;
    }
}

struct UnitG { const char* A; const char* B; int pm, pn; };
struct SchedG {
    typedef UnitG Unit;
    int G, c, nM, nN; const char* Abase; const char* Bbase; size_t astep, bstep;
    DI bool next(int i, Unit& u) const {
        const int L = i * G + c; if (L >= nM * nN) return false;
        int pm, pn; pg8::tile_of(L, nM, nN, pm, pn); u.pm = pm; u.pn = pn;
        u.A = Abase + (size_t)pm * astep; u.B = Bbase + (size_t)pn * bstep; return true;
    }
};
#define EPI_ROWS_BEGIN const int rowl0 = wr * 64 + fr, colb = wc * 32 + 8 * fq; _Pragma("unroll") for (int ai = 0; ai < 2; ++ai) _Pragma("unroll") for (int m = 0; m < 4; ++m) { const int rl = ai * 128 + m * 16 + rowl0;
#define EPI_ROWS_END }
DI u32x4 pack8(const f32x4 v0, const f32x4 v1) { u32x4 w; w.x = pk2(v0.x, v0.y); w.y = pk2(v0.z, v0.w); w.z = pk2(v1.x, v1.y); w.w = pk2(v1.z, v1.w); return w; }
DI void unpack8(const u32x4 w, f32x4& v0, f32x4& v1) { v0 = (f32x4){bf_lo(w.x), bf_hi(w.x), bf_lo(w.y), bf_hi(w.y)}; v1 = (f32x4){bf_lo(w.z), bf_hi(w.z), bf_lo(w.w), bf_hi(w.w)}; }

template <int PASS> struct EpiMerge {
    bf16_t* GR; bf16_t* GD;
    DI void operator()(const f32x4 (&acc)[2][2][4][2], const UnitG& u, int wr, int wc, int fr, int fq, int wid, int lane) const {
        EPI_ROWS_BEGIN
            const size_t off = (size_t)(u.pm * 256 + rl) * 2048 + u.pn * 256 + colb;
#pragma unroll
            for (int bj = 0; bj < 2; ++bj) {
                f32x4 g0, g1; unpack8(*(const GAS u32x4*)(GR + off + bj * 128), g0, g1);
                if (PASS == 0) { *(GAS u32x4*)(GR + off + bj * 128) = pack8(g0 * acc[ai][bj][m][0], g1 * acc[ai][bj][m][1]); }
                else { f32x4 d0, d1; unpack8(*(const GAS u32x4*)(GD + off + bj * 128), d0, d1);
                    *(GAS u32x4*)(GD + off + bj * 128) = pack8(g0 + d0 * acc[ai][bj][m][0], g1 + d1 * acc[ai][bj][m][1]); }
            }
        EPI_ROWS_END
    }
};
struct EpiResid {
    const float* xold; float* XF; bf16_t* XB; float* SSQ;
    DI void operator()(const f32x4 (&acc)[2][2][4][2], const UnitG& u, int wr, int wc, int fr, int fq, int wid, int lane) const {
        EPI_ROWS_BEGIN
            const size_t t = (size_t)(u.pm * 256 + rl); const size_t off = t * 2048 + u.pn * 256 + colb;
            float ss = 0.f;
#pragma unroll
            for (int bj = 0; bj < 2; ++bj) {
                const f32x4 x0 = *(const GAS f32x4*)(xold + off + bj * 128), x1 = *(const GAS f32x4*)(xold + off + bj * 128 + 4);
                const f32x4 y0 = x0 + acc[ai][bj][m][0], y1 = x1 + acc[ai][bj][m][1];
                *(GAS f32x4*)(XF + off + bj * 128) = y0; *(GAS f32x4*)(XF + off + bj * 128 + 4) = y1;
                *(GAS u32x4*)(XB + off + bj * 128) = pack8(y0, y1);
                ss += (y0.x * y0.x + y0.y * y0.y) + (y0.z * y0.z + y0.w * y0.w) + (y1.x * y1.x + y1.y * y1.y) + (y1.z * y1.z + y1.w * y1.w);
            }
            ss += __shfl_xor(ss, 16); ss += __shfl_xor(ss, 32);
            if (fq == 0) SSQ[t * 32 + u.pn * 4 + wc] = ss;
        EPI_ROWS_END
    }
};
struct EpiRowScale {
    const float* SSQ; bf16_t* out; float scale;
    DI void operator()(const f32x4 (&acc)[2][2][4][2], const UnitG& u, int wr, int wc, int fr, int fq, int wid, int lane) const {
        EPI_ROWS_BEGIN
            const size_t t = (size_t)(u.pm * 256 + rl); const size_t off = t * 2048 + u.pn * 256 + colb;
            const f32x4 p0 = *(const GAS f32x4*)(SSQ + t * 32 + fq * 8), p1 = *(const GAS f32x4*)(SSQ + t * 32 + fq * 8 + 4);
            float ss = (p0.x + p0.y) + (p0.z + p0.w) + (p1.x + p1.y) + (p1.z + p1.w);
            ss += __shfl_xor(ss, 16); ss += __shfl_xor(ss, 32);
            const float sc = scale / sqrtf(ss * (1.0f / 2048.0f) + EPS);
#pragma unroll
            for (int bj = 0; bj < 2; ++bj) *(GAS u32x4*)(out + off + bj * 128) = pack8(acc[ai][bj][m][0] * sc, acc[ai][bj][m][1] * sc);
        EPI_ROWS_END
    }
};
struct Sched7 {
    typedef UnitG Unit; int G, c; const char* QM; const char* KM;
    DI bool next(int i, Unit& u) const {
        const int L = i * G + c; if (L >= 256) return false;
        const int bh = L >> 3, pm = L & 7, b = bh >> 2, hd = bh & 3; u.pm = L; u.pn = 0;
        u.A = QM + ((size_t)(b * SEQ + pm * 256) * 2048 + hd * 512) * 2; u.B = KM + ((size_t)(b * MEMT) * 2048 + hd * 512) * 2; return true;
    }
};
struct EpiSoftmax {
    bf16_t* P; LAS float* X;
    DI void operator()(f32x4 (&acc)[2][2][4][2], const UnitG& u, int wr, int wc, int fr, int fq, int wid, int lane) const {
        LAS float* MX = X; LAS float* SM = X + 1024;
        EPI_ROWS_BEGIN
            float mx = -INFINITY;
#pragma unroll
            for (int bj = 0; bj < 2; ++bj)
#pragma unroll
                for (int n = 0; n < 2; ++n) { const f32x4 v = acc[ai][bj][m][n]; mx = fmaxf(mx, fmaxf(fmaxf(v.x, v.y), fmaxf(v.z, v.w))); }
            mx = fmaxf(mx, __shfl_xor(mx, 16)); mx = fmaxf(mx, __shfl_xor(mx, 32));
            if (fq == 0) MX[rl * 4 + wc] = mx;
        EPI_ROWS_END
        asm volatile("s_waitcnt lgkmcnt(0)" ::: "memory"); __builtin_amdgcn_s_barrier(); asm volatile("" ::: "memory");
        {
        EPI_ROWS_BEGIN
            const f32x4 q = *(LAS f32x4*)(MX + rl * 4); const float mx = fmaxf(fmaxf(q.x, q.y), fmaxf(q.z, q.w));
            float s = 0.f;
#pragma unroll
            for (int bj = 0; bj < 2; ++bj)
#pragma unroll
                for (int n = 0; n < 2; ++n) { f32x4 v = acc[ai][bj][m][n]; v.x = fast_exp2(v.x - mx); v.y = fast_exp2(v.y - mx); v.z = fast_exp2(v.z - mx); v.w = fast_exp2(v.w - mx);
                    acc[ai][bj][m][n] = v; s += (v.x + v.y) + (v.z + v.w); }
            s += __shfl_xor(s, 16); s += __shfl_xor(s, 32);
            if (fq == 0) SM[rl * 4 + wc] = s;
        EPI_ROWS_END
        }
        asm volatile("s_waitcnt lgkmcnt(0)" ::: "memory"); __builtin_amdgcn_s_barrier(); asm volatile("" ::: "memory");
        {
        EPI_ROWS_BEGIN
            const f32x4 q = *(LAS f32x4*)(SM + rl * 4); const float inv = 1.0f / ((q.x + q.y) + (q.z + q.w));
            bf16_t* rowp = P + (size_t)(u.pm * 256 + rl) * 256 + colb;
#pragma unroll
            for (int bj = 0; bj < 2; ++bj) *(GAS u32x4*)(rowp + bj * 128) = pack8(acc[ai][bj][m][0] * inv, acc[ai][bj][m][1] * inv);
        EPI_ROWS_END
        }
        asm volatile("s_waitcnt lgkmcnt(0)" ::: "memory"); __builtin_amdgcn_s_barrier(); asm volatile("" ::: "memory");
    }
};
struct Sched8 {
    typedef UnitG Unit; int G, c; const char* P; const char* VT;
    DI bool next(int i, Unit& u) const {
        const int L = i * G + c; if (L >= 512) return false;
        const int pn = L & 1, l2 = L >> 1, bh = l2 >> 3, pm = l2 & 7, b = bh >> 2, hd = bh & 3;
        u.pm = b * 8 + pm; u.pn = hd * 2 + pn;
        u.A = P + (size_t)(l2 * 256) * 256 * 2; u.B = VT + ((size_t)(hd * 512 + pn * 256) * 2048 + b * MEMT) * 2; return true;
    }
};
struct EpiPlain {
    bf16_t* out; int ldo;
    DI void operator()(const f32x4 (&acc)[2][2][4][2], const UnitG& u, int wr, int wc, int fr, int fq, int wid, int lane) const {
        EPI_ROWS_BEGIN
            bf16_t* rowp = out + (size_t)(u.pm * 256 + rl) * ldo + u.pn * 256 + colb;
#pragma unroll
            for (int bj = 0; bj < 2; ++bj) *(GAS u32x4*)(rowp + bj * 128) = pack8(acc[ai][bj][m][0], acc[ai][bj][m][1]);
        EPI_ROWS_END
    }
};

DI unsigned sortable(float v) { const unsigned b = __builtin_bit_cast(unsigned, v); return (b & 0x80000000u) ? ~b : (b | 0x80000000u); }
DI float unsortable(unsigned s) { const unsigned b = (s & 0x80000000u) ? (s & 0x7fffffffu) : ~s; return __builtin_bit_cast(float, b); }
#define PEER_CANDS(X) \
    X(0,0) X(0,1) X(0,2) X(0,3) X(0,4) X(0,5) X(0,6) X(0,7) X(0,8) X(0,9) X(0,10) X(0,11) X(0,12) X(0,13) X(0,14) X(0,15) \
    X(1,0) X(1,1) X(1,2) X(1,3) X(1,4) X(1,5) X(1,6) X(1,7) X(2,0) X(2,1) X(2,2) X(2,3) X(2,4) X(3,0) X(3,1) X(3,2) X(3,3) \
    X(4,0) X(4,1) X(4,2) X(5,0) X(5,1) X(6,0) X(6,1) X(7,0) X(7,1) X(8,0) X(9,0) X(10,0) X(11,0) X(12,0) X(13,0) X(14,0) X(15,0)
#define X(a, b) (unsigned char)((a) * 16 + (b)),
static __device__ const unsigned char peer_ab[50] = { PEER_CANDS(X) };
#undef X
DI void route_pass(const Frame& F, int tg, int h, LAS unsigned* topL  , LAS unsigned* resL  ) {
    const int lane = F.lane, rr = lane & 31, hh = lane >> 5; const size_t tok = (size_t)tg * 32 + rr;
    const bf16_t* PQ = (const bf16_t*)(F.ws + WS_PQ); const bf16_t* SUBK = (const bf16_t*)(F.ws + WS_SUBK);
#pragma unroll 1
    for (int p = 0; p < 2; ++p) {
        bf16x8 qf[8];
        { const bf16_t* qp = PQ + tok * 2048 + (2 * h + p) * 128 + 8 * hh;
#pragma unroll
          for (int s = 0; s < 8; ++s) qf[s] = *(const GAS bf16x8*)(qp + 16 * s); }
        unsigned key[64];
#pragma unroll
        for (int nb = 0; nb < 4; ++nb) {
            const bf16_t* kp = SUBK + ((size_t)((2 * h + p) * 128 + 32 * nb + rr)) * 128 + 8 * hh;
            f32x16 acc = zero16();
#pragma unroll
            for (int s = 0; s < 8; ++s) acc = MFMA32(*(const GAS bf16x8*)(kp + 16 * s), qf[s], acc);
#pragma unroll
            for (int reg = 0; reg < 16; ++reg) { const int n = 32 * nb + crow(reg, hh); key[nb * 16 + reg] = (sortable(acc[reg]) & ~0x7fu) | (unsigned)(127 - n); }
        }
#pragma unroll 1
        for (int rd = 0; rd < 16; ++rd) {
            unsigned m = key[0];
#pragma unroll
            for (int i = 1; i < 64; ++i) m = (key[i] > m) ? key[i] : m;
            const unsigned o = __shfl_xor(m, 32); m = (o > m) ? o : m;
            topL[(p * 16 + rd) * 64 + lane] = m;
#pragma unroll
            for (int i = 0; i < 64; ++i) key[i] = (key[i] == m) ? 0u : key[i];
        }
    }
    LDS_WAIT();
    unsigned ck[50];
    { float v1[16], v2[16];
#pragma unroll
      for (int k = 0; k < 16; ++k) { v1[k] = unsortable(topL[k * 64 + lane] & ~0x7fu); v2[k] = unsortable(topL[(16 + k) * 64 + lane] & ~0x7fu); }
      int k = 0;
#define X(a, b) ck[k] = (sortable(v1[a] + v2[b]) & ~0x3fu) | (unsigned)(63 - k); ++k;
      PEER_CANDS(X)
#undef X
    }
#pragma unroll 1
    for (int rd = 0; rd < 16; ++rd) {
        unsigned m = ck[0];
#pragma unroll
        for (int i = 1; i < 50; ++i) m = (ck[i] > m) ? ck[i] : m;
#pragma unroll
        for (int i = 0; i < 50; ++i) ck[i] = (ck[i] == m) ? 0u : ck[i];
        resL[rd * 64 + lane] = m;
    }
    LDS_WAIT();
    float cv[16]; unsigned ce[16];
#pragma unroll
    for (int k = 0; k < 16; ++k) {
        const unsigned m = resL[k * 64 + lane]; cv[k] = unsortable(m & ~0x3fu);
        const unsigned ab = peer_ab[63u - (m & 63u)];
        const unsigned i1 = 127u - (topL[(ab >> 4) * 64 + lane] & 0x7fu), i2 = 127u - (topL[(16 + (ab & 15u)) * 64 + lane] & 0x7fu);
        ce[k] = i1 * 128u + i2;
    }
    const float cmax = cv[0]; float gs = 0.f;
#pragma unroll
    for (int k = 0; k < 16; ++k) { cv[k] = fast_exp2((cv[k] - cmax) * 1.4426950408889634f); gs += cv[k]; }
    const float ginv = 1.0f / gs;
    if (hh == 0) {
        unsigned* ep = (unsigned*)(F.ws + WS_EIDX) + tok * 128 + h * 16; float* gp = (float*)(F.ws + WS_GATE) + tok * 128 + h * 16;
#pragma unroll
        for (int k = 0; k < 16; k += 4) { *(GAS u32x4*)(ep + k) = (u32x4){ce[k], ce[k + 1], ce[k + 2], ce[k + 3]}; *(GAS f32x4*)(gp + k) = (f32x4){cv[k] * ginv, cv[k + 1] * ginv, cv[k + 2] * ginv, cv[k + 3] * ginv}; }
    }
    LDS_WAIT();
}
DI void ph11_route(const Frame& F, const Args& a) {
    const int gw = F.bid * NWAVES + F.wave, NGW = F.G * NWAVES;
    LAS unsigned* topL = (LAS unsigned*)(F.lds + F.wave * 12288); LAS unsigned* resL = topL + 2048;
    for (int it = gw; it < 512 * 8; it += NGW) route_pass(F, it >> 3, it & 7, topL, resL);
    const int gt = F.bid * NTHREADS + F.tid, NGT = F.G * NTHREADS;
    const GAS f32x4* gf = (const GAS f32x4*)a.in[I_GFFN];
    for (int i = gt; i < 16384 * 256; i += NGT) {
        const int c8 = i & 255;
        const GAS f32x4* su = (const GAS f32x4*)a.in[I_PU] + 2 * (size_t)i; const GAS f32x4* sv = (const GAS f32x4*)a.in[I_PV] + 2 * (size_t)i;
        const f32x4 g0 = gf[2 * c8], g1 = gf[2 * c8 + 1];
        const f32x4 u0 = su[0] * g0, u1 = su[1] * g1, v0 = sv[0], v1 = sv[1];
        ((GAS u32x4*)(F.ws + WS_UTAB))[i] = pack8(u0, u1); ((GAS u32x4*)(F.ws + WS_VTAB))[i] = pack8(v0, v1);
    }
}

DI float gelu_erf(float v) {
    const float av = fabsf(v), t = fast_rcp(av * 0.2316418882f + 1.0f);
    float q = t * 0.5307027145f + (-0.7265760135f); q = q * t + 0.7107068705f; q = q * t + (-0.142248368f); q = q * t + 0.127414796f; q = q * t;
    const float e = fast_exp2((v * v) * (-0.72134752044f)); const float m = v * (q * e);
    return v < 0.f ? m : v - m;
}
DI float dot8(const u32x4& w, const float* xf) {
    return bf_lo(w.x) * xf[0] + bf_hi(w.x) * xf[1] + bf_lo(w.y) * xf[2] + bf_hi(w.y) * xf[3] + bf_lo(w.z) * xf[4] + bf_hi(w.z) * xf[5] + bf_lo(w.w) * xf[6] + bf_hi(w.w) * xf[7];
}
DI void axpy8(float* y, float w, const u32x4& v) {
    y[0] += w * bf_lo(v.x); y[1] += w * bf_hi(v.x); y[2] += w * bf_lo(v.y); y[3] += w * bf_hi(v.y); y[4] += w * bf_lo(v.z); y[5] += w * bf_hi(v.z); y[6] += w * bf_lo(v.w); y[7] += w * bf_hi(v.w);
}
DI void peer_token(const Frame& F, const Args& a, int t, LAS float* wl, LAS int* el) {
    const int lane = F.lane;
    const bf16_t* XB = (const bf16_t*)(F.ws + WS_XB); const bf16_t* UT = (const bf16_t*)(F.ws + WS_UTAB); const bf16_t* VTB = (const bf16_t*)(F.ws + WS_VTAB);
    float xf[32];
#pragma unroll
    for (int j = 0; j < 4; ++j) { const u32x4 w = *(const GAS u32x4*)(XB + (size_t)t * 2048 + (lane + 64 * j) * 8);
        xf[8 * j + 0] = bf_lo(w.x); xf[8 * j + 1] = bf_hi(w.x); xf[8 * j + 2] = bf_lo(w.y); xf[8 * j + 3] = bf_hi(w.y); xf[8 * j + 4] = bf_lo(w.z); xf[8 * j + 5] = bf_hi(w.z); xf[8 * j + 6] = bf_lo(w.w); xf[8 * j + 7] = bf_hi(w.w); }
    const float ssq = wave_sum((lane < 32) ? ((const float*)(F.ws + WS_SSQ2))[(size_t)t * 32 + lane] : 0.f);
    const float rstd2 = 1.0f / sqrtf(ssq * (1.0f / 2048.0f) + EPS);
    const int* ep = (const int*)(F.ws + WS_EIDX) + (size_t)t * 128; const float* gp = (const float*)(F.ws + WS_GATE) + (size_t)t * 128;
    el[lane] = ep[lane]; el[64 + lane] = ep[64 + lane];
    const float g_lo = gp[lane], g_hi = gp[64 + lane];
    LDS_WAIT();
    const int q4 = lane >> 4;
    for (int it = 0; it < 32; ++it) {
        u32x4 r[4][4];
#pragma unroll
        for (int q = 0; q < 4; ++q) { const int e = __builtin_amdgcn_readfirstlane(el[4 * it + q]); const bf16_t* up = UT + (size_t)e * 2048 + lane * 8;
#pragma unroll
            for (int j = 0; j < 4; ++j) r[q][j] = *(const GAS u32x4*)(up + 512 * j); }
        float d[4];
#pragma unroll
        for (int q = 0; q < 4; ++q) d[q] = (dot8(r[q][0], xf) + dot8(r[q][1], xf + 8)) + (dot8(r[q][2], xf + 16) + dot8(r[q][3], xf + 24));
        const bool up5 = (lane & 32) != 0;
        const float s0 = up5 ? d[0] : d[2], s1 = up5 ? d[1] : d[3];
        const float r0 = __shfl_xor(s0, 32), r1 = __shfl_xor(s1, 32);
        const float k0 = (up5 ? d[2] : d[0]) + r0, k1 = (up5 ? d[3] : d[1]) + r1;
        const bool up4 = (lane & 16) != 0;
        const float s2 = up4 ? k0 : k1; const float r2 = __shfl_xor(s2, 16);
        float v = (up4 ? k1 : k0) + r2;
        v += __shfl_xor(v, 8); v += __shfl_xor(v, 4); v += __shfl_xor(v, 2); v += __shfl_xor(v, 1);
        if ((lane & 15) == 0) wl[4 * it + q4] = gelu_erf(v * rstd2);
    }
    LDS_WAIT();
    { const float a_lo = wl[lane], a_hi = wl[64 + lane]; LDS_WAIT(); wl[lane] = a_lo * g_lo; wl[64 + lane] = a_hi * g_hi; LDS_WAIT(); }
    float y[32];
#pragma unroll
    for (int i = 0; i < 32; ++i) y[i] = 0.f;
    for (int it = 0; it < 32; ++it) {
        u32x4 r[4][4]; float w[4];
#pragma unroll
        for (int q = 0; q < 4; ++q) { const int e = __builtin_amdgcn_readfirstlane(el[4 * it + q]); w[q] = wl[4 * it + q]; const bf16_t* vp = VTB + (size_t)e * 2048 + lane * 8;
#pragma unroll
            for (int j = 0; j < 4; ++j) r[q][j] = *(const GAS u32x4*)(vp + 512 * j); }
#pragma unroll
        for (int q = 0; q < 4; ++q)
#pragma unroll
            for (int j = 0; j < 4; ++j) axpy8(y + 8 * j, w[q], r[q][j]);
    }
    float* xr = a.out + (size_t)t * 2048; const float* gfin = (const float*)a.in[I_GFINAL];
    float ss = 0.f;
#pragma unroll
    for (int j = 0; j < 4; ++j) { const f32x4 x0 = *(const GAS f32x4*)(xr + (lane + 64 * j) * 8), x1 = *(const GAS f32x4*)(xr + (lane + 64 * j) * 8 + 4);
        y[8 * j + 0] += x0.x; y[8 * j + 1] += x0.y; y[8 * j + 2] += x0.z; y[8 * j + 3] += x0.w; y[8 * j + 4] += x1.x; y[8 * j + 5] += x1.y; y[8 * j + 6] += x1.z; y[8 * j + 7] += x1.w;
#pragma unroll
        for (int i = 0; i < 8; ++i) ss += y[8 * j + i] * y[8 * j + i]; }
    const float rstd = 1.0f / sqrtf(wave_sum(ss) * (1.0f / 2048.0f) + EPS);
#pragma unroll
    for (int j = 0; j < 4; ++j) { const f32x4 g0 = *(const GAS f32x4*)(gfin + (lane + 64 * j) * 8), g1 = *(const GAS f32x4*)(gfin + (lane + 64 * j) * 8 + 4);
        *(GAS f32x4*)(xr + (lane + 64 * j) * 8) = (f32x4){y[8 * j] * rstd * g0.x, y[8 * j + 1] * rstd * g0.y, y[8 * j + 2] * rstd * g0.z, y[8 * j + 3] * rstd * g0.w};
        *(GAS f32x4*)(xr + (lane + 64 * j) * 8 + 4) = (f32x4){y[8 * j + 4] * rstd * g1.x, y[8 * j + 5] * rstd * g1.y, y[8 * j + 6] * rstd * g1.z, y[8 * j + 7] * rstd * g1.w}; }
    LDS_WAIT();
}
DI void ph12_peer(const Frame& F, const Args& a) {
    LAS float* wl = (LAS float*)(F.lds + F.wave * 1024); LAS int* el = (LAS int*)(F.lds + F.wave * 1024 + 512);
    const int gw = F.bid * NWAVES + F.wave, NGW = F.G * NWAVES;
    for (int t = gw; t < MT; t += NGW) peer_token(F, a, t, wl, el);
}

constexpr int NPHASES = 13;
#ifndef MK_ONE_LAUNCH
#define MK_ONE_LAUNCH 1
#endif
__global__ void __launch_bounds__(NTHREADS, 2) hybrid_fwd(Args args) {
    extern __shared__ __attribute__((aligned(16))) unsigned char lds_raw[];
    Frame F;
    F.lds = (LAS unsigned char*)lds_raw;
    F.tid = threadIdx.x; F.lane = F.tid & 63; F.wave = __builtin_amdgcn_readfirstlane(F.tid >> 6);
    F.G = gridDim.x; F.bid = blockIdx.x; F.ws = args.ws; F.dout = (unsigned char*)args.out;
    volatile LAS unsigned* MISC = (volatile LAS unsigned*)(F.lds + LDS_BYTES - 256);
    if (F.tid < 64) MISC[F.tid] = 0u;
    __syncthreads();
    XcdBarrier bar = xcd_barrier_post((unsigned*)(F.ws + WS_CTL) + 4096, MISC + 8);
    const int lo = args.ph_lo, hi = args.ph_hi;
#define IN(k) (lo <= (k) && (k) < hi)
#define SEAM(k) do { if (IN(k) && IN((k) + 1)) xcd_barrier(bar); } while (0)
    unsigned char* ws = F.ws;
    LAS unsigned char* ring = F.lds;

    if (IN(0)) { ph0_prologue(F, args); } SEAM(0);
    if (IN(1)) {
        Sched1 S{F.G, F.bid, ws, F.dout}; EpiProj E;
        pg8::gemm_phase<EpiProj, Sched1, true>(ring, DM, DM, DM, S, E);
    } SEAM(1);
    if (IN(2)) { ph2_mixers_a(F); } SEAM(2);
    if (IN(3)) { ph3_mixers_b(F); } SEAM(3);
    if (IN(4)) {
        { SchedG S{F.G, F.bid, 64, 8, (const char*)(ws + WS_RQ), (const char*)(ws + WS_WBR_T), (size_t)256 * 1024 * 2, (size_t)256 * 1024 * 2};
          EpiMerge<0> E{(bf16_t*)(ws + WS_GR), (bf16_t*)(ws + WS_GD)};
          pg8::gemm_phase<EpiMerge<0>, SchedG, true>(ring, 1024, 1024, 1024, S, E); }
        { SchedG S{F.G, F.bid, 64, 8, (const char*)(ws + WS_DQ), (const char*)(ws + WS_WBD_T), (size_t)256 * 1536 * 2, (size_t)256 * 512 * 2};
          EpiMerge<1> E{(bf16_t*)(ws + WS_GR), (bf16_t*)(ws + WS_GD)};
          pg8::gemm_phase<EpiMerge<1>, SchedG, true>(ring, 512, 1536, 512, S, E); }
    } SEAM(4);
    if (IN(5)) {
        SchedG S{F.G, F.bid, 64, 8, (const char*)(ws + WS_GD), (const char*)(ws + WS_WOUT_T), (size_t)256 * 2048 * 2, (size_t)256 * 2048 * 2};
        EpiResid E{(const float*)args.in[I_X], args.out, (bf16_t*)(ws + WS_XB), (float*)(ws + WS_SSQ1)};
        pg8::gemm_phase<EpiResid, SchedG, true>(ring, 2048, 2048, 2048, S, E);
    } SEAM(5);
    if (IN(6)) {
        SchedG S{F.G, F.bid, 64, 8, (const char*)(ws + WS_XB), (const char*)(ws + WS_WQ_T), (size_t)256 * 2048 * 2, (size_t)256 * 2048 * 2};
        EpiRowScale E{(const float*)(ws + WS_SSQ1), (bf16_t*)(ws + WS_QM), 0.04419417382415922f * 1.4426950408889634f};
        pg8::gemm_phase<EpiRowScale, SchedG, true>(ring, 2048, 2048, 2048, S, E);
    } SEAM(6);
    if (IN(7)) {
        Sched7 S{F.G, F.bid, (const char*)(ws + WS_QM), (const char*)(ws + WS_KM)};
        EpiSoftmax E{(bf16_t*)(ws + WS_P), (LAS float*)(F.lds + LDSX_OFF)};
        pg8::gemm_phase<EpiSoftmax, Sched7, true>(ring, 512, 2048, 2048, S, E);
    } SEAM(7);
    if (IN(8)) {
        Sched8 S{F.G, F.bid, (const char*)(ws + WS_P), (const char*)(ws + WS_VT)};
        EpiPlain E{(bf16_t*)(ws + WS_O), 2048};
        pg8::gemm_phase<EpiPlain, Sched8, true>(ring, 256, 256, 2048, S, E);
    } SEAM(8);
    if (IN(9)) {
        SchedG S{F.G, F.bid, 64, 8, (const char*)(ws + WS_O), (const char*)(ws + WS_WO_T), (size_t)256 * 2048 * 2, (size_t)256 * 2048 * 2};
        EpiResid E{args.out, args.out, (bf16_t*)(ws + WS_XB), (float*)(ws + WS_SSQ2)};
        pg8::gemm_phase<EpiResid, SchedG, true>(ring, 2048, 2048, 2048, S, E);
    } SEAM(9);
    if (IN(10)) {
        SchedG S{F.G, F.bid, 64, 8, (const char*)(ws + WS_XB), (const char*)(ws + WS_WPQ_T), (size_t)256 * 2048 * 2, (size_t)256 * 2048 * 2};
        EpiRowScale E{(const float*)(ws + WS_SSQ2), (bf16_t*)(ws + WS_PQ), 1.0f};
        pg8::gemm_phase<EpiRowScale, SchedG, true>(ring, 2048, 2048, 2048, S, E);
    } SEAM(10);
    if (IN(11)) { ph11_route(F, args); } SEAM(11);
    if (IN(12)) { ph12_peer(F, args); }
#undef IN
#undef SEAM
}

extern "C" void kernel_launch(void* const* d_in, const int* in_sizes, int n_in, void* d_out, int out_size, void* d_ws, size_t ws_size, hipStream_t stream) {
    static int grid = 0;
    if (grid == 0) {
        if (n_in != 19 || out_size != MT * DM || ws_size < WS_END) { fprintf(stderr, "kernel_launch: unexpected shapes (n_in %d, out %d, ws %zu)\n", n_in, out_size, ws_size); grid = -1; return; }
        int dev = 0, cus = 0;
        if (hipGetDevice(&dev) != hipSuccess || hipDeviceGetAttribute(&cus, hipDeviceAttributeMultiprocessorCount, dev) != hipSuccess) { grid = -1; return; }
        if (hipFuncSetAttribute((const void*)hybrid_fwd, hipFuncAttributeMaxDynamicSharedMemorySize, LDS_BYTES) != hipSuccess) { fprintf(stderr, "kernel_launch: hipFuncSetAttribute failed\n"); grid = -1; return; }
        (void)hipGetLastError();
        grid = cus;
    }
    if (grid < 0) return;
    (void)hipMemsetAsync((char*)d_ws + WS_CTL, 0, CTL_ZERO_BYTES, stream);
    Args a{};
    for (int i = 0; i < 19; ++i) a.in[i] = d_in[i];
    a.out = (float*)d_out; a.ws = (unsigned char*)d_ws;
    for (int i = 0; i < 64; ++i) { a.fret[i] = std::pow(10000.0, -(double)i / 63.0); a.frot[i] = std::pow(10000.0, -(double)i / 64.0); }
#if MK_ONE_LAUNCH
    a.ph_lo = 0; a.ph_hi = NPHASES;
    hipLaunchKernelGGL(hybrid_fwd, dim3(grid), dim3(NTHREADS), LDS_BYTES, stream, a);
#else
    for (int ph = 0; ph < NPHASES; ++ph) {
        a.ph_lo = ph; a.ph_hi = ph + 1;
        hipLaunchKernelGGL(hybrid_fwd, dim3(grid), dim3(NTHREADS), LDS_BYTES, stream, a);
    }
#endif
}
#ifdef PHASE_PROBE
#define PROBE(k) __global__ void __launch_bounds__(NTHREADS, 2) probe_ph##k(Args args) { \
    extern __shared__ __attribute__((aligned(16))) unsigned char lds_raw[]; Frame F; F.lds = (LAS unsigned char*)lds_raw; F.tid = threadIdx.x; F.lane = F.tid & 63; \
    F.wave = __builtin_amdgcn_readfirstlane(F.tid >> 6); F.G = gridDim.x; F.bid = blockIdx.x; F.ws = args.ws; F.dout = (unsigned char*)args.out; unsigned char* ws = F.ws; LAS unsigned char* ring = F.lds;
PROBE(0) ph0_prologue(F, args); }
PROBE(1) Sched1 S{F.G, F.bid, ws, F.dout}; EpiProj E; pg8::gemm_phase<EpiProj, Sched1, true>(ring, DM, DM, DM, S, E); }
PROBE(2) ph2_mixers_a(F); }
PROBE(3) ph3_mixers_b(F); }
PROBE(5) SchedG S{F.G, F.bid, 64, 8, (const char*)(ws + WS_GD), (const char*)(ws + WS_WOUT_T), (size_t)256 * 2048 * 2, (size_t)256 * 2048 * 2};
        EpiResid E{(const float*)args.in[I_X], args.out, (bf16_t*)(ws + WS_XB), (float*)(ws + WS_SSQ1)};
        pg8::gemm_phase<EpiResid, SchedG, true>(ring, 2048, 2048, 2048, S, E); }
PROBE(7) Sched7 S{F.G, F.bid, (const char*)(ws + WS_QM), (const char*)(ws + WS_KM)};
        EpiSoftmax E{(bf16_t*)(ws + WS_P), (LAS float*)(F.lds + LDSX_OFF)};
        pg8::gemm_phase<EpiSoftmax, Sched7, true>(ring, 512, 2048, 2048, S, E); }
PROBE(11) ph11_route(F, args); }
PROBE(12) ph12_peer(F, args); }
#endif
```

```cpp
#include <hip/hip_runtime.h>
#include <cstdio>
#include <cstdint>
#include <cmath>

#define LAS __attribute__((address_space(3)))
#define GAS __attribute__((address_space(1)))
#define DI __device__ __forceinline__
typedef unsigned short bf16_t;
typedef short bf16x8 __attribute__((ext_vector_type(8)));
typedef short s16x4 __attribute__((ext_vector_type(4)));
typedef short v4i16_t __attribute__((ext_vector_type(4)));
typedef float f32x2 __attribute__((ext_vector_type(2)));
typedef float f32x4 __attribute__((ext_vector_type(4)));
typedef float f32x16 __attribute__((ext_vector_type(16)));
typedef unsigned u32x2 __attribute__((ext_vector_type(2)));
typedef unsigned u32x4 __attribute__((ext_vector_type(4)));
typedef __bf16 bf16x2_t __attribute__((ext_vector_type(2)));

constexpr int NB = 8, SEQ = 2048, DM = 2048, MT = NB * SEQ;
constexpr int MEMT = 256, MROWS = NB * MEMT;
constexpr int INW = 12800;
constexpr float EPS = 1e-6f;
constexpr int NWAVES = 8, NTHREADS = 512;

constexpr size_t MiB = 1u << 20;
constexpr size_t WS_CTL = 0, CTL_ZERO_BYTES = 1 * MiB;
constexpr size_t WS_SSQ1 = 2 * MiB, WS_SSQ2 = 4 * MiB, WS_LSE = 6 * MiB, WS_EIDX = 8 * MiB, WS_GATE = 16 * MiB;
constexpr size_t WS_WIN_T = 24 * MiB, WS_WKV_T = 74 * MiB, WS_WBR_T = 90 * MiB, WS_WBD_T = 94 * MiB, WS_WOUT_T = 96 * MiB, WS_WQ_T = 104 * MiB, WS_WO_T = 112 * MiB, WS_WPQ_T = 120 * MiB;
constexpr size_t WS_SUBK = 128 * MiB, WS_KM = 130 * MiB, WS_VT = 138 * MiB;
constexpr size_t WS_RQ = 148 * MiB, WS_RK = 180 * MiB, WS_RV = 212 * MiB, WS_SG = 244 * MiB, WS_DQ = 276 * MiB, WS_DK = 324 * MiB, WS_DV = 372 * MiB, WS_GR = 420 * MiB, WS_GD = 484 * MiB;
constexpr size_t WS_END = 548 * MiB;
constexpr size_t WS_KVST = 24 * MiB;
constexpr size_t WS_XB = 24 * MiB;
constexpr size_t WS_QM = 180 * MiB;
constexpr size_t WS_PQ = 180 * MiB;
constexpr size_t WS_P = 244 * MiB;
constexpr size_t WS_O = 324 * MiB;
constexpr size_t WS_UTAB = 276 * MiB;
constexpr size_t WS_VTAB = 404 * MiB;
constexpr size_t DO_H1 = 0, DO_MEMN = 64 * MiB, DO_CSRET = 72 * MiB, DO_CSROT = 80 * MiB;

DI unsigned f2bf(float f) { unsigned u = __builtin_bit_cast(unsigned, f); return (u + 0x7fffu + ((u >> 16) & 1u)) >> 16; }
DI unsigned pk2(float lo, float hi) { f32x2 v = {lo, hi}; bf16x2_t b = __builtin_convertvector(v, bf16x2_t); return __builtin_bit_cast(unsigned, b); }
DI float bf_lo(unsigned w) { return __builtin_bit_cast(float, w << 16); }
DI float bf_hi(unsigned w) { return __builtin_bit_cast(float, w & 0xffff0000u); }
DI float wave_sum(float v) {
#pragma unroll
    for (int o = 1; o < 64; o <<= 1) v += __shfl_xor(v, o);
    return v;
}
#define LDS_WAIT() asm volatile("s_waitcnt lgkmcnt(0)" ::: "memory")
#define VM_WAIT() asm volatile("s_waitcnt vmcnt(0)" ::: "memory")
DI float fast_exp2(float x) { return __builtin_amdgcn_exp2f(x); }
DI float fast_rcp(float x) { return __builtin_amdgcn_rcpf(x); }
DI float sigmoid_f(float x) { return fast_rcp(1.f + fast_exp2(-1.4426950408889634f * x)); }

namespace pg8 {
constexpr int BM = 256, BK = 64, HALF = 128, HTB = HALF * BK * 2, STAGE_BYTES = 8 * HTB, NXCD = 8, WGM = 8;
__host__ __device__ __forceinline__ int lds_byte(int r, int c) { const int st = (r >> 4) * 2 + (c >> 5), rr = r & 15, cc = c & 31, ob = rr * 64 + cc * 2; return st * 1024 + (ob ^ (((ob >> 9) & 1) << 5)); }
__host__ __device__ __forceinline__ void stage_rc(int b, int& R, int& C) { const int st = b / 1024, sb = b % 1024, swz = sb ^ (((sb >> 9) & 1) << 5); R = (st >> 1) * 16 + swz / 64; C = (st & 1) * 32 + (swz % 64) / 2; }
__host__ __device__ __forceinline__ int perm32(int rho) { const int n = rho >> 4, i = rho & 15; return 8 * (i >> 2) + 4 * n + (i & 3); }

__device__ __forceinline__ void tile_of(int L, int nM, int nN, int& pm, int& pn) {
    const int nwg = nM * nN; int wgid = L;
    { const int q = nwg / NXCD, r = nwg % NXCD, xcd = wgid % NXCD, off = wgid / NXCD; wgid = (xcd < r ? xcd * (q + 1) : r * (q + 1) + (xcd - r) * q) + off; }
    const int nig = WGM * nN, gid = wgid / nig, fm = gid * WGM, gsz = (nM - fm) < WGM ? (nM - fm) : WGM;
    pm = fm + ((wgid % nig) % gsz); pn = (wgid % nig) / gsz;
}

template <class Epi, class Sched, bool ALIGN_EPI>
__device__ __forceinline__ void gemm_phase(LAS unsigned char* lds, const int K, const int lda, const int ldb, const Sched& S, const Epi& E) {
    typedef typename Sched::Unit Unit;
    const int tid = threadIdx.x, wid = __builtin_amdgcn_readfirstlane(tid >> 6), lane = tid & 63, wr = wid >> 2, wc = wid & 3, fr = lane & 15, fq = lane >> 4;
    const int nt = K / BK;
    unsigned voffA[2], voffB[2];
#pragma unroll
    for (int i = 0; i < 2; ++i) { int R, C; stage_rc(tid * 16 + i * 8192, R, C); const int Rb = (R & ~31) + perm32(R & 31);
        voffA[i] = (unsigned)(R * lda + C) * 2u; voffB[i] = (unsigned)(Rb * ldb + C) * 2u; }
    const size_t kstep = (size_t)(BK * 2);
    const size_t hstepA = (size_t)HALF * lda * 2, hstepB = (size_t)HALF * ldb * 2;
    const unsigned ldsw = (unsigned)wid * 1024u;
    const int aoff = lds_byte(wr * 64 + fr, fq * 8), boff = lds_byte(wc * 32 + fr, fq * 8);
#define PG8_SA(b, h) (((b) * 2 + (h)) * HTB)
#define PG8_SB(b, h) ((4 + (b) * 2 + (h)) * HTB)
#define PG8_STAGE(bufoff, gbase, voff) do { _Pragma("unroll") for (int _i = 0; _i < 2; ++_i) \
        __builtin_amdgcn_global_load_lds((const unsigned*)((const char*)(gbase) + (voff)[_i]), (LAS unsigned*)(lds + (bufoff) + ldsw + _i * 8192), 16, 0, 0); } while (0)
#define PG8_LDA(dst, b, h) do { _Pragma("unroll") for (int m = 0; m < 4; ++m) _Pragma("unroll") for (int k = 0; k < 2; ++k) dst[m][k] = *(const LAS bf16x8*)(lds + PG8_SA(b, h) + aoff + m * 2048 + k * 1024); } while (0)
#define PG8_LDB(dst, b, h) do { _Pragma("unroll") for (int n = 0; n < 2; ++n) _Pragma("unroll") for (int k = 0; k < 2; ++k) dst[n][k] = *(const LAS bf16x8*)(lds + PG8_SB(b, h) + boff + n * 2048 + k * 1024); } while (0)
#define PG8_MMA(ai, bj, At, Bt) do { __builtin_amdgcn_s_setprio(1); _Pragma("unroll") for (int m = 0; m < 4; ++m) _Pragma("unroll") for (int n = 0; n < 2; ++n) _Pragma("unroll") for (int k = 0; k < 2; ++k) \
        acc[ai][bj][m][n] = __builtin_amdgcn_mfma_f32_16x16x32_bf16(Bt[n][k], At[m][k], acc[ai][bj][m][n], 0, 0, 0); __builtin_amdgcn_s_setprio(0); } while (0)
#define PG8_WAIT_V(n) asm volatile("s_waitcnt vmcnt(" #n ")" ::: "memory")
#define PG8_WAIT_L(n) asm volatile("s_waitcnt lgkmcnt(" #n ")" ::: "memory")
#define PG8_BAR __builtin_amdgcn_s_barrier()
#define PG8_SCHED __builtin_amdgcn_sched_barrier(0)
    Unit cur, nxt; int ui = 0;
    if (!S.next(0, cur)) return;
    f32x4 acc[2][2][4][2];
#pragma unroll
    for (int a = 0; a < 2; ++a)
#pragma unroll
        for (int b = 0; b < 2; ++b)
#pragma unroll
            for (int m = 0; m < 4; ++m)
#pragma unroll
                for (int n = 0; n < 2; ++n) acc[a][b][m][n] = (f32x4){0.f, 0.f, 0.f, 0.f};
    bf16x8 At[4][2], B0[2][2], B1[2][2];
    const char* cA = cur.A; const char* cB = cur.B;
    PG8_STAGE(PG8_SB(0, 0), cB, voffB); PG8_STAGE(PG8_SB(0, 1), cB + hstepB, voffB); PG8_STAGE(PG8_SA(0, 0), cA, voffA); PG8_STAGE(PG8_SA(0, 1), cA + hstepA, voffA);
    if (wr == 1) PG8_BAR;
    PG8_WAIT_V(2); PG8_BAR;
    PG8_STAGE(PG8_SB(1, 0), cB + kstep, voffB); PG8_STAGE(PG8_SA(1, 0), cA + kstep, voffA); PG8_STAGE(PG8_SB(1, 1), cB + hstepB + kstep, voffB);
    PG8_WAIT_V(6); PG8_BAR;
    for (;;) {
        const bool has_next = S.next(ui + 1, nxt);
        const char* nA = has_next ? nxt.A : cA; const char* nB = has_next ? nxt.B : cB;
        for (int t = 0; t < nt; t += 2) {
            const bool last = (t == nt - 2);
            const char* a1 = cA + (size_t)(t + 1) * kstep;
            const char* a2 = last ? nA : cA + (size_t)(t + 2) * kstep; const char* b2 = last ? nB : cB + (size_t)(t + 2) * kstep;
            const char* a3 = a2 + kstep; const char* b3 = b2 + kstep;
            PG8_LDB(B0, 0, 0); PG8_LDB(B1, 0, 1); PG8_SCHED; PG8_LDA(At, 0, 0); PG8_STAGE(PG8_SA(1, 1), a1 + hstepA, voffA);
            PG8_WAIT_V(8); PG8_WAIT_L(0); PG8_BAR; PG8_MMA(0, 0, At, B0); PG8_MMA(0, 1, At, B1); PG8_BAR; PG8_SCHED;
            PG8_LDA(At, 0, 1); PG8_STAGE(PG8_SB(0, 0), b2, voffB); PG8_STAGE(PG8_SB(0, 1), b2 + hstepB, voffB); PG8_STAGE(PG8_SA(0, 0), a2, voffA);
            PG8_WAIT_V(8); PG8_WAIT_L(0); PG8_BAR; PG8_MMA(1, 0, At, B0); PG8_MMA(1, 1, At, B1); PG8_BAR; PG8_SCHED;
            PG8_LDB(B0, 1, 0); PG8_LDB(B1, 1, 1); PG8_SCHED; PG8_LDA(At, 1, 0); PG8_STAGE(PG8_SA(0, 1), a2 + hstepA, voffA);
            PG8_WAIT_V(8); PG8_WAIT_L(0); PG8_BAR; PG8_MMA(0, 0, At, B0); PG8_MMA(0, 1, At, B1); PG8_BAR; PG8_SCHED;
            PG8_LDA(At, 1, 1); PG8_STAGE(PG8_SB(1, 0), b3, voffB); PG8_STAGE(PG8_SB(1, 1), b3 + hstepB, voffB); PG8_STAGE(PG8_SA(1, 0), a3, voffA);
            PG8_WAIT_V(8); PG8_WAIT_L(0); PG8_BAR; PG8_MMA(1, 0, At, B0); PG8_MMA(1, 1, At, B1); PG8_BAR; PG8_SCHED;
        }
        if constexpr (ALIGN_EPI) { if (wr == 0) PG8_BAR; }
        E(acc, cur, wr, wc, fr, fq, wid, lane);
        if (!has_next) break;
#pragma unroll
        for (int a = 0; a < 2; ++a)
#pragma unroll
            for (int b = 0; b < 2; ++b)
#pragma unroll
                for (int m = 0; m < 4; ++m)
#pragma unroll
                    for (int n = 0; n < 2; ++n) acc[a][b][m][n] = (f32x4){0.f, 0.f, 0.f, 0.f};
        cur = nxt; cA = nA; cB = nB; ++ui;
        if constexpr (ALIGN_EPI) { if (wr == 1) PG8_BAR; }
    }
    PG8_WAIT_V(0);
    if constexpr (!ALIGN_EPI) { if (wr == 0) PG8_BAR; }
    PG8_BAR;
#undef PG8_SA
#undef PG8_SB
#undef PG8_STAGE
#undef PG8_LDA
#undef PG8_LDB
#undef PG8_MMA
#undef PG8_WAIT_V
#undef PG8_WAIT_L
#undef PG8_BAR
#undef PG8_SCHED
}
}

constexpr int RING_BYTES = 131072;
constexpr int LDSX_OFF = RING_BYTES;
constexpr int LDSCTL_OFF = RING_BYTES + 16384;
constexpr int LDS_BYTES = 163840;

typedef GAS unsigned gu32;
#define RLX_AGENT __ATOMIC_RELAXED, __HIP_MEMORY_SCOPE_AGENT

#define XB_TMO      128
#define XB_XCNT(j)  (256  + 64 * (j))
#define XB_XSUB(j)  (1280 + 64 * (j))
#define XB_XGEN(j)  (2304 + 64 * (j))
#define XB_TOP      3328
#define XB_TOPGEN   3392
#define XCD_BAR_WORDS 3456
#define XB_SPIN_CAP (1u << 20)
DI unsigned xb_ld(unsigned* p)              { return __hip_atomic_load(p, __ATOMIC_RELAXED, __HIP_MEMORY_SCOPE_AGENT); }
DI unsigned xb_add(unsigned* p, unsigned v) { return __hip_atomic_fetch_add(p, v, __ATOMIC_RELAXED, __HIP_MEMORY_SCOPE_AGENT); }
DI unsigned xb_xcc_id() { return (unsigned)__builtin_amdgcn_s_getreg((3 << 11) | 20) & 0xFu; }
#define XB_SPIN(cond, bar) do { unsigned _sp = 0; while (cond) { __builtin_amdgcn_s_sleep(1); \
    if ((++_sp & 255u) == 0u) { if (xb_ld(&(bar)[XB_TMO])) break; if (_sp > XB_SPIN_CAP) { atomicAdd(&(bar)[XB_TMO], 1u); break; } } } } while (0)
struct XcdBarrier { unsigned* bar; unsigned x; volatile LAS unsigned* st; };
DI XcdBarrier xcd_barrier_post(unsigned* bar, volatile LAS unsigned* st) {
    XcdBarrier b; b.bar = bar; b.x = xb_xcc_id(); b.st = st;
    if (threadIdx.x == 0) (void)xb_add(&bar[XB_XCNT(b.x)], 1u);
    return b;
}
DI void xcd_barrier_complete(unsigned* bar, unsigned x, unsigned& nloc, unsigned& nx) {
    const unsigned G = gridDim.x * gridDim.y * gridDim.z;
    unsigned sum, cnt, mine, sp = 0u;
    for (;;) {
        sum = 0u; cnt = 0u; mine = 0u;
#pragma unroll
        for (unsigned j = 0; j < 16; ++j) { const unsigned c = xb_ld(&bar[XB_XCNT(j)]); sum += c; cnt += (c > 0u) ? 1u : 0u; mine = (j == x) ? c : mine; }
        if (sum == G) break;
        __builtin_amdgcn_s_sleep(1);
        if ((++sp & 255u) == 0u) { if (xb_ld(&bar[XB_TMO])) break; if (sp > XB_SPIN_CAP) { atomicAdd(&bar[XB_TMO], 1u); break; } }
    }
    nloc = mine > 0u ? mine : 1u; nx = cnt > 0u ? cnt : 1u;
}
DI void xcd_barrier(const XcdBarrier& b) {
    asm volatile("s_waitcnt vmcnt(0)" ::: "memory");
    __syncthreads();
    if (threadIdx.x == 0) {
        unsigned* bar = b.bar;
        __builtin_amdgcn_s_waitcnt(0);
        unsigned nloc = b.st[0], nx = b.st[1];
        if (nloc == 0u) { xcd_barrier_complete(bar, b.x, nloc, nx); b.st[0] = nloc; b.st[1] = nx; }
        const unsigned old = xb_add(&bar[XB_XSUB(b.x)], 1u);
        const unsigned gen = old / nloc;
        if (old + 1u == (gen + 1u) * nloc) {
            __builtin_amdgcn_fence(__ATOMIC_RELEASE, "agent");
            asm volatile("s_waitcnt vmcnt(0)" ::: "memory");
            const unsigned og = xb_add(&bar[XB_TOP], 1u);
            const unsigned tg = og / nx;
            if (og + 1u == (tg + 1u) * nx) xb_add(&bar[XB_TOPGEN], 1u);
            else XB_SPIN(xb_ld(&bar[XB_TOPGEN]) == tg, bar);
            __builtin_amdgcn_fence(__ATOMIC_ACQUIRE, "agent");
            xb_add(&bar[XB_XGEN(b.x)], 1u);
            asm volatile("s_waitcnt vmcnt(0)" ::: "memory");
        } else {
            XB_SPIN(xb_ld(&bar[XB_XGEN(b.x)]) == gen, bar);
            __builtin_amdgcn_fence(__ATOMIC_ACQUIRE, "agent");
            asm volatile("s_waitcnt vmcnt(0)" ::: "memory");
        }
    }
    __syncthreads();
}

struct Args {
    const void* in[19]; float* out; unsigned char* ws; int ph_lo, ph_hi;
    double fret[64]; double frot[64];
};
struct Frame {
    LAS unsigned char* lds;
    int tid, lane, wave, G, bid;
    unsigned char* ws; unsigned char* dout;
};
enum { I_X = 0, I_MEM, I_POS, I_GMIX, I_WIN, I_WBR, I_WBD, I_WOUT, I_GCROSS, I_GMEM, I_WQ, I_WKV, I_WO, I_GFFN, I_WPQ, I_SUBK, I_PU, I_PV, I_GFINAL };

DI void tr_item(const float* W, int K, int N, bf16_t* WT, const float* scale, int rot_lo, int rot_hi, LAS float* scr, int item, int lane) {
    const int nblk = N / 32, kb = item / nblk, nb = item % nblk, k0 = 64 * kb, n0 = 32 * nb;
    const int nd = n0 + (lane & 31); int ns = nd;
    if (nd >= rot_lo && nd < rot_hi) { const int jj = nd & 127; ns = (nd - jj) + ((jj & 1) ? 64 : 0) + (jj >> 1); }
#pragma unroll 8
    for (int i = 0; i < 32; ++i) { const int kk = 2 * i + (lane >> 5); float w = W[(size_t)(k0 + kk) * N + ns]; if (scale) w *= scale[k0 + kk]; scr[kk * 33 + (lane & 31)] = w; }
    LDS_WAIT();
    const int c = lane & 7;
#pragma unroll
    for (int j = 0; j < 4; ++j) { const int n = (lane >> 3) + 8 * j; const LAS float* s = scr + (8 * c) * 33 + n;
        u32x4 o; o.x = pk2(s[0 * 33], s[1 * 33]); o.y = pk2(s[2 * 33], s[3 * 33]); o.z = pk2(s[4 * 33], s[5 * 33]); o.w = pk2(s[6 * 33], s[7 * 33]);
        *(GAS u32x4*)(WT + (size_t)(n0 + n) * K + k0 + 8 * c) = o; }
    LDS_WAIT();
}
DI void rms_row_bf16(const float* xrow, const float* g, bf16_t* orow, int lane) {
    const GAS f32x4* xr = (const GAS f32x4*)xrow + lane; const GAS f32x4* gr = (const GAS f32x4*)g + lane;
    f32x4 v[8]; float s = 0.f;
#pragma unroll
    for (int j = 0; j < 8; ++j) { v[j] = xr[64 * j]; s += (v[j].x * v[j].x + v[j].y * v[j].y) + (v[j].z * v[j].z + v[j].w * v[j].w); }
    const float rstd = 1.0f / sqrtf(wave_sum(s) * (1.f / DM) + EPS);
    GAS u32x2* o8 = (GAS u32x2*)orow + lane;
#pragma unroll
    for (int j = 0; j < 8; ++j) { const f32x4 gg = gr[64 * j]; u32x2 o; o.x = pk2(v[j].x * rstd * gg.x, v[j].y * rstd * gg.y); o.y = pk2(v[j].z * rstd * gg.z, v[j].w * rstd * gg.w); o8[64 * j] = o; }
}
DI void sincos_d(double a, float& c, float& s) {
    const double x = a * 0.63661977236758134308; const double q = __builtin_rint(x);
    double r = __builtin_fma(-q, 1.57079632679489655800, a); r = __builtin_fma(-q, 6.12323399573676603587e-17, r);
    const int qi = ((int)q) & 3; const double r2 = r * r;
    double sn = 1.0 / 6227020800.0; sn = sn * r2 - 1.0 / 39916800.0; sn = sn * r2 + 1.0 / 362880.0; sn = sn * r2 - 1.0 / 5040.0; sn = sn * r2 + 1.0 / 120.0; sn = sn * r2 - 1.0 / 6.0; sn = sn * r2 + 1.0; sn *= r;
    double cs = -1.0 / 87178291200.0; cs = cs * r2 + 1.0 / 479001600.0; cs = cs * r2 - 1.0 / 3628800.0; cs = cs * r2 + 1.0 / 40320.0; cs = cs * r2 - 1.0 / 720.0; cs = cs * r2 + 1.0 / 24.0; cs = cs * r2 - 0.5; cs = cs * r2 + 1.0;
    const double so = (qi == 0) ? sn : (qi == 1) ? cs : (qi == 2) ? -sn : -cs;
    const double co = (qi == 0) ? cs : (qi == 1) ? -sn : (qi == 2) ? -cs : sn;
    c = (float)co; s = (float)so;
}
DI void ph0_prologue(const Frame& F, const Args& a) {
    LAS float* scr = (LAS float*)(F.lds + F.wave * 8448);
    const int gw = F.bid * NWAVES + F.wave, NGW = F.G * NWAVES;
    unsigned char* ws = F.ws;
    constexpr int I_IN = (DM / 64) * (INW / 32), I_KV = (DM / 64) * (4096 / 32), I_BR = (1024 / 64) * (DM / 32), I_BD = (512 / 64) * (DM / 32), I_SQ = (DM / 64) * (DM / 32);
    constexpr int NITEMS = I_IN + I_KV + I_BR + I_BD + 4 * I_SQ;
    for (int it = gw; it < NITEMS; it += NGW) {
        int r = it;
        if (r < I_IN) { tr_item((const float*)a.in[I_WIN], DM, INW, (bf16_t*)(ws + WS_WIN_T), nullptr, 4096, 7168, scr, r, F.lane); continue; } r -= I_IN;
        if (r < I_KV) { tr_item((const float*)a.in[I_WKV], DM, 4096, (bf16_t*)(ws + WS_WKV_T), nullptr, 0, 0, scr, r, F.lane); continue; } r -= I_KV;
        if (r < I_BR) { tr_item((const float*)a.in[I_WBR], 1024, DM, (bf16_t*)(ws + WS_WBR_T), nullptr, 0, 0, scr, r, F.lane); continue; } r -= I_BR;
        if (r < I_BD) { tr_item((const float*)a.in[I_WBD], 512, DM, (bf16_t*)(ws + WS_WBD_T), nullptr, 0, 0, scr, r, F.lane); continue; } r -= I_BD;
        if (r < I_SQ) { tr_item((const float*)a.in[I_WOUT], DM, DM, (bf16_t*)(ws + WS_WOUT_T), nullptr, 0, 0, scr, r, F.lane); continue; } r -= I_SQ;
        if (r < I_SQ) { tr_item((const float*)a.in[I_WQ], DM, DM, (bf16_t*)(ws + WS_WQ_T), (const float*)a.in[I_GCROSS], 0, 0, scr, r, F.lane); continue; } r -= I_SQ;
        if (r < I_SQ) { tr_item((const float*)a.in[I_WO], DM, DM, (bf16_t*)(ws + WS_WO_T), nullptr, 0, 0, scr, r, F.lane); continue; } r -= I_SQ;
        tr_item((const float*)a.in[I_WPQ], DM, DM, (bf16_t*)(ws + WS_WPQ_T), (const float*)a.in[I_GFFN], 0, 0, scr, r, F.lane);
    }
    for (int m = gw; m < MT; m += NGW) rms_row_bf16((const float*)a.in[I_X] + (size_t)m * DM, (const float*)a.in[I_GMIX], (bf16_t*)(F.dout + DO_H1) + (size_t)m * DM, F.lane);
    for (int m = gw; m < MROWS; m += NGW) rms_row_bf16((const float*)a.in[I_MEM] + (size_t)m * DM, (const float*)a.in[I_GMEM], (bf16_t*)(F.dout + DO_MEMN) + (size_t)m * DM, F.lane);
    const int gt = F.bid * NTHREADS + F.tid, NGT = F.G * NTHREADS;
    for (int i = gt; i < 16 * 128 * 128 / 8; i += NGT) {
        const GAS f32x4* s = (const GAS f32x4*)a.in[I_SUBK] + 2 * (size_t)i; const f32x4 v0 = s[0], v1 = s[1];
        u32x4 o; o.x = pk2(v0.x, v0.y); o.y = pk2(v0.z, v0.w); o.z = pk2(v1.x, v1.y); o.w = pk2(v1.z, v1.w);
        ((GAS u32x4*)(ws + WS_SUBK))[i] = o;
    }
    for (int i = gt; i < MT * 64; i += NGT) {
        const int t = i >> 6, k = i & 63; const double pos = (double)((const int*)a.in[I_POS])[t];
        float c, s; sincos_d(pos * a.fret[k], c, s); ((GAS f32x2*)(F.dout + DO_CSRET))[i] = (f32x2){c, s};
        sincos_d(pos * a.frot[k], c, s); ((GAS f32x2*)(F.dout + DO_CSROT))[i] = (f32x2){c, s};
    }
}

struct Unit1 { const char* A; const char* B; int pm, pn; int mode; bf16_t* out; int ldo; float scale; const float* cs; };
struct Sched1 {
    typedef Unit1 Unit;
    int G, c; unsigned char* ws; unsigned char* dout;
    DI bool next(int i, Unit& u) const {
        const int L = i * G + c; if (L >= 3328) return false;
        if (L < 3200) {
            int pm, pn; pg8::tile_of(L, 64, 50, pm, pn); u.pm = pm; u.pn = pn;
            u.A = (const char*)(dout + DO_H1) + (size_t)pm * 256 * DM * 2; u.B = (const char*)(ws + WS_WIN_T) + (size_t)pn * 256 * DM * 2;
            u.scale = 1.f; u.cs = nullptr; u.mode = 0;
            const size_t rowoff = (size_t)pm * 256;
            if (pn < 4)       { u.mode = 1; u.out = (bf16_t*)(ws + WS_RQ) + rowoff * 1024 + (pn - 0) * 256; u.ldo = 1024; u.cs = (const float*)(dout + DO_CSRET); }
            else if (pn < 8)  { u.mode = 1; u.out = (bf16_t*)(ws + WS_RK) + rowoff * 1024 + (pn - 4) * 256; u.ldo = 1024; u.cs = (const float*)(dout + DO_CSRET); u.scale = 0.08838834764831845f; }
            else if (pn < 12) { u.out = (bf16_t*)(ws + WS_RV) + rowoff * 1024 + (pn - 8) * 256; u.ldo = 1024; }
            else if (pn < 16) { u.mode = 2; u.out = (bf16_t*)(ws + WS_SG) + rowoff * 1024 + (pn - 12) * 256; u.ldo = 1024; }
            else if (pn < 22) { u.mode = 1; u.out = (bf16_t*)(ws + WS_DQ) + rowoff * 1536 + (pn - 16) * 256; u.ldo = 1536; u.cs = (const float*)(dout + DO_CSROT); u.scale = 0.08838834764831845f * 1.4426950408889634f; }
            else if (pn < 28) { u.mode = 1; u.out = (bf16_t*)(ws + WS_DK) + rowoff * 1536 + (pn - 22) * 256; u.ldo = 1536; u.cs = (const float*)(dout + DO_CSROT); }
            else if (pn < 34) { u.out = (bf16_t*)(ws + WS_DV) + rowoff * 1536 + (pn - 28) * 256; u.ldo = 1536; }
            else if (pn < 42) { u.mode = 3; u.out = (bf16_t*)(ws + WS_GR) + rowoff * 2048 + (pn - 34) * 256; u.ldo = 2048; }
            else              { u.mode = 3; u.out = (bf16_t*)(ws + WS_GD) + rowoff * 2048 + (pn - 42) * 256; u.ldo = 2048; }
        } else {
            const int l = L - 3200; u.mode = 0; u.scale = 1.f; u.cs = nullptr; u.ldo = 2048;
            if (l < 64) { const int pm = l >> 3, pn = l & 7; u.pm = pm; u.pn = pn;
                u.A = (const char*)(dout + DO_MEMN) + (size_t)pm * 256 * DM * 2; u.B = (const char*)(ws + WS_WKV_T) + (size_t)pn * 256 * DM * 2;
                u.out = (bf16_t*)(ws + WS_KM) + (size_t)pm * 256 * 2048 + pn * 256; }
            else { const int l2 = l - 64, pm = l2 >> 3, pn = l2 & 7; u.pm = pm; u.pn = pn;
                u.A = (const char*)(ws + WS_WKV_T) + (size_t)(2048 + pm * 256) * DM * 2; u.B = (const char*)(dout + DO_MEMN) + (size_t)pn * 256 * DM * 2;
                u.out = (bf16_t*)(ws + WS_VT) + (size_t)pm * 256 * 2048 + pn * 256; }
        }
        return true;
    }
};
struct EpiProj {
    template <int MODE> DI void emit(const f32x4 (&acc)[2][2][4][2], const Unit1& u, int wr, int wc, int fr, int fq) const {
        const int rowl0 = wr * 64 + fr, colb = wc * 32 + 8 * fq;
#pragma unroll
        for (int ai = 0; ai < 2; ++ai)
#pragma unroll
            for (int m = 0; m < 4; ++m) {
                const int rl = ai * 128 + m * 16 + rowl0;
                f32x4 cs0 = {1.f, 0.f, 1.f, 0.f}, cs1 = cs0;
                if (MODE == 1) { const GAS f32x4* cp = (const GAS f32x4*)(u.cs + ((size_t)(u.pm * 256 + rl) * 64 + (colb >> 1)) * 2); cs0 = cp[0]; cs1 = cp[1]; }
                bf16_t* rowp = u.out + (size_t)rl * u.ldo + colb;
#pragma unroll
                for (int bj = 0; bj < 2; ++bj) {
                    f32x4 v0 = acc[ai][bj][m][0], v1 = acc[ai][bj][m][1];
                    if (MODE == 1) {
                        const f32x4 a0 = v0, a1 = v1; const float sc = u.scale;
                        v0.x = (a0.x * cs0.x - a0.y * cs0.y) * sc; v0.y = (a0.y * cs0.x + a0.x * cs0.y) * sc;
                        v0.z = (a0.z * cs0.z - a0.w * cs0.w) * sc; v0.w = (a0.w * cs0.z + a0.z * cs0.w) * sc;
                        v1.x = (a1.x * cs1.x - a1.y * cs1.y) * sc; v1.y = (a1.y * cs1.x + a1.x * cs1.y) * sc;
                        v1.z = (a1.z * cs1.z - a1.w * cs1.w) * sc; v1.w = (a1.w * cs1.z + a1.z * cs1.w) * sc;
                    } else if (MODE == 2) {
#pragma unroll
                        for (int e = 0; e < 4; ++e) { v0[e] = v0[e] * sigmoid_f(v0[e]); v1[e] = v1[e] * sigmoid_f(v1[e]); }
                    } else if (MODE == 3) {
#pragma unroll
                        for (int e = 0; e < 4; ++e) { v0[e] = sigmoid_f(v0[e]); v1[e] = sigmoid_f(v1[e]); }
                    }
                    u32x4 w; w.x = pk2(v0.x, v0.y); w.y = pk2(v0.z, v0.w); w.z = pk2(v1.x, v1.y); w.w = pk2(v1.z, v1.w);
                    *(GAS u32x4*)(rowp + bj * 128) = w;
                }
            }
    }
    DI void operator()(const f32x4 (&acc)[2][2][4][2], const Unit1& u, int wr, int wc, int fr, int fq, int wid, int lane) const {
        if (u.mode == 0) emit<0>(acc, u, wr, wc, fr, fq);
        else if (u.mode == 1) emit<1>(acc, u, wr, wc, fr, fq);
        else if (u.mode == 2) emit<2>(acc, u, wr, wc, fr, fq);
        else emit<3>(acc, u, wr, wc, fr, fq);
    }
};

#define MFMA32(a, b, c) __builtin_amdgcn_mfma_f32_32x32x16_bf16((a), (b), (c), 0, 0, 0)
DI int crow(int reg, int h) { return (reg & 3) + 8 * (reg >> 2) + 4 * h; }
DI s16x4 tr4(LAS const unsigned char* p) { return __builtin_bit_cast(s16x4, __builtin_amdgcn_ds_read_tr16_b64_v4i16((LAS v4i16_t*)p)); }
DI bf16x8 frag_tr(LAS const unsigned char* base, int pitch, int k0, int c0, int lane) {
    const int h = lane >> 5, blk = (lane >> 4) & 1, q = (lane & 15) >> 2, p = lane & 3;
    LAS const unsigned char* a = base + (k0 + 8 * h + q) * pitch + (c0 + 16 * blk + 4 * p) * 2;
    const s16x4 lo = tr4(a), hi = tr4(a + 4 * pitch);
    return __builtin_shufflevector(lo, hi, 0, 1, 2, 3, 4, 5, 6, 7);
}
DI bf16x8 frag_nt(LAS const unsigned char* base, int pitch, int r0, int k0, int lane) {
    return *(LAS const bf16x8*)(base + (r0 + (lane & 31)) * pitch + (k0 + 8 * (lane >> 5)) * 2);
}
DI f32x16 zero16() { f32x16 z;
#pragma unroll
    for (int i = 0; i < 16; ++i) z[i] = 0.f; return z; }
DI u32x4 scale_bf16x8(u32x4 v, float s) {
    u32x4 o; o.x = pk2(bf_lo(v.x) * s, bf_hi(v.x) * s); o.y = pk2(bf_lo(v.y) * s, bf_hi(v.y) * s); o.z = pk2(bf_lo(v.z) * s, bf_hi(v.z) * s); o.w = pk2(bf_lo(v.w) * s, bf_hi(v.w) * s); return o;
}
DI float ret_lg2gamma(int h) { return __builtin_log2f(1.0f - __builtin_exp2f(-5.0f - (float)h)); }

DI void ret_kv_item(const Frame& F, int bh, int n) {
    const int b = bh >> 3, h = bh & 7; const float lg = ret_lg2gamma(h);
    LAS unsigned char* VL = F.lds; LAS unsigned char* KL = F.lds + 128 * 320;
    const bf16_t* RK = (const bf16_t*)(F.ws + WS_RK); const bf16_t* RV = (const bf16_t*)(F.ws + WS_RV);
#pragma unroll
    for (int it = 0; it < 8; ++it) {
        const int idx = F.tid + NTHREADS * it, which = idx >> 11, rem = idx & 2047, row = rem >> 4, ch = rem & 15;
        const size_t tok = (size_t)b * SEQ + n * 128 + row;
        u32x4 v = *(const GAS u32x4*)((which ? RK : RV) + tok * 1024 + h * 128 + ch * 8);
        if (which) v = scale_bf16x8(v, fast_exp2(lg * (float)(127 - row)));
        *(LAS u32x4*)((which ? KL : VL) + row * 320 + ch * 16) = v;
    }
    __syncthreads();
    const int w = F.wave, lane = F.lane, eb = w >> 1, db0 = 2 * (w & 1);
    f32x16 acc0 = zero16(), acc1 = zero16();
#pragma unroll
    for (int s = 0; s < 8; ++s) {
        const bf16x8 a = frag_tr(VL, 320, 16 * s, 32 * eb, lane);
        const bf16x8 b0 = frag_tr(KL, 320, 16 * s, 32 * db0, lane), b1 = frag_tr(KL, 320, 16 * s, 32 * (db0 + 1), lane);
        acc0 = MFMA32(a, b0, acc0); acc1 = MFMA32(a, b1, acc1);
    }
    float* dst = (float*)(F.ws + WS_KVST) + ((size_t)(bh * 16 + n) * 128) * 128;
    const int r = lane & 31, hh = lane >> 5;
#pragma unroll
    for (int reg = 0; reg < 16; ++reg) { const int e = 32 * eb + crow(reg, hh);
        dst[(size_t)e * 128 + 32 * db0 + r] = acc0[reg]; dst[(size_t)e * 128 + 32 * (db0 + 1) + r] = acc1[reg]; }
    __syncthreads();
}

DI void dil_item(const Frame& F, int b, int head, int idx16) {
    const int g = head >> 2, r = (g == 0) ? 1 : (g == 1) ? 4 : 16, nbk = 16 / r, c = idx16 / nbk, n = idx16 % nbk;
    LAS unsigned char* VL = F.lds;
    LAS unsigned char* PL = F.lds + 256 * 320;
    LAS float* SMAX = (LAS float*)(F.lds + 256 * 320 + 128 * 528);
    LAS float* SSUM = SMAX + 256;
    bf16_t* DQ = (bf16_t*)(F.ws + WS_DQ); const bf16_t* DK = (const bf16_t*)(F.ws + WS_DK); const bf16_t* DV = (const bf16_t*)(F.ws + WS_DV);
    const size_t tb = (size_t)b * SEQ;
    const int kbmin = (n == 0) ? 4 : 0;
#pragma unroll
    for (int it = 0; it < 8; ++it) {
        const int idx = F.tid + NTHREADS * it, row = idx >> 4, ch = idx & 15;
        if (row >= 32 * kbmin) {
            const size_t tok = tb + (size_t)((128 * (n - 1) + row) * r + c);
            *(LAS u32x4*)(VL + row * 320 + ch * 16) = *(const GAS u32x4*)(DV + tok * 1536 + head * 128 + ch * 8);
        }
    }
    const int lane = F.lane, rr = lane & 31, hh = lane >> 5, wq = F.wave & 3, wd = F.wave >> 2;
    const int qi = 32 * wq + rr;
    const size_t tokq = tb + (size_t)((128 * n + qi) * r + c);
    bf16x8 qf[8];
    { const bf16_t* qp = DQ + tokq * 1536 + head * 128 + 8 * hh;
#pragma unroll
      for (int s = 0; s < 8; ++s) qf[s] = *(const GAS bf16x8*)(qp + 16 * s); }
    f32x16 st[3]; bool val[3]; float mloc = -INFINITY;
#pragma unroll
    for (int sl = 0; sl < 3; ++sl) {
        const int kb = wq + wd + 2 * sl; val[sl] = (kb <= wq + 4) && (kb >= kbmin);
        st[sl] = zero16();
        if (val[sl]) {
            const size_t tokk = tb + (size_t)((128 * (n - 1) + 32 * kb + rr) * r + c);
            const bf16_t* kp = DK + tokk * 1536 + head * 128 + 8 * hh;
            bf16x8 kf[8];
#pragma unroll
            for (int s = 0; s < 8; ++s) kf[s] = *(const GAS bf16x8*)(kp + 16 * s);
#pragma unroll
            for (int s = 0; s < 8; ++s) st[sl] = MFMA32(kf[s], qf[s], st[sl]);
#pragma unroll
            for (int reg = 0; reg < 16; ++reg) { const int jj = 32 * kb + crow(reg, hh); const bool ok = (jj >= qi) && (jj <= qi + 128);
                st[sl][reg] = ok ? st[sl][reg] : -INFINITY; mloc = fmaxf(mloc, st[sl][reg]); }
        }
    }
    mloc = fmaxf(mloc, __shfl_xor(mloc, 32));
    if (hh == 0) SMAX[wd * 128 + qi] = mloc;
    __syncthreads();
    const float mx = fmaxf(SMAX[qi], SMAX[128 + qi]);
    float lloc = 0.f;
#pragma unroll
    for (int sl = 0; sl < 3; ++sl) {
        if (val[sl]) { const int kb = wq + wd + 2 * sl;
#pragma unroll
            for (int reg = 0; reg < 16; ++reg) { const float p = fast_exp2(st[sl][reg] - mx); st[sl][reg] = p; lloc += p; }
#pragma unroll
            for (int g4 = 0; g4 < 4; ++g4) { u32x2 w; w.x = pk2(st[sl][4 * g4], st[sl][4 * g4 + 1]); w.y = pk2(st[sl][4 * g4 + 2], st[sl][4 * g4 + 3]);
                *(LAS u32x2*)(PL + qi * 528 + (32 * kb + 8 * g4 + 4 * hh) * 2) = w; }
        }
    }
    lloc += __shfl_xor(lloc, 32);
    if (hh == 0) SSUM[wd * 128 + qi] = lloc;
    __syncthreads();
    const float lsum = SSUM[qi] + SSUM[128 + qi];
    f32x16 o0 = zero16(), o1 = zero16();
    const int kb_lo = (wq > kbmin) ? wq : kbmin;
    for (int kb = kb_lo; kb <= wq + 4; ++kb) {
#pragma unroll
        for (int s = 0; s < 2; ++s) {
            const bf16x8 pb = frag_nt(PL, 528, 32 * wq, 32 * kb + 16 * s, lane);
            const bf16x8 a0 = frag_tr(VL, 320, 32 * kb + 16 * s, 64 * wd, lane), a1 = frag_tr(VL, 320, 32 * kb + 16 * s, 64 * wd + 32, lane);
            o0 = MFMA32(a0, pb, o0); o1 = MFMA32(a1, pb, o1);
        }
    }
    const float inv = 1.0f / lsum;
    bf16_t* op = DQ + tokq * 1536 + head * 128 + 64 * wd + 4 * hh;
#pragma unroll
    for (int g4 = 0; g4 < 4; ++g4) {
        u32x2 w0, w1; w0.x = pk2(o0[4 * g4] * inv, o0[4 * g4 + 1] * inv); w0.y = pk2(o0[4 * g4 + 2] * inv, o0[4 * g4 + 3] * inv);
        w1.x = pk2(o1[4 * g4] * inv, o1[4 * g4 + 1] * inv); w1.y = pk2(o1[4 * g4 + 2] * inv, o1[4 * g4 + 3] * inv);
        *(GAS u32x2*)(op + 8 * g4) = w0; *(GAS u32x2*)(op + 32 + 8 * g4) = w1;
    }
    if (wd == 0 && hh == 0) ((float*)(F.ws + WS_LSE))[(size_t)head * MT + tokq] = mx + __builtin_log2f(lsum);
    __syncthreads();
}

DI void ph2_mixers_a(const Frame& F) {
    for (int it = F.bid; it < 1024; it += F.G) ret_kv_item(F, it >> 4, it & 15);
    for (int it = F.bid; it < 1536; it += F.G) { const int b = it / 192, rem = it % 192; dil_item(F, b, rem >> 4, rem & 15); }
}

DI void ret_out_item(const Frame& F, int bh, int n) {
    const int b = bh >> 3, h = bh & 7; const float lg = ret_lg2gamma(h);
    LAS unsigned char* VL = F.lds;
    LAS unsigned char* PL = F.lds + 128 * 320;
    LAS unsigned char* PT = PL + 128 * 272;
    LAS float* SQ = (LAS float*)(PT + 128 * 272);
    bf16_t* RQ = (bf16_t*)(F.ws + WS_RQ); const bf16_t* RK = (const bf16_t*)(F.ws + WS_RK); const bf16_t* RV = (const bf16_t*)(F.ws + WS_RV); const bf16_t* SG = (const bf16_t*)(F.ws + WS_SG);
    const size_t tb = (size_t)b * SEQ + n * 128;
#pragma unroll
    for (int it = 0; it < 4; ++it) { const int idx = F.tid + NTHREADS * it, row = idx >> 4, ch = idx & 15;
        *(LAS u32x4*)(VL + row * 320 + ch * 16) = *(const GAS u32x4*)(RV + (tb + row) * 1024 + h * 128 + ch * 8); }
    { const float* kv = (const float*)(F.ws + WS_KVST) + (size_t)(bh * 16) * 16384;
#pragma unroll
      for (int it = 0; it < 8; ++it) { const int idx = F.tid + NTHREADS * it, e = idx >> 5, c4 = idx & 31;
          f32x4 acc = {0.f, 0.f, 0.f, 0.f};
          for (int m = 0; m < n; ++m) { const float wgt = fast_exp2(lg * 128.0f * (float)(n - 1 - m)); const f32x4 v = *(const GAS f32x4*)(kv + (size_t)m * 16384 + e * 128 + c4 * 4); acc += v * wgt; }
          u32x2 w; w.x = pk2(acc.x, acc.y); w.y = pk2(acc.z, acc.w);
          *(LAS u32x2*)(PT + e * 272 + c4 * 8) = w; } }
    const int lane = F.lane, rr = lane & 31, hh = lane >> 5, wq = F.wave & 3, we = F.wave >> 2;
    const int qi = 32 * wq + rr;
    bf16x8 qf[8];
    { const bf16_t* qp = RQ + (tb + qi) * 1024 + h * 128 + 8 * hh;
#pragma unroll
      for (int s = 0; s < 8; ++s) qf[s] = *(const GAS bf16x8*)(qp + 16 * s); }
#pragma unroll
    for (int sl = 0; sl < 2; ++sl) {
        const int kb = we + 2 * sl;
        if (kb <= wq) {
            const bf16_t* kp = RK + (tb + 32 * kb + rr) * 1024 + h * 128 + 8 * hh;
            bf16x8 kf[8];
#pragma unroll
            for (int s = 0; s < 8; ++s) kf[s] = *(const GAS bf16x8*)(kp + 16 * s);
            f32x16 st = zero16();
#pragma unroll
            for (int s = 0; s < 8; ++s) st = MFMA32(kf[s], qf[s], st);
#pragma unroll
            for (int reg = 0; reg < 16; ++reg) { const int j = 32 * kb + crow(reg, hh); st[reg] = (j <= qi) ? st[reg] * fast_exp2(lg * (float)(qi - j)) : 0.f; }
#pragma unroll
            for (int g4 = 0; g4 < 4; ++g4) { u32x2 w; w.x = pk2(st[4 * g4], st[4 * g4 + 1]); w.y = pk2(st[4 * g4 + 2], st[4 * g4 + 3]);
                *(LAS u32x2*)(PL + qi * 272 + (32 * kb + 8 * g4 + 4 * hh) * 2) = w; }
        }
    }
    __syncthreads();
    f32x16 in0 = zero16(), in1 = zero16(), cr0 = zero16(), cr1 = zero16();
    for (int kb = 0; kb <= wq; ++kb) {
#pragma unroll
        for (int s = 0; s < 2; ++s) {
            const bf16x8 pb = frag_nt(PL, 272, 32 * wq, 32 * kb + 16 * s, lane);
            const bf16x8 a0 = frag_tr(VL, 320, 32 * kb + 16 * s, 64 * we, lane), a1 = frag_tr(VL, 320, 32 * kb + 16 * s, 64 * we + 32, lane);
            in0 = MFMA32(a0, pb, in0); in1 = MFMA32(a1, pb, in1);
        }
    }
#pragma unroll
    for (int s = 0; s < 8; ++s) {
        const bf16x8 a0 = frag_nt(PT, 272, 64 * we, 16 * s, lane), a1 = frag_nt(PT, 272, 64 * we + 32, 16 * s, lane);
        cr0 = MFMA32(a0, qf[s], cr0); cr1 = MFMA32(a1, qf[s], cr1);
    }
    const float qw = fast_exp2(lg * (float)(qi + 1));
    float ss = 0.f;
#pragma unroll
    for (int reg = 0; reg < 16; ++reg) { in0[reg] += qw * cr0[reg]; in1[reg] += qw * cr1[reg]; ss += in0[reg] * in0[reg] + in1[reg] * in1[reg]; }
    ss += __shfl_xor(ss, 32);
    if (hh == 0) SQ[we * 128 + qi] = ss;
    __syncthreads();
    const float rstd = 1.0f / sqrtf((SQ[qi] + SQ[128 + qi]) * (1.0f / 128.0f) + EPS);
    const size_t off = (tb + qi) * 1024 + h * 128 + 64 * we + 4 * hh;
#pragma unroll
    for (int g4 = 0; g4 < 4; ++g4) {
        const u32x2 g0 = *(const GAS u32x2*)(SG + off + 8 * g4), g1 = *(const GAS u32x2*)(SG + off + 32 + 8 * g4);
        u32x2 w0, w1;
        w0.x = pk2(in0[4 * g4] * rstd * bf_lo(g0.x), in0[4 * g4 + 1] * rstd * bf_hi(g0.x)); w0.y = pk2(in0[4 * g4 + 2] * rstd * bf_lo(g0.y), in0[4 * g4 + 3] * rstd * bf_hi(g0.y));
        w1.x = pk2(in1[4 * g4] * rstd * bf_lo(g1.x), in1[4 * g4 + 1] * rstd * bf_hi(g1.x)); w1.y = pk2(in1[4 * g4 + 2] * rstd * bf_lo(g1.y), in1[4 * g4 + 3] * rstd * bf_hi(g1.y));
        *(GAS u32x2*)(RQ + off + 8 * g4) = w0; *(GAS u32x2*)(RQ + off + 32 + 8 * g4) = w1;
    }
    __syncthreads();
}
DI void ph3_mixers_b(const Frame& F) {
    for (int it = F.bid; it < 1024; it += F.G) ret_out_item(F, it >> 4, it & 15);
    bf16_t* DQ = (bf16_t*)(F.ws + WS_DQ); const float* LSE = (const float*)(F.ws + WS_LSE);
    const int gt = F.bid * NTHREADS + F.tid, NGT = F.G * NTHREADS;
    for (int i = gt; i < MT * 64; i += NGT) {
        const int t = i >> 6, hg = (i >> 4) & 3, ch = i & 15;
        const float l0 = LSE[(size_t)hg * MT + t], l1 = LSE[(size_t)(4 + hg) * MT + t], l2 = LSE[(size_t)(8 + hg) * MT + t];
        const float mx = fmaxf(l0, fmaxf(l1, l2)); float w0 = fast_exp2(l0 - mx), w1 = fast_exp2(l1 - mx), w2 = fast_exp2(l2 - mx);
        const float inv = 1.0f / (w0 + w1 + w2); w0 *= inv; w1 *= inv; w2 *= inv;
        bf16_t* p = DQ + (size_t)t * 1536 + hg * 128 + ch * 8;
        const u32x4 a = *(const GAS u32x4*)p, bq = *(const GAS u32x4*)(p + 512), cq = *(const GAS u32x4*)(p + 1024);
        u32x4 o;
        o.x = pk2(w0 * bf_lo(a.x) + w1 * bf_lo(bq.x) + w2 * bf_lo(cq.x), w0 * bf_hi(a.x) + w1 * bf_hi(bq.x) + w2 * bf_hi(cq.x));
        o.y = pk2(w0 * bf_lo(a.y) + w1 * bf_lo(bq.y) + w2 * bf_lo(cq.y), w0 * bf_hi(a.y) + w1 * bf_hi(bq.y) + w2 * bf_hi(cq.y));
        o.z = pk2(w0 * bf_lo(a.z) + w1 * bf_lo(bq.z) + w2 * bf_lo(cq.z), w0 * bf_hi(a.z) + w1 * bf_hi(bq.z) + w2 * bf_hi(cq.z));
        o.w = pk2(w0 * bf_lo(a.w) + w1 * bf_lo(bq.w) + w2 * bf_lo(cq.w), w0 * bf_hi(a.w) + w1 * bf_hi(bq.w) + w2 * bf_hi(cq.w));
        *(GAS u32x4*)p = o;
    }
}

struct UnitG { const char* A; const char* B; int pm, pn; };
struct SchedG {
    typedef UnitG Unit;
    int G, c, nM, nN; const char* Abase; const char* Bbase; size_t astep, bstep;
    DI bool next(int i, Unit& u) const {
        const int L = i * G + c; if (L >= nM * nN) return false;
        int pm, pn; pg8::tile_of(L, nM, nN, pm, pn); u.pm = pm; u.pn = pn;
        u.A = Abase + (size_t)pm * astep; u.B = Bbase + (size_t)pn * bstep; return true;
    }
};
#define EPI_ROWS_BEGIN const int rowl0 = wr * 64 + fr, colb = wc * 32 + 8 * fq; _Pragma("unroll") for (int ai = 0; ai < 2; ++ai) _Pragma("unroll") for (int m = 0; m < 4; ++m) { const int rl = ai * 128 + m * 16 + rowl0;
#define EPI_ROWS_END }
DI u32x4 pack8(const f32x4 v0, const f32x4 v1) { u32x4 w; w.x = pk2(v0.x, v0.y); w.y = pk2(v0.z, v0.w); w.z = pk2(v1.x, v1.y); w.w = pk2(v1.z, v1.w); return w; }
DI void unpack8(const u32x4 w, f32x4& v0, f32x4& v1) { v0 = (f32x4){bf_lo(w.x), bf_hi(w.x), bf_lo(w.y), bf_hi(w.y)}; v1 = (f32x4){bf_lo(w.z), bf_hi(w.z), bf_lo(w.w), bf_hi(w.w)}; }

template <int PASS> struct EpiMerge {
    bf16_t* GR; bf16_t* GD;
    DI void operator()(const f32x4 (&acc)[2][2][4][2], const UnitG& u, int wr, int wc, int fr, int fq, int wid, int lane) const {
        EPI_ROWS_BEGIN
            const size_t off = (size_t)(u.pm * 256 + rl) * 2048 + u.pn * 256 + colb;
#pragma unroll
            for (int bj = 0; bj < 2; ++bj) {
                f32x4 g0, g1; unpack8(*(const GAS u32x4*)(GR + off + bj * 128), g0, g1);
                if (PASS == 0) { *(GAS u32x4*)(GR + off + bj * 128) = pack8(g0 * acc[ai][bj][m][0], g1 * acc[ai][bj][m][1]); }
                else { f32x4 d0, d1; unpack8(*(const GAS u32x4*)(GD + off + bj * 128), d0, d1);
                    *(GAS u32x4*)(GD + off + bj * 128) = pack8(g0 + d0 * acc[ai][bj][m][0], g1 + d1 * acc[ai][bj][m][1]); }
            }
        EPI_ROWS_END
    }
};
struct EpiResid {
    const float* xold; float* XF; bf16_t* XB; float* SSQ;
    DI void operator()(const f32x4 (&acc)[2][2][4][2], const UnitG& u, int wr, int wc, int fr, int fq, int wid, int lane) const {
        EPI_ROWS_BEGIN
            const size_t t = (size_t)(u.pm * 256 + rl); const size_t off = t * 2048 + u.pn * 256 + colb;
            float ss = 0.f;
#pragma unroll
            for (int bj = 0; bj < 2; ++bj) {
                const f32x4 x0 = *(const GAS f32x4*)(xold + off + bj * 128), x1 = *(const GAS f32x4*)(xold + off + bj * 128 + 4);
                const f32x4 y0 = x0 + acc[ai][bj][m][0], y1 = x1 + acc[ai][bj][m][1];
                *(GAS f32x4*)(XF + off + bj * 128) = y0; *(GAS f32x4*)(XF + off + bj * 128 + 4) = y1;
                *(GAS u32x4*)(XB + off + bj * 128) = pack8(y0, y1);
                ss += (y0.x * y0.x + y0.y * y0.y) + (y0.z * y0.z + y0.w * y0.w) + (y1.x * y1.x + y1.y * y1.y) + (y1.z * y1.z + y1.w * y1.w);
            }
            ss += __shfl_xor(ss, 16); ss += __shfl_xor(ss, 32);
            if (fq == 0) SSQ[t * 32 + u.pn * 4 + wc] = ss;
        EPI_ROWS_END
    }
};
struct EpiRowScale {
    const float* SSQ; bf16_t* out; float scale;
    DI void operator()(const f32x4 (&acc)[2][2][4][2], const UnitG& u, int wr, int wc, int fr, int fq, int wid, int lane) const {
        EPI_ROWS_BEGIN
            const size_t t = (size_t)(u.pm * 256 + rl); const size_t off = t * 2048 + u.pn * 256 + colb;
            const f32x4 p0 = *(const GAS f32x4*)(SSQ + t * 32 + fq * 8), p1 = *(const GAS f32x4*)(SSQ + t * 32 + fq * 8 + 4);
            float ss = (p0.x + p0.y) + (p0.z + p0.w) + (p1.x + p1.y) + (p1.z + p1.w);
            ss += __shfl_xor(ss, 16); ss += __shfl_xor(ss, 32);
            const float sc = scale / sqrtf(ss * (1.0f / 2048.0f) + EPS);
#pragma unroll
            for (int bj = 0; bj < 2; ++bj) *(GAS u32x4*)(out + off + bj * 128) = pack8(acc[ai][bj][m][0] * sc, acc[ai][bj][m][1] * sc);
        EPI_ROWS_END
    }
};
struct Sched7 {
    typedef UnitG Unit; int G, c; const char* QM; const char* KM;
    DI bool next(int i, Unit& u) const {
        const int L = i * G + c; if (L >= 256) return false;
        const int bh = L >> 3, pm = L & 7, b = bh >> 2, hd = bh & 3; u.pm = L; u.pn = 0;
        u.A = QM + ((size_t)(b * SEQ + pm * 256) * 2048 + hd * 512) * 2; u.B = KM + ((size_t)(b * MEMT) * 2048 + hd * 512) * 2; return true;
    }
};
struct EpiSoftmax {
    bf16_t* P; LAS float* X;
    DI void operator()(f32x4 (&acc)[2][2][4][2], const UnitG& u, int wr, int wc, int fr, int fq, int wid, int lane) const {
        LAS float* MX = X; LAS float* SM = X + 1024;
        EPI_ROWS_BEGIN
            float mx = -INFINITY;
#pragma unroll
            for (int bj = 0; bj < 2; ++bj)
#pragma unroll
                for (int n = 0; n < 2; ++n) { const f32x4 v = acc[ai][bj][m][n]; mx = fmaxf(mx, fmaxf(fmaxf(v.x, v.y), fmaxf(v.z, v.w))); }
            mx = fmaxf(mx, __shfl_xor(mx, 16)); mx = fmaxf(mx, __shfl_xor(mx, 32));
            if (fq == 0) MX[rl * 4 + wc] = mx;
        EPI_ROWS_END
        asm volatile("s_waitcnt lgkmcnt(0)" ::: "memory"); __builtin_amdgcn_s_barrier(); asm volatile("" ::: "memory");
        {
        EPI_ROWS_BEGIN
            const f32x4 q = *(LAS f32x4*)(MX + rl * 4); const float mx = fmaxf(fmaxf(q.x, q.y), fmaxf(q.z, q.w));
            float s = 0.f;
#pragma unroll
            for (int bj = 0; bj < 2; ++bj)
#pragma unroll
                for (int n = 0; n < 2; ++n) { f32x4 v = acc[ai][bj][m][n]; v.x = fast_exp2(v.x - mx); v.y = fast_exp2(v.y - mx); v.z = fast_exp2(v.z - mx); v.w = fast_exp2(v.w - mx);
                    acc[ai][bj][m][n] = v; s += (v.x + v.y) + (v.z + v.w); }
            s += __shfl_xor(s, 16); s += __shfl_xor(s, 32);
            if (fq == 0) SM[rl * 4 + wc] = s;
        EPI_ROWS_END
        }
        asm volatile("s_waitcnt lgkmcnt(0)" ::: "memory"); __builtin_amdgcn_s_barrier(); asm volatile("" ::: "memory");
        {
        EPI_ROWS_BEGIN
            const f32x4 q = *(LAS f32x4*)(SM + rl * 4); const float inv = 1.0f / ((q.x + q.y) + (q.z + q.w));
            bf16_t* rowp = P + (size_t)(u.pm * 256 + rl) * 256 + colb;
#pragma unroll
            for (int bj = 0; bj < 2; ++bj) *(GAS u32x4*)(rowp + bj * 128) = pack8(acc[ai][bj][m][0] * inv, acc[ai][bj][m][1] * inv);
        EPI_ROWS_END
        }
        asm volatile("s_waitcnt lgkmcnt(0)" ::: "memory"); __builtin_amdgcn_s_barrier(); asm volatile("" ::: "memory");
    }
};
struct Sched8 {
    typedef UnitG Unit; int G, c; const char* P; const char* VT;
    DI bool next(int i, Unit& u) const {
        const int L = i * G + c; if (L >= 512) return false;
        const int pn = L & 1, l2 = L >> 1, bh = l2 >> 3, pm = l2 & 7, b = bh >> 2, hd = bh & 3;
        u.pm = b * 8 + pm; u.pn = hd * 2 + pn;
        u.A = P + (size_t)(l2 * 256) * 256 * 2; u.B = VT + ((size_t)(hd * 512 + pn * 256) * 2048 + b * MEMT) * 2; return true;
    }
};
struct EpiPlain {
    bf16_t* out; int ldo;
    DI void operator()(const f32x4 (&acc)[2][2][4][2], const UnitG& u, int wr, int wc, int fr, int fq, int wid, int lane) const {
        EPI_ROWS_BEGIN
            bf16_t* rowp = out + (size_t)(u.pm * 256 + rl) * ldo + u.pn * 256 + colb;
#pragma unroll
            for (int bj = 0; bj < 2; ++bj) *(GAS u32x4*)(rowp + bj * 128) = pack8(acc[ai][bj][m][0], acc[ai][bj][m][1]);
        EPI_ROWS_END
    }
};

constexpr float PEER_US = 128.0f, PEER_VS = 16.0f;
DI unsigned sortable(float v) { const unsigned b = __builtin_bit_cast(unsigned, v); return (b & 0x80000000u) ? ~b : (b | 0x80000000u); }
DI float unsortable(unsigned s) { const unsigned b = (s & 0x80000000u) ? (s & 0x7fffffffu) : ~s; return __builtin_bit_cast(float, b); }
#define PEER_CANDS(X) \
    X(0,0) X(0,1) X(0,2) X(0,3) X(0,4) X(0,5) X(0,6) X(0,7) X(0,8) X(0,9) X(0,10) X(0,11) X(0,12) X(0,13) X(0,14) X(0,15) \
    X(1,0) X(1,1) X(1,2) X(1,3) X(1,4) X(1,5) X(1,6) X(1,7) X(2,0) X(2,1) X(2,2) X(2,3) X(2,4) X(3,0) X(3,1) X(3,2) X(3,3) \
    X(4,0) X(4,1) X(4,2) X(5,0) X(5,1) X(6,0) X(6,1) X(7,0) X(7,1) X(8,0) X(9,0) X(10,0) X(11,0) X(12,0) X(13,0) X(14,0) X(15,0)
#define X(a, b) (unsigned char)((a) * 16 + (b)),
static __device__ const unsigned char peer_ab[50] = { PEER_CANDS(X) };
#undef X
DI void route_pass(const Frame& F, int tg, int h, LAS unsigned* topL  , LAS unsigned* resL  ) {
    const int lane = F.lane, rr = lane & 31, hh = lane >> 5; const size_t tok = (size_t)tg * 32 + rr;
    const bf16_t* PQ = (const bf16_t*)(F.ws + WS_PQ); const bf16_t* SUBK = (const bf16_t*)(F.ws + WS_SUBK);
#pragma unroll 1
    for (int p = 0; p < 2; ++p) {
        bf16x8 qf[8];
        { const bf16_t* qp = PQ + tok * 2048 + (2 * h + p) * 128 + 8 * hh;
#pragma unroll
          for (int s = 0; s < 8; ++s) qf[s] = *(const GAS bf16x8*)(qp + 16 * s); }
        unsigned key[64];
#pragma unroll
        for (int nb = 0; nb < 4; ++nb) {
            const bf16_t* kp = SUBK + ((size_t)((2 * h + p) * 128 + 32 * nb + rr)) * 128 + 8 * hh;
            f32x16 acc = zero16();
#pragma unroll
            for (int s = 0; s < 8; ++s) acc = MFMA32(*(const GAS bf16x8*)(kp + 16 * s), qf[s], acc);
#pragma unroll
            for (int reg = 0; reg < 16; ++reg) { const int n = 32 * nb + crow(reg, hh); key[nb * 16 + reg] = (sortable(acc[reg]) & ~0x7fu) | (unsigned)(127 - n); }
        }
#pragma unroll 1
        for (int rd = 0; rd < 16; ++rd) {
            unsigned m = key[0];
#pragma unroll
            for (int i = 1; i < 64; ++i) m = (key[i] > m) ? key[i] : m;
            const unsigned o = __shfl_xor(m, 32); m = (o > m) ? o : m;
            topL[(p * 16 + rd) * 64 + lane] = m;
#pragma unroll
            for (int i = 0; i < 64; ++i) key[i] = (key[i] == m) ? 0u : key[i];
        }
    }
    LDS_WAIT();
    unsigned ck[50];
    { float v1[16], v2[16];
#pragma unroll
      for (int k = 0; k < 16; ++k) { v1[k] = unsortable(topL[k * 64 + lane] & ~0x7fu); v2[k] = unsortable(topL[(16 + k) * 64 + lane] & ~0x7fu); }
      int k = 0;
#define X(a, b) ck[k] = (sortable(v1[a] + v2[b]) & ~0x3fu) | (unsigned)(63 - k); ++k;
      PEER_CANDS(X)
#undef X
    }
#pragma unroll 1
    for (int rd = 0; rd < 16; ++rd) {
        unsigned m = ck[0];
#pragma unroll
        for (int i = 1; i < 50; ++i) m = (ck[i] > m) ? ck[i] : m;
#pragma unroll
        for (int i = 0; i < 50; ++i) ck[i] = (ck[i] == m) ? 0u : ck[i];
        resL[rd * 64 + lane] = m;
    }
    LDS_WAIT();
    float cv[16]; unsigned ce[16];
#pragma unroll
    for (int k = 0; k < 16; ++k) {
        const unsigned m = resL[k * 64 + lane]; cv[k] = unsortable(m & ~0x3fu);
        const unsigned ab = peer_ab[63u - (m & 63u)];
        const unsigned i1 = 127u - (topL[(ab >> 4) * 64 + lane] & 0x7fu), i2 = 127u - (topL[(16 + (ab & 15u)) * 64 + lane] & 0x7fu);
        ce[k] = i1 * 128u + i2;
    }
    const float cmax = cv[0]; float gs = 0.f;
#pragma unroll
    for (int k = 0; k < 16; ++k) { cv[k] = fast_exp2((cv[k] - cmax) * 1.4426950408889634f); gs += cv[k]; }
    const float ginv = 1.0f / gs;
    if (hh == 0) {
        unsigned* ep = (unsigned*)(F.ws + WS_EIDX) + tok * 128 + h * 16; float* gp = (float*)(F.ws + WS_GATE) + tok * 128 + h * 16;
#pragma unroll
        for (int k = 0; k < 16; k += 4) { *(GAS u32x4*)(ep + k) = (u32x4){ce[k], ce[k + 1], ce[k + 2], ce[k + 3]}; *(GAS f32x4*)(gp + k) = (f32x4){cv[k] * ginv, cv[k + 1] * ginv, cv[k + 2] * ginv, cv[k + 3] * ginv}; }
    }
    LDS_WAIT();
}
DI void ph11_route(const Frame& F, const Args& a) {
    const int gw = F.bid * NWAVES + F.wave, NGW = F.G * NWAVES;
    LAS unsigned* topL = (LAS unsigned*)(F.lds + F.wave * 12288); LAS unsigned* resL = topL + 2048;
    for (int it = gw; it < 512 * 8; it += NGW) route_pass(F, it >> 3, it & 7, topL, resL);
    const int gt = F.bid * NTHREADS + F.tid, NGT = F.G * NTHREADS;
    const GAS f32x4* gf = (const GAS f32x4*)a.in[I_GFFN];
    for (int i = gt; i < 16384 * 128; i += NGT) {
        const int e = i >> 7, c = i & 127, sl = c >> 3, j = c & 7;
        const GAS f32x4* su = (const GAS f32x4*)a.in[I_PU] + 4 * (size_t)i; const GAS f32x4* sv = (const GAS f32x4*)a.in[I_PV] + 4 * (size_t)i;
        u32x4 ou, ov;
#pragma unroll
        for (int q = 0; q < 4; ++q) { const f32x4 g = gf[4 * c + q]; const f32x4 u = su[q] * g * PEER_US; const f32x4 v = sv[q] * PEER_VS;
            int pu = __builtin_amdgcn_cvt_pk_fp8_f32(u.x, u.y, 0, false); pu = __builtin_amdgcn_cvt_pk_fp8_f32(u.z, u.w, pu, true);
            int pv = __builtin_amdgcn_cvt_pk_fp8_f32(v.x, v.y, 0, false); pv = __builtin_amdgcn_cvt_pk_fp8_f32(v.z, v.w, pv, true);
            ou[q] = (unsigned)pu; ov[q] = (unsigned)pv; }
        const size_t dst = ((size_t)(sl * 16384 + e) * 128 + 16 * j);
        *(GAS u32x4*)(F.ws + WS_UTAB + dst) = ou; *(GAS u32x4*)(F.ws + WS_VTAB + dst) = ov;
    }
}

DI float gelu_erf(float v) {
    const float av = fabsf(v), t = fast_rcp(av * 0.2316418882f + 1.0f);
    float q = t * 0.5307027145f + (-0.7265760135f); q = q * t + 0.7107068705f; q = q * t + (-0.142248368f); q = q * t + 0.127414796f; q = q * t;
    const float e = fast_exp2((v * v) * (-0.72134752044f)); const float m = v * (q * e);
    return v < 0.f ? m : v - m;
}
DI void dec16(const u32x4 r, float* f) {
#pragma unroll
    for (int q = 0; q < 4; ++q) { const f32x2 lo = __builtin_amdgcn_cvt_pk_f32_fp8((int)r[q], false), hi = __builtin_amdgcn_cvt_pk_f32_fp8((int)r[q], true);
        f[4 * q] = lo.x; f[4 * q + 1] = lo.y; f[4 * q + 2] = hi.x; f[4 * q + 3] = hi.y; }
}
DI void ph12_peer(const Frame& F, const Args& a) {
    LAS int* EL = (LAS int*)F.lds;
    LAS float* PD = (LAS float*)(F.lds + 32768);
    LAS float* SSL = (LAS float*)(F.lds + 65536);
    const int lane = F.lane, g = lane >> 3, j = lane & 7;
    const bf16_t* XB = (const bf16_t*)(F.ws + WS_XB);
    const unsigned char* U8 = F.ws + WS_UTAB; const unsigned char* V8 = F.ws + WS_VTAB;
    for (int blk = F.bid; blk < MT / 64; blk += F.G) {
        const int tl0 = 8 * F.wave; const size_t tok0 = (size_t)blk * 64 + tl0;
#pragma unroll 1
        for (int tk = 0; tk < 8; ++tk) { const int* ep = (const int*)(F.ws + WS_EIDX) + (tok0 + tk) * 128;
            EL[(tl0 + tk) * 128 + lane] = ep[lane]; EL[(tl0 + tk) * 128 + 64 + lane] = ep[64 + lane];
            PD[(tl0 + tk) * 128 + lane] = 0.f; PD[(tl0 + tk) * 128 + 64 + lane] = 0.f; SSL[(tl0 + tk) * 64 + lane] = 0.f; }
        LDS_WAIT();
#pragma unroll 1
        for (int sl = 0; sl < 16; ++sl) {
            const unsigned char* ub = U8 + (size_t)sl * 16384 * 128 + 16 * j;
#pragma unroll 1
            for (int tk = 0; tk < 8; ++tk) {
                float x[16];
                { const GAS u32x4* xp = (const GAS u32x4*)(XB + (tok0 + tk) * 2048 + 128 * sl + 16 * j); const u32x4 x0 = xp[0], x1 = xp[1];
                  x[0] = bf_lo(x0.x); x[1] = bf_hi(x0.x); x[2] = bf_lo(x0.y); x[3] = bf_hi(x0.y); x[4] = bf_lo(x0.z); x[5] = bf_hi(x0.z); x[6] = bf_lo(x0.w); x[7] = bf_hi(x0.w);
                  x[8] = bf_lo(x1.x); x[9] = bf_hi(x1.x); x[10] = bf_lo(x1.y); x[11] = bf_hi(x1.y); x[12] = bf_lo(x1.z); x[13] = bf_hi(x1.z); x[14] = bf_lo(x1.w); x[15] = bf_hi(x1.w); }
                LAS const int* el = EL + (tl0 + tk) * 128 + g; LAS float* pd = PD + (tl0 + tk) * 128 + g;
#pragma unroll 1
                for (int half = 0; half < 2; ++half) {
                    u32x4 r[8];
#pragma unroll
                    for (int ii = 0; ii < 8; ++ii) { const int e = el[8 * (8 * half + ii)]; r[ii] = *(const GAS u32x4*)(ub + (size_t)e * 128); }
                    float mine = 0.f;
#pragma unroll
                    for (int ii = 0; ii < 8; ++ii) { float f[16]; dec16(r[ii], f); float d = 0.f;
#pragma unroll
                        for (int q = 0; q < 16; ++q) d += f[q] * x[q];
                        d += __shfl_xor(d, 1); d += __shfl_xor(d, 2); d += __shfl_xor(d, 4);
                        mine = (j == ii) ? d : mine; }
                    pd[8 * (8 * half + j)] += mine;
                }
            }
        }
        LDS_WAIT();
#pragma unroll 1
        for (int tk = 0; tk < 8; ++tk) {
            const size_t tok = tok0 + tk;
            const float ssq = wave_sum((lane < 32) ? ((const float*)(F.ws + WS_SSQ2))[tok * 32 + lane] : 0.f);
            const float sc = (1.0f / PEER_US) / sqrtf(ssq * (1.0f / 2048.0f) + EPS);
            const float* gp = (const float*)(F.ws + WS_GATE) + tok * 128;
            LAS float* pd = PD + (tl0 + tk) * 128;
            const float w0 = gp[lane] * gelu_erf(pd[lane] * sc), w1 = gp[64 + lane] * gelu_erf(pd[64 + lane] * sc);
            pd[lane] = w0 * (1.0f / PEER_VS); pd[64 + lane] = w1 * (1.0f / PEER_VS);
        }
        LDS_WAIT();
#pragma unroll 1
        for (int sl = 0; sl < 16; ++sl) {
            const unsigned char* vb = V8 + (size_t)sl * 16384 * 128 + 16 * j;
#pragma unroll 1
            for (int tk = 0; tk < 8; ++tk) {
                LAS const int* el = EL + (tl0 + tk) * 128 + g; LAS const float* pw = PD + (tl0 + tk) * 128 + g;
                float y[16];
#pragma unroll
                for (int q = 0; q < 16; ++q) y[q] = 0.f;
#pragma unroll 1
                for (int half = 0; half < 2; ++half) {
                    u32x4 r[8]; float w[8];
#pragma unroll
                    for (int ii = 0; ii < 8; ++ii) { const int e = el[8 * (8 * half + ii)]; w[ii] = pw[8 * (8 * half + ii)]; r[ii] = *(const GAS u32x4*)(vb + (size_t)e * 128); }
#pragma unroll
                    for (int ii = 0; ii < 8; ++ii) { float f[16]; dec16(r[ii], f);
#pragma unroll
                        for (int q = 0; q < 16; ++q) y[q] += w[ii] * f[q];
                        }
                }
                float z[8];
                { const bool up = (lane & 32) != 0;
#pragma unroll
                  for (int q = 0; q < 8; ++q) { const float snd = up ? y[q] : y[8 + q]; const float rcv = __shfl_xor(snd, 32); z[q] = (up ? y[8 + q] : y[q]) + rcv; } }
                float qq[4];
                { const bool up = (lane & 16) != 0;
#pragma unroll
                  for (int q = 0; q < 4; ++q) { const float snd = up ? z[q] : z[4 + q]; const float rcv = __shfl_xor(snd, 16); qq[q] = (up ? z[4 + q] : z[q]) + rcv; } }
                float p0, p1;
                { const bool up = (lane & 8) != 0;
                  const float s0 = up ? qq[0] : qq[2], s1 = up ? qq[1] : qq[3]; const float r0 = __shfl_xor(s0, 8), r1 = __shfl_xor(s1, 8);
                  p0 = (up ? qq[2] : qq[0]) + r0; p1 = (up ? qq[3] : qq[1]) + r1; }
                float* xr = a.out + (tok0 + tk) * 2048 + 128 * sl + 16 * j + 2 * g;
                const f32x2 x2 = *(const GAS f32x2*)xr; const f32x2 x3 = {x2.x + p0, x2.y + p1};
                *(GAS f32x2*)xr = x3;
                SSL[(tl0 + tk) * 64 + lane] += x3.x * x3.x + x3.y * x3.y;
            }
        }
        LDS_WAIT();
        const float* gfin = (const float*)a.in[I_GFINAL];
#pragma unroll 1
        for (int tk = 0; tk < 8; ++tk) {
            const float rstd = 1.0f / sqrtf(wave_sum(SSL[(tl0 + tk) * 64 + lane]) * (1.0f / 2048.0f) + EPS);
            float* xr = a.out + (tok0 + tk) * 2048 + 16 * j + 2 * g;
#pragma unroll 4
            for (int sl = 0; sl < 16; ++sl) { const f32x2 v = *(const GAS f32x2*)(xr + 128 * sl); const f32x2 gg = *(const GAS f32x2*)(gfin + 128 * sl + 16 * j + 2 * g);
                *(GAS f32x2*)(xr + 128 * sl) = (f32x2){v.x * rstd * gg.x, v.y * rstd * gg.y}; }
        }
        LDS_WAIT();
    }
}

constexpr int NPHASES = 13;
#ifndef MK_ONE_LAUNCH
#define MK_ONE_LAUNCH 1
#endif
__global__ void __launch_bounds__(NTHREADS, 2) hybrid_fwd(Args args) {
    extern __shared__ __attribute__((aligned(16))) unsigned char lds_raw[];
    Frame F;
    F.lds = (LAS unsigned char*)lds_raw;
    F.tid = threadIdx.x; F.lane = F.tid & 63; F.wave = __builtin_amdgcn_readfirstlane(F.tid >> 6);
    F.G = gridDim.x; F.bid = blockIdx.x; F.ws = args.ws; F.dout = (unsigned char*)args.out;
    volatile LAS unsigned* MISC = (volatile LAS unsigned*)(F.lds + LDS_BYTES - 256);
    if (F.tid < 64) MISC[F.tid] = 0u;
    __syncthreads();
    XcdBarrier bar = xcd_barrier_post((unsigned*)(F.ws + WS_CTL) + 4096, MISC + 8);
    const int lo = args.ph_lo, hi = args.ph_hi;
#define IN(k) (lo <= (k) && (k) < hi)
#define SEAM(k) do { if (IN(k) && IN((k) + 1)) xcd_barrier(bar); } while (0)
    unsigned char* ws = F.ws;
    LAS unsigned char* ring = F.lds;

    if (IN(0)) { ph0_prologue(F, args); } SEAM(0);
    if (IN(1)) {
        Sched1 S{F.G, F.bid, ws, F.dout}; EpiProj E;
        pg8::gemm_phase<EpiProj, Sched1, true>(ring, DM, DM, DM, S, E);
    } SEAM(1);
    if (IN(2)) { ph2_mixers_a(F); } SEAM(2);
    if (IN(3)) { ph3_mixers_b(F); } SEAM(3);
    if (IN(4)) {
        { SchedG S{F.G, F.bid, 64, 8, (const char*)(ws + WS_RQ), (const char*)(ws + WS_WBR_T), (size_t)256 * 1024 * 2, (size_t)256 * 1024 * 2};
          EpiMerge<0> E{(bf16_t*)(ws + WS_GR), (bf16_t*)(ws + WS_GD)};
          pg8::gemm_phase<EpiMerge<0>, SchedG, true>(ring, 1024, 1024, 1024, S, E); }
        { SchedG S{F.G, F.bid, 64, 8, (const char*)(ws + WS_DQ), (const char*)(ws + WS_WBD_T), (size_t)256 * 1536 * 2, (size_t)256 * 512 * 2};
          EpiMerge<1> E{(bf16_t*)(ws + WS_GR), (bf16_t*)(ws + WS_GD)};
          pg8::gemm_phase<EpiMerge<1>, SchedG, true>(ring, 512, 1536, 512, S, E); }
    } SEAM(4);
    if (IN(5)) {
        SchedG S{F.G, F.bid, 64, 8, (const char*)(ws + WS_GD), (const char*)(ws + WS_WOUT_T), (size_t)256 * 2048 * 2, (size_t)256 * 2048 * 2};
        EpiResid E{(const float*)args.in[I_X], args.out, (bf16_t*)(ws + WS_XB), (float*)(ws + WS_SSQ1)};
        pg8::gemm_phase<EpiResid, SchedG, true>(ring, 2048, 2048, 2048, S, E);
    } SEAM(5);
    if (IN(6)) {
        SchedG S{F.G, F.bid, 64, 8, (const char*)(ws + WS_XB), (const char*)(ws + WS_WQ_T), (size_t)256 * 2048 * 2, (size_t)256 * 2048 * 2};
        EpiRowScale E{(const float*)(ws + WS_SSQ1), (bf16_t*)(ws + WS_QM), 0.04419417382415922f * 1.4426950408889634f};
        pg8::gemm_phase<EpiRowScale, SchedG, true>(ring, 2048, 2048, 2048, S, E);
    } SEAM(6);
    if (IN(7)) {
        Sched7 S{F.G, F.bid, (const char*)(ws + WS_QM), (const char*)(ws + WS_KM)};
        EpiSoftmax E{(bf16_t*)(ws + WS_P), (LAS float*)(F.lds + LDSX_OFF)};
        pg8::gemm_phase<EpiSoftmax, Sched7, true>(ring, 512, 2048, 2048, S, E);
    } SEAM(7);
    if (IN(8)) {
        Sched8 S{F.G, F.bid, (const char*)(ws + WS_P), (const char*)(ws + WS_VT)};
        EpiPlain E{(bf16_t*)(ws + WS_O), 2048};
        pg8::gemm_phase<EpiPlain, Sched8, true>(ring, 256, 256, 2048, S, E);
    } SEAM(8);
    if (IN(9)) {
        SchedG S{F.G, F.bid, 64, 8, (const char*)(ws + WS_O), (const char*)(ws + WS_WO_T), (size_t)256 * 2048 * 2, (size_t)256 * 2048 * 2};
        EpiResid E{args.out, args.out, (bf16_t*)(ws + WS_XB), (float*)(ws + WS_SSQ2)};
        pg8::gemm_phase<EpiResid, SchedG, true>(ring, 2048, 2048, 2048, S, E);
    } SEAM(9);
    if (IN(10)) {
        SchedG S{F.G, F.bid, 64, 8, (const char*)(ws + WS_XB), (const char*)(ws + WS_WPQ_T), (size_t)256 * 2048 * 2, (size_t)256 * 2048 * 2};
        EpiRowScale E{(const float*)(ws + WS_SSQ2), (bf16_t*)(ws + WS_PQ), 1.0f};
        pg8::gemm_phase<EpiRowScale, SchedG, true>(ring, 2048, 2048, 2048, S, E);
    } SEAM(10);
    if (IN(11)) { ph11_route(F, args); } SEAM(11);
    if (IN(12)) { ph12_peer(F, args); }
#undef IN
#undef SEAM
}

extern "C" void kernel_launch(void* const* d_in, const int* in_sizes, int n_in, void* d_out, int out_size, void* d_ws, size_t ws_size, hipStream_t stream) {
    static int grid = 0;
    if (grid == 0) {
        if (n_in != 19 || out_size != MT * DM || ws_size < WS_END) { fprintf(stderr, "kernel_launch: unexpected shapes (n_in %d, out %d, ws %zu)\n", n_in, out_size, ws_size); grid = -1; return; }
        int dev = 0, cus = 0;
        if (hipGetDevice(&dev) != hipSuccess || hipDeviceGetAttribute(&cus, hipDeviceAttributeMultiprocessorCount, dev) != hipSuccess) { grid = -1; return; }
        if (hipFuncSetAttribute((const void*)hybrid_fwd, hipFuncAttributeMaxDynamicSharedMemorySize, LDS_BYTES) != hipSuccess) { fprintf(stderr, "kernel_launch: hipFuncSetAttribute failed\n"); grid = -1; return; }
        (void)hipGetLastError();
        grid = cus;
    }
    if (grid < 0) return;
    (void)hipMemsetAsync((char*)d_ws + WS_CTL, 0, CTL_ZERO_BYTES, stream);
    Args a{};
    for (int i = 0; i < 19; ++i) a.in[i] = d_in[i];
    a.out = (float*)d_out; a.ws = (unsigned char*)d_ws;
    for (int i = 0; i < 64; ++i) { a.fret[i] = std::pow(10000.0, -(double)i / 63.0); a.frot[i] = std::pow(10000.0, -(double)i / 64.0); }
#if MK_ONE_LAUNCH
    a.ph_lo = 0; a.ph_hi = NPHASES;
    hipLaunchKernelGGL(hybrid_fwd, dim3(grid), dim3(NTHREADS), LDS_BYTES, stream, a);
#else
    for (int ph = 0; ph < NPHASES; ++ph) {
        a.ph_lo = ph; a.ph_hi = ph + 1;
        hipLaunchKernelGGL(hybrid_fwd, dim3(grid), dim3(NTHREADS), LDS_BYTES, stream, a);
    }
#endif
}
#ifdef PHASE_PROBE
#define PROBE(k) __global__ void __launch_bounds__(NTHREADS, 2) probe_ph##k(Args args) { \
    extern __shared__ __attribute__((aligned(16))) unsigned char lds_raw[]; Frame F; F.lds = (LAS unsigned char*)lds_raw; F.tid = threadIdx.x; F.lane = F.tid & 63; \
    F.wave = __builtin_amdgcn_readfirstlane(F.tid >> 6); F.G = gridDim.x; F.bid = blockIdx.x; F.ws = args.ws; F.dout = (unsigned char*)args.out; unsigned char* ws = F.ws; LAS unsigned char* ring = F.lds;
PROBE(0) ph0_prologue(F, args); }
PROBE(1) Sched1 S{F.G, F.bid, ws, F.dout}; EpiProj E; pg8::gemm_phase<EpiProj, Sched1, true>(ring, DM, DM, DM, S, E); }
PROBE(2) ph2_mixers_a(F); }
PROBE(3) ph3_mixers_b(F); }
PROBE(5) SchedG S{F.G, F.bid, 64, 8, (const char*)(ws + WS_GD), (const char*)(ws + WS_WOUT_T), (size_t)256 * 2048 * 2, (size_t)256 * 2048 * 2};
        EpiResid E{(const float*)args.in[I_X], args.out, (bf16_t*)(ws + WS_XB), (float*)(ws + WS_SSQ1)};
        pg8::gemm_phase<EpiResid, SchedG, true>(ring, 2048, 2048, 2048, S, E); }
PROBE(7) Sched7 S{F.G, F.bid, (const char*)(ws + WS_QM), (const char*)(ws + WS_KM)};
        EpiSoftmax E{(bf16_t*)(ws + WS_P), (LAS float*)(F.lds + LDSX_OFF)};
        pg8::gemm_phase<EpiSoftmax, Sched7, true>(ring, 512, 2048, 2048, S, E); }
PROBE(11) ph11_route(F, args); }
PROBE(12) ph12_peer(F, args); }
#endif
```

```cpp
#include <hip/hip_runtime.h>
#include <cstdio>
#include <cstdint>
#include <cmath>

#define LAS __attribute__((address_space(3)))
#define GAS __attribute__((address_space(1)))
#define DI __device__ __forceinline__
typedef unsigned short bf16_t;
typedef short bf16x8 __attribute__((ext_vector_type(8)));
typedef short s16x4 __attribute__((ext_vector_type(4)));
typedef short v4i16_t __attribute__((ext_vector_type(4)));
typedef float f32x2 __attribute__((ext_vector_type(2)));
typedef float f32x4 __attribute__((ext_vector_type(4)));
typedef float f32x16 __attribute__((ext_vector_type(16)));
typedef unsigned u32x2 __attribute__((ext_vector_type(2)));
typedef unsigned u32x4 __attribute__((ext_vector_type(4)));
typedef __bf16 bf16x2_t __attribute__((ext_vector_type(2)));

constexpr int NB = 8, SEQ = 2048, DM = 2048, MT = NB * SEQ;
constexpr int MEMT = 256, MROWS = NB * MEMT;
constexpr int INW = 12800;
constexpr float EPS = 1e-6f;
constexpr int NWAVES = 8, NTHREADS = 512;

constexpr size_t MiB = 1u << 20;
constexpr size_t WS_CTL = 0, CTL_ZERO_BYTES = 1 * MiB;
constexpr size_t WS_SSQ1 = 2 * MiB, WS_SSQ2 = 4 * MiB, WS_LSE = 6 * MiB, WS_EIDX = 8 * MiB, WS_GATE = 16 * MiB;
constexpr size_t WS_WIN_T = 24 * MiB, WS_WKV_T = 74 * MiB, WS_WBR_T = 90 * MiB, WS_WBD_T = 94 * MiB, WS_WOUT_T = 96 * MiB, WS_WQ_T = 104 * MiB, WS_WO_T = 112 * MiB, WS_WPQ_T = 120 * MiB;
constexpr size_t WS_SUBK = 128 * MiB, WS_KM = 130 * MiB, WS_VT = 138 * MiB;
constexpr size_t WS_RQ = 148 * MiB, WS_RK = 180 * MiB, WS_RV = 212 * MiB, WS_SG = 244 * MiB, WS_DQ = 276 * MiB, WS_DK = 324 * MiB, WS_DV = 372 * MiB, WS_GR = 420 * MiB, WS_GD = 484 * MiB;
constexpr size_t WS_END = 548 * MiB;
constexpr size_t WS_KVST = 24 * MiB;
constexpr size_t WS_XB = 24 * MiB;
constexpr size_t WS_QM = 180 * MiB;
constexpr size_t WS_PQ = 180 * MiB;
constexpr size_t WS_P = 244 * MiB;
constexpr size_t WS_O = 324 * MiB;
constexpr size_t WS_UTAB = 276 * MiB;
constexpr size_t WS_VTAB = 404 * MiB;
constexpr size_t DO_H1 = 0, DO_MEMN = 64 * MiB, DO_CSRET = 72 * MiB, DO_CSROT = 80 * MiB;
constexpr size_t DO_PREVT = 0;

DI unsigned f2bf(float f) { unsigned u = __builtin_bit_cast(unsigned, f); return (u + 0x7fffu + ((u >> 16) & 1u)) >> 16; }
DI unsigned pk2(float lo, float hi) { f32x2 v = {lo, hi}; bf16x2_t b = __builtin_convertvector(v, bf16x2_t); return __builtin_bit_cast(unsigned, b); }
DI float bf_lo(unsigned w) { return __builtin_bit_cast(float, w << 16); }
DI float bf_hi(unsigned w) { return __builtin_bit_cast(float, w & 0xffff0000u); }
DI float wave_sum(float v) {
#pragma unroll
    for (int o = 1; o < 64; o <<= 1) v += __shfl_xor(v, o);
    return v;
}
#define LDS_WAIT() asm volatile("s_waitcnt lgkmcnt(0)" ::: "memory")
#define VM_WAIT() asm volatile("s_waitcnt vmcnt(0)" ::: "memory")
DI float fast_exp2(float x) { return __builtin_amdgcn_exp2f(x); }
DI float fast_rcp(float x) { return __builtin_amdgcn_rcpf(x); }
DI float sigmoid_f(float x) { return fast_rcp(1.f + fast_exp2(-1.4426950408889634f * x)); }

namespace pg8 {
constexpr int BM = 256, BK = 64, HALF = 128, HTB = HALF * BK * 2, STAGE_BYTES = 8 * HTB, NXCD = 8, WGM = 8;
__host__ __device__ __forceinline__ int lds_byte(int r, int c) { const int st = (r >> 4) * 2 + (c >> 5), rr = r & 15, cc = c & 31, ob = rr * 64 + cc * 2; return st * 1024 + (ob ^ (((ob >> 9) & 1) << 5)); }
__host__ __device__ __forceinline__ void stage_rc(int b, int& R, int& C) { const int st = b / 1024, sb = b % 1024, swz = sb ^ (((sb >> 9) & 1) << 5); R = (st >> 1) * 16 + swz / 64; C = (st & 1) * 32 + (swz % 64) / 2; }
__host__ __device__ __forceinline__ int perm32(int rho) { const int n = rho >> 4, i = rho & 15; return 8 * (i >> 2) + 4 * n + (i & 3); }

__device__ __forceinline__ void tile_of(int L, int nM, int nN, int& pm, int& pn) {
    const int nwg = nM * nN; int wgid = L;
    { const int q = nwg / NXCD, r = nwg % NXCD, xcd = wgid % NXCD, off = wgid / NXCD; wgid = (xcd < r ? xcd * (q + 1) : r * (q + 1) + (xcd - r) * q) + off; }
    const int nig = WGM * nN, gid = wgid / nig, fm = gid * WGM, gsz = (nM - fm) < WGM ? (nM - fm) : WGM;
    pm = fm + ((wgid % nig) % gsz); pn = (wgid % nig) / gsz;
}

template <class Epi, class Sched, bool ALIGN_EPI>
__device__ __forceinline__ void gemm_phase(LAS unsigned char* lds, const int tid, const int K, const int lda, const int ldb, const Sched& S, const Epi& E) {
    typedef typename Sched::Unit Unit;
    const int wid = __builtin_amdgcn_readfirstlane(tid >> 6), lane = tid & 63, wr = wid >> 2, wc = wid & 3, fr = lane & 15, fq = lane >> 4;
    const int nt = K / BK;
    unsigned voffA[2], voffB[2];
#pragma unroll
    for (int i = 0; i < 2; ++i) { int R, C; stage_rc(tid * 16 + i * 8192, R, C); const int Rb = (R & ~31) + perm32(R & 31);
        voffA[i] = (unsigned)(R * lda + C) * 2u; voffB[i] = (unsigned)(Rb * ldb + C) * 2u; }
    const size_t kstep = (size_t)(BK * 2);
    const size_t hstepA = (size_t)HALF * lda * 2, hstepB = (size_t)HALF * ldb * 2;
    const unsigned ldsw = (unsigned)wid * 1024u;
    const int aoff = lds_byte(wr * 64 + fr, fq * 8), boff = lds_byte(wc * 32 + fr, fq * 8);
#define PG8_SA(b, h) (((b) * 2 + (h)) * HTB)
#define PG8_SB(b, h) ((4 + (b) * 2 + (h)) * HTB)
#define PG8_STAGE(bufoff, gbase, voff) do { _Pragma("unroll") for (int _i = 0; _i < 2; ++_i) \
        __builtin_amdgcn_global_load_lds((const unsigned*)((const char*)(gbase) + (voff)[_i]), (LAS unsigned*)(lds + (bufoff) + ldsw + _i * 8192), 16, 0, 0); } while (0)
#define PG8_LDA(dst, b, h) do { _Pragma("unroll") for (int m = 0; m < 4; ++m) _Pragma("unroll") for (int k = 0; k < 2; ++k) dst[m][k] = *(const LAS bf16x8*)(lds + PG8_SA(b, h) + aoff + m * 2048 + k * 1024); } while (0)
#define PG8_LDB(dst, b, h) do { _Pragma("unroll") for (int n = 0; n < 2; ++n) _Pragma("unroll") for (int k = 0; k < 2; ++k) dst[n][k] = *(const LAS bf16x8*)(lds + PG8_SB(b, h) + boff + n * 2048 + k * 1024); } while (0)
#define PG8_MMA(ai, bj, At, Bt) do { __builtin_amdgcn_s_setprio(1); _Pragma("unroll") for (int m = 0; m < 4; ++m) _Pragma("unroll") for (int n = 0; n < 2; ++n) _Pragma("unroll") for (int k = 0; k < 2; ++k) \
        acc[ai][bj][m][n] = __builtin_amdgcn_mfma_f32_16x16x32_bf16(Bt[n][k], At[m][k], acc[ai][bj][m][n], 0, 0, 0); __builtin_amdgcn_s_setprio(0); } while (0)
#define PG8_WAIT_V(n) asm volatile("s_waitcnt vmcnt(" #n ")" ::: "memory")
#define PG8_WAIT_L(n) asm volatile("s_waitcnt lgkmcnt(" #n ")" ::: "memory")
#define PG8_BAR __builtin_amdgcn_s_barrier()
#define PG8_SCHED __builtin_amdgcn_sched_barrier(0)
    Unit cur, nxt; int ui = 0;
    if (!S.next(0, cur)) return;
    f32x4 acc[2][2][4][2];
#pragma unroll
    for (int a = 0; a < 2; ++a)
#pragma unroll
        for (int b = 0; b < 2; ++b)
#pragma unroll
            for (int m = 0; m < 4; ++m)
#pragma unroll
                for (int n = 0; n < 2; ++n) acc[a][b][m][n] = (f32x4){0.f, 0.f, 0.f, 0.f};
    bf16x8 At[4][2], B0[2][2], B1[2][2];
    const char* cA = cur.A; const char* cB = cur.B;
    PG8_STAGE(PG8_SB(0, 0), cB, voffB); PG8_STAGE(PG8_SB(0, 1), cB + hstepB, voffB); PG8_STAGE(PG8_SA(0, 0), cA, voffA); PG8_STAGE(PG8_SA(0, 1), cA + hstepA, voffA);
    if (wr == 1) PG8_BAR;
    PG8_WAIT_V(2); PG8_BAR;
    PG8_STAGE(PG8_SB(1, 0), cB + kstep, voffB); PG8_STAGE(PG8_SA(1, 0), cA + kstep, voffA); PG8_STAGE(PG8_SB(1, 1), cB + hstepB + kstep, voffB);
    PG8_WAIT_V(6); PG8_BAR;
    for (;;) {
        const bool has_next = S.next(ui + 1, nxt);
        const char* nA = has_next ? nxt.A : cA; const char* nB = has_next ? nxt.B : cB;
        for (int t = 0; t < nt; t += 2) {
            const bool last = (t == nt - 2);
            const char* a1 = cA + (size_t)(t + 1) * kstep;
            const char* a2 = last ? nA : cA + (size_t)(t + 2) * kstep; const char* b2 = last ? nB : cB + (size_t)(t + 2) * kstep;
            const char* a3 = a2 + kstep; const char* b3 = b2 + kstep;
            PG8_LDB(B0, 0, 0); PG8_LDB(B1, 0, 1); PG8_SCHED; PG8_LDA(At, 0, 0); PG8_STAGE(PG8_SA(1, 1), a1 + hstepA, voffA);
            PG8_WAIT_V(8); PG8_WAIT_L(0); PG8_BAR; PG8_MMA(0, 0, At, B0); PG8_MMA(0, 1, At, B1); PG8_BAR; PG8_SCHED;
            PG8_LDA(At, 0, 1); PG8_STAGE(PG8_SB(0, 0), b2, voffB); PG8_STAGE(PG8_SB(0, 1), b2 + hstepB, voffB); PG8_STAGE(PG8_SA(0, 0), a2, voffA);
            PG8_WAIT_V(8); PG8_WAIT_L(0); PG8_BAR; PG8_MMA(1, 0, At, B0); PG8_MMA(1, 1, At, B1); PG8_BAR; PG8_SCHED;
            PG8_LDB(B0, 1, 0); PG8_LDB(B1, 1, 1); PG8_SCHED; PG8_LDA(At, 1, 0); PG8_STAGE(PG8_SA(0, 1), a2 + hstepA, voffA);
            PG8_WAIT_V(8); PG8_WAIT_L(0); PG8_BAR; PG8_MMA(0, 0, At, B0); PG8_MMA(0, 1, At, B1); PG8_BAR; PG8_SCHED;
            PG8_LDA(At, 1, 1); PG8_STAGE(PG8_SB(1, 0), b3, voffB); PG8_STAGE(PG8_SB(1, 1), b3 + hstepB, voffB); PG8_STAGE(PG8_SA(1, 0), a3, voffA);
            PG8_WAIT_V(8); PG8_WAIT_L(0); PG8_BAR; PG8_MMA(1, 0, At, B0); PG8_MMA(1, 1, At, B1); PG8_BAR; PG8_SCHED;
        }
        if constexpr (ALIGN_EPI) { if (wr == 0) PG8_BAR; }
        E(acc, cur, wr, wc, fr, fq, wid, lane);
        if (!has_next) break;
#pragma unroll
        for (int a = 0; a < 2; ++a)
#pragma unroll
            for (int b = 0; b < 2; ++b)
#pragma unroll
                for (int m = 0; m < 4; ++m)
#pragma unroll
                    for (int n = 0; n < 2; ++n) acc[a][b][m][n] = (f32x4){0.f, 0.f, 0.f, 0.f};
        cur = nxt; cA = nA; cB = nB; ++ui;
        if constexpr (ALIGN_EPI) { if (wr == 1) PG8_BAR; }
    }
    PG8_WAIT_V(0);
    if constexpr (!ALIGN_EPI) { if (wr == 0) PG8_BAR; }
    PG8_BAR;
#undef PG8_SA
#undef PG8_SB
#undef PG8_STAGE
#undef PG8_LDA
#undef PG8_LDB
#undef PG8_MMA
#undef PG8_WAIT_V
#undef PG8_WAIT_L
#undef PG8_BAR
#undef PG8_SCHED
}
}

constexpr int RING_BYTES = 131072;
constexpr int LDSX_OFF = RING_BYTES;
constexpr int LDSCTL_OFF = RING_BYTES + 16384;
constexpr int LDS_BYTES = 163840;

typedef GAS unsigned gu32;
#define RLX_AGENT __ATOMIC_RELAXED, __HIP_MEMORY_SCOPE_AGENT

#define XB_TMO      128
#define XB_XCNT(j)  (256  + 64 * (j))
#define XB_XSUB(j)  (1280 + 64 * (j))
#define XB_XGEN(j)  (2304 + 64 * (j))
#define XB_TOP      3328
#define XB_TOPGEN   3392
#define XCD_BAR_WORDS 3456
#define XB_SPIN_CAP (1u << 20)
DI unsigned xb_ld(unsigned* p)              { return __hip_atomic_load(p, __ATOMIC_RELAXED, __HIP_MEMORY_SCOPE_AGENT); }
DI unsigned xb_add(unsigned* p, unsigned v) { return __hip_atomic_fetch_add(p, v, __ATOMIC_RELAXED, __HIP_MEMORY_SCOPE_AGENT); }
DI unsigned xb_xcc_id() { return (unsigned)__builtin_amdgcn_s_getreg((3 << 11) | 20) & 0xFu; }
#define XB_SPIN(cond, bar) do { unsigned _sp = 0; while (cond) { __builtin_amdgcn_s_sleep(1); \
    if ((++_sp & 255u) == 0u) { if (xb_ld(&(bar)[XB_TMO])) break; if (_sp > XB_SPIN_CAP) { atomicAdd(&(bar)[XB_TMO], 1u); break; } } } } while (0)
struct XcdBarrier { unsigned* bar; unsigned x; volatile LAS unsigned* st; };
DI XcdBarrier xcd_barrier_post(unsigned* bar, volatile LAS unsigned* st) {
    XcdBarrier b; b.bar = bar; b.x = xb_xcc_id(); b.st = st;
    if (threadIdx.x == 0) (void)xb_add(&bar[XB_XCNT(b.x)], 1u);
    return b;
}
DI void xcd_barrier_complete(unsigned* bar, unsigned x, unsigned& nloc, unsigned& nx) {
    const unsigned G = gridDim.x * gridDim.y * gridDim.z;
    unsigned sum, cnt, mine, sp = 0u;
    for (;;) {
        sum = 0u; cnt = 0u; mine = 0u;
#pragma unroll
        for (unsigned j = 0; j < 16; ++j) { const unsigned c = xb_ld(&bar[XB_XCNT(j)]); sum += c; cnt += (c > 0u) ? 1u : 0u; mine = (j == x) ? c : mine; }
        if (sum == G) break;
        __builtin_amdgcn_s_sleep(1);
        if ((++sp & 255u) == 0u) { if (xb_ld(&bar[XB_TMO])) break; if (sp > XB_SPIN_CAP) { atomicAdd(&bar[XB_TMO], 1u); break; } }
    }
    nloc = mine > 0u ? mine : 1u; nx = cnt > 0u ? cnt : 1u;
}
DI void xcd_barrier(const XcdBarrier& b) {
    asm volatile("s_waitcnt vmcnt(0)" ::: "memory");
    __syncthreads();
    if (threadIdx.x == 0) {
        unsigned* bar = b.bar;
        __builtin_amdgcn_s_waitcnt(0);
        unsigned nloc = b.st[0], nx = b.st[1];
        if (nloc == 0u) { xcd_barrier_complete(bar, b.x, nloc, nx); b.st[0] = nloc; b.st[1] = nx; }
        const unsigned old = xb_add(&bar[XB_XSUB(b.x)], 1u);
        const unsigned gen = old / nloc;
        if (old + 1u == (gen + 1u) * nloc) {
            __builtin_amdgcn_fence(__ATOMIC_RELEASE, "agent");
            asm volatile("s_waitcnt vmcnt(0)" ::: "memory");
            const unsigned og = xb_add(&bar[XB_TOP], 1u);
            const unsigned tg = og / nx;
            if (og + 1u == (tg + 1u) * nx) xb_add(&bar[XB_TOPGEN], 1u);
            else XB_SPIN(xb_ld(&bar[XB_TOPGEN]) == tg, bar);
            __builtin_amdgcn_fence(__ATOMIC_ACQUIRE, "agent");
            xb_add(&bar[XB_XGEN(b.x)], 1u);
            asm volatile("s_waitcnt vmcnt(0)" ::: "memory");
        } else {
            XB_SPIN(xb_ld(&bar[XB_XGEN(b.x)]) == gen, bar);
            __builtin_amdgcn_fence(__ATOMIC_ACQUIRE, "agent");
            asm volatile("s_waitcnt vmcnt(0)" ::: "memory");
        }
    }
    __syncthreads();
}

struct Args {
    const void* in[19]; float* out; unsigned char* ws; int ph_lo, ph_hi;
    double fret[64]; double frot[64];
};
DI int lane_id() { int l; asm volatile("v_mbcnt_lo_u32_b32 %0, -1, 0\n\tv_mbcnt_hi_u32_b32 %0, -1, %0" : "=v"(l)); return l; }
struct Frame {
    LAS unsigned char* lds;
    int tid, lane, wave, G, bid;
    unsigned char* ws; unsigned char* dout;
};
#ifndef PROBE_PHASE
#define PROBE_PHASE -1
#endif
#define ISTAMP(F, k) do { if (PROBE_PHASE >= 20) { __syncthreads(); FSTAMP(F, k); } } while (0)
#define FSTAMP(F, k) do { if (PROBE_PHASE >= 0 && (F).bid == 0 && (F).tid == 0) { volatile LAS unsigned long long* ts_ = (volatile LAS unsigned long long*)((F).lds + LDS_BYTES - 64); \
    const unsigned long long t_ = __builtin_amdgcn_s_memrealtime(); if ((k) == PROBE_PHASE) ts_[1] = t_ - ts_[0]; ts_[0] = t_; } } while (0)
enum { I_X = 0, I_MEM, I_POS, I_GMIX, I_WIN, I_WBR, I_WBD, I_WOUT, I_GCROSS, I_GMEM, I_WQ, I_WKV, I_WO, I_GFFN, I_WPQ, I_SUBK, I_PU, I_PV, I_GFINAL };

DI void tr_item(const float* W, int K, int N, bf16_t* WT, const float* scale, int rot_lo, int rot_hi, LAS float* scr, int item, int lane) {
    const int nblk = N / 64, kb = item / nblk, nb = item % nblk, k0 = 64 * kb, c0 = 64 * nb;
    f32x4 wv[16];
#pragma unroll
    for (int i = 0; i < 16; ++i) { const int kk = 4 * i + (lane >> 4); wv[i] = *(const GAS f32x4*)(W + (size_t)(k0 + kk) * N + c0 + 4 * (lane & 15)); }
    if (scale) {
#pragma unroll
        for (int i = 0; i < 16; ++i) wv[i] = wv[i] * scale[k0 + 4 * i + (lane >> 4)];
    }
#pragma unroll
    for (int i = 0; i < 16; ++i) { const int kk = 4 * i + (lane >> 4); *(LAS f32x4*)(scr + kk * 68 + 4 * (lane & 15)) = wv[i]; }
    LDS_WAIT();
    const bool rot = (c0 >= rot_lo) && (c0 < rot_hi);
    const int hb = c0 & ~127, half = (c0 >> 6) & 1;
    const int c = lane & 7;
#pragma unroll
    for (int j = 0; j < 8; ++j) { const int n = (lane >> 3) + 8 * j; const LAS float* sp = scr + (8 * c) * 68 + n;
        u32x4 o; o.x = pk2(sp[0 * 68], sp[1 * 68]); o.y = pk2(sp[2 * 68], sp[3 * 68]); o.z = pk2(sp[4 * 68], sp[5 * 68]); o.w = pk2(sp[6 * 68], sp[7 * 68]);
        const int drow = rot ? (hb + 2 * n + half) : (c0 + n);
        *(GAS u32x4*)(WT + (size_t)drow * K + k0 + 8 * c) = o; }
    LDS_WAIT();
}
DI void rms_row_bf16(const float* xrow, const float* g, bf16_t* orow, int lane) {
    const GAS f32x4* xr = (const GAS f32x4*)xrow + lane; const GAS f32x4* gr = (const GAS f32x4*)g + lane;
    f32x4 v[8]; float s = 0.f;
#pragma unroll
    for (int j = 0; j < 8; ++j) { v[j] = xr[64 * j]; s += (v[j].x * v[j].x + v[j].y * v[j].y) + (v[j].z * v[j].z + v[j].w * v[j].w); }
    const float rstd = 1.0f / sqrtf(wave_sum(s) * (1.f / DM) + EPS);
    GAS u32x2* o8 = (GAS u32x2*)orow + lane;
#pragma unroll
    for (int j = 0; j < 8; ++j) { const f32x4 gg = gr[64 * j]; u32x2 o; o.x = pk2(v[j].x * rstd * gg.x, v[j].y * rstd * gg.y); o.y = pk2(v[j].z * rstd * gg.z, v[j].w * rstd * gg.w); o8[64 * j] = o; }
}
DI void sincos_d(double a, float& c, float& s) {
    const double x = a * 0.63661977236758134308; const double q = __builtin_rint(x);
    double r = __builtin_fma(-q, 1.57079632679489655800, a); r = __builtin_fma(-q, 6.12323399573676603587e-17, r);
    const int qi = ((int)q) & 3; const double r2 = r * r;
    double sn = 1.0 / 6227020800.0; sn = sn * r2 - 1.0 / 39916800.0; sn = sn * r2 + 1.0 / 362880.0; sn = sn * r2 - 1.0 / 5040.0; sn = sn * r2 + 1.0 / 120.0; sn = sn * r2 - 1.0 / 6.0; sn = sn * r2 + 1.0; sn *= r;
    double cs = -1.0 / 87178291200.0; cs = cs * r2 + 1.0 / 479001600.0; cs = cs * r2 - 1.0 / 3628800.0; cs = cs * r2 + 1.0 / 40320.0; cs = cs * r2 - 1.0 / 720.0; cs = cs * r2 + 1.0 / 24.0; cs = cs * r2 - 0.5; cs = cs * r2 + 1.0;
    const double so = (qi == 0) ? sn : (qi == 1) ? cs : (qi == 2) ? -sn : -cs;
    const double co = (qi == 0) ? cs : (qi == 1) ? -sn : (qi == 2) ? -cs : sn;
    c = (float)co; s = (float)so;
}
DI void ph0_prologue(const Frame& F, const Args& a) {
    LAS float* scr = (LAS float*)(F.lds + F.wave * 17408);
    const int gw = F.bid * NWAVES + F.wave, NGW = F.G * NWAVES;
    unsigned char* ws = F.ws;
    constexpr int I_IN = (DM / 64) * (INW / 64), I_KV = (DM / 64) * (4096 / 64), I_BR = (1024 / 64) * (DM / 64), I_BD = (512 / 64) * (DM / 64), I_SQ = (DM / 64) * (DM / 64);
    constexpr int NITEMS = I_IN + I_KV + I_BR + I_BD + 4 * I_SQ;
    for (int it = gw; it < NITEMS; it += NGW) {
        int r = it;
        if (r < I_IN) { tr_item((const float*)a.in[I_WIN], DM, INW, (bf16_t*)(ws + WS_WIN_T), nullptr, 4096, 7168, scr, r, F.lane); continue; } r -= I_IN;
        if (r < I_KV) { tr_item((const float*)a.in[I_WKV], DM, 4096, (bf16_t*)(ws + WS_WKV_T), nullptr, 0, 0, scr, r, F.lane); continue; } r -= I_KV;
        if (r < I_BR) { tr_item((const float*)a.in[I_WBR], 1024, DM, (bf16_t*)(ws + WS_WBR_T), nullptr, 0, 0, scr, r, F.lane); continue; } r -= I_BR;
        if (r < I_BD) { tr_item((const float*)a.in[I_WBD], 512, DM, (bf16_t*)(ws + WS_WBD_T), nullptr, 0, 0, scr, r, F.lane); continue; } r -= I_BD;
        if (r < I_SQ) { tr_item((const float*)a.in[I_WOUT], DM, DM, (bf16_t*)(ws + WS_WOUT_T), nullptr, 0, 0, scr, r, F.lane); continue; } r -= I_SQ;
        if (r < I_SQ) { tr_item((const float*)a.in[I_WQ], DM, DM, (bf16_t*)(ws + WS_WQ_T), (const float*)a.in[I_GCROSS], 0, 0, scr, r, F.lane); continue; } r -= I_SQ;
        if (r < I_SQ) { tr_item((const float*)a.in[I_WO], DM, DM, (bf16_t*)(ws + WS_WO_T), nullptr, 0, 0, scr, r, F.lane); continue; } r -= I_SQ;
        tr_item((const float*)a.in[I_WPQ], DM, DM, (bf16_t*)(ws + WS_WPQ_T), (const float*)a.in[I_GFFN], 0, 0, scr, r, F.lane);
    }
    ISTAMP(F, 42);
    for (int m = gw; m < MT; m += NGW) rms_row_bf16((const float*)a.in[I_X] + (size_t)m * DM, (const float*)a.in[I_GMIX], (bf16_t*)(F.dout + DO_H1) + (size_t)m * DM, F.lane);
    for (int m = gw; m < MROWS; m += NGW) rms_row_bf16((const float*)a.in[I_MEM] + (size_t)m * DM, (const float*)a.in[I_GMEM], (bf16_t*)(F.dout + DO_MEMN) + (size_t)m * DM, F.lane);
    ISTAMP(F, 43);
    const int gt = F.bid * NTHREADS + F.tid, NGT = F.G * NTHREADS;
    for (int i = gt; i < 16 * 128 * 128 / 8; i += NGT) {
        const GAS f32x4* s = (const GAS f32x4*)a.in[I_SUBK] + 2 * (size_t)i; const f32x4 v0 = s[0], v1 = s[1];
        u32x4 o; o.x = pk2(v0.x, v0.y); o.y = pk2(v0.z, v0.w); o.z = pk2(v1.x, v1.y); o.w = pk2(v1.z, v1.w);
        ((GAS u32x4*)(ws + WS_SUBK))[i] = o;
    }
    for (int i = gt; i < MT * 64; i += NGT) {
        const int t = i >> 6, k = i & 63; const double pos = (double)((const int*)a.in[I_POS])[t];
        { const double rv = pos * a.fret[k] * 0.15915494309189533577; const float fr = (float)(rv - __builtin_floor(rv));
          ((GAS f32x2*)(F.dout + DO_CSRET))[i] = (f32x2){__builtin_amdgcn_cosf(fr), __builtin_amdgcn_sinf(fr)}; }
        { const double rv = pos * a.frot[k] * 0.15915494309189533577; const float fr = (float)(rv - __builtin_floor(rv));
          ((GAS f32x2*)(F.dout + DO_CSROT))[i] = (f32x2){__builtin_amdgcn_cosf(fr), __builtin_amdgcn_sinf(fr)}; }
    }
}

struct Unit1 { const char* A; const char* B; int pm, pn; int mode; bf16_t* out; int ldo; float scale; const float* cs; };
struct Sched1 {
    typedef Unit1 Unit;
    int G, c; unsigned char* ws; unsigned char* dout;
    DI bool next(int i, Unit& u) const {
        const int L = i * G + c; if (L >= 3328) return false;
        if (L < 3200) {
            int pm, pn; pg8::tile_of(L, 64, 50, pm, pn); u.pm = pm; u.pn = pn;
            u.A = (const char*)(dout + DO_H1) + (size_t)pm * 256 * DM * 2; u.B = (const char*)(ws + WS_WIN_T) + (size_t)pn * 256 * DM * 2;
            u.scale = 1.f; u.cs = nullptr; u.mode = 0;
            const size_t rowoff = (size_t)pm * 256;
            if (pn < 4)       { u.mode = 1; u.out = (bf16_t*)(ws + WS_RQ) + rowoff * 1024 + (pn - 0) * 256; u.ldo = 1024; u.cs = (const float*)(dout + DO_CSRET); }
            else if (pn < 8)  { u.mode = 1; u.out = (bf16_t*)(ws + WS_RK) + rowoff * 1024 + (pn - 4) * 256; u.ldo = 1024; u.cs = (const float*)(dout + DO_CSRET); u.scale = 0.08838834764831845f; }
            else if (pn < 12) { u.out = (bf16_t*)(ws + WS_RV) + rowoff * 1024 + (pn - 8) * 256; u.ldo = 1024; }
            else if (pn < 16) { u.mode = 2; u.out = (bf16_t*)(ws + WS_SG) + rowoff * 1024 + (pn - 12) * 256; u.ldo = 1024; }
            else if (pn < 22) { u.mode = 1; u.out = (bf16_t*)(ws + WS_DQ) + rowoff * 1536 + (pn - 16) * 256; u.ldo = 1536; u.cs = (const float*)(dout + DO_CSROT); u.scale = 0.08838834764831845f * 1.4426950408889634f; }
            else if (pn < 28) { u.mode = 1; u.out = (bf16_t*)(ws + WS_DK) + rowoff * 1536 + (pn - 22) * 256; u.ldo = 1536; u.cs = (const float*)(dout + DO_CSROT); }
            else if (pn < 34) { u.out = (bf16_t*)(ws + WS_DV) + rowoff * 1536 + (pn - 28) * 256; u.ldo = 1536; }
            else if (pn < 42) { u.mode = 3; u.out = (bf16_t*)(ws + WS_GR) + rowoff * 2048 + (pn - 34) * 256; u.ldo = 2048; }
            else              { u.mode = 3; u.out = (bf16_t*)(ws + WS_GD) + rowoff * 2048 + (pn - 42) * 256; u.ldo = 2048; }
        } else {
            const int l = L - 3200; u.mode = 0; u.scale = 1.f; u.cs = nullptr; u.ldo = 2048;
            if (l < 64) { const int pm = l >> 3, pn = l & 7; u.pm = pm; u.pn = pn;
                u.A = (const char*)(dout + DO_MEMN) + (size_t)pm * 256 * DM * 2; u.B = (const char*)(ws + WS_WKV_T) + (size_t)pn * 256 * DM * 2;
                u.out = (bf16_t*)(ws + WS_KM) + (size_t)pm * 256 * 2048 + pn * 256; }
            else { const int l2 = l - 64, pm = l2 >> 3, pn = l2 & 7; u.pm = pm; u.pn = pn;
                u.A = (const char*)(ws + WS_WKV_T) + (size_t)(2048 + pm * 256) * DM * 2; u.B = (const char*)(dout + DO_MEMN) + (size_t)pn * 256 * DM * 2;
                u.out = (bf16_t*)(ws + WS_VT) + (size_t)pm * 256 * 2048 + pn * 256; }
        }
        return true;
    }
};
struct EpiNull1 {
    DI void operator()(const f32x4 (&acc)[2][2][4][2], const Unit1& u, int wr, int wc, int fr, int fq, int wid, int lane) const {
#pragma unroll
        for (int ai = 0; ai < 2; ++ai)
#pragma unroll
            for (int bj = 0; bj < 2; ++bj)
#pragma unroll
                for (int m = 0; m < 4; ++m) { asm volatile("" :: "v"(acc[ai][bj][m][0]), "v"(acc[ai][bj][m][1])); }
    }
};
struct EpiProj {
    template <int MODE> DI void emit(const f32x4 (&acc)[2][2][4][2], const Unit1& u, int wr, int wc, int fr, int fq) const {
        const int rowl0 = wr * 64 + fr, colb = wc * 32 + 8 * fq;
        f32x4 cs[2][4][2];
        if (MODE == 1) {
#pragma unroll
            for (int ai = 0; ai < 2; ++ai)
#pragma unroll
                for (int m = 0; m < 4; ++m) { const GAS f32x4* cp = (const GAS f32x4*)(u.cs + ((size_t)(u.pm * 256 + ai * 128 + m * 16 + rowl0) * 64 + (colb >> 1)) * 2); cs[ai][m][0] = cp[0]; cs[ai][m][1] = cp[1]; }
        }
#pragma unroll
        for (int ai = 0; ai < 2; ++ai)
#pragma unroll
            for (int m = 0; m < 4; ++m) {
                const int rl = ai * 128 + m * 16 + rowl0;
                f32x4 cs0 = {1.f, 0.f, 1.f, 0.f}, cs1 = cs0;
                if (MODE == 1) { cs0 = cs[ai][m][0]; cs1 = cs[ai][m][1]; }
                bf16_t* rowp = u.out + (size_t)rl * u.ldo + colb;
#pragma unroll
                for (int bj = 0; bj < 2; ++bj) {
                    f32x4 v0 = acc[ai][bj][m][0], v1 = acc[ai][bj][m][1];
                    if (MODE == 1) {
                        const f32x4 a0 = v0, a1 = v1; const float sc = u.scale;
                        v0.x = (a0.x * cs0.x - a0.y * cs0.y) * sc; v0.y = (a0.y * cs0.x + a0.x * cs0.y) * sc;
                        v0.z = (a0.z * cs0.z - a0.w * cs0.w) * sc; v0.w = (a0.w * cs0.z + a0.z * cs0.w) * sc;
                        v1.x = (a1.x * cs1.x - a1.y * cs1.y) * sc; v1.y = (a1.y * cs1.x + a1.x * cs1.y) * sc;
                        v1.z = (a1.z * cs1.z - a1.w * cs1.w) * sc; v1.w = (a1.w * cs1.z + a1.z * cs1.w) * sc;
                    } else if (MODE == 2) {
#pragma unroll
                        for (int e = 0; e < 4; ++e) { v0[e] = v0[e] * sigmoid_f(v0[e]); v1[e] = v1[e] * sigmoid_f(v1[e]); }
                    } else if (MODE == 3) {
#pragma unroll
                        for (int e = 0; e < 4; ++e) { v0[e] = sigmoid_f(v0[e]); v1[e] = sigmoid_f(v1[e]); }
                    }
                    u32x4 w; w.x = pk2(v0.x, v0.y); w.y = pk2(v0.z, v0.w); w.z = pk2(v1.x, v1.y); w.w = pk2(v1.z, v1.w);
                    *(GAS u32x4*)(rowp + bj * 128) = w;
                }
            }
    }
    DI void operator()(const f32x4 (&acc)[2][2][4][2], const Unit1& u, int wr, int wc, int fr, int fq, int wid, int lane) const {
        if (u.mode == 0) emit<0>(acc, u, wr, wc, fr, fq);
        else if (u.mode == 1) emit<1>(acc, u, wr, wc, fr, fq);
        else if (u.mode == 2) emit<2>(acc, u, wr, wc, fr, fq);
        else emit<3>(acc, u, wr, wc, fr, fq);
    }
};

#define MFMA32(a, b, c) __builtin_amdgcn_mfma_f32_32x32x16_bf16((a), (b), (c), 0, 0, 0)
DI int crow(int reg, int h) { return (reg & 3) + 8 * (reg >> 2) + 4 * h; }
DI s16x4 tr4(LAS const unsigned char* p) { return __builtin_bit_cast(s16x4, __builtin_amdgcn_ds_read_tr16_b64_v4i16((LAS v4i16_t*)p)); }
DI bf16x8 frag_tr(LAS const unsigned char* base, int pitch, int k0, int c0, int lane) {
    const int h = lane >> 5, blk = (lane >> 4) & 1, q = (lane & 15) >> 2, p = lane & 3;
    LAS const unsigned char* a = base + (k0 + 8 * h + q) * pitch + (c0 + 16 * blk + 4 * p) * 2;
    const s16x4 lo = tr4(a), hi = tr4(a + 4 * pitch);
    return __builtin_shufflevector(lo, hi, 0, 1, 2, 3, 4, 5, 6, 7);
}
DI bf16x8 frag_nt(LAS const unsigned char* base, int pitch, int r0, int k0, int lane) {
    return *(LAS const bf16x8*)(base + (r0 + (lane & 31)) * pitch + (k0 + 8 * (lane >> 5)) * 2);
}
DI f32x16 zero16() { f32x16 z;
#pragma unroll
    for (int i = 0; i < 16; ++i) z[i] = 0.f; return z; }
DI u32x4 scale_bf16x8(u32x4 v, float s) {
    u32x4 o; o.x = pk2(bf_lo(v.x) * s, bf_hi(v.x) * s); o.y = pk2(bf_lo(v.y) * s, bf_hi(v.y) * s); o.z = pk2(bf_lo(v.z) * s, bf_hi(v.z) * s); o.w = pk2(bf_lo(v.w) * s, bf_hi(v.w) * s); return o;
}
DI float ret_lg2gamma(int h) { return __builtin_log2f(1.0f - __builtin_exp2f(-5.0f - (float)h)); }

DI void ret_kv_item(const Frame& F, int bh, int n) {
    const int b = bh >> 3, h = bh & 7; const float lg = ret_lg2gamma(h);
    LAS unsigned char* VL = F.lds; LAS unsigned char* KL = F.lds + 128 * 320;
    const bf16_t* RK = (const bf16_t*)(F.ws + WS_RK); const bf16_t* RV = (const bf16_t*)(F.ws + WS_RV);
#pragma unroll
    for (int it = 0; it < 8; ++it) {
        const int idx = F.tid + NTHREADS * it, which = idx >> 11, rem = idx & 2047, row = rem >> 4, ch = rem & 15;
        const size_t tok = (size_t)b * SEQ + n * 128 + row;
        u32x4 v = *(const GAS u32x4*)((which ? RK : RV) + tok * 1024 + h * 128 + ch * 8);
        if (which) v = scale_bf16x8(v, fast_exp2(lg * (float)(127 - row)));
        *(LAS u32x4*)((which ? KL : VL) + row * 320 + ch * 16) = v;
    }
    __syncthreads();
    const int w = F.wave, lane = F.lane, eb = w >> 1, db0 = 2 * (w & 1);
    f32x16 acc0 = zero16(), acc1 = zero16();
#pragma unroll
    for (int s = 0; s < 8; ++s) {
        const bf16x8 a = frag_tr(VL, 320, 16 * s, 32 * eb, lane);
        const bf16x8 b0 = frag_tr(KL, 320, 16 * s, 32 * db0, lane), b1 = frag_tr(KL, 320, 16 * s, 32 * (db0 + 1), lane);
        acc0 = MFMA32(a, b0, acc0); acc1 = MFMA32(a, b1, acc1);
    }
    float* dst = (float*)(F.ws + WS_KVST) + ((size_t)(bh * 16 + n) * 128) * 128;
    const int r = lane & 31, hh = lane >> 5;
#pragma unroll
    for (int reg = 0; reg < 16; ++reg) { const int e = 32 * eb + crow(reg, hh);
        dst[(size_t)e * 128 + 32 * db0 + r] = acc0[reg]; dst[(size_t)e * 128 + 32 * (db0 + 1) + r] = acc1[reg]; }
    __syncthreads();
}

struct DilRegs { u32x4 vst[8], kst[8]; bf16x8 qf[8]; };
DI void dil_issue(const Frame& F, int item, DilRegs& R) {
    const int b = item / 192, rem = item % 192, head = rem >> 4, idx16 = rem & 15;
    const int g = head >> 2, r = (g == 0) ? 1 : (g == 1) ? 4 : 16, nbk = 16 / r, c = idx16 / nbk, n = idx16 % nbk;
    const bf16_t* DQ = (const bf16_t*)(F.ws + WS_DQ); const bf16_t* DK = (const bf16_t*)(F.ws + WS_DK); const bf16_t* DV = (const bf16_t*)(F.ws + WS_DV);
    const size_t tb = (size_t)b * SEQ; const int kbmin = (n == 0) ? 4 : 0;
    const int lane = F.lane, rr = lane & 31, hh = lane >> 5, wq = F.wave & 3;
#pragma unroll
    for (int it = 0; it < 8; ++it) {
        const int idx = F.tid + NTHREADS * it, row = idx >> 4, ch = idx & 15; const int rowl = (row >= 32 * kbmin) ? row : 128 + (row & 127);
        const size_t tok = tb + (size_t)((128 * (n - 1) + rowl) * r + c);
        R.vst[it] = *(const GAS u32x4*)(DV + tok * 1536 + head * 128 + ch * 8);
        R.kst[it] = *(const GAS u32x4*)(DK + tok * 1536 + head * 128 + ch * 8);
    }
    const size_t tokq = tb + (size_t)((128 * n + 32 * wq + rr) * r + c);
    const bf16_t* qp = DQ + tokq * 1536 + head * 128 + 8 * hh;
#pragma unroll
    for (int s = 0; s < 8; ++s) R.qf[s] = *(const GAS bf16x8*)(qp + 16 * s);
}
DI void dil_item(const Frame& F, int item, int nxt, DilRegs& R) {
    const int b = item / 192, rem = item % 192, head = rem >> 4, idx16 = rem & 15;
    const int g = head >> 2, r = (g == 0) ? 1 : (g == 1) ? 4 : 16, nbk = 16 / r, c = idx16 / nbk, n = idx16 % nbk;
    LAS unsigned char* VL = F.lds;
    LAS unsigned char* KL = F.lds + 256 * 320;
    LAS unsigned char* PL = F.lds + 256 * 320;
    LAS float* SMAX = (LAS float*)(F.lds + 256 * 320 + 256 * 272);
    LAS float* SSUM = SMAX + 256;
    bf16_t* DQ = (bf16_t*)(F.ws + WS_DQ);
    const size_t tb = (size_t)b * SEQ;
    const int kbmin = (n == 0) ? 4 : 0;
    const int lane = F.lane, rr = lane & 31, hh = lane >> 5, wq = F.wave & 3, wd = F.wave >> 2;
    const int qi = 32 * wq + rr;
    const size_t tokq = tb + (size_t)((128 * n + qi) * r + c);
#pragma unroll
    for (int it = 0; it < 8; ++it) { const int idx = F.tid + NTHREADS * it, row = idx >> 4, ch = idx & 15;
        if (row >= 32 * kbmin) { *(LAS u32x4*)(VL + row * 320 + ch * 16) = R.vst[it]; *(LAS u32x4*)(KL + row * 272 + ch * 16) = R.kst[it]; } }
    bf16x8 qf[8];
#pragma unroll
    for (int s = 0; s < 8; ++s) qf[s] = R.qf[s];
    __syncthreads();
    f32x16 st[3]; bool val[3]; float mloc = -INFINITY;
#pragma unroll
    for (int sl = 0; sl < 3; ++sl) {
        const int kb = wq + wd + 2 * sl; val[sl] = (kb <= wq + 4) && (kb >= kbmin);
        st[sl] = zero16();
        if (val[sl]) {
#pragma unroll
            for (int s = 0; s < 8; ++s) st[sl] = MFMA32(frag_nt(KL, 272, 32 * kb, 16 * s, lane), qf[s], st[sl]);
#pragma unroll
            for (int reg = 0; reg < 16; ++reg) { const int jj = 32 * kb + crow(reg, hh); const bool ok = (jj >= qi) && (jj <= qi + 128);
                st[sl][reg] = ok ? st[sl][reg] : -INFINITY; mloc = fmaxf(mloc, st[sl][reg]); }
        }
    }
    dil_issue(F, nxt, R);
    mloc = fmaxf(mloc, __shfl_xor(mloc, 32));
    if (hh == 0) SMAX[wd * 128 + qi] = mloc;
    __syncthreads();
    const float mx = fmaxf(SMAX[qi], SMAX[128 + qi]);
    float lloc = 0.f;
#pragma unroll
    for (int sl = 0; sl < 3; ++sl) {
        if (val[sl]) { const int kb = wq + wd + 2 * sl;
#pragma unroll
            for (int reg = 0; reg < 16; ++reg) { const float p = fast_exp2(st[sl][reg] - mx); st[sl][reg] = p; lloc += p; }
#pragma unroll
            for (int g4 = 0; g4 < 4; ++g4) { u32x2 w; w.x = pk2(st[sl][4 * g4], st[sl][4 * g4 + 1]); w.y = pk2(st[sl][4 * g4 + 2], st[sl][4 * g4 + 3]);
                *(LAS u32x2*)(PL + qi * 528 + (32 * kb + 8 * g4 + 4 * hh) * 2) = w; }
        }
    }
    lloc += __shfl_xor(lloc, 32);
    if (hh == 0) SSUM[wd * 128 + qi] = lloc;
    __syncthreads();
    const float lsum = SSUM[qi] + SSUM[128 + qi];
    f32x16 o0 = zero16(), o1 = zero16();
    const int kb_lo = (wq > kbmin) ? wq : kbmin;
    for (int kb = kb_lo; kb <= wq + 4; ++kb) {
#pragma unroll
        for (int s = 0; s < 2; ++s) {
            const bf16x8 pb = frag_nt(PL, 528, 32 * wq, 32 * kb + 16 * s, lane);
            const bf16x8 a0 = frag_tr(VL, 320, 32 * kb + 16 * s, 64 * wd, lane), a1 = frag_tr(VL, 320, 32 * kb + 16 * s, 64 * wd + 32, lane);
            o0 = MFMA32(a0, pb, o0); o1 = MFMA32(a1, pb, o1);
        }
    }
    const float inv = 1.0f / lsum;
    bf16_t* op = DQ + tokq * 1536 + head * 128 + 64 * wd + 4 * hh;
#pragma unroll
    for (int g4 = 0; g4 < 4; ++g4) {
        u32x2 w0, w1; w0.x = pk2(o0[4 * g4] * inv, o0[4 * g4 + 1] * inv); w0.y = pk2(o0[4 * g4 + 2] * inv, o0[4 * g4 + 3] * inv);
        w1.x = pk2(o1[4 * g4] * inv, o1[4 * g4 + 1] * inv); w1.y = pk2(o1[4 * g4 + 2] * inv, o1[4 * g4 + 3] * inv);
        *(GAS u32x2*)(op + 8 * g4) = w0; *(GAS u32x2*)(op + 32 + 8 * g4) = w1;
    }
    if (wd == 0 && hh == 0) ((float*)(F.ws + WS_LSE))[(size_t)head * MT + tokq] = mx + __builtin_log2f(lsum);
    __syncthreads();
}

DI void ph2_mixers_a(const Frame& F) {
    for (int it = F.bid; it < 1024; it += F.G) ret_kv_item(F, it >> 4, it & 15);
    ISTAMP(F, 40);
    { DilRegs R; if (F.bid < 1536) dil_issue(F, F.bid, R);
      for (int it = F.bid; it < 1536; it += F.G) dil_item(F, it, (it + F.G < 1536) ? it + F.G : it, R); }
}

DI void ret_out_item(const Frame& F, int bh, int n) {
    const int b = bh >> 3, h = bh & 7; const float lg = ret_lg2gamma(h);
    LAS unsigned char* VL = F.lds;
    LAS unsigned char* PL = F.lds + 128 * 320;
    LAS unsigned char* PT = PL + 128 * 272;
    LAS float* SQ = (LAS float*)(PT + 128 * 272);
    bf16_t* RQ = (bf16_t*)(F.ws + WS_RQ); const bf16_t* RK = (const bf16_t*)(F.ws + WS_RK); const bf16_t* RV = (const bf16_t*)(F.ws + WS_RV); const bf16_t* SG = (const bf16_t*)(F.ws + WS_SG);
    const size_t tb = (size_t)b * SEQ + n * 128;
    LAS unsigned char* KL = (LAS unsigned char*)(SQ + 256);
    const int lane = F.lane, rr = lane & 31, hh = lane >> 5, wq = F.wave & 3, we = F.wave >> 2;
    const int qi = 32 * wq + rr;
    u32x4 vst[4], kst[4], pst[4];
    { const bf16_t* pv = (const bf16_t*)(F.dout + DO_PREVT) + (size_t)(bh * 16 + n) * 16384;
#pragma unroll
      for (int it = 0; it < 4; ++it) { const int idx = F.tid + NTHREADS * it, row = idx >> 4, ch = idx & 15;
          vst[it] = *(const GAS u32x4*)(RV + (tb + row) * 1024 + h * 128 + ch * 8);
          kst[it] = *(const GAS u32x4*)(RK + (tb + row) * 1024 + h * 128 + ch * 8);
          pst[it] = *(const GAS u32x4*)(pv + row * 128 + ch * 8); } }
    bf16x8 qf[8];
    { const bf16_t* qp = RQ + (tb + qi) * 1024 + h * 128 + 8 * hh;
#pragma unroll
      for (int s = 0; s < 8; ++s) qf[s] = *(const GAS bf16x8*)(qp + 16 * s); }
#pragma unroll
    for (int it = 0; it < 4; ++it) { const int idx = F.tid + NTHREADS * it, row = idx >> 4, ch = idx & 15;
        *(LAS u32x4*)(VL + row * 320 + ch * 16) = vst[it]; *(LAS u32x4*)(KL + row * 272 + ch * 16) = kst[it]; *(LAS u32x4*)(PT + row * 272 + ch * 16) = pst[it]; }
    __syncthreads();
#pragma unroll
    for (int sl = 0; sl < 2; ++sl) {
        const int kb = we + 2 * sl;
        if (kb <= wq) {
            f32x16 st = zero16();
#pragma unroll
            for (int s = 0; s < 8; ++s) st = MFMA32(frag_nt(KL, 272, 32 * kb, 16 * s, lane), qf[s], st);
#pragma unroll
            for (int reg = 0; reg < 16; ++reg) { const int j = 32 * kb + crow(reg, hh); st[reg] = (j <= qi) ? st[reg] * fast_exp2(lg * (float)(qi - j)) : 0.f; }
#pragma unroll
            for (int g4 = 0; g4 < 4; ++g4) { u32x2 w; w.x = pk2(st[4 * g4], st[4 * g4 + 1]); w.y = pk2(st[4 * g4 + 2], st[4 * g4 + 3]);
                *(LAS u32x2*)(PL + qi * 272 + (32 * kb + 8 * g4 + 4 * hh) * 2) = w; }
        }
    }
    __syncthreads();
    f32x16 in0 = zero16(), in1 = zero16(), cr0 = zero16(), cr1 = zero16();
    for (int kb = 0; kb <= wq; ++kb) {
#pragma unroll
        for (int s = 0; s < 2; ++s) {
            const bf16x8 pb = frag_nt(PL, 272, 32 * wq, 32 * kb + 16 * s, lane);
            const bf16x8 a0 = frag_tr(VL, 320, 32 * kb + 16 * s, 64 * we, lane), a1 = frag_tr(VL, 320, 32 * kb + 16 * s, 64 * we + 32, lane);
            in0 = MFMA32(a0, pb, in0); in1 = MFMA32(a1, pb, in1);
        }
    }
#pragma unroll
    for (int s = 0; s < 8; ++s) {
        const bf16x8 a0 = frag_nt(PT, 272, 64 * we, 16 * s, lane), a1 = frag_nt(PT, 272, 64 * we + 32, 16 * s, lane);
        cr0 = MFMA32(a0, qf[s], cr0); cr1 = MFMA32(a1, qf[s], cr1);
    }
    const float qw = fast_exp2(lg * (float)(qi + 1));
    float ss = 0.f;
#pragma unroll
    for (int reg = 0; reg < 16; ++reg) { in0[reg] += qw * cr0[reg]; in1[reg] += qw * cr1[reg]; ss += in0[reg] * in0[reg] + in1[reg] * in1[reg]; }
    ss += __shfl_xor(ss, 32);
    if (hh == 0) SQ[we * 128 + qi] = ss;
    __syncthreads();
    const float rstd = 1.0f / sqrtf((SQ[qi] + SQ[128 + qi]) * (1.0f / 128.0f) + EPS);
    const size_t off = (tb + qi) * 1024 + h * 128 + 64 * we + 4 * hh;
#pragma unroll
    for (int g4 = 0; g4 < 4; ++g4) {
        const u32x2 g0 = *(const GAS u32x2*)(SG + off + 8 * g4), g1 = *(const GAS u32x2*)(SG + off + 32 + 8 * g4);
        u32x2 w0, w1;
        w0.x = pk2(in0[4 * g4] * rstd * bf_lo(g0.x), in0[4 * g4 + 1] * rstd * bf_hi(g0.x)); w0.y = pk2(in0[4 * g4 + 2] * rstd * bf_lo(g0.y), in0[4 * g4 + 3] * rstd * bf_hi(g0.y));
        w1.x = pk2(in1[4 * g4] * rstd * bf_lo(g1.x), in1[4 * g4 + 1] * rstd * bf_hi(g1.x)); w1.y = pk2(in1[4 * g4 + 2] * rstd * bf_lo(g1.y), in1[4 * g4 + 3] * rstd * bf_hi(g1.y));
        *(GAS u32x2*)(RQ + off + 8 * g4) = w0; *(GAS u32x2*)(RQ + off + 32 + 8 * g4) = w1;
    }
    __syncthreads();
}
DI void ph_scan(const Frame& F) {
    const int gt = F.bid * NTHREADS + F.tid, NGT = F.G * NTHREADS;
    for (int i = gt; i < 64 * 4096; i += NGT) {
        const int bh = i >> 12, c4 = i & 4095; const float cd = fast_exp2(ret_lg2gamma(bh & 7) * 128.0f);
        const float* kv = (const float*)(F.ws + WS_KVST) + (size_t)(bh * 16) * 16384 + c4 * 4;
        bf16_t* pv = (bf16_t*)(F.dout + DO_PREVT) + (size_t)(bh * 16) * 16384 + c4 * 4;
        f32x4 v[16];
#pragma unroll
        for (int n = 0; n < 15; ++n) v[n] = *(const GAS f32x4*)(kv + (size_t)n * 16384);
        f32x4 st = {0.f, 0.f, 0.f, 0.f};
#pragma unroll
        for (int n = 0; n < 16; ++n) { u32x2 w; w.x = pk2(st.x, st.y); w.y = pk2(st.z, st.w); *(GAS u32x2*)(pv + (size_t)n * 16384) = w; if (n < 15) st = st * cd + v[n]; }
    }
}
DI void ph3_mixers_b(const Frame& F) {
    for (int it = F.bid; it < 1024; it += F.G) ret_out_item(F, it >> 4, it & 15);
    bf16_t* DQ = (bf16_t*)(F.ws + WS_DQ); const float* LSE = (const float*)(F.ws + WS_LSE);
    const int gt = F.bid * NTHREADS + F.tid, NGT = F.G * NTHREADS;
    for (int i = gt; i < MT * 64; i += NGT) {
        const int t = i >> 6, hg = (i >> 4) & 3, ch = i & 15;
        const float l0 = LSE[(size_t)hg * MT + t], l1 = LSE[(size_t)(4 + hg) * MT + t], l2 = LSE[(size_t)(8 + hg) * MT + t];
        const float mx = fmaxf(l0, fmaxf(l1, l2)); float w0 = fast_exp2(l0 - mx), w1 = fast_exp2(l1 - mx), w2 = fast_exp2(l2 - mx);
        const float inv = 1.0f / (w0 + w1 + w2); w0 *= inv; w1 *= inv; w2 *= inv;
        bf16_t* p = DQ + (size_t)t * 1536 + hg * 128 + ch * 8;
        const u32x4 a = *(const GAS u32x4*)p, bq = *(const GAS u32x4*)(p + 512), cq = *(const GAS u32x4*)(p + 1024);
        u32x4 o;
        o.x = pk2(w0 * bf_lo(a.x) + w1 * bf_lo(bq.x) + w2 * bf_lo(cq.x), w0 * bf_hi(a.x) + w1 * bf_hi(bq.x) + w2 * bf_hi(cq.x));
        o.y = pk2(w0 * bf_lo(a.y) + w1 * bf_lo(bq.y) + w2 * bf_lo(cq.y), w0 * bf_hi(a.y) + w1 * bf_hi(bq.y) + w2 * bf_hi(cq.y));
        o.z = pk2(w0 * bf_lo(a.z) + w1 * bf_lo(bq.z) + w2 * bf_lo(cq.z), w0 * bf_hi(a.z) + w1 * bf_hi(bq.z) + w2 * bf_hi(cq.z));
        o.w = pk2(w0 * bf_lo(a.w) + w1 * bf_lo(bq.w) + w2 * bf_lo(cq.w), w0 * bf_hi(a.w) + w1 * bf_hi(bq.w) + w2 * bf_hi(cq.w));
        *(GAS u32x4*)p = o;
    }
}

struct UnitG { const char* A; const char* B; int pm, pn; };
struct SchedG {
    typedef UnitG Unit;
    int G, c, nM, nN; const char* Abase; const char* Bbase; size_t astep, bstep;
    DI bool next(int i, Unit& u) const {
        const int L = i * G + c; if (L >= nM * nN) return false;
        int pm, pn; pg8::tile_of(L, nM, nN, pm, pn); u.pm = pm; u.pn = pn;
        u.A = Abase + (size_t)pm * astep; u.B = Bbase + (size_t)pn * bstep; return true;
    }
};
#define EPI_ROWS_BEGIN const int rowl0 = wr * 64 + fr, colb = wc * 32 + 8 * fq; _Pragma("unroll") for (int ai = 0; ai < 2; ++ai) _Pragma("unroll") for (int m = 0; m < 4; ++m) { const int rl = ai * 128 + m * 16 + rowl0;
#define EPI_ROWS_END }
DI u32x4 pack8(const f32x4 v0, const f32x4 v1) { u32x4 w; w.x = pk2(v0.x, v0.y); w.y = pk2(v0.z, v0.w); w.z = pk2(v1.x, v1.y); w.w = pk2(v1.z, v1.w); return w; }
DI void unpack8(const u32x4 w, f32x4& v0, f32x4& v1) { v0 = (f32x4){bf_lo(w.x), bf_hi(w.x), bf_lo(w.y), bf_hi(w.y)}; v1 = (f32x4){bf_lo(w.z), bf_hi(w.z), bf_lo(w.w), bf_hi(w.w)}; }

template <int PASS> struct EpiMerge {
    bf16_t* GR; bf16_t* GD;
    DI void operator()(const f32x4 (&acc)[2][2][4][2], const UnitG& u, int wr, int wc, int fr, int fq, int wid, int lane) const {
        const int rowl0 = wr * 64 + fr, colb = wc * 32 + 8 * fq;
        const size_t base = (size_t)(u.pm * 256 + rowl0) * 2048 + u.pn * 256 + colb;
#pragma unroll
        for (int ai = 0; ai < 2; ++ai) {
            u32x4 gr[4][2], gd[4][2];
#pragma unroll
            for (int m = 0; m < 4; ++m)
#pragma unroll
                for (int bj = 0; bj < 2; ++bj) { const size_t off = base + (size_t)(ai * 128 + m * 16) * 2048 + bj * 128;
                    gr[m][bj] = *(const GAS u32x4*)(GR + off); if (PASS == 1) gd[m][bj] = *(const GAS u32x4*)(GD + off); }
#pragma unroll
            for (int m = 0; m < 4; ++m)
#pragma unroll
                for (int bj = 0; bj < 2; ++bj) { const size_t off = base + (size_t)(ai * 128 + m * 16) * 2048 + bj * 128;
                    f32x4 g0, g1; unpack8(gr[m][bj], g0, g1);
                    if (PASS == 0) *(GAS u32x4*)(GR + off) = pack8(g0 * acc[ai][bj][m][0], g1 * acc[ai][bj][m][1]);
                    else { f32x4 d0, d1; unpack8(gd[m][bj], d0, d1); *(GAS u32x4*)(GD + off) = pack8(g0 + d0 * acc[ai][bj][m][0], g1 + d1 * acc[ai][bj][m][1]); } }
        }
    }
};
template <bool F32IN> struct EpiResid {
    const float* xf; bf16_t* XB; float* SSQ;
    DI void operator()(const f32x4 (&acc)[2][2][4][2], const UnitG& u, int wr, int wc, int fr, int fq, int wid, int lane) const {
        const int rowl0 = wr * 64 + fr, colb = wc * 32 + 8 * fq;
        const size_t trow = (size_t)(u.pm * 256 + rowl0); const size_t base = trow * 2048 + u.pn * 256 + colb;
#pragma unroll
        for (int ai = 0; ai < 2; ++ai) {
            f32x4 xo[4][2][2];
#pragma unroll
            for (int m = 0; m < 4; ++m)
#pragma unroll
                for (int bj = 0; bj < 2; ++bj) { const size_t off = base + (size_t)(ai * 128 + m * 16) * 2048 + bj * 128;
                    if (F32IN) { xo[m][bj][0] = *(const GAS f32x4*)(xf + off); xo[m][bj][1] = *(const GAS f32x4*)(xf + off + 4); }
                    else unpack8(*(const GAS u32x4*)(XB + off), xo[m][bj][0], xo[m][bj][1]); }
#pragma unroll
            for (int m = 0; m < 4; ++m) { float ss = 0.f;
#pragma unroll
                for (int bj = 0; bj < 2; ++bj) { const size_t off = base + (size_t)(ai * 128 + m * 16) * 2048 + bj * 128;
                    const f32x4 y0 = xo[m][bj][0] + acc[ai][bj][m][0], y1 = xo[m][bj][1] + acc[ai][bj][m][1];
                    *(GAS u32x4*)(XB + off) = pack8(y0, y1);
                    ss += (y0.x * y0.x + y0.y * y0.y) + (y0.z * y0.z + y0.w * y0.w) + (y1.x * y1.x + y1.y * y1.y) + (y1.z * y1.z + y1.w * y1.w); }
                ss += __shfl_xor(ss, 16); ss += __shfl_xor(ss, 32);
                if (fq == 0) SSQ[(trow + ai * 128 + m * 16) * 32 + u.pn * 4 + wc] = ss; }
        }
    }
};
struct EpiRowScale {
    const float* SSQ; bf16_t* out; float scale;
    DI void operator()(const f32x4 (&acc)[2][2][4][2], const UnitG& u, int wr, int wc, int fr, int fq, int wid, int lane) const {
        const int rowl0 = wr * 64 + fr, colb = wc * 32 + 8 * fq;
        const size_t trow = (size_t)(u.pm * 256 + rowl0);
        f32x4 p[2][4][2];
#pragma unroll
        for (int ai = 0; ai < 2; ++ai)
#pragma unroll
            for (int m = 0; m < 4; ++m) { const float* sp = SSQ + (trow + ai * 128 + m * 16) * 32 + fq * 8; p[ai][m][0] = *(const GAS f32x4*)sp; p[ai][m][1] = *(const GAS f32x4*)(sp + 4); }
#pragma unroll
        for (int ai = 0; ai < 2; ++ai)
#pragma unroll
            for (int m = 0; m < 4; ++m) {
                const f32x4 p0 = p[ai][m][0], p1 = p[ai][m][1];
                float ss = (p0.x + p0.y) + (p0.z + p0.w) + (p1.x + p1.y) + (p1.z + p1.w);
                ss += __shfl_xor(ss, 16); ss += __shfl_xor(ss, 32);
                const float sc = scale / sqrtf(ss * (1.0f / 2048.0f) + EPS);
                bf16_t* rowp = out + (trow + ai * 128 + m * 16) * 2048 + u.pn * 256 + colb;
#pragma unroll
                for (int bj = 0; bj < 2; ++bj) *(GAS u32x4*)(rowp + bj * 128) = pack8(acc[ai][bj][m][0] * sc, acc[ai][bj][m][1] * sc);
            }
    }
};
struct EpiNull {
    DI void operator()(const f32x4 (&acc)[2][2][4][2], const UnitG& u, int wr, int wc, int fr, int fq, int wid, int lane) const {
#pragma unroll
        for (int ai = 0; ai < 2; ++ai)
#pragma unroll
            for (int bj = 0; bj < 2; ++bj)
#pragma unroll
                for (int m = 0; m < 4; ++m) { asm volatile("" :: "v"(acc[ai][bj][m][0]), "v"(acc[ai][bj][m][1])); }
    }
};
struct Sched7 {
    typedef UnitG Unit; int G, c; const char* QM; const char* KM;
    DI bool next(int i, Unit& u) const {
        const int L = i * G + c; if (L >= 256) return false;
        const int bh = L >> 3, pm = L & 7, b = bh >> 2, hd = bh & 3; u.pm = L; u.pn = 0;
        u.A = QM + ((size_t)(b * SEQ + pm * 256) * 2048 + hd * 512) * 2; u.B = KM + ((size_t)(b * MEMT) * 2048 + hd * 512) * 2; return true;
    }
};
struct EpiSoftmax {
    bf16_t* P; LAS float* X;
    DI void operator()(f32x4 (&acc)[2][2][4][2], const UnitG& u, int wr, int wc, int fr, int fq, int wid, int lane) const {
        LAS float* MX = X; LAS float* SM = X + 1024;
        EPI_ROWS_BEGIN
            float mx = -INFINITY;
#pragma unroll
            for (int bj = 0; bj < 2; ++bj)
#pragma unroll
                for (int n = 0; n < 2; ++n) { const f32x4 v = acc[ai][bj][m][n]; mx = fmaxf(mx, fmaxf(fmaxf(v.x, v.y), fmaxf(v.z, v.w))); }
            mx = fmaxf(mx, __shfl_xor(mx, 16)); mx = fmaxf(mx, __shfl_xor(mx, 32));
            if (fq == 0) MX[rl * 4 + wc] = mx;
        EPI_ROWS_END
        asm volatile("s_waitcnt lgkmcnt(0)" ::: "memory"); __builtin_amdgcn_s_barrier(); asm volatile("" ::: "memory");
        {
        EPI_ROWS_BEGIN
            const f32x4 q = *(LAS f32x4*)(MX + rl * 4); const float mx = fmaxf(fmaxf(q.x, q.y), fmaxf(q.z, q.w));
            float s = 0.f;
#pragma unroll
            for (int bj = 0; bj < 2; ++bj)
#pragma unroll
                for (int n = 0; n < 2; ++n) { f32x4 v = acc[ai][bj][m][n]; v.x = fast_exp2(v.x - mx); v.y = fast_exp2(v.y - mx); v.z = fast_exp2(v.z - mx); v.w = fast_exp2(v.w - mx);
                    acc[ai][bj][m][n] = v; s += (v.x + v.y) + (v.z + v.w); }
            s += __shfl_xor(s, 16); s += __shfl_xor(s, 32);
            if (fq == 0) SM[rl * 4 + wc] = s;
        EPI_ROWS_END
        }
        asm volatile("s_waitcnt lgkmcnt(0)" ::: "memory"); __builtin_amdgcn_s_barrier(); asm volatile("" ::: "memory");
        {
        EPI_ROWS_BEGIN
            const f32x4 q = *(LAS f32x4*)(SM + rl * 4); const float inv = 1.0f / ((q.x + q.y) + (q.z + q.w));
            bf16_t* rowp = P + (size_t)(u.pm * 256 + rl) * 256 + colb;
#pragma unroll
            for (int bj = 0; bj < 2; ++bj) *(GAS u32x4*)(rowp + bj * 128) = pack8(acc[ai][bj][m][0] * inv, acc[ai][bj][m][1] * inv);
        EPI_ROWS_END
        }
        asm volatile("s_waitcnt lgkmcnt(0)" ::: "memory"); __builtin_amdgcn_s_barrier(); asm volatile("" ::: "memory");
    }
};
struct Sched8 {
    typedef UnitG Unit; int G, c; const char* P; const char* VT;
    DI bool next(int i, Unit& u) const {
        const int L = i * G + c; if (L >= 512) return false;
        const int pn = L & 1, l2 = L >> 1, bh = l2 >> 3, pm = l2 & 7, b = bh >> 2, hd = bh & 3;
        u.pm = b * 8 + pm; u.pn = hd * 2 + pn;
        u.A = P + (size_t)(l2 * 256) * 256 * 2; u.B = VT + ((size_t)(hd * 512 + pn * 256) * 2048 + b * MEMT) * 2; return true;
    }
};
struct EpiPlain {
    bf16_t* out; int ldo;
    DI void operator()(const f32x4 (&acc)[2][2][4][2], const UnitG& u, int wr, int wc, int fr, int fq, int wid, int lane) const {
        EPI_ROWS_BEGIN
            bf16_t* rowp = out + (size_t)(u.pm * 256 + rl) * ldo + u.pn * 256 + colb;
#pragma unroll
            for (int bj = 0; bj < 2; ++bj) *(GAS u32x4*)(rowp + bj * 128) = pack8(acc[ai][bj][m][0], acc[ai][bj][m][1]);
        EPI_ROWS_END
    }
};

constexpr float PEER_US = 128.0f, PEER_VS = 16.0f;
DI unsigned sortable(float v) { const unsigned b = __builtin_bit_cast(unsigned, v); return (b & 0x80000000u) ? ~b : (b | 0x80000000u); }
DI float unsortable(unsigned s) { const unsigned b = (s & 0x80000000u) ? (s & 0x7fffffffu) : ~s; return __builtin_bit_cast(float, b); }
#define PEER_CANDS(X) \
    X(0,0) X(0,1) X(0,2) X(0,3) X(0,4) X(0,5) X(0,6) X(0,7) X(0,8) X(0,9) X(0,10) X(0,11) X(0,12) X(0,13) X(0,14) X(0,15) \
    X(1,0) X(1,1) X(1,2) X(1,3) X(1,4) X(1,5) X(1,6) X(1,7) X(2,0) X(2,1) X(2,2) X(2,3) X(2,4) X(3,0) X(3,1) X(3,2) X(3,3) \
    X(4,0) X(4,1) X(4,2) X(5,0) X(5,1) X(6,0) X(6,1) X(7,0) X(7,1) X(8,0) X(9,0) X(10,0) X(11,0) X(12,0) X(13,0) X(14,0) X(15,0)
#define X(a, b) (unsigned char)((a) * 16 + (b)),
static __device__ const unsigned char peer_ab[50] = { PEER_CANDS(X) };
#undef X
DI void cmpex_desc(unsigned& a, unsigned& b) { const unsigned mx = a > b ? a : b, mn = a > b ? b : a; a = mx; b = mn; }
template <int BASE> DI void sort16_desc(unsigned (&k)[64]) {
#pragma unroll
    for (int size = 2; size <= 16; size <<= 1)
#pragma unroll
        for (int stride = size >> 1; stride > 0; stride >>= 1)
#pragma unroll
            for (int i = 0; i < 16; ++i) { const int l = i ^ stride;
                if (l > i) { if ((i & size) == 0) cmpex_desc(k[BASE + i], k[BASE + l]); else cmpex_desc(k[BASE + l], k[BASE + i]); } }
}
template <int A, int B> DI void merge_top16(unsigned (&k)[64]) {
#pragma unroll
    for (int i = 0; i < 16; ++i) k[A + i] = (k[A + i] > k[B + 15 - i]) ? k[A + i] : k[B + 15 - i];
#pragma unroll
    for (int stride = 8; stride > 0; stride >>= 1)
#pragma unroll
        for (int i = 0; i < 16; ++i) { const int l = i ^ stride; if (l > i) cmpex_desc(k[A + i], k[A + l]); }
}
DI void top16_of_64(unsigned (&k)[64]) {
    sort16_desc<0>(k); sort16_desc<16>(k); sort16_desc<32>(k); sort16_desc<48>(k);
    merge_top16<0, 16>(k); merge_top16<32, 48>(k); merge_top16<0, 32>(k);
}
DI void route_pass(const Frame& F, int tg, int h, LAS unsigned* topL  ) {
    const int lane = F.lane, rr = lane & 31, hh = lane >> 5; const size_t tok = (size_t)tg * 32 + rr;
    const bf16_t* PQ = (const bf16_t*)(F.ws + WS_PQ); const bf16_t* SUBK = (const bf16_t*)(F.ws + WS_SUBK);
#pragma unroll 1
    for (int p = 0; p < 2; ++p) {
        bf16x8 qf[8];
        { const bf16_t* qp = PQ + tok * 2048 + (2 * h + p) * 128 + 8 * hh;
#pragma unroll
          for (int s = 0; s < 8; ++s) qf[s] = *(const GAS bf16x8*)(qp + 16 * s); }
        unsigned key[64];
#pragma unroll
        for (int nb = 0; nb < 4; ++nb) {
            const bf16_t* kp = SUBK + ((size_t)((2 * h + p) * 128 + 32 * nb + rr)) * 128 + 8 * hh;
            f32x16 acc = zero16();
#pragma unroll
            for (int s = 0; s < 8; ++s) acc = MFMA32(*(const GAS bf16x8*)(kp + 16 * s), qf[s], acc);
#pragma unroll
            for (int reg = 0; reg < 16; ++reg) { const int n = 32 * nb + crow(reg, hh); key[nb * 16 + reg] = (sortable(acc[reg]) & ~0x7fu) | (unsigned)(127 - n); }
        }
        top16_of_64(key);
        unsigned oth[16];
#pragma unroll
        for (int i = 0; i < 16; ++i) oth[i] = __shfl_xor(key[i], 32);
#pragma unroll
        for (int i = 0; i < 16; ++i) key[i] = (key[i] > oth[15 - i]) ? key[i] : oth[15 - i];
#pragma unroll
        for (int stride = 8; stride > 0; stride >>= 1)
#pragma unroll
            for (int i = 0; i < 16; ++i) { const int l = i ^ stride; if (l > i) cmpex_desc(key[i], key[l]); }
#pragma unroll
        for (int i = 0; i < 16; ++i) topL[(p * 16 + i) * 64 + lane] = key[i];
    }
    LDS_WAIT();
    unsigned ck[64];
    { float v1[16], v2[16];
#pragma unroll
      for (int k = 0; k < 16; ++k) { v1[k] = unsortable(topL[k * 64 + lane] & ~0x7fu); v2[k] = unsortable(topL[(16 + k) * 64 + lane] & ~0x7fu); }
      int k = 0;
#define X(a, b) ck[k] = (sortable(v1[a] + v2[b]) & ~0x3fu) | (unsigned)(63 - k); ++k;
      PEER_CANDS(X)
#undef X
#pragma unroll
      for (int i = 50; i < 64; ++i) ck[i] = 0u;
    }
    top16_of_64(ck);
    LDS_WAIT();
    float cv[16]; unsigned ce[16];
#pragma unroll
    for (int k = 0; k < 16; ++k) {
        const unsigned m = ck[k]; cv[k] = unsortable(m & ~0x3fu);
        const unsigned ab = peer_ab[63u - (m & 63u)];
        const unsigned i1 = 127u - (topL[(ab >> 4) * 64 + lane] & 0x7fu), i2 = 127u - (topL[(16 + (ab & 15u)) * 64 + lane] & 0x7fu);
        ce[k] = i1 * 128u + i2;
    }
    const float cmax = cv[0]; float gs = 0.f;
#pragma unroll
    for (int k = 0; k < 16; ++k) { cv[k] = fast_exp2((cv[k] - cmax) * 1.4426950408889634f); gs += cv[k]; }
    const float ginv = 1.0f / gs;
    if (hh == 0) {
        unsigned* ep = (unsigned*)(F.ws + WS_EIDX) + tok * 128 + h * 16; float* gp = (float*)(F.ws + WS_GATE) + tok * 128 + h * 16;
#pragma unroll
        for (int k = 0; k < 16; k += 4) { *(GAS u32x4*)(ep + k) = (u32x4){ce[k], ce[k + 1], ce[k + 2], ce[k + 3]}; *(GAS f32x4*)(gp + k) = (f32x4){cv[k] * ginv, cv[k + 1] * ginv, cv[k + 2] * ginv, cv[k + 3] * ginv}; }
    }
    LDS_WAIT();
}
DI void ph11_route(const Frame& F, const Args& a) {
    const int gw = F.bid * NWAVES + F.wave, NGW = F.G * NWAVES;
    LAS unsigned* topL = (LAS unsigned*)(F.lds + F.wave * 8192);
    for (int it = gw; it < 512 * 8; it += NGW) route_pass(F, it >> 3, it & 7, topL);
    ISTAMP(F, 41);
    const int gt = F.bid * NTHREADS + F.tid, NGT = F.G * NTHREADS;
    const GAS f32x4* gf = (const GAS f32x4*)a.in[I_GFFN];
    for (int i = gt; i < 16384 * 128; i += NGT) {
        const int e = i >> 7, c = i & 127, sl = c >> 3, j = c & 7;
        const GAS f32x4* su = (const GAS f32x4*)a.in[I_PU] + 4 * (size_t)i; const GAS f32x4* sv = (const GAS f32x4*)a.in[I_PV] + 4 * (size_t)i;
        u32x4 ou, ov;
#pragma unroll
        for (int q = 0; q < 4; ++q) { const f32x4 g = gf[4 * c + q]; const f32x4 u = su[q] * g * PEER_US; const f32x4 v = sv[q] * PEER_VS;
            int pu = __builtin_amdgcn_cvt_pk_fp8_f32(u.x, u.y, 0, false); pu = __builtin_amdgcn_cvt_pk_fp8_f32(u.z, u.w, pu, true);
            int pv = __builtin_amdgcn_cvt_pk_fp8_f32(v.x, v.y, 0, false); pv = __builtin_amdgcn_cvt_pk_fp8_f32(v.z, v.w, pv, true);
            ou[q] = (unsigned)pu; ov[q] = (unsigned)pv; }
        const size_t dst = ((size_t)(sl * 16384 + e) * 128 + 16 * j);
        *(GAS u32x4*)(F.ws + WS_UTAB + dst) = ou; *(GAS u32x4*)(F.ws + WS_VTAB + dst) = ov;
    }
}

DI float gelu_erf(float v) {
    const float av = fabsf(v), t = fast_rcp(av * 0.2316418882f + 1.0f);
    float q = t * 0.5307027145f + (-0.7265760135f); q = q * t + 0.7107068705f; q = q * t + (-0.142248368f); q = q * t + 0.127414796f; q = q * t;
    const float e = fast_exp2((v * v) * (-0.72134752044f)); const float m = v * (q * e);
    return v < 0.f ? m : v - m;
}
template <int CTRL> DI float dpp_f(float v) { return __builtin_bit_cast(float, __builtin_amdgcn_update_dpp(0, __builtin_bit_cast(int, v), CTRL, 0xf, 0xf, false)); }
DI float sum8(float d) { d += dpp_f<0xB1>(d); d += dpp_f<0x4E>(d); d += dpp_f<0x141>(d); return d; }
struct PeerBatch { u32x4 r[8]; };
struct PeerOffs { unsigned o[8]; };
DI void peer_offs(PeerOffs& O, LAS const int* el  , unsigned loff  ) {
#pragma unroll
    for (int ii = 0; ii < 8; ++ii) O.o[ii] = (unsigned)el[8 * ii] + loff;
}
DI void peer_issue(PeerBatch& B, const unsigned char* tb  , const PeerOffs& O) {
#pragma unroll
    for (int ii = 0; ii < 8; ++ii) B.r[ii] = *(const GAS u32x4*)(tb + O.o[ii]);
}

template <int VAR> DI void peer_u_pass(const Frame& F, LAS float* PD, LAS const int* elw, const unsigned char* U8, const bf16_t* XB, size_t tok0, int tl0) {
    const int lane = F.lane, g = lane >> 3, j = lane & 7;
        {
            const unsigned char* ub0 = U8; const unsigned loff = 16u * (unsigned)j; const bf16_t* xb0 = XB + tok0 * 2048 + 16 * j;
            PeerBatch Ba, Bb;
            LAS unsigned char* XS = F.lds + 81920 + F.wave * 4096;
            const bf16_t* xq_src = XB + (tok0 + (lane >> 3)) * 2048 + 16 * (lane & 7);
            u32x4 xq0 = *(const GAS u32x4*)xq_src, xq1 = *(const GAS u32x4*)(xq_src + 8);
#define U_COMPUTE(B, b) do { \
                const u32x4 xc0 = *(LAS const u32x4*)(xs_), xc1 = *(LAS const u32x4*)(xs_ + 16); \
                const unsigned xw_[8] = {xc0.x, xc0.y, xc0.z, xc0.w, xc1.x, xc1.y, xc1.z, xc1.w};        \
                float d_[8]; \
                _Pragma("unroll") for (int ii = 0; ii < 8; ++ii) d_[ii] = 0.f; \
                _Pragma("unroll") for (int q = 0; q < 4; ++q) { \
                    _Pragma("unroll") for (int ii = 0; ii < 8; ++ii) d_[ii] = __builtin_amdgcn_fdot2_f32_bf16(__builtin_amdgcn_cvt_scalef32_pk_bf16_fp8((int)(B).r[ii][q], 1.0f, false), __builtin_bit_cast(bf16x2_t, xw_[2 * q]), d_[ii], false); \
                    _Pragma("unroll") for (int ii = 0; ii < 8; ++ii) d_[ii] = __builtin_amdgcn_fdot2_f32_bf16(__builtin_amdgcn_cvt_scalef32_pk_bf16_fp8((int)(B).r[ii][q], 1.0f, true), __builtin_bit_cast(bf16x2_t, xw_[2 * q + 1]), d_[ii], false); } \
                  \
                float e_[4]; _Pragma("unroll") for (int m = 0; m < 4; ++m) { const float snd = bit0 ? d_[m] : d_[4 + m]; e_[m] = (bit0 ? d_[4 + m] : d_[m]) + dpp_f<0xB1>(snd); } \
                float f_[2]; _Pragma("unroll") for (int m = 0; m < 2; ++m) { const float snd = bit1 ? e_[m] : e_[2 + m]; f_[m] = (bit1 ? e_[2 + m] : e_[m]) + dpp_f<0x4E>(snd); } \
                const float snd_ = bit2 ? f_[0] : f_[1]; const float mine_ = (bit2 ? f_[1] : f_[0]) + __shfl_xor(snd_, 4); \
                if (VAR == 2) { asm volatile("" :: "v"(mine_)); } else PD[tl0 * 128 + 64 * (b) + 8 * jrev + g] += mine_; } while (0)
            const bool bit0 = (lane & 1) != 0, bit1 = (lane & 2) != 0, bit2 = (lane & 4) != 0; const int jrev = ((lane & 1) << 2) | (lane & 2) | ((lane >> 2) & 1);
            PeerBatch Bc, Bd;
            PeerOffs PO;
#define U_OFFS(fb) do { const int fb_ = ((fb) < 255) ? (fb) : 255; peer_offs(PO, elw + 64 * (fb_ & 15), loff); } while (0)
#define U_ISSUE(B, fb) do { const int fb_ = ((fb) < 255) ? (fb) : 255; peer_issue(B, ub0 + (size_t)(fb_ >> 4) * (16384 * 128), PO); U_OFFS((fb) + 1); } while (0)
#define U_STEP(B, fb, Bn, fbn) do { \
                U_ISSUE(Bn, fbn); \
                __builtin_amdgcn_sched_barrier(0); \
                LAS const unsigned char* xs_ = XS + (((fb) >> 4) & 1) * 2048 + ((((fb) >> 1) & 7) * 8 + j) * 32; \
                if (VAR == 3) { _Pragma("unroll") for (int ii = 0; ii < 8; ++ii) asm volatile("" :: "v"((B).r[ii])); } else U_COMPUTE(B, (fb) & 15); \
                __builtin_amdgcn_sched_barrier(0); } while (0)
            U_OFFS(0); U_ISSUE(Ba, 0); U_ISSUE(Bb, 1); U_ISSUE(Bc, 2);
#pragma unroll 1
            for (int fb = 0; fb < 256; fb += 4) {
                if ((fb & 15) == 0) { const int sl = fb >> 4;
                    *(LAS u32x4*)(XS + (sl & 1) * 2048 + lane * 32) = xq0; *(LAS u32x4*)(XS + (sl & 1) * 2048 + lane * 32 + 16) = xq1;
                    if (VAR != 1 && VAR != 3) { const bf16_t* xp = xq_src + 128 * ((sl < 15) ? sl + 1 : 15); xq0 = *(const GAS u32x4*)xp; xq1 = *(const GAS u32x4*)(xp + 8); }
                }
                U_STEP(Ba, fb, Bd, fb + 3);
                U_STEP(Bb, fb + 1, Ba, fb + 4);
                U_STEP(Bc, fb + 2, Bb, fb + 5);
                U_STEP(Bd, fb + 3, Bc, fb + 6);
            }
#undef U_STEP
#undef U_ISSUE
#undef U_OFFS
#undef U_COMPUTE
        }
}
DI void ph12_peer(const Frame& F, const Args& a) {
    LAS int* EL = (LAS int*)F.lds;
    LAS float* PD = (LAS float*)(F.lds + 32768);
    LAS float* SSL = (LAS float*)(F.lds + 65536);
    LAS unsigned* WB = (LAS unsigned*)(F.lds + 114688);
    const int lane = F.lane, g = lane >> 3, j = lane & 7;
    const bf16_t* XB = (const bf16_t*)(F.ws + WS_XB);
    const unsigned char* U8 = F.ws + WS_UTAB; const unsigned char* V8 = F.ws + WS_VTAB;
    for (int blk = F.bid; blk < MT / 64; blk += F.G) {
        const int tl0 = 8 * F.wave; const size_t tok0 = (size_t)blk * 64 + tl0;
        { int e0[8], e1[8];
#pragma unroll
          for (int tk = 0; tk < 8; ++tk) { const int* ep = (const int*)(F.ws + WS_EIDX) + (tok0 + tk) * 128; e0[tk] = ep[lane]; e1[tk] = ep[64 + lane]; }
#pragma unroll
          for (int tk = 0; tk < 8; ++tk) {
            EL[(tl0 + tk) * 128 + lane] = e0[tk] * 128; EL[(tl0 + tk) * 128 + 64 + lane] = e1[tk] * 128;
            PD[(tl0 + tk) * 128 + lane] = 0.f; PD[(tl0 + tk) * 128 + 64 + lane] = 0.f; SSL[(tl0 + tk) * 64 + lane] = 0.f; } }
        LDS_WAIT();
        LAS const int* elw = EL + tl0 * 128 + g;
        peer_u_pass<0>(F, PD, elw, U8, XB, tok0, tl0);
#if PROBE_PHASE >= 30 && PROBE_PHASE <= 33
        LDS_WAIT(); __syncthreads(); ISTAMP(F, 29);
        peer_u_pass<PROBE_PHASE - 30>(F, (LAS float*)(F.lds + 131072), elw, U8, XB, tok0, tl0);
        LDS_WAIT(); __syncthreads(); ISTAMP(F, PROBE_PHASE);
#endif
        LDS_WAIT(); ISTAMP(F, 20);
#pragma unroll 1
        for (int tk = 0; tk < 8; ++tk) {
            const size_t tok = tok0 + tk;
            const float ssq = wave_sum((lane < 32) ? ((const float*)(F.ws + WS_SSQ2))[tok * 32 + lane] : 0.f);
            const float sc = (1.0f / PEER_US) / sqrtf(ssq * (1.0f / 2048.0f) + EPS);
            const float* gp = (const float*)(F.ws + WS_GATE) + tok * 128;
            LAS float* pd = PD + (tl0 + tk) * 128;
            const float w0 = gp[lane] * gelu_erf(pd[lane] * sc), w1 = gp[64 + lane] * gelu_erf(pd[64 + lane] * sc);
            pd[lane] = w0 * (1.0f / PEER_VS); pd[64 + lane] = w1 * (1.0f / PEER_VS);
            LDS_WAIT();
            { const int k1 = 16 * (lane >> 3) + (lane & 7); WB[(tl0 + tk) * 64 + lane] = pk2(pd[k1], pd[k1 + 8]); }
        }
        LDS_WAIT(); ISTAMP(F, 21);
        LAS const unsigned* pww = WB + tl0 * 64 + g;
        {
            const unsigned char* vb0 = V8; const unsigned loff = 16u * (unsigned)j;
            PeerBatch Ba, Bb;
            float y[16];
#define V_COMPUTE(B, b) do { \
                LAS const unsigned* pw_ = pww + 32 * (b); \
                _Pragma("unroll") for (int mm = 0; mm < 4; ++mm) { const bf16x2_t w2_ = __builtin_bit_cast(bf16x2_t, pw_[8 * mm]); \
                    _Pragma("unroll") for (int q = 0; q < 4; ++q) { \
                        const unsigned pa_ = __builtin_amdgcn_perm((B).r[2 * mm + 1][q], (B).r[2 * mm][q], 0x05010400u), pb_ = __builtin_amdgcn_perm((B).r[2 * mm + 1][q], (B).r[2 * mm][q], 0x07030602u); \
                        y[4 * q + 0] = __builtin_amdgcn_fdot2_f32_bf16(__builtin_amdgcn_cvt_scalef32_pk_bf16_fp8((int)pa_, 1.0f, false), w2_, y[4 * q + 0], false); \
                        y[4 * q + 1] = __builtin_amdgcn_fdot2_f32_bf16(__builtin_amdgcn_cvt_scalef32_pk_bf16_fp8((int)pa_, 1.0f, true), w2_, y[4 * q + 1], false); \
                        y[4 * q + 2] = __builtin_amdgcn_fdot2_f32_bf16(__builtin_amdgcn_cvt_scalef32_pk_bf16_fp8((int)pb_, 1.0f, false), w2_, y[4 * q + 2], false); \
                        y[4 * q + 3] = __builtin_amdgcn_fdot2_f32_bf16(__builtin_amdgcn_cvt_scalef32_pk_bf16_fp8((int)pb_, 1.0f, true), w2_, y[4 * q + 3], false); } } } while (0)
            PeerBatch Bc, Bd;
            PeerOffs PO;
#define V_OFFS(fb) do { const int fb_ = ((fb) < 255) ? (fb) : 255; peer_offs(PO, elw + 64 * (fb_ & 15), loff); } while (0)
#define V_ISSUE(B, fb) do { const int fb_ = ((fb) < 255) ? (fb) : 255; peer_issue(B, vb0 + (size_t)(fb_ >> 4) * (16384 * 128), PO); V_OFFS((fb) + 1); } while (0)
#define V_STEP(B, fb, Bn, fbn) do { \
                V_ISSUE(Bn, fbn); \
                __builtin_amdgcn_sched_barrier(0); \
                V_COMPUTE(B, (fb) & 15); \
                __builtin_amdgcn_sched_barrier(0); } while (0)
#define V_FINISH(fb, xw) do { const int tk = ((fb) >> 1) & 7, sl = (fb) >> 4; \
                float z[8]; \
                _Pragma("unroll") for (int q = 0; q < 8; ++q) {            \
                    float a0 = y[q], b0 = y[8 + q]; \
                    asm volatile("v_nop\n\tv_nop\n\tv_permlane32_swap_b32 %0, %1" : "+v"(a0), "+v"(b0)); \
                    z[q] = a0 + b0; } \
                float qq[4]; \
                { const bool up = (lane & 16) != 0; \
                  _Pragma("unroll") for (int q = 0; q < 4; ++q) { const float snd = up ? z[q] : z[4 + q]; qq[q] = (up ? z[4 + q] : z[q]) + __shfl_xor(snd, 16); } } \
                f32x2 p; \
                { const bool up = (lane & 8) != 0; \
                  const float s0 = up ? qq[0] : qq[2], s1 = up ? qq[1] : qq[3]; p.x = (up ? qq[2] : qq[0]) + dpp_f<0x128>(s0); p.y = (up ? qq[3] : qq[1]) + dpp_f<0x128>(s1); } \
                const size_t eo = (tok0 + tk) * 2048 + 128 * sl + 16 * j + 2 * g; \
                const f32x2 x3 = (f32x2){bf_lo(xw), bf_hi(xw)} + p; \
                *(GAS f32x2*)(a.out + eo) = x3; \
                SSL[(tl0 + tk) * 64 + lane] += x3.x * x3.x + x3.y * x3.y; \
                _Pragma("unroll") for (int q = 0; q < 16; ++q) y[q] = 0.f; } while (0)
            V_OFFS(0); V_ISSUE(Ba, 0); V_ISSUE(Bb, 1); V_ISSUE(Bc, 2);
#pragma unroll
            for (int q = 0; q < 16; ++q) y[q] = 0.f;
#pragma unroll 1
            for (int fb = 0; fb < 256; fb += 4) {
                const unsigned xwA = *(const GAS unsigned*)(XB + (tok0 + ((fb >> 1) & 7)) * 2048 + 128 * (fb >> 4) + 16 * j + 2 * g);
                const unsigned xwB = *(const GAS unsigned*)(XB + (tok0 + (((fb + 2) >> 1) & 7)) * 2048 + 128 * (fb >> 4) + 16 * j + 2 * g);
                V_STEP(Ba, fb, Bd, fb + 3);
                V_STEP(Bb, fb + 1, Ba, fb + 4);
                V_FINISH(fb + 1, xwA);
                V_STEP(Bc, fb + 2, Bb, fb + 5);
                V_STEP(Bd, fb + 3, Bc, fb + 6);
                V_FINISH(fb + 3, xwB);
            }
#undef V_FINISH
#undef V_STEP
#undef V_ISSUE
#undef V_OFFS
#undef V_COMPUTE
        }
        LDS_WAIT(); ISTAMP(F, 22);
        const float* gfin = (const float*)a.in[I_GFINAL];
#pragma unroll 1
        for (int tk = 0; tk < 8; ++tk) {
            const float rstd = 1.0f / sqrtf(wave_sum(SSL[(tl0 + tk) * 64 + lane]) * (1.0f / 2048.0f) + EPS);
            float* xr = a.out + (tok0 + tk) * 2048 + 16 * j + 2 * g;
            f32x2 vv[16];
#pragma unroll
            for (int sl = 0; sl < 16; ++sl) vv[sl] = *(const GAS f32x2*)(xr + 128 * sl);
#pragma unroll
            for (int sl = 0; sl < 16; ++sl) { const f32x2 gg = *(const GAS f32x2*)(gfin + 128 * sl + 16 * j + 2 * g);
                *(GAS f32x2*)(xr + 128 * sl) = (f32x2){vv[sl].x * rstd * gg.x, vv[sl].y * rstd * gg.y}; }
        }
        LDS_WAIT();
    }
}

constexpr int NPHASES = 14;
#ifndef MK_ONE_LAUNCH
#define MK_ONE_LAUNCH 1
#endif
__global__ void __launch_bounds__(NTHREADS, 2) hybrid_fwd(Args args) {
    extern __shared__ __attribute__((aligned(16))) unsigned char lds_raw[];
    Frame F;
    F.lds = (LAS unsigned char*)lds_raw;
    F.tid = threadIdx.x; F.lane = F.tid & 63; F.wave = __builtin_amdgcn_readfirstlane(F.tid >> 6);
    F.G = gridDim.x; F.bid = blockIdx.x; F.ws = args.ws; F.dout = (unsigned char*)args.out;
    volatile LAS unsigned* MISC = (volatile LAS unsigned*)(F.lds + LDS_BYTES - 256);
    if (F.tid < 64) MISC[F.tid] = 0u;
    __syncthreads();
    XcdBarrier bar = xcd_barrier_post((unsigned*)(F.ws + WS_CTL) + 4096, MISC + 8);
    const int lo = args.ph_lo, hi = args.ph_hi;
#ifndef PROBE_MULT
#define PROBE_MULT 16
#endif
    if (PROBE_PHASE >= 0 && F.bid == 0 && F.tid == 0) { volatile LAS unsigned long long* ts_ = (volatile LAS unsigned long long*)(F.lds + LDS_BYTES - 64); ts_[0] = __builtin_amdgcn_s_memrealtime(); ts_[1] = 0; }
#define STAMP(k) FSTAMP(F, k)
#define IN(k) (lo <= (k) && (k) < hi && (F.lane = lane_id(), F.tid = F.wave * 64 + F.lane, true))
#define SEAM(k) do { if (IN(k) && IN((k) + 1)) xcd_barrier(bar); } while (0)
    unsigned char* ws = F.ws;
    LAS unsigned char* ring = F.lds;

    if (IN(0)) { ph0_prologue(F, args); } SEAM(0); STAMP(0);
    if (IN(1)) {
        Sched1 S{F.G, F.bid, ws, F.dout}; EpiProj E;
        pg8::gemm_phase<EpiProj, Sched1, true>(ring, F.tid, DM, DM, DM, S, E);
#if PROBE_PHASE == 52
        { __syncthreads(); ISTAMP(F, 51); Sched1 S2{F.G, F.bid, ws, F.dout}; EpiNull1 EN; pg8::gemm_phase<EpiNull1, Sched1, true>(ring, F.tid, DM, DM, DM, S2, EN); __syncthreads(); ISTAMP(F, 52); }
#endif
    } SEAM(1); STAMP(1);
    if (IN(2)) { ph2_mixers_a(F); } SEAM(2); STAMP(2);
    if (IN(3)) { ph_scan(F); } SEAM(3); STAMP(3);
    if (IN(4)) { ph3_mixers_b(F); } SEAM(4); STAMP(4);
    if (IN(5)) {
        { SchedG S{F.G, F.bid, 64, 8, (const char*)(ws + WS_RQ), (const char*)(ws + WS_WBR_T), (size_t)256 * 1024 * 2, (size_t)256 * 1024 * 2};
          EpiMerge<0> E{(bf16_t*)(ws + WS_GR), (bf16_t*)(ws + WS_GD)};
          pg8::gemm_phase<EpiMerge<0>, SchedG, true>(ring, F.tid, 1024, 1024, 1024, S, E); }
        { SchedG S{F.G, F.bid, 64, 8, (const char*)(ws + WS_DQ), (const char*)(ws + WS_WBD_T), (size_t)256 * 1536 * 2, (size_t)256 * 512 * 2};
          EpiMerge<1> E{(bf16_t*)(ws + WS_GR), (bf16_t*)(ws + WS_GD)};
          pg8::gemm_phase<EpiMerge<1>, SchedG, true>(ring, F.tid, 512, 1536, 512, S, E); }
    } SEAM(5); STAMP(5);
    if (IN(6)) {
        SchedG S{F.G, F.bid, 64, 8, (const char*)(ws + WS_GD), (const char*)(ws + WS_WOUT_T), (size_t)256 * 2048 * 2, (size_t)256 * 2048 * 2};
        EpiResid<true> E{(const float*)args.in[I_X], (bf16_t*)(ws + WS_XB), (float*)(ws + WS_SSQ1)};
        pg8::gemm_phase<EpiResid<true>, SchedG, true>(ring, F.tid, 2048, 2048, 2048, S, E);
    } SEAM(6); STAMP(6);
    if (IN(7)) {
        SchedG S{F.G, F.bid, 64, 8, (const char*)(ws + WS_XB), (const char*)(ws + WS_WQ_T), (size_t)256 * 2048 * 2, (size_t)256 * 2048 * 2};
        EpiRowScale E{(const float*)(ws + WS_SSQ1), (bf16_t*)(ws + WS_QM), 0.04419417382415922f * 1.4426950408889634f};
        pg8::gemm_phase<EpiRowScale, SchedG, true>(ring, F.tid, 2048, 2048, 2048, S, E);
#if PROBE_PHASE == 50
        { __syncthreads(); ISTAMP(F, 49); SchedG S2{F.G, F.bid, 64, 8, (const char*)(ws + WS_XB), (const char*)(ws + WS_WQ_T), (size_t)256 * 2048 * 2, (size_t)256 * 2048 * 2};
          EpiNull EN; pg8::gemm_phase<EpiNull, SchedG, true>(ring, F.tid, 2048, 2048, 2048, S2, EN); __syncthreads(); ISTAMP(F, 50); }
#endif
    } SEAM(7); STAMP(7);
    if (IN(8)) {
        Sched7 S{F.G, F.bid, (const char*)(ws + WS_QM), (const char*)(ws + WS_KM)};
        EpiSoftmax E{(bf16_t*)(ws + WS_P), (LAS float*)(F.lds + LDSX_OFF)};
        pg8::gemm_phase<EpiSoftmax, Sched7, true>(ring, F.tid, 512, 2048, 2048, S, E);
    } SEAM(8); STAMP(8);
    if (IN(9)) {
        Sched8 S{F.G, F.bid, (const char*)(ws + WS_P), (const char*)(ws + WS_VT)};
        EpiPlain E{(bf16_t*)(ws + WS_O), 2048};
        pg8::gemm_phase<EpiPlain, Sched8, true>(ring, F.tid, 256, 256, 2048, S, E);
    } SEAM(9); STAMP(9);
    if (IN(10)) {
        SchedG S{F.G, F.bid, 64, 8, (const char*)(ws + WS_O), (const char*)(ws + WS_WO_T), (size_t)256 * 2048 * 2, (size_t)256 * 2048 * 2};
        EpiResid<false> E{nullptr, (bf16_t*)(ws + WS_XB), (float*)(ws + WS_SSQ2)};
        pg8::gemm_phase<EpiResid<false>, SchedG, true>(ring, F.tid, 2048, 2048, 2048, S, E);
    } SEAM(10); STAMP(10);
    if (IN(11)) {
        SchedG S{F.G, F.bid, 64, 8, (const char*)(ws + WS_XB), (const char*)(ws + WS_WPQ_T), (size_t)256 * 2048 * 2, (size_t)256 * 2048 * 2};
        EpiRowScale E{(const float*)(ws + WS_SSQ2), (bf16_t*)(ws + WS_PQ), 1.0f};
        pg8::gemm_phase<EpiRowScale, SchedG, true>(ring, F.tid, 2048, 2048, 2048, S, E);
    } SEAM(11); STAMP(11);
    if (IN(12)) { ph11_route(F, args); } SEAM(12); STAMP(12);
    if (IN(13)) { ph12_peer(F, args); }
    if (PROBE_PHASE >= 0 && F.bid == 0) { __syncthreads(); STAMP(13); __syncthreads(); const unsigned long long t0_ = __builtin_amdgcn_s_memrealtime();
        const unsigned long long tsel_ = ((volatile LAS unsigned long long*)(F.lds + LDS_BYTES - 64))[1];
        while (__builtin_amdgcn_s_memrealtime() - t0_ < (unsigned long long)PROBE_MULT * tsel_) __builtin_amdgcn_s_sleep(8); }
#undef IN
#undef SEAM
}

extern "C" void kernel_launch(void* const* d_in, const int* in_sizes, int n_in, void* d_out, int out_size, void* d_ws, size_t ws_size, hipStream_t stream) {
    static int grid = 0;
    if (grid == 0) {
        if (n_in != 19 || out_size != MT * DM || ws_size < WS_END) { fprintf(stderr, "kernel_launch: unexpected shapes (n_in %d, out %d, ws %zu)\n", n_in, out_size, ws_size); grid = -1; return; }
        int dev = 0, cus = 0;
        if (hipGetDevice(&dev) != hipSuccess || hipDeviceGetAttribute(&cus, hipDeviceAttributeMultiprocessorCount, dev) != hipSuccess) { grid = -1; return; }
        if (hipFuncSetAttribute((const void*)hybrid_fwd, hipFuncAttributeMaxDynamicSharedMemorySize, LDS_BYTES) != hipSuccess) { fprintf(stderr, "kernel_launch: hipFuncSetAttribute failed\n"); grid = -1; return; }
        (void)hipGetLastError();
        grid = cus;
    }
    if (grid < 0) return;
    (void)hipMemsetAsync((char*)d_ws + WS_CTL, 0, CTL_ZERO_BYTES, stream);
    Args a{};
    for (int i = 0; i < 19; ++i) a.in[i] = d_in[i];
    a.out = (float*)d_out; a.ws = (unsigned char*)d_ws;
    for (int i = 0; i < 64; ++i) { a.fret[i] = std::pow(10000.0, -(double)i / 63.0); a.frot[i] = std::pow(10000.0, -(double)i / 64.0); }
#if MK_ONE_LAUNCH
    a.ph_lo = 0; a.ph_hi = NPHASES;
    hipLaunchKernelGGL(hybrid_fwd, dim3(grid), dim3(NTHREADS), LDS_BYTES, stream, a);
#else
    for (int ph = 0; ph < NPHASES; ++ph) {
        a.ph_lo = ph; a.ph_hi = ph + 1;
        hipLaunchKernelGGL(hybrid_fwd, dim3(grid), dim3(NTHREADS), LDS_BYTES, stream, a);
    }
#endif
}
#ifdef PHASE_PROBE
#define PROBE(k) __global__ void __launch_bounds__(NTHREADS, 2) probe_ph##k(Args args) { \
    extern __shared__ __attribute__((aligned(16))) unsigned char lds_raw[]; Frame F; F.lds = (LAS unsigned char*)lds_raw; F.tid = threadIdx.x; F.lane = F.tid & 63; \
    F.wave = __builtin_amdgcn_readfirstlane(F.tid >> 6); F.G = gridDim.x; F.bid = blockIdx.x; F.ws = args.ws; F.dout = (unsigned char*)args.out; unsigned char* ws = F.ws; LAS unsigned char* ring = F.lds;
PROBE(0) ph0_prologue(F, args); }
PROBE(1) Sched1 S{F.G, F.bid, ws, F.dout}; EpiProj E; pg8::gemm_phase<EpiProj, Sched1, true>(ring, F.tid, DM, DM, DM, S, E); }
PROBE(2) ph2_mixers_a(F); }
PROBE(3) ph3_mixers_b(F); }
PROBE(5) SchedG S{F.G, F.bid, 64, 8, (const char*)(ws + WS_GD), (const char*)(ws + WS_WOUT_T), (size_t)256 * 2048 * 2, (size_t)256 * 2048 * 2};
        EpiResid<true> E{(const float*)args.in[I_X], (bf16_t*)(ws + WS_XB), (float*)(ws + WS_SSQ1)};
        pg8::gemm_phase<EpiResid<true>, SchedG, true>(ring, F.tid, 2048, 2048, 2048, S, E); }
PROBE(7) Sched7 S{F.G, F.bid, (const char*)(ws + WS_QM), (const char*)(ws + WS_KM)};
        EpiSoftmax E{(bf16_t*)(ws + WS_P), (LAS float*)(F.lds + LDSX_OFF)};
        pg8::gemm_phase<EpiSoftmax, Sched7, true>(ring, F.tid, 512, 2048, 2048, S, E); }
PROBE(11) ph11_route(F, args); }
PROBE(12) ph12_peer(F, args); }
#endif
```

```cpp
#include <hip/hip_runtime.h>
#include <cstdio>
#include <cstdint>
#include <cmath>

#define LAS __attribute__((address_space(3)))
#define GAS __attribute__((address_space(1)))
#define DI __device__ __forceinline__
typedef unsigned short bf16_t;
typedef short bf16x8 __attribute__((ext_vector_type(8)));
typedef short s16x4 __attribute__((ext_vector_type(4)));
typedef short v4i16_t __attribute__((ext_vector_type(4)));
typedef float f32x2 __attribute__((ext_vector_type(2)));
typedef float f32x4 __attribute__((ext_vector_type(4)));
typedef float f32x16 __attribute__((ext_vector_type(16)));
typedef unsigned u32x2 __attribute__((ext_vector_type(2)));
typedef unsigned u32x4 __attribute__((ext_vector_type(4)));
typedef __bf16 bf16x2_t __attribute__((ext_vector_type(2)));

constexpr int NB = 8, SEQ = 2048, DM = 2048, MT = NB * SEQ;
constexpr int MEMT = 256, MROWS = NB * MEMT;
constexpr int INW = 12800;
constexpr float EPS = 1e-6f;
constexpr int NWAVES = 8, NTHREADS = 512;

constexpr size_t MiB = 1u << 20;
constexpr size_t WS_CTL = 0, CTL_ZERO_BYTES = 1 * MiB;
constexpr size_t WS_SSQ1 = 2 * MiB, WS_SSQ2 = 4 * MiB, WS_LSE = 6 * MiB, WS_EIDX = 8 * MiB, WS_GATE = 16 * MiB;
constexpr size_t WS_WIN_T = 24 * MiB, WS_WKV_T = 74 * MiB, WS_WBR_T = 90 * MiB, WS_WBD_T = 94 * MiB, WS_WOUT_T = 96 * MiB, WS_WQ_T = 104 * MiB, WS_WO_T = 112 * MiB, WS_WPQ_T = 120 * MiB;
constexpr size_t WS_SUBK = 128 * MiB, WS_KM = 130 * MiB, WS_VT = 138 * MiB;
constexpr size_t WS_RQ = 148 * MiB, WS_RK = 180 * MiB, WS_RV = 212 * MiB, WS_SG = 244 * MiB, WS_DQ = 276 * MiB, WS_DK = 324 * MiB, WS_DV = 372 * MiB, WS_GR = 420 * MiB, WS_GD = 484 * MiB;
constexpr size_t WS_END = 548 * MiB;
constexpr size_t WS_KVST = 24 * MiB;
constexpr size_t WS_XB = 24 * MiB;
constexpr size_t WS_QM = 180 * MiB;
constexpr size_t WS_PQ = 180 * MiB;
constexpr size_t WS_P = 244 * MiB;
constexpr size_t WS_O = 324 * MiB;
constexpr size_t WS_UTAB = 276 * MiB;
constexpr size_t WS_VTAB = 404 * MiB;
constexpr size_t DO_H1 = 0, DO_MEMN = 64 * MiB, DO_CSRET = 72 * MiB, DO_CSROT = 80 * MiB;
constexpr size_t DO_PREVT = 0;

DI unsigned f2bf(float f) { unsigned u = __builtin_bit_cast(unsigned, f); return (u + 0x7fffu + ((u >> 16) & 1u)) >> 16; }
DI unsigned pk2(float lo, float hi) { f32x2 v = {lo, hi}; bf16x2_t b = __builtin_convertvector(v, bf16x2_t); return __builtin_bit_cast(unsigned, b); }
DI float bf_lo(unsigned w) { return __builtin_bit_cast(float, w << 16); }
DI float bf_hi(unsigned w) { return __builtin_bit_cast(float, w & 0xffff0000u); }
DI float wave_sum(float v) {
#pragma unroll
    for (int o = 1; o < 64; o <<= 1) v += __shfl_xor(v, o);
    return v;
}
#define LDS_WAIT() asm volatile("s_waitcnt lgkmcnt(0)" ::: "memory")
#define VM_WAIT() asm volatile("s_waitcnt vmcnt(0)" ::: "memory")
DI float fast_exp2(float x) { return __builtin_amdgcn_exp2f(x); }
DI float fast_rcp(float x) { return __builtin_amdgcn_rcpf(x); }
DI float sigmoid_f(float x) { return fast_rcp(1.f + fast_exp2(-1.4426950408889634f * x)); }

namespace pg8 {
constexpr int BM = 256, BK = 64, HALF = 128, HTB = HALF * BK * 2, STAGE_BYTES = 8 * HTB, NXCD = 8, WGM = 8;
__host__ __device__ __forceinline__ int lds_byte(int r, int c) { const int st = (r >> 4) * 2 + (c >> 5), rr = r & 15, cc = c & 31, ob = rr * 64 + cc * 2; return st * 1024 + (ob ^ (((ob >> 9) & 1) << 5)); }
__host__ __device__ __forceinline__ void stage_rc(int b, int& R, int& C) { const int st = b / 1024, sb = b % 1024, swz = sb ^ (((sb >> 9) & 1) << 5); R = (st >> 1) * 16 + swz / 64; C = (st & 1) * 32 + (swz % 64) / 2; }
__host__ __device__ __forceinline__ int perm32(int rho) { const int n = rho >> 4, i = rho & 15; return 8 * (i >> 2) + 4 * n + (i & 3); }

template <int WGM_> __device__ __forceinline__ void tile_of(int L, int nM, int nN, int& pm, int& pn) {
    const int nwg = nM * nN; int wgid = L;
    { const int q = nwg / NXCD, r = nwg % NXCD, xcd = wgid % NXCD, off = wgid / NXCD; wgid = (xcd < r ? xcd * (q + 1) : r * (q + 1) + (xcd - r) * q) + off; }
    const int nig = WGM_ * nN, gid = wgid / nig, fm = gid * WGM_, gsz = (nM - fm) < WGM_ ? (nM - fm) : WGM_;
    pm = fm + ((wgid % nig) % gsz); pn = (wgid % nig) / gsz;
}

template <class Epi, class Sched, bool ALIGN_EPI>
__device__ __forceinline__ void gemm_phase(LAS unsigned char* lds, const int tid, const int K, const int lda, const int ldb, const Sched& S, const Epi& E) {
    typedef typename Sched::Unit Unit;
    const int wid = __builtin_amdgcn_readfirstlane(tid >> 6), lane = tid & 63, wr = wid >> 2, wc = wid & 3, fr = lane & 15, fq = lane >> 4;
    const int nt = K / BK;
    unsigned voffA[2], voffB[2];
#pragma unroll
    for (int i = 0; i < 2; ++i) { int R, C; stage_rc(tid * 16 + i * 8192, R, C); const int Rb = (R & ~31) + perm32(R & 31);
        voffA[i] = (unsigned)(R * lda + C) * 2u; voffB[i] = (unsigned)(Rb * ldb + C) * 2u; }
    const size_t kstep = (size_t)(BK * 2);
    const size_t hstepA = (size_t)HALF * lda * 2, hstepB = (size_t)HALF * ldb * 2;
    const unsigned ldsw = (unsigned)wid * 1024u;
    const int aoff = lds_byte(wr * 64 + fr, fq * 8), boff = lds_byte(wc * 32 + fr, fq * 8);
#define PG8_SA(b, h) (((b) * 2 + (h)) * HTB)
#define PG8_SB(b, h) ((4 + (b) * 2 + (h)) * HTB)
#define PG8_STAGE(bufoff, gbase, voff) do { _Pragma("unroll") for (int _i = 0; _i < 2; ++_i) \
        __builtin_amdgcn_global_load_lds((const unsigned*)((const char*)(gbase) + (voff)[_i]), (LAS unsigned*)(lds + (bufoff) + ldsw + _i * 8192), 16, 0, 0); } while (0)
#define PG8_LDA(dst, b, h) do { _Pragma("unroll") for (int m = 0; m < 4; ++m) _Pragma("unroll") for (int k = 0; k < 2; ++k) dst[m][k] = *(const LAS bf16x8*)(lds + PG8_SA(b, h) + aoff + m * 2048 + k * 1024); } while (0)
#define PG8_LDB(dst, b, h) do { _Pragma("unroll") for (int n = 0; n < 2; ++n) _Pragma("unroll") for (int k = 0; k < 2; ++k) dst[n][k] = *(const LAS bf16x8*)(lds + PG8_SB(b, h) + boff + n * 2048 + k * 1024); } while (0)
#define PG8_MMA(ai, bj, At, Bt) do { __builtin_amdgcn_s_setprio(1); _Pragma("unroll") for (int m = 0; m < 4; ++m) _Pragma("unroll") for (int n = 0; n < 2; ++n) _Pragma("unroll") for (int k = 0; k < 2; ++k) \
        acc[ai][bj][m][n] = __builtin_amdgcn_mfma_f32_16x16x32_bf16(Bt[n][k], At[m][k], acc[ai][bj][m][n], 0, 0, 0); __builtin_amdgcn_s_setprio(0); } while (0)
#define PG8_WAIT_V(n) asm volatile("s_waitcnt vmcnt(" #n ")" ::: "memory")
#define PG8_WAIT_L(n) asm volatile("s_waitcnt lgkmcnt(" #n ")" ::: "memory")
#define PG8_BAR __builtin_amdgcn_s_barrier()
#define PG8_SCHED __builtin_amdgcn_sched_barrier(0)
    Unit cur, nxt; int ui = 0;
    if (!S.next(0, cur)) return;
    f32x4 acc[2][2][4][2];
#pragma unroll
    for (int a = 0; a < 2; ++a)
#pragma unroll
        for (int b = 0; b < 2; ++b)
#pragma unroll
            for (int m = 0; m < 4; ++m)
#pragma unroll
                for (int n = 0; n < 2; ++n) acc[a][b][m][n] = (f32x4){0.f, 0.f, 0.f, 0.f};
    bf16x8 At[4][2], B0[2][2], B1[2][2];
    const char* cA = cur.A; const char* cB = cur.B;
    PG8_STAGE(PG8_SB(0, 0), cB, voffB); PG8_STAGE(PG8_SB(0, 1), cB + hstepB, voffB); PG8_STAGE(PG8_SA(0, 0), cA, voffA); PG8_STAGE(PG8_SA(0, 1), cA + hstepA, voffA);
    if (wr == 1) PG8_BAR;
    PG8_WAIT_V(2); PG8_BAR;
    PG8_STAGE(PG8_SB(1, 0), cB + kstep, voffB); PG8_STAGE(PG8_SA(1, 0), cA + kstep, voffA); PG8_STAGE(PG8_SB(1, 1), cB + hstepB + kstep, voffB);
    PG8_WAIT_V(6); PG8_BAR;
    for (;;) {
        const bool has_next = S.next(ui + 1, nxt);
        const char* nA = has_next ? nxt.A : cA; const char* nB = has_next ? nxt.B : cB;
        for (int t = 0; t < nt; t += 2) {
            const bool last = (t == nt - 2);
            const char* a1 = cA + (size_t)(t + 1) * kstep;
            const char* a2 = last ? nA : cA + (size_t)(t + 2) * kstep; const char* b2 = last ? nB : cB + (size_t)(t + 2) * kstep;
            const char* a3 = a2 + kstep; const char* b3 = b2 + kstep;
            PG8_LDB(B0, 0, 0); PG8_LDB(B1, 0, 1); PG8_SCHED; PG8_LDA(At, 0, 0); PG8_STAGE(PG8_SA(1, 1), a1 + hstepA, voffA);
            PG8_WAIT_V(8); PG8_WAIT_L(0); PG8_BAR; PG8_MMA(0, 0, At, B0); PG8_MMA(0, 1, At, B1); PG8_BAR; PG8_SCHED;
            PG8_LDA(At, 0, 1); PG8_STAGE(PG8_SB(0, 0), b2, voffB); PG8_STAGE(PG8_SB(0, 1), b2 + hstepB, voffB); PG8_STAGE(PG8_SA(0, 0), a2, voffA);
            PG8_WAIT_V(8); PG8_WAIT_L(0); PG8_BAR; PG8_MMA(1, 0, At, B0); PG8_MMA(1, 1, At, B1); PG8_BAR; PG8_SCHED;
            PG8_LDB(B0, 1, 0); PG8_LDB(B1, 1, 1); PG8_SCHED; PG8_LDA(At, 1, 0); PG8_STAGE(PG8_SA(0, 1), a2 + hstepA, voffA);
            PG8_WAIT_V(8); PG8_WAIT_L(0); PG8_BAR; PG8_MMA(0, 0, At, B0); PG8_MMA(0, 1, At, B1); PG8_BAR; PG8_SCHED;
            PG8_LDA(At, 1, 1); PG8_STAGE(PG8_SB(1, 0), b3, voffB); PG8_STAGE(PG8_SB(1, 1), b3 + hstepB, voffB); PG8_STAGE(PG8_SA(1, 0), a3, voffA);
            PG8_WAIT_V(8); PG8_WAIT_L(0); PG8_BAR; PG8_MMA(1, 0, At, B0); PG8_MMA(1, 1, At, B1); PG8_BAR; PG8_SCHED;
        }
        if constexpr (ALIGN_EPI) { if (wr == 0) PG8_BAR; }
        E(acc, cur, wr, wc, fr, fq, wid, lane);
        if (!has_next) break;
#pragma unroll
        for (int a = 0; a < 2; ++a)
#pragma unroll
            for (int b = 0; b < 2; ++b)
#pragma unroll
                for (int m = 0; m < 4; ++m)
#pragma unroll
                    for (int n = 0; n < 2; ++n) acc[a][b][m][n] = (f32x4){0.f, 0.f, 0.f, 0.f};
        cur = nxt; cA = nA; cB = nB; ++ui;
        if constexpr (ALIGN_EPI) { if (wr == 1) PG8_BAR; }
    }
    PG8_WAIT_V(0);
    if constexpr (!ALIGN_EPI) { if (wr == 0) PG8_BAR; }
    PG8_BAR;
#undef PG8_SA
#undef PG8_SB
#undef PG8_STAGE
#undef PG8_LDA
#undef PG8_LDB
#undef PG8_MMA
#undef PG8_WAIT_V
#undef PG8_WAIT_L
#undef PG8_BAR
#undef PG8_SCHED
}
}

constexpr int RING_BYTES = 131072;
constexpr int LDSX_OFF = RING_BYTES;
constexpr int LDSCTL_OFF = RING_BYTES + 16384;
constexpr int LDS_BYTES = 163840;

typedef GAS unsigned gu32;
#define RLX_AGENT __ATOMIC_RELAXED, __HIP_MEMORY_SCOPE_AGENT

#define XB_TMO      128
#define XB_XCNT(j)  (256  + 64 * (j))
#define XB_XSUB(j)  (1280 + 64 * (j))
#define XB_XGEN(j)  (2304 + 64 * (j))
#define XB_TOP      3328
#define XB_TOPGEN   3392
#define XCD_BAR_WORDS 3456
#define XB_SPIN_CAP (1u << 20)
DI unsigned xb_ld(unsigned* p)              { return __hip_atomic_load(p, __ATOMIC_RELAXED, __HIP_MEMORY_SCOPE_AGENT); }
DI unsigned xb_add(unsigned* p, unsigned v) { return __hip_atomic_fetch_add(p, v, __ATOMIC_RELAXED, __HIP_MEMORY_SCOPE_AGENT); }
DI unsigned xb_xcc_id() { return (unsigned)__builtin_amdgcn_s_getreg((3 << 11) | 20) & 0xFu; }
#define XB_SPIN(cond, bar) do { unsigned _sp = 0; while (cond) { __builtin_amdgcn_s_sleep(1); \
    if ((++_sp & 255u) == 0u) { if (xb_ld(&(bar)[XB_TMO])) break; if (_sp > XB_SPIN_CAP) { atomicAdd(&(bar)[XB_TMO], 1u); break; } } } } while (0)
struct XcdBarrier { unsigned* bar; unsigned x; volatile LAS unsigned* st; };
DI XcdBarrier xcd_barrier_post(unsigned* bar, volatile LAS unsigned* st) {
    XcdBarrier b; b.bar = bar; b.x = xb_xcc_id(); b.st = st;
    if (threadIdx.x == 0) (void)xb_add(&bar[XB_XCNT(b.x)], 1u);
    return b;
}
DI void xcd_barrier_complete(unsigned* bar, unsigned x, unsigned& nloc, unsigned& nx) {
    const unsigned G = gridDim.x * gridDim.y * gridDim.z;
    unsigned sum, cnt, mine, sp = 0u;
    for (;;) {
        sum = 0u; cnt = 0u; mine = 0u;
#pragma unroll
        for (unsigned j = 0; j < 16; ++j) { const unsigned c = xb_ld(&bar[XB_XCNT(j)]); sum += c; cnt += (c > 0u) ? 1u : 0u; mine = (j == x) ? c : mine; }
        if (sum == G) break;
        __builtin_amdgcn_s_sleep(1);
        if ((++sp & 255u) == 0u) { if (xb_ld(&bar[XB_TMO])) break; if (sp > XB_SPIN_CAP) { atomicAdd(&bar[XB_TMO], 1u); break; } }
    }
    nloc = mine > 0u ? mine : 1u; nx = cnt > 0u ? cnt : 1u;
}
DI void xcd_barrier(const XcdBarrier& b) {
    asm volatile("s_waitcnt vmcnt(0)" ::: "memory");
    __syncthreads();
    if (threadIdx.x == 0) {
        unsigned* bar = b.bar;
        __builtin_amdgcn_s_waitcnt(0);
        unsigned nloc = b.st[0], nx = b.st[1];
        if (nloc == 0u) { xcd_barrier_complete(bar, b.x, nloc, nx); b.st[0] = nloc; b.st[1] = nx; }
        const unsigned old = xb_add(&bar[XB_XSUB(b.x)], 1u);
        const unsigned gen = old / nloc;
        if (old + 1u == (gen + 1u) * nloc) {
            __builtin_amdgcn_fence(__ATOMIC_RELEASE, "agent");
            asm volatile("s_waitcnt vmcnt(0)" ::: "memory");
            const unsigned og = xb_add(&bar[XB_TOP], 1u);
            const unsigned tg = og / nx;
            if (og + 1u == (tg + 1u) * nx) xb_add(&bar[XB_TOPGEN], 1u);
            else XB_SPIN(xb_ld(&bar[XB_TOPGEN]) == tg, bar);
            __builtin_amdgcn_fence(__ATOMIC_ACQUIRE, "agent");
            xb_add(&bar[XB_XGEN(b.x)], 1u);
            asm volatile("s_waitcnt vmcnt(0)" ::: "memory");
        } else {
            XB_SPIN(xb_ld(&bar[XB_XGEN(b.x)]) == gen, bar);
            __builtin_amdgcn_fence(__ATOMIC_ACQUIRE, "agent");
            asm volatile("s_waitcnt vmcnt(0)" ::: "memory");
        }
    }
    __syncthreads();
}

struct Args {
    const void* in[19]; float* out; unsigned char* ws; int ph_lo, ph_hi;
    double fret[64]; double frot[64];
};
DI int lane_id() { int l; asm volatile("v_mbcnt_lo_u32_b32 %0, -1, 0\n\tv_mbcnt_hi_u32_b32 %0, -1, %0" : "=v"(l)); return l; }
struct Frame {
    LAS unsigned char* lds;
    int tid, lane, wave, G, bid;
    unsigned char* ws; unsigned char* dout;
};
#ifndef PROBE_PHASE
#define PROBE_PHASE -1
#endif
#define ISTAMP(F, k) do { if (PROBE_PHASE >= 20) { __syncthreads(); FSTAMP(F, k); } } while (0)
#define FSTAMP(F, k) do { if (PROBE_PHASE >= 0 && (F).bid == 0 && (F).tid == 0) { volatile LAS unsigned long long* ts_ = (volatile LAS unsigned long long*)((F).lds + LDS_BYTES - 64); \
    const unsigned long long t_ = __builtin_amdgcn_s_memrealtime(); if ((k) == PROBE_PHASE) ts_[1] = t_ - ts_[0]; ts_[0] = t_; } } while (0)
enum { I_X = 0, I_MEM, I_POS, I_GMIX, I_WIN, I_WBR, I_WBD, I_WOUT, I_GCROSS, I_GMEM, I_WQ, I_WKV, I_WO, I_GFFN, I_WPQ, I_SUBK, I_PU, I_PV, I_GFINAL };

DI void tr_item(const float* W, int K, int N, bf16_t* WT, const float* scale, int rot_lo, int rot_hi, LAS float* scr, int item, int lane) {
    const int nblk = N / 64, kb = item / nblk, nb = item % nblk, k0 = 64 * kb, c0 = 64 * nb;
    f32x4 wv[16];
#pragma unroll
    for (int i = 0; i < 16; ++i) { const int kk = 4 * i + (lane >> 4); wv[i] = *(const GAS f32x4*)(W + (size_t)(k0 + kk) * N + c0 + 4 * (lane & 15)); }
    if (scale) {
#pragma unroll
        for (int i = 0; i < 16; ++i) wv[i] = wv[i] * scale[k0 + 4 * i + (lane >> 4)];
    }
#pragma unroll
    for (int i = 0; i < 16; ++i) { const int kk = 4 * i + (lane >> 4); *(LAS f32x4*)(scr + kk * 68 + 4 * (lane & 15)) = wv[i]; }
    LDS_WAIT();
    const bool rot = (c0 >= rot_lo) && (c0 < rot_hi);
    const int hb = c0 & ~127, half = (c0 >> 6) & 1;
    const int c = lane & 7;
#pragma unroll
    for (int j = 0; j < 8; ++j) { const int n = (lane >> 3) + 8 * j; const LAS float* sp = scr + (8 * c) * 68 + n;
        u32x4 o; o.x = pk2(sp[0 * 68], sp[1 * 68]); o.y = pk2(sp[2 * 68], sp[3 * 68]); o.z = pk2(sp[4 * 68], sp[5 * 68]); o.w = pk2(sp[6 * 68], sp[7 * 68]);
        const int drow = rot ? (hb + 2 * n + half) : (c0 + n);
        *(GAS u32x4*)(WT + (size_t)drow * K + k0 + 8 * c) = o; }
    LDS_WAIT();
}
DI void rms_row_bf16(const float* xrow, const float* g, bf16_t* orow, int lane) {
    const GAS f32x4* xr = (const GAS f32x4*)xrow + lane; const GAS f32x4* gr = (const GAS f32x4*)g + lane;
    f32x4 v[8]; float s = 0.f;
#pragma unroll
    for (int j = 0; j < 8; ++j) { v[j] = xr[64 * j]; s += (v[j].x * v[j].x + v[j].y * v[j].y) + (v[j].z * v[j].z + v[j].w * v[j].w); }
    const float rstd = 1.0f / sqrtf(wave_sum(s) * (1.f / DM) + EPS);
    GAS u32x2* o8 = (GAS u32x2*)orow + lane;
#pragma unroll
    for (int j = 0; j < 8; ++j) { const f32x4 gg = gr[64 * j]; u32x2 o; o.x = pk2(v[j].x * rstd * gg.x, v[j].y * rstd * gg.y); o.y = pk2(v[j].z * rstd * gg.z, v[j].w * rstd * gg.w); o8[64 * j] = o; }
}
DI void sincos_d(double a, float& c, float& s) {
    const double x = a * 0.63661977236758134308; const double q = __builtin_rint(x);
    double r = __builtin_fma(-q, 1.57079632679489655800, a); r = __builtin_fma(-q, 6.12323399573676603587e-17, r);
    const int qi = ((int)q) & 3; const double r2 = r * r;
    double sn = 1.0 / 6227020800.0; sn = sn * r2 - 1.0 / 39916800.0; sn = sn * r2 + 1.0 / 362880.0; sn = sn * r2 - 1.0 / 5040.0; sn = sn * r2 + 1.0 / 120.0; sn = sn * r2 - 1.0 / 6.0; sn = sn * r2 + 1.0; sn *= r;
    double cs = -1.0 / 87178291200.0; cs = cs * r2 + 1.0 / 479001600.0; cs = cs * r2 - 1.0 / 3628800.0; cs = cs * r2 + 1.0 / 40320.0; cs = cs * r2 - 1.0 / 720.0; cs = cs * r2 + 1.0 / 24.0; cs = cs * r2 - 0.5; cs = cs * r2 + 1.0;
    const double so = (qi == 0) ? sn : (qi == 1) ? cs : (qi == 2) ? -sn : -cs;
    const double co = (qi == 0) ? cs : (qi == 1) ? -sn : (qi == 2) ? -cs : sn;
    c = (float)co; s = (float)so;
}
DI void ph0_prologue(const Frame& F, const Args& a) {
    LAS float* scr = (LAS float*)(F.lds + F.wave * 17408);
    const int gw = F.bid * NWAVES + F.wave, NGW = F.G * NWAVES;
    unsigned char* ws = F.ws;
    constexpr int I_IN = (DM / 64) * (INW / 64), I_KV = (DM / 64) * (4096 / 64), I_BR = (1024 / 64) * (DM / 64), I_BD = (512 / 64) * (DM / 64), I_SQ = (DM / 64) * (DM / 64);
    constexpr int NITEMS = I_IN + I_KV + I_BR + I_BD + 4 * I_SQ;
    for (int it = gw; it < NITEMS; it += NGW) {
        int r = it;
        if (r < I_IN) { tr_item((const float*)a.in[I_WIN], DM, INW, (bf16_t*)(ws + WS_WIN_T), nullptr, 4096, 7168, scr, r, F.lane); continue; } r -= I_IN;
        if (r < I_KV) { tr_item((const float*)a.in[I_WKV], DM, 4096, (bf16_t*)(ws + WS_WKV_T), nullptr, 0, 0, scr, r, F.lane); continue; } r -= I_KV;
        if (r < I_BR) { tr_item((const float*)a.in[I_WBR], 1024, DM, (bf16_t*)(ws + WS_WBR_T), nullptr, 0, 0, scr, r, F.lane); continue; } r -= I_BR;
        if (r < I_BD) { tr_item((const float*)a.in[I_WBD], 512, DM, (bf16_t*)(ws + WS_WBD_T), nullptr, 0, 0, scr, r, F.lane); continue; } r -= I_BD;
        if (r < I_SQ) { tr_item((const float*)a.in[I_WOUT], DM, DM, (bf16_t*)(ws + WS_WOUT_T), nullptr, 0, 0, scr, r, F.lane); continue; } r -= I_SQ;
        if (r < I_SQ) { tr_item((const float*)a.in[I_WQ], DM, DM, (bf16_t*)(ws + WS_WQ_T), (const float*)a.in[I_GCROSS], 0, 0, scr, r, F.lane); continue; } r -= I_SQ;
        if (r < I_SQ) { tr_item((const float*)a.in[I_WO], DM, DM, (bf16_t*)(ws + WS_WO_T), nullptr, 0, 0, scr, r, F.lane); continue; } r -= I_SQ;
        tr_item((const float*)a.in[I_WPQ], DM, DM, (bf16_t*)(ws + WS_WPQ_T), (const float*)a.in[I_GFFN], 0, 0, scr, r, F.lane);
    }
    ISTAMP(F, 42);
    for (int m = gw; m < MT; m += NGW) rms_row_bf16((const float*)a.in[I_X] + (size_t)m * DM, (const float*)a.in[I_GMIX], (bf16_t*)(F.dout + DO_H1) + (size_t)m * DM, F.lane);
    for (int m = gw; m < MROWS; m += NGW) rms_row_bf16((const float*)a.in[I_MEM] + (size_t)m * DM, (const float*)a.in[I_GMEM], (bf16_t*)(F.dout + DO_MEMN) + (size_t)m * DM, F.lane);
    ISTAMP(F, 43);
    const int gt = F.bid * NTHREADS + F.tid, NGT = F.G * NTHREADS;
    for (int i = gt; i < 16 * 128 * 128 / 8; i += NGT) {
        const GAS f32x4* s = (const GAS f32x4*)a.in[I_SUBK] + 2 * (size_t)i; const f32x4 v0 = s[0], v1 = s[1];
        u32x4 o; o.x = pk2(v0.x, v0.y); o.y = pk2(v0.z, v0.w); o.z = pk2(v1.x, v1.y); o.w = pk2(v1.z, v1.w);
        ((GAS u32x4*)(ws + WS_SUBK))[i] = o;
    }
    for (int i = gt; i < MT * 64; i += NGT) {
        const int t = i >> 6, k = i & 63; const double pos = (double)((const int*)a.in[I_POS])[t];
        { const double rv = pos * a.fret[k] * 0.15915494309189533577; const float fr = (float)(rv - __builtin_floor(rv));
          ((GAS f32x2*)(F.dout + DO_CSRET))[i] = (f32x2){__builtin_amdgcn_cosf(fr), __builtin_amdgcn_sinf(fr)}; }
        { const double rv = pos * a.frot[k] * 0.15915494309189533577; const float fr = (float)(rv - __builtin_floor(rv));
          ((GAS f32x2*)(F.dout + DO_CSROT))[i] = (f32x2){__builtin_amdgcn_cosf(fr), __builtin_amdgcn_sinf(fr)}; }
    }
}

#ifndef WGM_PROJ
#define WGM_PROJ 2
#endif
#ifndef WGM_MID
#define WGM_MID 4
#endif
struct Unit1 { const char* A; const char* B; int pm, pn; int mode; bf16_t* out; int ldo; float scale; const float* cs; };
struct Sched1 {
    typedef Unit1 Unit;
    int G, c; unsigned char* ws; unsigned char* dout;
    DI bool next(int i, Unit& u) const {
        const int L = i * G + c; if (L >= 3328) return false;
        if (L < 3200) {
            int pm, pn; pg8::tile_of<WGM_PROJ>(L, 64, 50, pm, pn); u.pm = pm; u.pn = pn;
            u.A = (const char*)(dout + DO_H1) + (size_t)pm * 256 * DM * 2; u.B = (const char*)(ws + WS_WIN_T) + (size_t)pn * 256 * DM * 2;
            u.scale = 1.f; u.cs = nullptr; u.mode = 0;
            const size_t rowoff = (size_t)pm * 256;
            if (pn < 4)       { u.mode = 1; u.out = (bf16_t*)(ws + WS_RQ) + rowoff * 1024 + (pn - 0) * 256; u.ldo = 1024; u.cs = (const float*)(dout + DO_CSRET); }
            else if (pn < 8)  { u.mode = 1; u.out = (bf16_t*)(ws + WS_RK) + rowoff * 1024 + (pn - 4) * 256; u.ldo = 1024; u.cs = (const float*)(dout + DO_CSRET); u.scale = 0.08838834764831845f; }
            else if (pn < 12) { u.out = (bf16_t*)(ws + WS_RV) + rowoff * 1024 + (pn - 8) * 256; u.ldo = 1024; }
            else if (pn < 16) { u.mode = 2; u.out = (bf16_t*)(ws + WS_SG) + rowoff * 1024 + (pn - 12) * 256; u.ldo = 1024; }
            else if (pn < 22) { u.mode = 1; u.out = (bf16_t*)(ws + WS_DQ) + rowoff * 1536 + (pn - 16) * 256; u.ldo = 1536; u.cs = (const float*)(dout + DO_CSROT); u.scale = 0.08838834764831845f * 1.4426950408889634f; }
            else if (pn < 28) { u.mode = 1; u.out = (bf16_t*)(ws + WS_DK) + rowoff * 1536 + (pn - 22) * 256; u.ldo = 1536; u.cs = (const float*)(dout + DO_CSROT); }
            else if (pn < 34) { u.out = (bf16_t*)(ws + WS_DV) + rowoff * 1536 + (pn - 28) * 256; u.ldo = 1536; }
            else if (pn < 42) { u.mode = 3; u.out = (bf16_t*)(ws + WS_GR) + rowoff * 2048 + (pn - 34) * 256; u.ldo = 2048; }
            else              { u.mode = 3; u.out = (bf16_t*)(ws + WS_GD) + rowoff * 2048 + (pn - 42) * 256; u.ldo = 2048; }
        } else {
            const int l = L - 3200; u.mode = 0; u.scale = 1.f; u.cs = nullptr; u.ldo = 2048;
            if (l < 64) { const int pm = l >> 3, pn = l & 7; u.pm = pm; u.pn = pn;
                u.A = (const char*)(dout + DO_MEMN) + (size_t)pm * 256 * DM * 2; u.B = (const char*)(ws + WS_WKV_T) + (size_t)pn * 256 * DM * 2;
                u.out = (bf16_t*)(ws + WS_KM) + (size_t)pm * 256 * 2048 + pn * 256; }
            else { const int l2 = l - 64, pm = l2 >> 3, pn = l2 & 7; u.pm = pm; u.pn = pn;
                u.A = (const char*)(ws + WS_WKV_T) + (size_t)(2048 + pm * 256) * DM * 2; u.B = (const char*)(dout + DO_MEMN) + (size_t)pn * 256 * DM * 2;
                u.out = (bf16_t*)(ws + WS_VT) + (size_t)pm * 256 * 2048 + pn * 256; }
        }
        return true;
    }
};
struct EpiNull1 {
    DI void operator()(const f32x4 (&acc)[2][2][4][2], const Unit1& u, int wr, int wc, int fr, int fq, int wid, int lane) const {
#pragma unroll
        for (int ai = 0; ai < 2; ++ai)
#pragma unroll
            for (int bj = 0; bj < 2; ++bj)
#pragma unroll
                for (int m = 0; m < 4; ++m) { asm volatile("" :: "v"(acc[ai][bj][m][0]), "v"(acc[ai][bj][m][1])); }
    }
};
struct EpiProj {
    template <int MODE> DI void emit(const f32x4 (&acc)[2][2][4][2], const Unit1& u, int wr, int wc, int fr, int fq) const {
        const int rowl0 = wr * 64 + fr, colb = wc * 32 + 8 * fq;
        f32x4 cs[2][4][2];
        if (MODE == 1) {
#pragma unroll
            for (int ai = 0; ai < 2; ++ai)
#pragma unroll
                for (int m = 0; m < 4; ++m) { const GAS f32x4* cp = (const GAS f32x4*)(u.cs + ((size_t)(u.pm * 256 + ai * 128 + m * 16 + rowl0) * 64 + (colb >> 1)) * 2); cs[ai][m][0] = cp[0]; cs[ai][m][1] = cp[1]; }
        }
#pragma unroll
        for (int ai = 0; ai < 2; ++ai)
#pragma unroll
            for (int m = 0; m < 4; ++m) {
                const int rl = ai * 128 + m * 16 + rowl0;
                f32x4 cs0 = {1.f, 0.f, 1.f, 0.f}, cs1 = cs0;
                if (MODE == 1) { cs0 = cs[ai][m][0]; cs1 = cs[ai][m][1]; }
                bf16_t* rowp = u.out + (size_t)rl * u.ldo + colb;
#pragma unroll
                for (int bj = 0; bj < 2; ++bj) {
                    f32x4 v0 = acc[ai][bj][m][0], v1 = acc[ai][bj][m][1];
                    if (MODE == 1) {
                        const f32x4 a0 = v0, a1 = v1; const float sc = u.scale;
                        v0.x = (a0.x * cs0.x - a0.y * cs0.y) * sc; v0.y = (a0.y * cs0.x + a0.x * cs0.y) * sc;
                        v0.z = (a0.z * cs0.z - a0.w * cs0.w) * sc; v0.w = (a0.w * cs0.z + a0.z * cs0.w) * sc;
                        v1.x = (a1.x * cs1.x - a1.y * cs1.y) * sc; v1.y = (a1.y * cs1.x + a1.x * cs1.y) * sc;
                        v1.z = (a1.z * cs1.z - a1.w * cs1.w) * sc; v1.w = (a1.w * cs1.z + a1.z * cs1.w) * sc;
                    } else if (MODE == 2) {
#pragma unroll
                        for (int e = 0; e < 4; ++e) { v0[e] = v0[e] * sigmoid_f(v0[e]); v1[e] = v1[e] * sigmoid_f(v1[e]); }
                    } else if (MODE == 3) {
#pragma unroll
                        for (int e = 0; e < 4; ++e) { v0[e] = sigmoid_f(v0[e]); v1[e] = sigmoid_f(v1[e]); }
                    }
                    u32x4 w; w.x = pk2(v0.x, v0.y); w.y = pk2(v0.z, v0.w); w.z = pk2(v1.x, v1.y); w.w = pk2(v1.z, v1.w);
                    *(GAS u32x4*)(rowp + bj * 128) = w;
                }
            }
    }
    DI void operator()(const f32x4 (&acc)[2][2][4][2], const Unit1& u, int wr, int wc, int fr, int fq, int wid, int lane) const {
        if (u.mode == 0) emit<0>(acc, u, wr, wc, fr, fq);
        else if (u.mode == 1) emit<1>(acc, u, wr, wc, fr, fq);
        else if (u.mode == 2) emit<2>(acc, u, wr, wc, fr, fq);
        else emit<3>(acc, u, wr, wc, fr, fq);
    }
};

#define MFMA32(a, b, c) __builtin_amdgcn_mfma_f32_32x32x16_bf16((a), (b), (c), 0, 0, 0)
DI int crow(int reg, int h) { return (reg & 3) + 8 * (reg >> 2) + 4 * h; }
DI s16x4 tr4(LAS const unsigned char* p) { return __builtin_bit_cast(s16x4, __builtin_amdgcn_ds_read_tr16_b64_v4i16((LAS v4i16_t*)p)); }
DI bf16x8 frag_tr(LAS const unsigned char* base, int pitch, int k0, int c0, int lane) {
    const int h = lane >> 5, blk = (lane >> 4) & 1, q = (lane & 15) >> 2, p = lane & 3;
    LAS const unsigned char* a = base + (k0 + 8 * h + q) * pitch + (c0 + 16 * blk + 4 * p) * 2;
    const s16x4 lo = tr4(a), hi = tr4(a + 4 * pitch);
    return __builtin_shufflevector(lo, hi, 0, 1, 2, 3, 4, 5, 6, 7);
}
DI bf16x8 frag_nt(LAS const unsigned char* base, int pitch, int r0, int k0, int lane) {
    return *(LAS const bf16x8*)(base + (r0 + (lane & 31)) * pitch + (k0 + 8 * (lane >> 5)) * 2);
}
DI f32x16 zero16() { f32x16 z;
#pragma unroll
    for (int i = 0; i < 16; ++i) z[i] = 0.f; return z; }
DI u32x4 scale_bf16x8(u32x4 v, float s) {
    u32x4 o; o.x = pk2(bf_lo(v.x) * s, bf_hi(v.x) * s); o.y = pk2(bf_lo(v.y) * s, bf_hi(v.y) * s); o.z = pk2(bf_lo(v.z) * s, bf_hi(v.z) * s); o.w = pk2(bf_lo(v.w) * s, bf_hi(v.w) * s); return o;
}
DI float ret_lg2gamma(int h) { return __builtin_log2f(1.0f - __builtin_exp2f(-5.0f - (float)h)); }

DI void ret_kv_item(const Frame& F, int bh, int n) {
    const int b = bh >> 3, h = bh & 7; const float lg = ret_lg2gamma(h);
    LAS unsigned char* VL = F.lds; LAS unsigned char* KL = F.lds + 128 * 320;
    const bf16_t* RK = (const bf16_t*)(F.ws + WS_RK); const bf16_t* RV = (const bf16_t*)(F.ws + WS_RV);
#pragma unroll
    for (int it = 0; it < 8; ++it) {
        const int idx = F.tid + NTHREADS * it, which = idx >> 11, rem = idx & 2047, row = rem >> 4, ch = rem & 15;
        const size_t tok = (size_t)b * SEQ + n * 128 + row;
        u32x4 v = *(const GAS u32x4*)((which ? RK : RV) + tok * 1024 + h * 128 + ch * 8);
        if (which) v = scale_bf16x8(v, fast_exp2(lg * (float)(127 - row)));
        *(LAS u32x4*)((which ? KL : VL) + row * 320 + ch * 16) = v;
    }
    __syncthreads();
    const int w = F.wave, lane = F.lane, eb = w >> 1, db0 = 2 * (w & 1);
    f32x16 acc0 = zero16(), acc1 = zero16();
#pragma unroll
    for (int s = 0; s < 8; ++s) {
        const bf16x8 a = frag_tr(VL, 320, 16 * s, 32 * eb, lane);
        const bf16x8 b0 = frag_tr(KL, 320, 16 * s, 32 * db0, lane), b1 = frag_tr(KL, 320, 16 * s, 32 * (db0 + 1), lane);
        acc0 = MFMA32(a, b0, acc0); acc1 = MFMA32(a, b1, acc1);
    }
    float* dst = (float*)(F.ws + WS_KVST) + ((size_t)(bh * 16 + n) * 128) * 128;
    const int r = lane & 31, hh = lane >> 5;
#pragma unroll
    for (int reg = 0; reg < 16; ++reg) { const int e = 32 * eb + crow(reg, hh);
        dst[(size_t)e * 128 + 32 * db0 + r] = acc0[reg]; dst[(size_t)e * 128 + 32 * (db0 + 1) + r] = acc1[reg]; }
    __syncthreads();
}

struct DilRegs { u32x4 vst[8], kst[8]; bf16x8 qf[8]; };
DI void dil_issue(const Frame& F, int item, DilRegs& R) {
    const int b = item / 192, rem = item % 192, head = rem >> 4, idx16 = rem & 15;
    const int g = head >> 2, r = (g == 0) ? 1 : (g == 1) ? 4 : 16, nbk = 16 / r, c = idx16 / nbk, n = idx16 % nbk;
    const bf16_t* DQ = (const bf16_t*)(F.ws + WS_DQ); const bf16_t* DK = (const bf16_t*)(F.ws + WS_DK); const bf16_t* DV = (const bf16_t*)(F.ws + WS_DV);
    const size_t tb = (size_t)b * SEQ; const int kbmin = (n == 0) ? 4 : 0;
    const int lane = F.lane, rr = lane & 31, hh = lane >> 5, wq = F.wave & 3;
#pragma unroll
    for (int it = 0; it < 8; ++it) {
        const int idx = F.tid + NTHREADS * it, row = idx >> 4, ch = idx & 15; const int rowl = (row >= 32 * kbmin) ? row : 128 + (row & 127);
        const size_t tok = tb + (size_t)((128 * (n - 1) + rowl) * r + c);
        R.vst[it] = *(const GAS u32x4*)(DV + tok * 1536 + head * 128 + ch * 8);
        R.kst[it] = *(const GAS u32x4*)(DK + tok * 1536 + head * 128 + ch * 8);
    }
    const size_t tokq = tb + (size_t)((128 * n + 32 * wq + rr) * r + c);
    const bf16_t* qp = DQ + tokq * 1536 + head * 128 + 8 * hh;
#pragma unroll
    for (int s = 0; s < 8; ++s) R.qf[s] = *(const GAS bf16x8*)(qp + 16 * s);
}
DI void dil_item(const Frame& F, int item, int nxt, DilRegs& R) {
    const int b = item / 192, rem = item % 192, head = rem >> 4, idx16 = rem & 15;
    const int g = head >> 2, r = (g == 0) ? 1 : (g == 1) ? 4 : 16, nbk = 16 / r, c = idx16 / nbk, n = idx16 % nbk;
    LAS unsigned char* VL = F.lds;
    LAS unsigned char* KL = F.lds + 256 * 320;
    LAS unsigned char* PL = F.lds + 256 * 320;
    LAS float* SMAX = (LAS float*)(F.lds + 256 * 320 + 256 * 272);
    LAS float* SSUM = SMAX + 256;
    bf16_t* DQ = (bf16_t*)(F.ws + WS_DQ);
    const size_t tb = (size_t)b * SEQ;
    const int kbmin = (n == 0) ? 4 : 0;
    const int lane = F.lane, rr = lane & 31, hh = lane >> 5, wq = F.wave & 3, wd = F.wave >> 2;
    const int qi = 32 * wq + rr;
    const size_t tokq = tb + (size_t)((128 * n + qi) * r + c);
#pragma unroll
    for (int it = 0; it < 8; ++it) { const int idx = F.tid + NTHREADS * it, row = idx >> 4, ch = idx & 15;
        if (row >= 32 * kbmin) { *(LAS u32x4*)(VL + row * 320 + ch * 16) = R.vst[it]; *(LAS u32x4*)(KL + row * 272 + ch * 16) = R.kst[it]; } }
    bf16x8 qf[8];
#pragma unroll
    for (int s = 0; s < 8; ++s) qf[s] = R.qf[s];
    __syncthreads();
    f32x16 st[3]; bool val[3]; float mloc = -INFINITY;
#pragma unroll
    for (int sl = 0; sl < 3; ++sl) {
        const int kb = wq + wd + 2 * sl; val[sl] = (kb <= wq + 4) && (kb >= kbmin);
        st[sl] = zero16();
        if (val[sl]) {
#pragma unroll
            for (int s = 0; s < 8; ++s) st[sl] = MFMA32(frag_nt(KL, 272, 32 * kb, 16 * s, lane), qf[s], st[sl]);
#pragma unroll
            for (int reg = 0; reg < 16; ++reg) { const int jj = 32 * kb + crow(reg, hh); const bool ok = (jj >= qi) && (jj <= qi + 128);
                st[sl][reg] = ok ? st[sl][reg] : -INFINITY; mloc = fmaxf(mloc, st[sl][reg]); }
        }
    }
    dil_issue(F, nxt, R);
    mloc = fmaxf(mloc, __shfl_xor(mloc, 32));
    if (hh == 0) SMAX[wd * 128 + qi] = mloc;
    __syncthreads();
    const float mx = fmaxf(SMAX[qi], SMAX[128 + qi]);
    float lloc = 0.f;
#pragma unroll
    for (int sl = 0; sl < 3; ++sl) {
        if (val[sl]) { const int kb = wq + wd + 2 * sl;
#pragma unroll
            for (int reg = 0; reg < 16; ++reg) { const float p = fast_exp2(st[sl][reg] - mx); st[sl][reg] = p; lloc += p; }
#pragma unroll
            for (int g4 = 0; g4 < 4; ++g4) { u32x2 w; w.x = pk2(st[sl][4 * g4], st[sl][4 * g4 + 1]); w.y = pk2(st[sl][4 * g4 + 2], st[sl][4 * g4 + 3]);
                *(LAS u32x2*)(PL + qi * 528 + (32 * kb + 8 * g4 + 4 * hh) * 2) = w; }
        }
    }
    lloc += __shfl_xor(lloc, 32);
    if (hh == 0) SSUM[wd * 128 + qi] = lloc;
    __syncthreads();
    const float lsum = SSUM[qi] + SSUM[128 + qi];
    f32x16 o0 = zero16(), o1 = zero16();
    const int kb_lo = (wq > kbmin) ? wq : kbmin;
    for (int kb = kb_lo; kb <= wq + 4; ++kb) {
#pragma unroll
        for (int s = 0; s < 2; ++s) {
            const bf16x8 pb = frag_nt(PL, 528, 32 * wq, 32 * kb + 16 * s, lane);
            const bf16x8 a0 = frag_tr(VL, 320, 32 * kb + 16 * s, 64 * wd, lane), a1 = frag_tr(VL, 320, 32 * kb + 16 * s, 64 * wd + 32, lane);
            o0 = MFMA32(a0, pb, o0); o1 = MFMA32(a1, pb, o1);
        }
    }
    const float inv = 1.0f / lsum;
    bf16_t* op = DQ + tokq * 1536 + head * 128 + 64 * wd + 4 * hh;
#pragma unroll
    for (int g4 = 0; g4 < 4; ++g4) {
        u32x2 w0, w1; w0.x = pk2(o0[4 * g4] * inv, o0[4 * g4 + 1] * inv); w0.y = pk2(o0[4 * g4 + 2] * inv, o0[4 * g4 + 3] * inv);
        w1.x = pk2(o1[4 * g4] * inv, o1[4 * g4 + 1] * inv); w1.y = pk2(o1[4 * g4 + 2] * inv, o1[4 * g4 + 3] * inv);
        *(GAS u32x2*)(op + 8 * g4) = w0; *(GAS u32x2*)(op + 32 + 8 * g4) = w1;
    }
    if (wd == 0 && hh == 0) ((float*)(F.ws + WS_LSE))[(size_t)head * MT + tokq] = mx + __builtin_log2f(lsum);
    __syncthreads();
}

DI void ph2_mixers_a(const Frame& F) {
    for (int it = F.bid; it < 1024; it += F.G) ret_kv_item(F, it >> 4, it & 15);
    ISTAMP(F, 40);
    { DilRegs R; if (F.bid < 1536) dil_issue(F, F.bid, R);
      for (int it = F.bid; it < 1536; it += F.G) dil_item(F, it, (it + F.G < 1536) ? it + F.G : it, R); }
}

DI void ret_out_item(const Frame& F, int bh, int n) {
    const int b = bh >> 3, h = bh & 7; const float lg = ret_lg2gamma(h);
    LAS unsigned char* VL = F.lds;
    LAS unsigned char* PL = F.lds + 128 * 320;
    LAS unsigned char* PT = PL + 128 * 272;
    LAS float* SQ = (LAS float*)(PT + 128 * 272);
    bf16_t* RQ = (bf16_t*)(F.ws + WS_RQ); const bf16_t* RK = (const bf16_t*)(F.ws + WS_RK); const bf16_t* RV = (const bf16_t*)(F.ws + WS_RV); const bf16_t* SG = (const bf16_t*)(F.ws + WS_SG);
    const size_t tb = (size_t)b * SEQ + n * 128;
    LAS unsigned char* KL = (LAS unsigned char*)(SQ + 256);
    const int lane = F.lane, rr = lane & 31, hh = lane >> 5, wq = F.wave & 3, we = F.wave >> 2;
    const int qi = 32 * wq + rr;
    u32x4 vst[4], kst[4], pst[4];
    { const bf16_t* pv = (const bf16_t*)(F.dout + DO_PREVT) + (size_t)(bh * 16 + n) * 16384;
#pragma unroll
      for (int it = 0; it < 4; ++it) { const int idx = F.tid + NTHREADS * it, row = idx >> 4, ch = idx & 15;
          vst[it] = *(const GAS u32x4*)(RV + (tb + row) * 1024 + h * 128 + ch * 8);
          kst[it] = *(const GAS u32x4*)(RK + (tb + row) * 1024 + h * 128 + ch * 8);
          pst[it] = *(const GAS u32x4*)(pv + row * 128 + ch * 8); } }
    bf16x8 qf[8];
    { const bf16_t* qp = RQ + (tb + qi) * 1024 + h * 128 + 8 * hh;
#pragma unroll
      for (int s = 0; s < 8; ++s) qf[s] = *(const GAS bf16x8*)(qp + 16 * s); }
#pragma unroll
    for (int it = 0; it < 4; ++it) { const int idx = F.tid + NTHREADS * it, row = idx >> 4, ch = idx & 15;
        *(LAS u32x4*)(VL + row * 320 + ch * 16) = vst[it]; *(LAS u32x4*)(KL + row * 272 + ch * 16) = kst[it]; *(LAS u32x4*)(PT + row * 272 + ch * 16) = pst[it]; }
    __syncthreads();
#pragma unroll
    for (int sl = 0; sl < 2; ++sl) {
        const int kb = we + 2 * sl;
        if (kb <= wq) {
            f32x16 st = zero16();
#pragma unroll
            for (int s = 0; s < 8; ++s) st = MFMA32(frag_nt(KL, 272, 32 * kb, 16 * s, lane), qf[s], st);
#pragma unroll
            for (int reg = 0; reg < 16; ++reg) { const int j = 32 * kb + crow(reg, hh); st[reg] = (j <= qi) ? st[reg] * fast_exp2(lg * (float)(qi - j)) : 0.f; }
#pragma unroll
            for (int g4 = 0; g4 < 4; ++g4) { u32x2 w; w.x = pk2(st[4 * g4], st[4 * g4 + 1]); w.y = pk2(st[4 * g4 + 2], st[4 * g4 + 3]);
                *(LAS u32x2*)(PL + qi * 272 + (32 * kb + 8 * g4 + 4 * hh) * 2) = w; }
        }
    }
    __syncthreads();
    f32x16 in0 = zero16(), in1 = zero16(), cr0 = zero16(), cr1 = zero16();
    for (int kb = 0; kb <= wq; ++kb) {
#pragma unroll
        for (int s = 0; s < 2; ++s) {
            const bf16x8 pb = frag_nt(PL, 272, 32 * wq, 32 * kb + 16 * s, lane);
            const bf16x8 a0 = frag_tr(VL, 320, 32 * kb + 16 * s, 64 * we, lane), a1 = frag_tr(VL, 320, 32 * kb + 16 * s, 64 * we + 32, lane);
            in0 = MFMA32(a0, pb, in0); in1 = MFMA32(a1, pb, in1);
        }
    }
#pragma unroll
    for (int s = 0; s < 8; ++s) {
        const bf16x8 a0 = frag_nt(PT, 272, 64 * we, 16 * s, lane), a1 = frag_nt(PT, 272, 64 * we + 32, 16 * s, lane);
        cr0 = MFMA32(a0, qf[s], cr0); cr1 = MFMA32(a1, qf[s], cr1);
    }
    const float qw = fast_exp2(lg * (float)(qi + 1));
    float ss = 0.f;
#pragma unroll
    for (int reg = 0; reg < 16; ++reg) { in0[reg] += qw * cr0[reg]; in1[reg] += qw * cr1[reg]; ss += in0[reg] * in0[reg] + in1[reg] * in1[reg]; }
    ss += __shfl_xor(ss, 32);
    if (hh == 0) SQ[we * 128 + qi] = ss;
    __syncthreads();
    const float rstd = 1.0f / sqrtf((SQ[qi] + SQ[128 + qi]) * (1.0f / 128.0f) + EPS);
    const size_t off = (tb + qi) * 1024 + h * 128 + 64 * we + 4 * hh;
#pragma unroll
    for (int g4 = 0; g4 < 4; ++g4) {
        const u32x2 g0 = *(const GAS u32x2*)(SG + off + 8 * g4), g1 = *(const GAS u32x2*)(SG + off + 32 + 8 * g4);
        u32x2 w0, w1;
        w0.x = pk2(in0[4 * g4] * rstd * bf_lo(g0.x), in0[4 * g4 + 1] * rstd * bf_hi(g0.x)); w0.y = pk2(in0[4 * g4 + 2] * rstd * bf_lo(g0.y), in0[4 * g4 + 3] * rstd * bf_hi(g0.y));
        w1.x = pk2(in1[4 * g4] * rstd * bf_lo(g1.x), in1[4 * g4 + 1] * rstd * bf_hi(g1.x)); w1.y = pk2(in1[4 * g4 + 2] * rstd * bf_lo(g1.y), in1[4 * g4 + 3] * rstd * bf_hi(g1.y));
        *(GAS u32x2*)(RQ + off + 8 * g4) = w0; *(GAS u32x2*)(RQ + off + 32 + 8 * g4) = w1;
    }
    __syncthreads();
}
DI void ph_scan(const Frame& F) {
    const int gt = F.bid * NTHREADS + F.tid, NGT = F.G * NTHREADS;
    for (int i = gt; i < 64 * 4096; i += NGT) {
        const int bh = i >> 12, c4 = i & 4095; const float cd = fast_exp2(ret_lg2gamma(bh & 7) * 128.0f);
        const float* kv = (const float*)(F.ws + WS_KVST) + (size_t)(bh * 16) * 16384 + c4 * 4;
        bf16_t* pv = (bf16_t*)(F.dout + DO_PREVT) + (size_t)(bh * 16) * 16384 + c4 * 4;
        f32x4 v[16];
#pragma unroll
        for (int n = 0; n < 15; ++n) v[n] = *(const GAS f32x4*)(kv + (size_t)n * 16384);
        f32x4 st = {0.f, 0.f, 0.f, 0.f};
#pragma unroll
        for (int n = 0; n < 16; ++n) { u32x2 w; w.x = pk2(st.x, st.y); w.y = pk2(st.z, st.w); *(GAS u32x2*)(pv + (size_t)n * 16384) = w; if (n < 15) st = st * cd + v[n]; }
    }
}
DI void ph3_mixers_b(const Frame& F) {
    for (int it = F.bid; it < 1024; it += F.G) ret_out_item(F, it >> 4, it & 15);
    bf16_t* DQ = (bf16_t*)(F.ws + WS_DQ); const float* LSE = (const float*)(F.ws + WS_LSE);
    const int gt = F.bid * NTHREADS + F.tid, NGT = F.G * NTHREADS;
    for (int i = gt; i < MT * 64; i += NGT) {
        const int t = i >> 6, hg = (i >> 4) & 3, ch = i & 15;
        const float l0 = LSE[(size_t)hg * MT + t], l1 = LSE[(size_t)(4 + hg) * MT + t], l2 = LSE[(size_t)(8 + hg) * MT + t];
        const float mx = fmaxf(l0, fmaxf(l1, l2)); float w0 = fast_exp2(l0 - mx), w1 = fast_exp2(l1 - mx), w2 = fast_exp2(l2 - mx);
        const float inv = 1.0f / (w0 + w1 + w2); w0 *= inv; w1 *= inv; w2 *= inv;
        bf16_t* p = DQ + (size_t)t * 1536 + hg * 128 + ch * 8;
        const u32x4 a = *(const GAS u32x4*)p, bq = *(const GAS u32x4*)(p + 512), cq = *(const GAS u32x4*)(p + 1024);
        u32x4 o;
        o.x = pk2(w0 * bf_lo(a.x) + w1 * bf_lo(bq.x) + w2 * bf_lo(cq.x), w0 * bf_hi(a.x) + w1 * bf_hi(bq.x) + w2 * bf_hi(cq.x));
        o.y = pk2(w0 * bf_lo(a.y) + w1 * bf_lo(bq.y) + w2 * bf_lo(cq.y), w0 * bf_hi(a.y) + w1 * bf_hi(bq.y) + w2 * bf_hi(cq.y));
        o.z = pk2(w0 * bf_lo(a.z) + w1 * bf_lo(bq.z) + w2 * bf_lo(cq.z), w0 * bf_hi(a.z) + w1 * bf_hi(bq.z) + w2 * bf_hi(cq.z));
        o.w = pk2(w0 * bf_lo(a.w) + w1 * bf_lo(bq.w) + w2 * bf_lo(cq.w), w0 * bf_hi(a.w) + w1 * bf_hi(bq.w) + w2 * bf_hi(cq.w));
        *(GAS u32x4*)p = o;
    }
}

struct UnitG { const char* A; const char* B; int pm, pn; };
struct SchedG {
    typedef UnitG Unit;
    int G, c, nM, nN; const char* Abase; const char* Bbase; size_t astep, bstep;
    DI bool next(int i, Unit& u) const {
        const int L = i * G + c; if (L >= nM * nN) return false;
        int pm, pn; pg8::tile_of<WGM_MID>(L, nM, nN, pm, pn); u.pm = pm; u.pn = pn;
        u.A = Abase + (size_t)pm * astep; u.B = Bbase + (size_t)pn * bstep; return true;
    }
};
#define EPI_ROWS_BEGIN const int rowl0 = wr * 64 + fr, colb = wc * 32 + 8 * fq; _Pragma("unroll") for (int ai = 0; ai < 2; ++ai) _Pragma("unroll") for (int m = 0; m < 4; ++m) { const int rl = ai * 128 + m * 16 + rowl0;
#define EPI_ROWS_END }
DI u32x4 pack8(const f32x4 v0, const f32x4 v1) { u32x4 w; w.x = pk2(v0.x, v0.y); w.y = pk2(v0.z, v0.w); w.z = pk2(v1.x, v1.y); w.w = pk2(v1.z, v1.w); return w; }
DI void unpack8(const u32x4 w, f32x4& v0, f32x4& v1) { v0 = (f32x4){bf_lo(w.x), bf_hi(w.x), bf_lo(w.y), bf_hi(w.y)}; v1 = (f32x4){bf_lo(w.z), bf_hi(w.z), bf_lo(w.w), bf_hi(w.w)}; }

template <int PASS> struct EpiMerge {
    bf16_t* GR; bf16_t* GD;
    DI void operator()(const f32x4 (&acc)[2][2][4][2], const UnitG& u, int wr, int wc, int fr, int fq, int wid, int lane) const {
        const int rowl0 = wr * 64 + fr, colb = wc * 32 + 8 * fq;
        const size_t base = (size_t)(u.pm * 256 + rowl0) * 2048 + u.pn * 256 + colb;
#pragma unroll
        for (int ai = 0; ai < 2; ++ai) {
            u32x4 gr[4][2], gd[4][2];
#pragma unroll
            for (int m = 0; m < 4; ++m)
#pragma unroll
                for (int bj = 0; bj < 2; ++bj) { const size_t off = base + (size_t)(ai * 128 + m * 16) * 2048 + bj * 128;
                    gr[m][bj] = *(const GAS u32x4*)(GR + off); if (PASS == 1) gd[m][bj] = *(const GAS u32x4*)(GD + off); }
#pragma unroll
            for (int m = 0; m < 4; ++m)
#pragma unroll
                for (int bj = 0; bj < 2; ++bj) { const size_t off = base + (size_t)(ai * 128 + m * 16) * 2048 + bj * 128;
                    f32x4 g0, g1; unpack8(gr[m][bj], g0, g1);
                    if (PASS == 0) *(GAS u32x4*)(GR + off) = pack8(g0 * acc[ai][bj][m][0], g1 * acc[ai][bj][m][1]);
                    else { f32x4 d0, d1; unpack8(gd[m][bj], d0, d1); *(GAS u32x4*)(GD + off) = pack8(g0 + d0 * acc[ai][bj][m][0], g1 + d1 * acc[ai][bj][m][1]); } }
        }
    }
};
template <bool F32IN> struct EpiResid {
    const float* xf; bf16_t* XB; float* SSQ;
    DI void operator()(const f32x4 (&acc)[2][2][4][2], const UnitG& u, int wr, int wc, int fr, int fq, int wid, int lane) const {
        const int rowl0 = wr * 64 + fr, colb = wc * 32 + 8 * fq;
        const size_t trow = (size_t)(u.pm * 256 + rowl0); const size_t base = trow * 2048 + u.pn * 256 + colb;
#pragma unroll
        for (int ai = 0; ai < 2; ++ai) {
            f32x4 xo[4][2][2];
#pragma unroll
            for (int m = 0; m < 4; ++m)
#pragma unroll
                for (int bj = 0; bj < 2; ++bj) { const size_t off = base + (size_t)(ai * 128 + m * 16) * 2048 + bj * 128;
                    if (F32IN) { xo[m][bj][0] = *(const GAS f32x4*)(xf + off); xo[m][bj][1] = *(const GAS f32x4*)(xf + off + 4); }
                    else unpack8(*(const GAS u32x4*)(XB + off), xo[m][bj][0], xo[m][bj][1]); }
#pragma unroll
            for (int m = 0; m < 4; ++m) { float ss = 0.f;
#pragma unroll
                for (int bj = 0; bj < 2; ++bj) { const size_t off = base + (size_t)(ai * 128 + m * 16) * 2048 + bj * 128;
                    const f32x4 y0 = xo[m][bj][0] + acc[ai][bj][m][0], y1 = xo[m][bj][1] + acc[ai][bj][m][1];
                    *(GAS u32x4*)(XB + off) = pack8(y0, y1);
                    ss += (y0.x * y0.x + y0.y * y0.y) + (y0.z * y0.z + y0.w * y0.w) + (y1.x * y1.x + y1.y * y1.y) + (y1.z * y1.z + y1.w * y1.w); }
                ss += __shfl_xor(ss, 16); ss += __shfl_xor(ss, 32);
                if (fq == 0) SSQ[(trow + ai * 128 + m * 16) * 32 + u.pn * 4 + wc] = ss; }
        }
    }
};
struct EpiRowScale {
    const float* SSQ; bf16_t* out; float scale;
    DI void operator()(const f32x4 (&acc)[2][2][4][2], const UnitG& u, int wr, int wc, int fr, int fq, int wid, int lane) const {
        const int rowl0 = wr * 64 + fr, colb = wc * 32 + 8 * fq;
        const size_t trow = (size_t)(u.pm * 256 + rowl0);
        f32x4 p[2][4][2];
#pragma unroll
        for (int ai = 0; ai < 2; ++ai)
#pragma unroll
            for (int m = 0; m < 4; ++m) { const float* sp = SSQ + (trow + ai * 128 + m * 16) * 32 + fq * 8; p[ai][m][0] = *(const GAS f32x4*)sp; p[ai][m][1] = *(const GAS f32x4*)(sp + 4); }
#pragma unroll
        for (int ai = 0; ai < 2; ++ai)
#pragma unroll
            for (int m = 0; m < 4; ++m) {
                const f32x4 p0 = p[ai][m][0], p1 = p[ai][m][1];
                float ss = (p0.x + p0.y) + (p0.z + p0.w) + (p1.x + p1.y) + (p1.z + p1.w);
                ss += __shfl_xor(ss, 16); ss += __shfl_xor(ss, 32);
                const float sc = scale / sqrtf(ss * (1.0f / 2048.0f) + EPS);
                bf16_t* rowp = out + (trow + ai * 128 + m * 16) * 2048 + u.pn * 256 + colb;
#pragma unroll
                for (int bj = 0; bj < 2; ++bj) *(GAS u32x4*)(rowp + bj * 128) = pack8(acc[ai][bj][m][0] * sc, acc[ai][bj][m][1] * sc);
            }
    }
};
struct EpiNull {
    DI void operator()(const f32x4 (&acc)[2][2][4][2], const UnitG& u, int wr, int wc, int fr, int fq, int wid, int lane) const {
#pragma unroll
        for (int ai = 0; ai < 2; ++ai)
#pragma unroll
            for (int bj = 0; bj < 2; ++bj)
#pragma unroll
                for (int m = 0; m < 4; ++m) { asm volatile("" :: "v"(acc[ai][bj][m][0]), "v"(acc[ai][bj][m][1])); }
    }
};
struct Sched7 {
    typedef UnitG Unit; int G, c; const char* QM; const char* KM;
    DI bool next(int i, Unit& u) const {
        const int L = i * G + c; if (L >= 256) return false;
        const int bh = L >> 3, pm = L & 7, b = bh >> 2, hd = bh & 3; u.pm = L; u.pn = 0;
        u.A = QM + ((size_t)(b * SEQ + pm * 256) * 2048 + hd * 512) * 2; u.B = KM + ((size_t)(b * MEMT) * 2048 + hd * 512) * 2; return true;
    }
};
struct EpiSoftmax {
    bf16_t* P; LAS float* X;
    DI void operator()(f32x4 (&acc)[2][2][4][2], const UnitG& u, int wr, int wc, int fr, int fq, int wid, int lane) const {
        LAS float* MX = X; LAS float* SM = X + 1024;
        EPI_ROWS_BEGIN
            float mx = -INFINITY;
#pragma unroll
            for (int bj = 0; bj < 2; ++bj)
#pragma unroll
                for (int n = 0; n < 2; ++n) { const f32x4 v = acc[ai][bj][m][n]; mx = fmaxf(mx, fmaxf(fmaxf(v.x, v.y), fmaxf(v.z, v.w))); }
            mx = fmaxf(mx, __shfl_xor(mx, 16)); mx = fmaxf(mx, __shfl_xor(mx, 32));
            if (fq == 0) MX[rl * 4 + wc] = mx;
        EPI_ROWS_END
        asm volatile("s_waitcnt lgkmcnt(0)" ::: "memory"); __builtin_amdgcn_s_barrier(); asm volatile("" ::: "memory");
        {
        EPI_ROWS_BEGIN
            const f32x4 q = *(LAS f32x4*)(MX + rl * 4); const float mx = fmaxf(fmaxf(q.x, q.y), fmaxf(q.z, q.w));
            float s = 0.f;
#pragma unroll
            for (int bj = 0; bj < 2; ++bj)
#pragma unroll
                for (int n = 0; n < 2; ++n) { f32x4 v = acc[ai][bj][m][n]; v.x = fast_exp2(v.x - mx); v.y = fast_exp2(v.y - mx); v.z = fast_exp2(v.z - mx); v.w = fast_exp2(v.w - mx);
                    acc[ai][bj][m][n] = v; s += (v.x + v.y) + (v.z + v.w); }
            s += __shfl_xor(s, 16); s += __shfl_xor(s, 32);
            if (fq == 0) SM[rl * 4 + wc] = s;
        EPI_ROWS_END
        }
        asm volatile("s_waitcnt lgkmcnt(0)" ::: "memory"); __builtin_amdgcn_s_barrier(); asm volatile("" ::: "memory");
        {
        EPI_ROWS_BEGIN
            const f32x4 q = *(LAS f32x4*)(SM + rl * 4); const float inv = 1.0f / ((q.x + q.y) + (q.z + q.w));
            bf16_t* rowp = P + (size_t)(u.pm * 256 + rl) * 256 + colb;
#pragma unroll
            for (int bj = 0; bj < 2; ++bj) *(GAS u32x4*)(rowp + bj * 128) = pack8(acc[ai][bj][m][0] * inv, acc[ai][bj][m][1] * inv);
        EPI_ROWS_END
        }
        asm volatile("s_waitcnt lgkmcnt(0)" ::: "memory"); __builtin_amdgcn_s_barrier(); asm volatile("" ::: "memory");
    }
};
struct Sched8 {
    typedef UnitG Unit; int G, c; const char* P; const char* VT;
    DI bool next(int i, Unit& u) const {
        const int L = i * G + c; if (L >= 512) return false;
        const int pn = L & 1, l2 = L >> 1, bh = l2 >> 3, pm = l2 & 7, b = bh >> 2, hd = bh & 3;
        u.pm = b * 8 + pm; u.pn = hd * 2 + pn;
        u.A = P + (size_t)(l2 * 256) * 256 * 2; u.B = VT + ((size_t)(hd * 512 + pn * 256) * 2048 + b * MEMT) * 2; return true;
    }
};
struct EpiPlain {
    bf16_t* out; int ldo;
    DI void operator()(const f32x4 (&acc)[2][2][4][2], const UnitG& u, int wr, int wc, int fr, int fq, int wid, int lane) const {
        EPI_ROWS_BEGIN
            bf16_t* rowp = out + (size_t)(u.pm * 256 + rl) * ldo + u.pn * 256 + colb;
#pragma unroll
            for (int bj = 0; bj < 2; ++bj) *(GAS u32x4*)(rowp + bj * 128) = pack8(acc[ai][bj][m][0], acc[ai][bj][m][1]);
        EPI_ROWS_END
    }
};

constexpr float PEER_US = 128.0f, PEER_VS = 16.0f;
DI unsigned sortable(float v) { const unsigned b = __builtin_bit_cast(unsigned, v); return (b & 0x80000000u) ? ~b : (b | 0x80000000u); }
DI float unsortable(unsigned s) { const unsigned b = (s & 0x80000000u) ? (s & 0x7fffffffu) : ~s; return __builtin_bit_cast(float, b); }
#define PEER_CANDS(X) \
    X(0,0) X(0,1) X(0,2) X(0,3) X(0,4) X(0,5) X(0,6) X(0,7) X(0,8) X(0,9) X(0,10) X(0,11) X(0,12) X(0,13) X(0,14) X(0,15) \
    X(1,0) X(1,1) X(1,2) X(1,3) X(1,4) X(1,5) X(1,6) X(1,7) X(2,0) X(2,1) X(2,2) X(2,3) X(2,4) X(3,0) X(3,1) X(3,2) X(3,3) \
    X(4,0) X(4,1) X(4,2) X(5,0) X(5,1) X(6,0) X(6,1) X(7,0) X(7,1) X(8,0) X(9,0) X(10,0) X(11,0) X(12,0) X(13,0) X(14,0) X(15,0)
#define X(a, b) (unsigned char)((a) * 16 + (b)),
static __device__ const unsigned char peer_ab[50] = { PEER_CANDS(X) };
#undef X
DI void cmpex_desc(unsigned& a, unsigned& b) { const unsigned mx = a > b ? a : b, mn = a > b ? b : a; a = mx; b = mn; }
template <int BASE> DI void sort16_desc(unsigned (&k)[64]) {
#pragma unroll
    for (int size = 2; size <= 16; size <<= 1)
#pragma unroll
        for (int stride = size >> 1; stride > 0; stride >>= 1)
#pragma unroll
            for (int i = 0; i < 16; ++i) { const int l = i ^ stride;
                if (l > i) { if ((i & size) == 0) cmpex_desc(k[BASE + i], k[BASE + l]); else cmpex_desc(k[BASE + l], k[BASE + i]); } }
}
template <int A, int B> DI void merge_top16(unsigned (&k)[64]) {
#pragma unroll
    for (int i = 0; i < 16; ++i) k[A + i] = (k[A + i] > k[B + 15 - i]) ? k[A + i] : k[B + 15 - i];
#pragma unroll
    for (int stride = 8; stride > 0; stride >>= 1)
#pragma unroll
        for (int i = 0; i < 16; ++i) { const int l = i ^ stride; if (l > i) cmpex_desc(k[A + i], k[A + l]); }
}
DI void top16_of_64(unsigned (&k)[64]) {
    sort16_desc<0>(k); sort16_desc<16>(k); sort16_desc<32>(k); sort16_desc<48>(k);
    merge_top16<0, 16>(k); merge_top16<32, 48>(k); merge_top16<0, 32>(k);
}
DI void route_pass(const Frame& F, int tg, int h, LAS unsigned* topL  ) {
    const int lane = F.lane, rr = lane & 31, hh = lane >> 5; const size_t tok = (size_t)tg * 32 + rr;
    const bf16_t* PQ = (const bf16_t*)(F.ws + WS_PQ); const bf16_t* SUBK = (const bf16_t*)(F.ws + WS_SUBK);
#pragma unroll 1
    for (int p = 0; p < 2; ++p) {
        bf16x8 qf[8];
        { const bf16_t* qp = PQ + tok * 2048 + (2 * h + p) * 128 + 8 * hh;
#pragma unroll
          for (int s = 0; s < 8; ++s) qf[s] = *(const GAS bf16x8*)(qp + 16 * s); }
        unsigned key[64];
#pragma unroll
        for (int nb = 0; nb < 4; ++nb) {
            const bf16_t* kp = SUBK + ((size_t)((2 * h + p) * 128 + 32 * nb + rr)) * 128 + 8 * hh;
            f32x16 acc = zero16();
#pragma unroll
            for (int s = 0; s < 8; ++s) acc = MFMA32(*(const GAS bf16x8*)(kp + 16 * s), qf[s], acc);
#pragma unroll
            for (int reg = 0; reg < 16; ++reg) { const int n = 32 * nb + crow(reg, hh); key[nb * 16 + reg] = (sortable(acc[reg]) & ~0x7fu) | (unsigned)(127 - n); }
        }
        top16_of_64(key);
        unsigned oth[16];
#pragma unroll
        for (int i = 0; i < 16; ++i) oth[i] = __shfl_xor(key[i], 32);
#pragma unroll
        for (int i = 0; i < 16; ++i) key[i] = (key[i] > oth[15 - i]) ? key[i] : oth[15 - i];
#pragma unroll
        for (int stride = 8; stride > 0; stride >>= 1)
#pragma unroll
            for (int i = 0; i < 16; ++i) { const int l = i ^ stride; if (l > i) cmpex_desc(key[i], key[l]); }
#pragma unroll
        for (int i = 0; i < 16; ++i) topL[(p * 16 + i) * 64 + lane] = key[i];
    }
    LDS_WAIT();
    unsigned ck[64];
    { float v1[16], v2[16];
#pragma unroll
      for (int k = 0; k < 16; ++k) { v1[k] = unsortable(topL[k * 64 + lane] & ~0x7fu); v2[k] = unsortable(topL[(16 + k) * 64 + lane] & ~0x7fu); }
      int k = 0;
#define X(a, b) ck[k] = (sortable(v1[a] + v2[b]) & ~0x3fu) | (unsigned)(63 - k); ++k;
      PEER_CANDS(X)
#undef X
#pragma unroll
      for (int i = 50; i < 64; ++i) ck[i] = 0u;
    }
    top16_of_64(ck);
    LDS_WAIT();
    float cv[16]; unsigned ce[16];
#pragma unroll
    for (int k = 0; k < 16; ++k) {
        const unsigned m = ck[k]; cv[k] = unsortable(m & ~0x3fu);
        const unsigned ab = peer_ab[63u - (m & 63u)];
        const unsigned i1 = 127u - (topL[(ab >> 4) * 64 + lane] & 0x7fu), i2 = 127u - (topL[(16 + (ab & 15u)) * 64 + lane] & 0x7fu);
        ce[k] = i1 * 128u + i2;
    }
    const float cmax = cv[0]; float gs = 0.f;
#pragma unroll
    for (int k = 0; k < 16; ++k) { cv[k] = fast_exp2((cv[k] - cmax) * 1.4426950408889634f); gs += cv[k]; }
    const float ginv = 1.0f / gs;
    if (hh == 0) {
        unsigned* ep = (unsigned*)(F.ws + WS_EIDX) + tok * 128 + h * 16; float* gp = (float*)(F.ws + WS_GATE) + tok * 128 + h * 16;
#pragma unroll
        for (int k = 0; k < 16; k += 4) { *(GAS u32x4*)(ep + k) = (u32x4){ce[k], ce[k + 1], ce[k + 2], ce[k + 3]}; *(GAS f32x4*)(gp + k) = (f32x4){cv[k] * ginv, cv[k + 1] * ginv, cv[k + 2] * ginv, cv[k + 3] * ginv}; }
    }
    LDS_WAIT();
}
DI void ph11_route(const Frame& F, const Args& a) {
    const int gw = F.bid * NWAVES + F.wave, NGW = F.G * NWAVES;
    LAS unsigned* topL = (LAS unsigned*)(F.lds + F.wave * 8192);
    for (int it = gw; it < 512 * 8; it += NGW) route_pass(F, it >> 3, it & 7, topL);
    ISTAMP(F, 41);
    const int gt = F.bid * NTHREADS + F.tid, NGT = F.G * NTHREADS;
    const GAS f32x4* gf = (const GAS f32x4*)a.in[I_GFFN];
    for (int i = gt; i < 16384 * 128; i += NGT) {
        const int e = i >> 7, c = i & 127, sl = c >> 3, j = c & 7;
        const GAS f32x4* su = (const GAS f32x4*)a.in[I_PU] + 4 * (size_t)i; const GAS f32x4* sv = (const GAS f32x4*)a.in[I_PV] + 4 * (size_t)i;
        u32x4 ou, ov;
#pragma unroll
        for (int q = 0; q < 4; ++q) { const f32x4 g = gf[4 * c + q]; const f32x4 u = su[q] * g * PEER_US; const f32x4 v = sv[q] * PEER_VS;
            int pu = __builtin_amdgcn_cvt_pk_fp8_f32(u.x, u.y, 0, false); pu = __builtin_amdgcn_cvt_pk_fp8_f32(u.z, u.w, pu, true);
            int pv = __builtin_amdgcn_cvt_pk_fp8_f32(v.x, v.y, 0, false); pv = __builtin_amdgcn_cvt_pk_fp8_f32(v.z, v.w, pv, true);
            ou[q] = (unsigned)pu; ov[q] = (unsigned)pv; }
        const size_t dst = ((size_t)(sl * 16384 + e) * 128 + 16 * j);
        *(GAS u32x4*)(F.ws + WS_UTAB + dst) = ou; *(GAS u32x4*)(F.ws + WS_VTAB + dst) = ov;
    }
}

DI float gelu_erf(float v) {
    const float av = fabsf(v), t = fast_rcp(av * 0.2316418882f + 1.0f);
    float q = t * 0.5307027145f + (-0.7265760135f); q = q * t + 0.7107068705f; q = q * t + (-0.142248368f); q = q * t + 0.127414796f; q = q * t;
    const float e = fast_exp2((v * v) * (-0.72134752044f)); const float m = v * (q * e);
    return v < 0.f ? m : v - m;
}
template <int CTRL> DI float dpp_f(float v) { return __builtin_bit_cast(float, __builtin_amdgcn_update_dpp(0, __builtin_bit_cast(int, v), CTRL, 0xf, 0xf, false)); }
DI float sum8(float d) { d += dpp_f<0xB1>(d); d += dpp_f<0x4E>(d); d += dpp_f<0x141>(d); return d; }
struct PeerBatch { u32x4 r[8]; };
struct PeerOffs { unsigned o[8]; };
DI void peer_offs(PeerOffs& O, LAS const int* el  , unsigned loff  ) {
#pragma unroll
    for (int ii = 0; ii < 8; ++ii) O.o[ii] = (unsigned)el[8 * ii] + loff;
}
DI void peer_issue(PeerBatch& B, const unsigned char* tb  , const PeerOffs& O) {
#pragma unroll
    for (int ii = 0; ii < 8; ++ii) B.r[ii] = *(const GAS u32x4*)(tb + O.o[ii]);
}

template <int VAR> DI void peer_u_pass(const Frame& F, LAS float* PD, LAS const int* elw, const unsigned char* U8, const bf16_t* XB, size_t tok0, int tl0) {
    const int lane = F.lane, g = lane >> 3, j = lane & 7;
        {
            const unsigned char* ub0 = U8; const unsigned loff = 16u * (unsigned)j; const bf16_t* xb0 = XB + tok0 * 2048 + 16 * j;
            PeerBatch Ba, Bb;
            LAS unsigned char* XS = F.lds + 81920 + F.wave * 4096;
            const bf16_t* xq_src = XB + (tok0 + (lane >> 3)) * 2048 + 16 * (lane & 7);
            u32x4 xq0 = *(const GAS u32x4*)xq_src, xq1 = *(const GAS u32x4*)(xq_src + 8);
#define U_COMPUTE(B, b) do { \
                const u32x4 xc0 = *(LAS const u32x4*)(xs_), xc1 = *(LAS const u32x4*)(xs_ + 16); \
                const unsigned xw_[8] = {xc0.x, xc0.y, xc0.z, xc0.w, xc1.x, xc1.y, xc1.z, xc1.w};        \
                float d_[8]; \
                _Pragma("unroll") for (int ii = 0; ii < 8; ++ii) d_[ii] = 0.f; \
                _Pragma("unroll") for (int q = 0; q < 4; ++q) { \
                    _Pragma("unroll") for (int ii = 0; ii < 8; ++ii) d_[ii] = __builtin_amdgcn_fdot2_f32_bf16(__builtin_amdgcn_cvt_scalef32_pk_bf16_fp8((int)(B).r[ii][q], 1.0f, false), __builtin_bit_cast(bf16x2_t, xw_[2 * q]), d_[ii], false); \
                    _Pragma("unroll") for (int ii = 0; ii < 8; ++ii) d_[ii] = __builtin_amdgcn_fdot2_f32_bf16(__builtin_amdgcn_cvt_scalef32_pk_bf16_fp8((int)(B).r[ii][q], 1.0f, true), __builtin_bit_cast(bf16x2_t, xw_[2 * q + 1]), d_[ii], false); } \
                  \
                float e_[4]; _Pragma("unroll") for (int m = 0; m < 4; ++m) { const float snd = bit0 ? d_[m] : d_[4 + m]; e_[m] = (bit0 ? d_[4 + m] : d_[m]) + dpp_f<0xB1>(snd); } \
                float f_[2]; _Pragma("unroll") for (int m = 0; m < 2; ++m) { const float snd = bit1 ? e_[m] : e_[2 + m]; f_[m] = (bit1 ? e_[2 + m] : e_[m]) + dpp_f<0x4E>(snd); } \
                const float snd_ = bit2 ? f_[0] : f_[1]; const float mine_ = (bit2 ? f_[1] : f_[0]) + __shfl_xor(snd_, 4); \
                if (VAR == 2) { asm volatile("" :: "v"(mine_)); } else PD[tl0 * 128 + 64 * (b) + 8 * jrev + g] += mine_; } while (0)
            const bool bit0 = (lane & 1) != 0, bit1 = (lane & 2) != 0, bit2 = (lane & 4) != 0; const int jrev = ((lane & 1) << 2) | (lane & 2) | ((lane >> 2) & 1);
            PeerBatch Bc, Bd;
            PeerOffs PO;
#define U_OFFS(fb) do { const int fb_ = ((fb) < 255) ? (fb) : 255; peer_offs(PO, elw + 64 * (fb_ & 15), loff); } while (0)
#define U_ISSUE(B, fb) do { const int fb_ = ((fb) < 255) ? (fb) : 255; peer_issue(B, ub0 + (size_t)(fb_ >> 4) * (16384 * 128), PO); U_OFFS((fb) + 1); } while (0)
#define U_STEP(B, fb, Bn, fbn) do { \
                U_ISSUE(Bn, fbn); \
                __builtin_amdgcn_sched_barrier(0); \
                LAS const unsigned char* xs_ = XS + (((fb) >> 4) & 1) * 2048 + ((((fb) >> 1) & 7) * 8 + j) * 32; \
                if (VAR == 3) { _Pragma("unroll") for (int ii = 0; ii < 8; ++ii) asm volatile("" :: "v"((B).r[ii])); } else U_COMPUTE(B, (fb) & 15); \
                __builtin_amdgcn_sched_barrier(0); } while (0)
            U_OFFS(0); U_ISSUE(Ba, 0); U_ISSUE(Bb, 1); U_ISSUE(Bc, 2);
#pragma unroll 1
            for (int fb = 0; fb < 256; fb += 4) {
                if ((fb & 15) == 0) { const int sl = fb >> 4;
                    *(LAS u32x4*)(XS + (sl & 1) * 2048 + lane * 32) = xq0; *(LAS u32x4*)(XS + (sl & 1) * 2048 + lane * 32 + 16) = xq1;
                    if (VAR != 1 && VAR != 3) { const bf16_t* xp = xq_src + 128 * ((sl < 15) ? sl + 1 : 15); xq0 = *(const GAS u32x4*)xp; xq1 = *(const GAS u32x4*)(xp + 8); }
                }
                U_STEP(Ba, fb, Bd, fb + 3);
                U_STEP(Bb, fb + 1, Ba, fb + 4);
                U_STEP(Bc, fb + 2, Bb, fb + 5);
                U_STEP(Bd, fb + 3, Bc, fb + 6);
            }
#undef U_STEP
#undef U_ISSUE
#undef U_OFFS
#undef U_COMPUTE
        }
}
DI void ph12_peer(const Frame& F, const Args& a) {
    LAS int* EL = (LAS int*)F.lds;
    LAS float* PD = (LAS float*)(F.lds + 32768);
    LAS float* SSL = (LAS float*)(F.lds + 65536);
    LAS unsigned* WB = (LAS unsigned*)(F.lds + 114688);
    const int lane = F.lane, g = lane >> 3, j = lane & 7;
    const bf16_t* XB = (const bf16_t*)(F.ws + WS_XB);
    const unsigned char* U8 = F.ws + WS_UTAB; const unsigned char* V8 = F.ws + WS_VTAB;
    for (int blk = F.bid; blk < MT / 64; blk += F.G) {
        const int tl0 = 8 * F.wave; const size_t tok0 = (size_t)blk * 64 + tl0;
        { int e0[8], e1[8];
#pragma unroll
          for (int tk = 0; tk < 8; ++tk) { const int* ep = (const int*)(F.ws + WS_EIDX) + (tok0 + tk) * 128; e0[tk] = ep[lane]; e1[tk] = ep[64 + lane]; }
#pragma unroll
          for (int tk = 0; tk < 8; ++tk) {
            EL[(tl0 + tk) * 128 + lane] = e0[tk] * 128; EL[(tl0 + tk) * 128 + 64 + lane] = e1[tk] * 128;
            PD[(tl0 + tk) * 128 + lane] = 0.f; PD[(tl0 + tk) * 128 + 64 + lane] = 0.f; SSL[(tl0 + tk) * 64 + lane] = 0.f; } }
        LDS_WAIT();
        LAS const int* elw = EL + tl0 * 128 + g;
        peer_u_pass<0>(F, PD, elw, U8, XB, tok0, tl0);
#if PROBE_PHASE >= 30 && PROBE_PHASE <= 33
        LDS_WAIT(); __syncthreads(); ISTAMP(F, 29);
        peer_u_pass<PROBE_PHASE - 30>(F, (LAS float*)(F.lds + 131072), elw, U8, XB, tok0, tl0);
        LDS_WAIT(); __syncthreads(); ISTAMP(F, PROBE_PHASE);
#endif
        LDS_WAIT(); ISTAMP(F, 20);
#pragma unroll 1
        for (int tk = 0; tk < 8; ++tk) {
            const size_t tok = tok0 + tk;
            const float ssq = wave_sum((lane < 32) ? ((const float*)(F.ws + WS_SSQ2))[tok * 32 + lane] : 0.f);
            const float sc = (1.0f / PEER_US) / sqrtf(ssq * (1.0f / 2048.0f) + EPS);
            const float* gp = (const float*)(F.ws + WS_GATE) + tok * 128;
            LAS float* pd = PD + (tl0 + tk) * 128;
            const float w0 = gp[lane] * gelu_erf(pd[lane] * sc), w1 = gp[64 + lane] * gelu_erf(pd[64 + lane] * sc);
            pd[lane] = w0 * (1.0f / PEER_VS); pd[64 + lane] = w1 * (1.0f / PEER_VS);
            LDS_WAIT();
            { const int k1 = 16 * (lane >> 3) + (lane & 7); WB[(tl0 + tk) * 64 + lane] = pk2(pd[k1], pd[k1 + 8]); }
        }
        LDS_WAIT(); ISTAMP(F, 21);
        LAS const unsigned* pww = WB + tl0 * 64 + g;
        {
            const unsigned char* vb0 = V8; const unsigned loff = 16u * (unsigned)j;
            PeerBatch Ba, Bb;
            float y[16];
#define V_COMPUTE(B, b) do { \
                LAS const unsigned* pw_ = pww + 32 * (b); \
                _Pragma("unroll") for (int mm = 0; mm < 4; ++mm) { const bf16x2_t w2_ = __builtin_bit_cast(bf16x2_t, pw_[8 * mm]); \
                    _Pragma("unroll") for (int q = 0; q < 4; ++q) { \
                        const unsigned pa_ = __builtin_amdgcn_perm((B).r[2 * mm + 1][q], (B).r[2 * mm][q], 0x05010400u), pb_ = __builtin_amdgcn_perm((B).r[2 * mm + 1][q], (B).r[2 * mm][q], 0x07030602u); \
                        y[4 * q + 0] = __builtin_amdgcn_fdot2_f32_bf16(__builtin_amdgcn_cvt_scalef32_pk_bf16_fp8((int)pa_, 1.0f, false), w2_, y[4 * q + 0], false); \
                        y[4 * q + 1] = __builtin_amdgcn_fdot2_f32_bf16(__builtin_amdgcn_cvt_scalef32_pk_bf16_fp8((int)pa_, 1.0f, true), w2_, y[4 * q + 1], false); \
                        y[4 * q + 2] = __builtin_amdgcn_fdot2_f32_bf16(__builtin_amdgcn_cvt_scalef32_pk_bf16_fp8((int)pb_, 1.0f, false), w2_, y[4 * q + 2], false); \
                        y[4 * q + 3] = __builtin_amdgcn_fdot2_f32_bf16(__builtin_amdgcn_cvt_scalef32_pk_bf16_fp8((int)pb_, 1.0f, true), w2_, y[4 * q + 3], false); } } } while (0)
            PeerBatch Bc, Bd;
            PeerOffs PO;
#define V_OFFS(fb) do { const int fb_ = ((fb) < 255) ? (fb) : 255; peer_offs(PO, elw + 64 * (fb_ & 15), loff); } while (0)
#define V_ISSUE(B, fb) do { const int fb_ = ((fb) < 255) ? (fb) : 255; peer_issue(B, vb0 + (size_t)(fb_ >> 4) * (16384 * 128), PO); V_OFFS((fb) + 1); } while (0)
#define V_STEP(B, fb, Bn, fbn) do { \
                V_ISSUE(Bn, fbn); \
                __builtin_amdgcn_sched_barrier(0); \
                V_COMPUTE(B, (fb) & 15); \
                __builtin_amdgcn_sched_barrier(0); } while (0)
#define V_FINISH(fb, xw) do { const int tk = ((fb) >> 1) & 7, sl = (fb) >> 4; \
                float z[8]; \
                _Pragma("unroll") for (int q = 0; q < 8; ++q) {            \
                    float a0 = y[q], b0 = y[8 + q]; \
                    asm volatile("v_nop\n\tv_nop\n\tv_permlane32_swap_b32 %0, %1" : "+v"(a0), "+v"(b0)); \
                    z[q] = a0 + b0; } \
                float qq[4]; \
                { const bool up = (lane & 16) != 0; \
                  _Pragma("unroll") for (int q = 0; q < 4; ++q) { const float snd = up ? z[q] : z[4 + q]; qq[q] = (up ? z[4 + q] : z[q]) + __shfl_xor(snd, 16); } } \
                f32x2 p; \
                { const bool up = (lane & 8) != 0; \
                  const float s0 = up ? qq[0] : qq[2], s1 = up ? qq[1] : qq[3]; p.x = (up ? qq[2] : qq[0]) + dpp_f<0x128>(s0); p.y = (up ? qq[3] : qq[1]) + dpp_f<0x128>(s1); } \
                const size_t eo = (tok0 + tk) * 2048 + 128 * sl + 16 * j + 2 * g; \
                const f32x2 x3 = (f32x2){bf_lo(xw), bf_hi(xw)} + p; \
                *(GAS f32x2*)(a.out + eo) = x3; \
                SSL[(tl0 + tk) * 64 + lane] += x3.x * x3.x + x3.y * x3.y; \
                _Pragma("unroll") for (int q = 0; q < 16; ++q) y[q] = 0.f; } while (0)
            V_OFFS(0); V_ISSUE(Ba, 0); V_ISSUE(Bb, 1); V_ISSUE(Bc, 2);
#pragma unroll
            for (int q = 0; q < 16; ++q) y[q] = 0.f;
#pragma unroll 1
            for (int fb = 0; fb < 256; fb += 4) {
                const unsigned xwA = *(const GAS unsigned*)(XB + (tok0 + ((fb >> 1) & 7)) * 2048 + 128 * (fb >> 4) + 16 * j + 2 * g);
                const unsigned xwB = *(const GAS unsigned*)(XB + (tok0 + (((fb + 2) >> 1) & 7)) * 2048 + 128 * (fb >> 4) + 16 * j + 2 * g);
                V_STEP(Ba, fb, Bd, fb + 3);
                V_STEP(Bb, fb + 1, Ba, fb + 4);
                V_FINISH(fb + 1, xwA);
                V_STEP(Bc, fb + 2, Bb, fb + 5);
                V_STEP(Bd, fb + 3, Bc, fb + 6);
                V_FINISH(fb + 3, xwB);
            }
#undef V_FINISH
#undef V_STEP
#undef V_ISSUE
#undef V_OFFS
#undef V_COMPUTE
        }
        LDS_WAIT(); ISTAMP(F, 22);
        const float* gfin = (const float*)a.in[I_GFINAL];
#pragma unroll 1
        for (int tk = 0; tk < 8; ++tk) {
            const float rstd = 1.0f / sqrtf(wave_sum(SSL[(tl0 + tk) * 64 + lane]) * (1.0f / 2048.0f) + EPS);
            float* xr = a.out + (tok0 + tk) * 2048 + 16 * j + 2 * g;
            f32x2 vv[16];
#pragma unroll
            for (int sl = 0; sl < 16; ++sl) vv[sl] = *(const GAS f32x2*)(xr + 128 * sl);
#pragma unroll
            for (int sl = 0; sl < 16; ++sl) { const f32x2 gg = *(const GAS f32x2*)(gfin + 128 * sl + 16 * j + 2 * g);
                *(GAS f32x2*)(xr + 128 * sl) = (f32x2){vv[sl].x * rstd * gg.x, vv[sl].y * rstd * gg.y}; }
        }
        LDS_WAIT();
    }
}

constexpr int NPHASES = 14;
#ifndef MK_ONE_LAUNCH
#define MK_ONE_LAUNCH 1
#endif
__global__ void __launch_bounds__(NTHREADS, 2) hybrid_fwd(Args args) {
    extern __shared__ __attribute__((aligned(16))) unsigned char lds_raw[];
    Frame F;
    F.lds = (LAS unsigned char*)lds_raw;
    F.tid = threadIdx.x; F.lane = F.tid & 63; F.wave = __builtin_amdgcn_readfirstlane(F.tid >> 6);
    F.G = gridDim.x; F.bid = blockIdx.x; F.ws = args.ws; F.dout = (unsigned char*)args.out;
    volatile LAS unsigned* MISC = (volatile LAS unsigned*)(F.lds + LDS_BYTES - 256);
    if (F.tid < 64) MISC[F.tid] = 0u;
    __syncthreads();
    XcdBarrier bar = xcd_barrier_post((unsigned*)(F.ws + WS_CTL) + 4096, MISC + 8);
    const int lo = args.ph_lo, hi = args.ph_hi;
#ifndef PROBE_MULT
#define PROBE_MULT 16
#endif
    if (PROBE_PHASE >= 0 && F.bid == 0 && F.tid == 0) { volatile LAS unsigned long long* ts_ = (volatile LAS unsigned long long*)(F.lds + LDS_BYTES - 64); ts_[0] = __builtin_amdgcn_s_memrealtime(); ts_[1] = 0; }
#define STAMP(k) FSTAMP(F, k)
#define IN(k) (lo <= (k) && (k) < hi && (F.lane = lane_id(), F.tid = F.wave * 64 + F.lane, true))
#define SEAM(k) do { if (IN(k) && IN((k) + 1)) xcd_barrier(bar); } while (0)
    unsigned char* ws = F.ws;
    LAS unsigned char* ring = F.lds;

    if (IN(0)) { ph0_prologue(F, args); } SEAM(0); STAMP(0);
    if (IN(1)) {
        Sched1 S{F.G, F.bid, ws, F.dout}; EpiProj E;
        pg8::gemm_phase<EpiProj, Sched1, true>(ring, F.tid, DM, DM, DM, S, E);
#if PROBE_PHASE == 52
        { __syncthreads(); ISTAMP(F, 51); Sched1 S2{F.G, F.bid, ws, F.dout}; EpiNull1 EN; pg8::gemm_phase<EpiNull1, Sched1, true>(ring, F.tid, DM, DM, DM, S2, EN); __syncthreads(); ISTAMP(F, 52); }
#endif
    } SEAM(1); STAMP(1);
    if (IN(2)) { ph2_mixers_a(F); } SEAM(2); STAMP(2);
    if (IN(3)) { ph_scan(F); } SEAM(3); STAMP(3);
    if (IN(4)) { ph3_mixers_b(F); } SEAM(4); STAMP(4);
    if (IN(5)) {
        { SchedG S{F.G, F.bid, 64, 8, (const char*)(ws + WS_RQ), (const char*)(ws + WS_WBR_T), (size_t)256 * 1024 * 2, (size_t)256 * 1024 * 2};
          EpiMerge<0> E{(bf16_t*)(ws + WS_GR), (bf16_t*)(ws + WS_GD)};
          pg8::gemm_phase<EpiMerge<0>, SchedG, true>(ring, F.tid, 1024, 1024, 1024, S, E); }
        { SchedG S{F.G, F.bid, 64, 8, (const char*)(ws + WS_DQ), (const char*)(ws + WS_WBD_T), (size_t)256 * 1536 * 2, (size_t)256 * 512 * 2};
          EpiMerge<1> E{(bf16_t*)(ws + WS_GR), (bf16_t*)(ws + WS_GD)};
          pg8::gemm_phase<EpiMerge<1>, SchedG, true>(ring, F.tid, 512, 1536, 512, S, E); }
    } SEAM(5); STAMP(5);
    if (IN(6)) {
        SchedG S{F.G, F.bid, 64, 8, (const char*)(ws + WS_GD), (const char*)(ws + WS_WOUT_T), (size_t)256 * 2048 * 2, (size_t)256 * 2048 * 2};
        EpiResid<true> E{(const float*)args.in[I_X], (bf16_t*)(ws + WS_XB), (float*)(ws + WS_SSQ1)};
        pg8::gemm_phase<EpiResid<true>, SchedG, true>(ring, F.tid, 2048, 2048, 2048, S, E);
    } SEAM(6); STAMP(6);
    if (IN(7)) {
        SchedG S{F.G, F.bid, 64, 8, (const char*)(ws + WS_XB), (const char*)(ws + WS_WQ_T), (size_t)256 * 2048 * 2, (size_t)256 * 2048 * 2};
        EpiRowScale E{(const float*)(ws + WS_SSQ1), (bf16_t*)(ws + WS_QM), 0.04419417382415922f * 1.4426950408889634f};
        pg8::gemm_phase<EpiRowScale, SchedG, true>(ring, F.tid, 2048, 2048, 2048, S, E);
#if PROBE_PHASE == 50
        { __syncthreads(); ISTAMP(F, 49); SchedG S2{F.G, F.bid, 64, 8, (const char*)(ws + WS_XB), (const char*)(ws + WS_WQ_T), (size_t)256 * 2048 * 2, (size_t)256 * 2048 * 2};
          EpiNull EN; pg8::gemm_phase<EpiNull, SchedG, true>(ring, F.tid, 2048, 2048, 2048, S2, EN); __syncthreads(); ISTAMP(F, 50); }
#endif
    } SEAM(7); STAMP(7);
    if (IN(8)) {
        Sched7 S{F.G, F.bid, (const char*)(ws + WS_QM), (const char*)(ws + WS_KM)};
        EpiSoftmax E{(bf16_t*)(ws + WS_P), (LAS float*)(F.lds + LDSX_OFF)};
        pg8::gemm_phase<EpiSoftmax, Sched7, true>(ring, F.tid, 512, 2048, 2048, S, E);
    } SEAM(8); STAMP(8);
    if (IN(9)) {
        Sched8 S{F.G, F.bid, (const char*)(ws + WS_P), (const char*)(ws + WS_VT)};
        EpiPlain E{(bf16_t*)(ws + WS_O), 2048};
        pg8::gemm_phase<EpiPlain, Sched8, true>(ring, F.tid, 256, 256, 2048, S, E);
    } SEAM(9); STAMP(9);
    if (IN(10)) {
        SchedG S{F.G, F.bid, 64, 8, (const char*)(ws + WS_O), (const char*)(ws + WS_WO_T), (size_t)256 * 2048 * 2, (size_t)256 * 2048 * 2};
        EpiResid<false> E{nullptr, (bf16_t*)(ws + WS_XB), (float*)(ws + WS_SSQ2)};
        pg8::gemm_phase<EpiResid<false>, SchedG, true>(ring, F.tid, 2048, 2048, 2048, S, E);
    } SEAM(10); STAMP(10);
    if (IN(11)) {
        SchedG S{F.G, F.bid, 64, 8, (const char*)(ws + WS_XB), (const char*)(ws + WS_WPQ_T), (size_t)256 * 2048 * 2, (size_t)256 * 2048 * 2};
        EpiRowScale E{(const float*)(ws + WS_SSQ2), (bf16_t*)(ws + WS_PQ), 1.0f};
        pg8::gemm_phase<EpiRowScale, SchedG, true>(ring, F.tid, 2048, 2048, 2048, S, E);
    } SEAM(11); STAMP(11);
    if (IN(12)) { ph11_route(F, args); } SEAM(12); STAMP(12);
    if (IN(13)) { ph12_peer(F, args); }
    if (PROBE_PHASE >= 0 && F.bid == 0) { __syncthreads(); STAMP(13); __syncthreads(); const unsigned long long t0_ = __builtin_amdgcn_s_memrealtime();
        const unsigned long long tsel_ = ((volatile LAS unsigned long long*)(F.lds + LDS_BYTES - 64))[1];
        while (__builtin_amdgcn_s_memrealtime() - t0_ < (unsigned long long)PROBE_MULT * tsel_) __builtin_amdgcn_s_sleep(8); }
#undef IN
#undef SEAM
}

extern "C" void kernel_launch(void* const* d_in, const int* in_sizes, int n_in, void* d_out, int out_size, void* d_ws, size_t ws_size, hipStream_t stream) {
    static int grid = 0;
    if (grid == 0) {
        if (n_in != 19 || out_size != MT * DM || ws_size < WS_END) { fprintf(stderr, "kernel_launch: unexpected shapes (n_in %d, out %d, ws %zu)\n", n_in, out_size, ws_size); grid = -1; return; }
        int dev = 0, cus = 0;
        if (hipGetDevice(&dev) != hipSuccess || hipDeviceGetAttribute(&cus, hipDeviceAttributeMultiprocessorCount, dev) != hipSuccess) { grid = -1; return; }
        if (hipFuncSetAttribute((const void*)hybrid_fwd, hipFuncAttributeMaxDynamicSharedMemorySize, LDS_BYTES) != hipSuccess) { fprintf(stderr, "kernel_launch: hipFuncSetAttribute failed\n"); grid = -1; return; }
        (void)hipGetLastError();
        grid = cus;
    }
    if (grid < 0) return;
    (void)hipMemsetAsync((char*)d_ws + WS_CTL, 0, CTL_ZERO_BYTES, stream);
    Args a{};
    for (int i = 0; i < 19; ++i) a.in[i] = d_in[i];
    a.out = (float*)d_out; a.ws = (unsigned char*)d_ws;
    for (int i = 0; i < 64; ++i) { a.fret[i] = std::pow(10000.0, -(double)i / 63.0); a.frot[i] = std::pow(10000.0, -(double)i / 64.0); }
#if MK_ONE_LAUNCH
    a.ph_lo = 0; a.ph_hi = NPHASES;
    hipLaunchKernelGGL(hybrid_fwd, dim3(grid), dim3(NTHREADS), LDS_BYTES, stream, a);
#else
    for (int ph = 0; ph < NPHASES; ++ph) {
        a.ph_lo = ph; a.ph_hi = ph + 1;
        hipLaunchKernelGGL(hybrid_fwd, dim3(grid), dim3(NTHREADS), LDS_BYTES, stream, a);
    }
#endif
}
#ifdef PHASE_PROBE
#define PROBE(k) __global__ void __launch_bounds__(NTHREADS, 2) probe_ph##k(Args args) { \
    extern __shared__ __attribute__((aligned(16))) unsigned char lds_raw[]; Frame F; F.lds = (LAS unsigned char*)lds_raw; F.tid = threadIdx.x; F.lane = F.tid & 63; \
    F.wave = __builtin_amdgcn_readfirstlane(F.tid >> 6); F.G = gridDim.x; F.bid = blockIdx.x; F.ws = args.ws; F.dout = (unsigned char*)args.out; unsigned char* ws = F.ws; LAS unsigned char* ring = F.lds;
PROBE(0) ph0_prologue(F, args); }
PROBE(1) Sched1 S{F.G, F.bid, ws, F.dout}; EpiProj E; pg8::gemm_phase<EpiProj, Sched1, true>(ring, F.tid, DM, DM, DM, S, E); }
PROBE(2) ph2_mixers_a(F); }
PROBE(3) ph3_mixers_b(F); }
PROBE(5) SchedG S{F.G, F.bid, 64, 8, (const char*)(ws + WS_GD), (const char*)(ws + WS_WOUT_T), (size_t)256 * 2048 * 2, (size_t)256 * 2048 * 2};
        EpiResid<true> E{(const float*)args.in[I_X], (bf16_t*)(ws + WS_XB), (float*)(ws + WS_SSQ1)};
        pg8::gemm_phase<EpiResid<true>, SchedG, true>(ring, F.tid, 2048, 2048, 2048, S, E); }
PROBE(7) Sched7 S{F.G, F.bid, (const char*)(ws + WS_QM), (const char*)(ws + WS_KM)};
        EpiSoftmax E{(bf16_t*)(ws + WS_P), (LAS float*)(F.lds + LDSX_OFF)};
        pg8::gemm_phase<EpiSoftmax, Sched7, true>(ring, F.tid, 512, 2048, 2048, S, E); }
PROBE(11) ph11_route(F, args); }
PROBE(12) ph12_peer(F, args); }
#endif
```

```cpp
#include <hip/hip_runtime.h>
#include <cstdio>
#include <cstdint>
#include <cmath>

#define LAS __attribute__((address_space(3)))
#define GAS __attribute__((address_space(1)))
#define DI __device__ __forceinline__
typedef unsigned short bf16_t;
typedef short bf16x8 __attribute__((ext_vector_type(8)));
typedef short s16x4 __attribute__((ext_vector_type(4)));
typedef short v4i16_t __attribute__((ext_vector_type(4)));
typedef float f32x2 __attribute__((ext_vector_type(2)));
typedef float f32x4 __attribute__((ext_vector_type(4)));
typedef float f32x16 __attribute__((ext_vector_type(16)));
typedef unsigned u32x2 __attribute__((ext_vector_type(2)));
typedef unsigned u32x4 __attribute__((ext_vector_type(4)));
typedef __bf16 bf16x2_t __attribute__((ext_vector_type(2)));

constexpr int NB = 8, SEQ = 2048, DM = 2048, MT = NB * SEQ;
constexpr int MEMT = 256, MROWS = NB * MEMT;
constexpr int INW = 12800;
constexpr float EPS = 1e-6f;
constexpr int NWAVES = 8, NTHREADS = 512;

constexpr size_t MiB = 1u << 20;
constexpr size_t WS_CTL = 0, CTL_ZERO_BYTES = 1 * MiB;
constexpr size_t WS_SSQ1 = 2 * MiB, WS_SSQ2 = 4 * MiB, WS_LSE = 6 * MiB, WS_EIDX = 8 * MiB, WS_GATE = 16 * MiB;
constexpr size_t WS_WIN_T = 24 * MiB, WS_WKV_T = 74 * MiB, WS_WBR_T = 90 * MiB, WS_WBD_T = 94 * MiB, WS_WOUT_T = 96 * MiB, WS_WQ_T = 104 * MiB, WS_WO_T = 112 * MiB, WS_WPQ_T = 120 * MiB;
constexpr size_t WS_SUBK = 128 * MiB, WS_KM = 130 * MiB, WS_VT = 138 * MiB;
constexpr size_t WS_RQ = 148 * MiB, WS_RK = 180 * MiB, WS_RV = 212 * MiB, WS_SG = 244 * MiB, WS_DQ = 276 * MiB, WS_DK = 324 * MiB, WS_DV = 372 * MiB, WS_GR = 420 * MiB, WS_GD = 484 * MiB;
constexpr size_t WS_END = 548 * MiB;
constexpr size_t WS_KVST = 24 * MiB;
constexpr size_t WS_XB = 24 * MiB;
constexpr size_t WS_QM = 180 * MiB;
constexpr size_t WS_PQ = 180 * MiB;
constexpr size_t WS_P = 244 * MiB;
constexpr size_t WS_O = 324 * MiB;
constexpr size_t WS_UTAB = 276 * MiB;
constexpr size_t WS_VTAB = 404 * MiB;
constexpr size_t DO_H1 = 0, DO_MEMN = 64 * MiB, DO_CSRET = 72 * MiB, DO_CSROT = 80 * MiB;
constexpr size_t DO_PREVT = 0;

DI unsigned f2bf(float f) { unsigned u = __builtin_bit_cast(unsigned, f); return (u + 0x7fffu + ((u >> 16) & 1u)) >> 16; }
DI unsigned pk2(float lo, float hi) { f32x2 v = {lo, hi}; bf16x2_t b = __builtin_convertvector(v, bf16x2_t); return __builtin_bit_cast(unsigned, b); }
DI float bf_lo(unsigned w) { return __builtin_bit_cast(float, w << 16); }
DI float bf_hi(unsigned w) { return __builtin_bit_cast(float, w & 0xffff0000u); }
DI float wave_sum(float v) {
#pragma unroll
    for (int o = 1; o < 64; o <<= 1) v += __shfl_xor(v, o);
    return v;
}
#define LDS_WAIT() asm volatile("s_waitcnt lgkmcnt(0)" ::: "memory")
#define VM_WAIT() asm volatile("s_waitcnt vmcnt(0)" ::: "memory")
DI float fast_exp2(float x) { return __builtin_amdgcn_exp2f(x); }
DI float fast_rcp(float x) { return __builtin_amdgcn_rcpf(x); }
DI float sigmoid_f(float x) { return fast_rcp(1.f + fast_exp2(-1.4426950408889634f * x)); }

namespace pg8 {
constexpr int BM = 256, BK = 64, HALF = 128, HTB = HALF * BK * 2, STAGE_BYTES = 8 * HTB, NXCD = 8, WGM = 8;
__host__ __device__ __forceinline__ int lds_byte(int r, int c) { const int st = (r >> 4) * 2 + (c >> 5), rr = r & 15, cc = c & 31, ob = rr * 64 + cc * 2; return st * 1024 + (ob ^ (((ob >> 9) & 1) << 5)); }
__host__ __device__ __forceinline__ void stage_rc(int b, int& R, int& C) { const int st = b / 1024, sb = b % 1024, swz = sb ^ (((sb >> 9) & 1) << 5); R = (st >> 1) * 16 + swz / 64; C = (st & 1) * 32 + (swz % 64) / 2; }
__host__ __device__ __forceinline__ int perm32(int rho) { const int n = rho >> 4, i = rho & 15; return 8 * (i >> 2) + 4 * n + (i & 3); }

template <int WGM_> __device__ __forceinline__ void tile_of(int L, int nM, int nN, int& pm, int& pn) {
    const int nwg = nM * nN; int wgid = L;
    { const int q = nwg / NXCD, r = nwg % NXCD, xcd = wgid % NXCD, off = wgid / NXCD; wgid = (xcd < r ? xcd * (q + 1) : r * (q + 1) + (xcd - r) * q) + off; }
    const int nig = WGM_ * nN, gid = wgid / nig, fm = gid * WGM_, gsz = (nM - fm) < WGM_ ? (nM - fm) : WGM_;
    pm = fm + ((wgid % nig) % gsz); pn = (wgid % nig) / gsz;
}

template <class Epi, class Sched, bool ALIGN_EPI>
__device__ __forceinline__ void gemm_phase(LAS unsigned char* lds, const int tid, const int K, const int lda, const int ldb, const Sched& S, const Epi& E) {
    typedef typename Sched::Unit Unit;
    const int wid = __builtin_amdgcn_readfirstlane(tid >> 6), lane = tid & 63, wr = wid >> 2, wc = wid & 3, fr = lane & 15, fq = lane >> 4;
    const int nt = K / BK;
    unsigned voffA[2], voffB[2];
#pragma unroll
    for (int i = 0; i < 2; ++i) { int R, C; stage_rc(tid * 16 + i * 8192, R, C); const int Rb = (R & ~31) + perm32(R & 31);
        voffA[i] = (unsigned)(R * lda + C) * 2u; voffB[i] = (unsigned)(Rb * ldb + C) * 2u; }
    const size_t kstep = (size_t)(BK * 2);
    const size_t hstepA = (size_t)HALF * lda * 2, hstepB = (size_t)HALF * ldb * 2;
    const unsigned ldsw = (unsigned)wid * 1024u;
    const int aoff = lds_byte(wr * 64 + fr, fq * 8), boff = lds_byte(wc * 32 + fr, fq * 8);
#define PG8_SA(b, h) (((b) * 2 + (h)) * HTB)
#define PG8_SB(b, h) ((4 + (b) * 2 + (h)) * HTB)
#define PG8_STAGE(bufoff, gbase, voff) do { _Pragma("unroll") for (int _i = 0; _i < 2; ++_i) \
        __builtin_amdgcn_global_load_lds((const unsigned*)((const char*)(gbase) + (voff)[_i]), (LAS unsigned*)(lds + (bufoff) + ldsw + _i * 8192), 16, 0, 0); } while (0)
#define PG8_LDA(dst, b, h) do { _Pragma("unroll") for (int m = 0; m < 4; ++m) _Pragma("unroll") for (int k = 0; k < 2; ++k) dst[m][k] = *(const LAS bf16x8*)(lds + PG8_SA(b, h) + aoff + m * 2048 + k * 1024); } while (0)
#define PG8_LDB(dst, b, h) do { _Pragma("unroll") for (int n = 0; n < 2; ++n) _Pragma("unroll") for (int k = 0; k < 2; ++k) dst[n][k] = *(const LAS bf16x8*)(lds + PG8_SB(b, h) + boff + n * 2048 + k * 1024); } while (0)
#define PG8_MMA(ai, bj, At, Bt) do { __builtin_amdgcn_s_setprio(1); _Pragma("unroll") for (int m = 0; m < 4; ++m) _Pragma("unroll") for (int n = 0; n < 2; ++n) _Pragma("unroll") for (int k = 0; k < 2; ++k) \
        acc[ai][bj][m][n] = __builtin_amdgcn_mfma_f32_16x16x32_bf16(Bt[n][k], At[m][k], acc[ai][bj][m][n], 0, 0, 0); __builtin_amdgcn_s_setprio(0); } while (0)
#define PG8_WAIT_V(n) asm volatile("s_waitcnt vmcnt(" #n ")" ::: "memory")
#define PG8_WAIT_L(n) asm volatile("s_waitcnt lgkmcnt(" #n ")" ::: "memory")
#define PG8_BAR __builtin_amdgcn_s_barrier()
#define PG8_SCHED __builtin_amdgcn_sched_barrier(0)
    Unit cur, nxt; int ui = 0;
    if (!S.next(0, cur)) return;
    f32x4 acc[2][2][4][2];
#pragma unroll
    for (int a = 0; a < 2; ++a)
#pragma unroll
        for (int b = 0; b < 2; ++b)
#pragma unroll
            for (int m = 0; m < 4; ++m)
#pragma unroll
                for (int n = 0; n < 2; ++n) acc[a][b][m][n] = (f32x4){0.f, 0.f, 0.f, 0.f};
    bf16x8 At[4][2], B0[2][2], B1[2][2];
    const char* cA = cur.A; const char* cB = cur.B;
    PG8_STAGE(PG8_SB(0, 0), cB, voffB); PG8_STAGE(PG8_SB(0, 1), cB + hstepB, voffB); PG8_STAGE(PG8_SA(0, 0), cA, voffA); PG8_STAGE(PG8_SA(0, 1), cA + hstepA, voffA);
    if (wr == 1) PG8_BAR;
    PG8_WAIT_V(2); PG8_BAR;
    PG8_STAGE(PG8_SB(1, 0), cB + kstep, voffB); PG8_STAGE(PG8_SA(1, 0), cA + kstep, voffA); PG8_STAGE(PG8_SB(1, 1), cB + hstepB + kstep, voffB);
    PG8_WAIT_V(6); PG8_BAR;
    for (;;) {
        const bool has_next = S.next(ui + 1, nxt);
        const char* nA = has_next ? nxt.A : cA; const char* nB = has_next ? nxt.B : cB;
        for (int t = 0; t < nt; t += 2) {
            const bool last = (t == nt - 2);
            const char* a1 = cA + (size_t)(t + 1) * kstep;
            const char* a2 = last ? nA : cA + (size_t)(t + 2) * kstep; const char* b2 = last ? nB : cB + (size_t)(t + 2) * kstep;
            const char* a3 = a2 + kstep; const char* b3 = b2 + kstep;
            PG8_LDB(B0, 0, 0); PG8_LDB(B1, 0, 1); PG8_SCHED; PG8_LDA(At, 0, 0); PG8_STAGE(PG8_SA(1, 1), a1 + hstepA, voffA);
            PG8_WAIT_V(8); PG8_WAIT_L(0); PG8_BAR; PG8_MMA(0, 0, At, B0); PG8_MMA(0, 1, At, B1); PG8_BAR; PG8_SCHED;
            PG8_LDA(At, 0, 1); PG8_STAGE(PG8_SB(0, 0), b2, voffB); PG8_STAGE(PG8_SB(0, 1), b2 + hstepB, voffB); PG8_STAGE(PG8_SA(0, 0), a2, voffA);
            PG8_WAIT_V(8); PG8_WAIT_L(0); PG8_BAR; PG8_MMA(1, 0, At, B0); PG8_MMA(1, 1, At, B1); PG8_BAR; PG8_SCHED;
            PG8_LDB(B0, 1, 0); PG8_LDB(B1, 1, 1); PG8_SCHED; PG8_LDA(At, 1, 0); PG8_STAGE(PG8_SA(0, 1), a2 + hstepA, voffA);
            PG8_WAIT_V(8); PG8_WAIT_L(0); PG8_BAR; PG8_MMA(0, 0, At, B0); PG8_MMA(0, 1, At, B1); PG8_BAR; PG8_SCHED;
            PG8_LDA(At, 1, 1); PG8_STAGE(PG8_SB(1, 0), b3, voffB); PG8_STAGE(PG8_SB(1, 1), b3 + hstepB, voffB); PG8_STAGE(PG8_SA(1, 0), a3, voffA);
            PG8_WAIT_V(8); PG8_WAIT_L(0); PG8_BAR; PG8_MMA(1, 0, At, B0); PG8_MMA(1, 1, At, B1); PG8_BAR; PG8_SCHED;
        }
        if constexpr (ALIGN_EPI) { if (wr == 0) PG8_BAR; }
        E(acc, cur, wr, wc, fr, fq, wid, lane);
        if (!has_next) break;
#pragma unroll
        for (int a = 0; a < 2; ++a)
#pragma unroll
            for (int b = 0; b < 2; ++b)
#pragma unroll
                for (int m = 0; m < 4; ++m)
#pragma unroll
                    for (int n = 0; n < 2; ++n) acc[a][b][m][n] = (f32x4){0.f, 0.f, 0.f, 0.f};
        cur = nxt; cA = nA; cB = nB; ++ui;
        if constexpr (ALIGN_EPI) { if (wr == 1) PG8_BAR; }
    }
    PG8_WAIT_V(0);
    if constexpr (!ALIGN_EPI) { if (wr == 0) PG8_BAR; }
    PG8_BAR;
#undef PG8_SA
#undef PG8_SB
#undef PG8_STAGE
#undef PG8_LDA
#undef PG8_LDB
#undef PG8_MMA
#undef PG8_WAIT_V
#undef PG8_WAIT_L
#undef PG8_BAR
#undef PG8_SCHED
}
}

constexpr int RING_BYTES = 131072;
constexpr int LDSX_OFF = RING_BYTES;
constexpr int LDSCTL_OFF = RING_BYTES + 16384;
constexpr int LDS_BYTES = 163840;

typedef GAS unsigned gu32;
#define RLX_AGENT __ATOMIC_RELAXED, __HIP_MEMORY_SCOPE_AGENT

#define XB_TMO      128
#define XB_XCNT(j)  (256  + 64 * (j))
#define XB_XSUB(j)  (1280 + 64 * (j))
#define XB_XGEN(j)  (2304 + 64 * (j))
#define XB_TOP      3328
#define XB_TOPGEN   3392
#define XCD_BAR_WORDS 3456
#define XB_SPIN_CAP (1u << 20)
DI unsigned xb_ld(unsigned* p)              { return __hip_atomic_load(p, __ATOMIC_RELAXED, __HIP_MEMORY_SCOPE_AGENT); }
DI unsigned xb_add(unsigned* p, unsigned v) { return __hip_atomic_fetch_add(p, v, __ATOMIC_RELAXED, __HIP_MEMORY_SCOPE_AGENT); }
DI unsigned xb_xcc_id() { return (unsigned)__builtin_amdgcn_s_getreg((3 << 11) | 20) & 0xFu; }
#define XB_SPIN(cond, bar) do { unsigned _sp = 0; while (cond) { __builtin_amdgcn_s_sleep(1); \
    if ((++_sp & 255u) == 0u) { if (xb_ld(&(bar)[XB_TMO])) break; if (_sp > XB_SPIN_CAP) { atomicAdd(&(bar)[XB_TMO], 1u); break; } } } } while (0)
struct XcdBarrier { unsigned* bar; unsigned x; volatile LAS unsigned* st; };
DI XcdBarrier xcd_barrier_post(unsigned* bar, volatile LAS unsigned* st) {
    XcdBarrier b; b.bar = bar; b.x = xb_xcc_id(); b.st = st;
    if (threadIdx.x == 0) (void)xb_add(&bar[XB_XCNT(b.x)], 1u);
    return b;
}
DI void xcd_barrier_complete(unsigned* bar, unsigned x, unsigned& nloc, unsigned& nx) {
    const unsigned G = gridDim.x * gridDim.y * gridDim.z;
    unsigned sum, cnt, mine, sp = 0u;
    for (;;) {
        sum = 0u; cnt = 0u; mine = 0u;
#pragma unroll
        for (unsigned j = 0; j < 16; ++j) { const unsigned c = xb_ld(&bar[XB_XCNT(j)]); sum += c; cnt += (c > 0u) ? 1u : 0u; mine = (j == x) ? c : mine; }
        if (sum == G) break;
        __builtin_amdgcn_s_sleep(1);
        if ((++sp & 255u) == 0u) { if (xb_ld(&bar[XB_TMO])) break; if (sp > XB_SPIN_CAP) { atomicAdd(&bar[XB_TMO], 1u); break; } }
    }
    nloc = mine > 0u ? mine : 1u; nx = cnt > 0u ? cnt : 1u;
}
DI void xcd_barrier(const XcdBarrier& b) {
    asm volatile("s_waitcnt vmcnt(0)" ::: "memory");
    __syncthreads();
    if (threadIdx.x == 0) {
        unsigned* bar = b.bar;
        __builtin_amdgcn_s_waitcnt(0);
        unsigned nloc = b.st[0], nx = b.st[1];
        if (nloc == 0u) { xcd_barrier_complete(bar, b.x, nloc, nx); b.st[0] = nloc; b.st[1] = nx; }
        const unsigned old = xb_add(&bar[XB_XSUB(b.x)], 1u);
        const unsigned gen = old / nloc;
        if (old + 1u == (gen + 1u) * nloc) {
            __builtin_amdgcn_fence(__ATOMIC_RELEASE, "agent");
            asm volatile("s_waitcnt vmcnt(0)" ::: "memory");
            const unsigned og = xb_add(&bar[XB_TOP], 1u);
            const unsigned tg = og / nx;
            if (og + 1u == (tg + 1u) * nx) xb_add(&bar[XB_TOPGEN], 1u);
            else XB_SPIN(xb_ld(&bar[XB_TOPGEN]) == tg, bar);
            __builtin_amdgcn_fence(__ATOMIC_ACQUIRE, "agent");
            xb_add(&bar[XB_XGEN(b.x)], 1u);
            asm volatile("s_waitcnt vmcnt(0)" ::: "memory");
        } else {
            XB_SPIN(xb_ld(&bar[XB_XGEN(b.x)]) == gen, bar);
            __builtin_amdgcn_fence(__ATOMIC_ACQUIRE, "agent");
            asm volatile("s_waitcnt vmcnt(0)" ::: "memory");
        }
    }
    __syncthreads();
}

struct Args {
    const void* in[19]; float* out; unsigned char* ws; int ph_lo, ph_hi;
    double fret[64]; double frot[64];
};
DI int lane_id() { int l; asm volatile("v_mbcnt_lo_u32_b32 %0, -1, 0\n\tv_mbcnt_hi_u32_b32 %0, -1, %0" : "=v"(l)); return l; }
struct Frame {
    LAS unsigned char* lds;
    int tid, lane, wave, G, bid;
    unsigned char* ws; unsigned char* dout;
};
#ifndef PROBE_PHASE
#define PROBE_PHASE -1
#endif
#define ISTAMP(F, k) do { if (PROBE_PHASE >= 20) { __syncthreads(); FSTAMP(F, k); } } while (0)
#define FSTAMP(F, k) do { if (PROBE_PHASE >= 0 && (F).bid == 0 && (F).tid == 0) { volatile LAS unsigned long long* ts_ = (volatile LAS unsigned long long*)((F).lds + LDS_BYTES - 64); \
    const unsigned long long t_ = __builtin_amdgcn_s_memrealtime(); if ((k) == PROBE_PHASE) ts_[1] = t_ - ts_[0]; ts_[0] = t_; } } while (0)
enum { I_X = 0, I_MEM, I_POS, I_GMIX, I_WIN, I_WBR, I_WBD, I_WOUT, I_GCROSS, I_GMEM, I_WQ, I_WKV, I_WO, I_GFFN, I_WPQ, I_SUBK, I_PU, I_PV, I_GFINAL };

DI void tr_item(const float* W, int K, int N, bf16_t* WT, const float* scale, int rot_lo, int rot_hi, LAS float* scr, int item, int lane) {
    const int nblk = N / 64, kb = item / nblk, nb = item % nblk, k0 = 64 * kb, c0 = 64 * nb;
    f32x4 wv[16];
#pragma unroll
    for (int i = 0; i < 16; ++i) { const int kk = 4 * i + (lane >> 4); wv[i] = *(const GAS f32x4*)(W + (size_t)(k0 + kk) * N + c0 + 4 * (lane & 15)); }
    if (scale) {
#pragma unroll
        for (int i = 0; i < 16; ++i) wv[i] = wv[i] * scale[k0 + 4 * i + (lane >> 4)];
    }
#pragma unroll
    for (int i = 0; i < 16; ++i) { const int kk = 4 * i + (lane >> 4); *(LAS f32x4*)(scr + kk * 68 + 4 * (lane & 15)) = wv[i]; }
    LDS_WAIT();
    const bool rot = (c0 >= rot_lo) && (c0 < rot_hi);
    const int hb = c0 & ~127, half = (c0 >> 6) & 1;
    const int c = lane & 7;
#pragma unroll
    for (int j = 0; j < 8; ++j) { const int n = (lane >> 3) + 8 * j; const LAS float* sp = scr + (8 * c) * 68 + n;
        u32x4 o; o.x = pk2(sp[0 * 68], sp[1 * 68]); o.y = pk2(sp[2 * 68], sp[3 * 68]); o.z = pk2(sp[4 * 68], sp[5 * 68]); o.w = pk2(sp[6 * 68], sp[7 * 68]);
        const int drow = rot ? (hb + 2 * n + half) : (c0 + n);
        *(GAS u32x4*)(WT + (size_t)drow * K + k0 + 8 * c) = o; }
    LDS_WAIT();
}
DI void rms_row_bf16(const float* xrow, const float* g, bf16_t* orow, int lane) {
    const GAS f32x4* xr = (const GAS f32x4*)xrow + lane; const GAS f32x4* gr = (const GAS f32x4*)g + lane;
    f32x4 v[8]; float s = 0.f;
#pragma unroll
    for (int j = 0; j < 8; ++j) { v[j] = xr[64 * j]; s += (v[j].x * v[j].x + v[j].y * v[j].y) + (v[j].z * v[j].z + v[j].w * v[j].w); }
    const float rstd = 1.0f / sqrtf(wave_sum(s) * (1.f / DM) + EPS);
    GAS u32x2* o8 = (GAS u32x2*)orow + lane;
#pragma unroll
    for (int j = 0; j < 8; ++j) { const f32x4 gg = gr[64 * j]; u32x2 o; o.x = pk2(v[j].x * rstd * gg.x, v[j].y * rstd * gg.y); o.y = pk2(v[j].z * rstd * gg.z, v[j].w * rstd * gg.w); o8[64 * j] = o; }
}
DI void sincos_d(double a, float& c, float& s) {
    const double x = a * 0.63661977236758134308; const double q = __builtin_rint(x);
    double r = __builtin_fma(-q, 1.57079632679489655800, a); r = __builtin_fma(-q, 6.12323399573676603587e-17, r);
    const int qi = ((int)q) & 3; const double r2 = r * r;
    double sn = 1.0 / 6227020800.0; sn = sn * r2 - 1.0 / 39916800.0; sn = sn * r2 + 1.0 / 362880.0; sn = sn * r2 - 1.0 / 5040.0; sn = sn * r2 + 1.0 / 120.0; sn = sn * r2 - 1.0 / 6.0; sn = sn * r2 + 1.0; sn *= r;
    double cs = -1.0 / 87178291200.0; cs = cs * r2 + 1.0 / 479001600.0; cs = cs * r2 - 1.0 / 3628800.0; cs = cs * r2 + 1.0 / 40320.0; cs = cs * r2 - 1.0 / 720.0; cs = cs * r2 + 1.0 / 24.0; cs = cs * r2 - 0.5; cs = cs * r2 + 1.0;
    const double so = (qi == 0) ? sn : (qi == 1) ? cs : (qi == 2) ? -sn : -cs;
    const double co = (qi == 0) ? cs : (qi == 1) ? -sn : (qi == 2) ? -cs : sn;
    c = (float)co; s = (float)so;
}
DI void ph0_prologue(const Frame& F, const Args& a) {
    LAS float* scr = (LAS float*)(F.lds + F.wave * 17408);
    const int gw = F.bid * NWAVES + F.wave, NGW = F.G * NWAVES;
    unsigned char* ws = F.ws;
    constexpr int I_IN = (DM / 64) * (INW / 64), I_KV = (DM / 64) * (4096 / 64), I_BR = (1024 / 64) * (DM / 64), I_BD = (512 / 64) * (DM / 64), I_SQ = (DM / 64) * (DM / 64);
    constexpr int NITEMS = I_IN + I_KV + I_BR + I_BD + 4 * I_SQ;
    for (int it = gw; it < NITEMS; it += NGW) {
        int r = it;
        if (r < I_IN) { tr_item((const float*)a.in[I_WIN], DM, INW, (bf16_t*)(ws + WS_WIN_T), nullptr, 4096, 7168, scr, r, F.lane); continue; } r -= I_IN;
        if (r < I_KV) { tr_item((const float*)a.in[I_WKV], DM, 4096, (bf16_t*)(ws + WS_WKV_T), nullptr, 0, 0, scr, r, F.lane); continue; } r -= I_KV;
        if (r < I_BR) { tr_item((const float*)a.in[I_WBR], 1024, DM, (bf16_t*)(ws + WS_WBR_T), nullptr, 0, 0, scr, r, F.lane); continue; } r -= I_BR;
        if (r < I_BD) { tr_item((const float*)a.in[I_WBD], 512, DM, (bf16_t*)(ws + WS_WBD_T), nullptr, 0, 0, scr, r, F.lane); continue; } r -= I_BD;
        if (r < I_SQ) { tr_item((const float*)a.in[I_WOUT], DM, DM, (bf16_t*)(ws + WS_WOUT_T), nullptr, 0, 0, scr, r, F.lane); continue; } r -= I_SQ;
        if (r < I_SQ) { tr_item((const float*)a.in[I_WQ], DM, DM, (bf16_t*)(ws + WS_WQ_T), (const float*)a.in[I_GCROSS], 0, 0, scr, r, F.lane); continue; } r -= I_SQ;
        if (r < I_SQ) { tr_item((const float*)a.in[I_WO], DM, DM, (bf16_t*)(ws + WS_WO_T), nullptr, 0, 0, scr, r, F.lane); continue; } r -= I_SQ;
        tr_item((const float*)a.in[I_WPQ], DM, DM, (bf16_t*)(ws + WS_WPQ_T), (const float*)a.in[I_GFFN], 0, 0, scr, r, F.lane);
    }
    ISTAMP(F, 42);
    for (int m = gw; m < MT; m += NGW) rms_row_bf16((const float*)a.in[I_X] + (size_t)m * DM, (const float*)a.in[I_GMIX], (bf16_t*)(F.dout + DO_H1) + (size_t)m * DM, F.lane);
    for (int m = gw; m < MROWS; m += NGW) rms_row_bf16((const float*)a.in[I_MEM] + (size_t)m * DM, (const float*)a.in[I_GMEM], (bf16_t*)(F.dout + DO_MEMN) + (size_t)m * DM, F.lane);
    ISTAMP(F, 43);
    const int gt = F.bid * NTHREADS + F.tid, NGT = F.G * NTHREADS;
    for (int i = gt; i < 16 * 128 * 128 / 8; i += NGT) {
        const GAS f32x4* s = (const GAS f32x4*)a.in[I_SUBK] + 2 * (size_t)i; const f32x4 v0 = s[0], v1 = s[1];
        u32x4 o; o.x = pk2(v0.x, v0.y); o.y = pk2(v0.z, v0.w); o.z = pk2(v1.x, v1.y); o.w = pk2(v1.z, v1.w);
        ((GAS u32x4*)(ws + WS_SUBK))[i] = o;
    }
    for (int i = gt; i < MT * 64; i += NGT) {
        const int t = i >> 6, k = i & 63; const double pos = (double)((const int*)a.in[I_POS])[t];
        { const double rv = pos * a.fret[k] * 0.15915494309189533577; const float fr = (float)(rv - __builtin_floor(rv));
          ((GAS f32x2*)(F.dout + DO_CSRET))[i] = (f32x2){__builtin_amdgcn_cosf(fr), __builtin_amdgcn_sinf(fr)}; }
        { const double rv = pos * a.frot[k] * 0.15915494309189533577; const float fr = (float)(rv - __builtin_floor(rv));
          ((GAS f32x2*)(F.dout + DO_CSROT))[i] = (f32x2){__builtin_amdgcn_cosf(fr), __builtin_amdgcn_sinf(fr)}; }
    }
}

#ifndef WGM_PROJ
#define WGM_PROJ 4
#endif
#ifndef WGM_MID
#define WGM_MID 4
#endif
struct Unit1 { const char* A; const char* B; int pm, pn; int mode; bf16_t* out; int ldo; float scale; const float* cs; };
struct Sched1 {
    typedef Unit1 Unit;
    int G, c; unsigned char* ws; unsigned char* dout;
    DI bool next(int i, Unit& u) const {
        const int L = i * G + c; if (L >= 3328) return false;
        if (L < 3200) {
            int pm, pn; pg8::tile_of<WGM_PROJ>(L, 64, 50, pm, pn); u.pm = pm; u.pn = pn;
            u.A = (const char*)(dout + DO_H1) + (size_t)pm * 256 * DM * 2; u.B = (const char*)(ws + WS_WIN_T) + (size_t)pn * 256 * DM * 2;
            u.scale = 1.f; u.cs = nullptr; u.mode = 0;
            const size_t rowoff = (size_t)pm * 256;
            if (pn < 4)       { u.mode = 1; u.out = (bf16_t*)(ws + WS_RQ) + rowoff * 1024 + (pn - 0) * 256; u.ldo = 1024; u.cs = (const float*)(dout + DO_CSRET); }
            else if (pn < 8)  { u.mode = 1; u.out = (bf16_t*)(ws + WS_RK) + rowoff * 1024 + (pn - 4) * 256; u.ldo = 1024; u.cs = (const float*)(dout + DO_CSRET); u.scale = 0.08838834764831845f; }
            else if (pn < 12) { u.out = (bf16_t*)(ws + WS_RV) + rowoff * 1024 + (pn - 8) * 256; u.ldo = 1024; }
            else if (pn < 16) { u.mode = 2; u.out = (bf16_t*)(ws + WS_SG) + rowoff * 1024 + (pn - 12) * 256; u.ldo = 1024; }
            else if (pn < 22) { u.mode = 1; u.out = (bf16_t*)(ws + WS_DQ) + rowoff * 1536 + (pn - 16) * 256; u.ldo = 1536; u.cs = (const float*)(dout + DO_CSROT); u.scale = 0.08838834764831845f * 1.4426950408889634f; }
            else if (pn < 28) { u.mode = 1; u.out = (bf16_t*)(ws + WS_DK) + rowoff * 1536 + (pn - 22) * 256; u.ldo = 1536; u.cs = (const float*)(dout + DO_CSROT); }
            else if (pn < 34) { u.out = (bf16_t*)(ws + WS_DV) + rowoff * 1536 + (pn - 28) * 256; u.ldo = 1536; }
            else if (pn < 42) { u.mode = 3; u.out = (bf16_t*)(ws + WS_GR) + rowoff * 2048 + (pn - 34) * 256; u.ldo = 2048; }
            else              { u.mode = 3; u.out = (bf16_t*)(ws + WS_GD) + rowoff * 2048 + (pn - 42) * 256; u.ldo = 2048; }
        } else {
            const int l = L - 3200; u.mode = 0; u.scale = 1.f; u.cs = nullptr; u.ldo = 2048;
            if (l < 64) { const int pm = l >> 3, pn = l & 7; u.pm = pm; u.pn = pn;
                u.A = (const char*)(dout + DO_MEMN) + (size_t)pm * 256 * DM * 2; u.B = (const char*)(ws + WS_WKV_T) + (size_t)pn * 256 * DM * 2;
                u.out = (bf16_t*)(ws + WS_KM) + (size_t)pm * 256 * 2048 + pn * 256; }
            else { const int l2 = l - 64, pm = l2 >> 3, pn = l2 & 7; u.pm = pm; u.pn = pn;
                u.A = (const char*)(ws + WS_WKV_T) + (size_t)(2048 + pm * 256) * DM * 2; u.B = (const char*)(dout + DO_MEMN) + (size_t)pn * 256 * DM * 2;
                u.out = (bf16_t*)(ws + WS_VT) + (size_t)pm * 256 * 2048 + pn * 256; }
        }
        return true;
    }
};
struct EpiNull1 {
    DI void operator()(const f32x4 (&acc)[2][2][4][2], const Unit1& u, int wr, int wc, int fr, int fq, int wid, int lane) const {
#pragma unroll
        for (int ai = 0; ai < 2; ++ai)
#pragma unroll
            for (int bj = 0; bj < 2; ++bj)
#pragma unroll
                for (int m = 0; m < 4; ++m) { asm volatile("" :: "v"(acc[ai][bj][m][0]), "v"(acc[ai][bj][m][1])); }
    }
};
struct EpiProj {
    template <int MODE> DI void emit(const f32x4 (&acc)[2][2][4][2], const Unit1& u, int wr, int wc, int fr, int fq) const {
        const int rowl0 = wr * 64 + fr, colb = wc * 32 + 8 * fq;
        f32x4 cs[2][4][2];
        if (MODE == 1) {
#pragma unroll
            for (int ai = 0; ai < 2; ++ai)
#pragma unroll
                for (int m = 0; m < 4; ++m) { const GAS f32x4* cp = (const GAS f32x4*)(u.cs + ((size_t)(u.pm * 256 + ai * 128 + m * 16 + rowl0) * 64 + (colb >> 1)) * 2); cs[ai][m][0] = cp[0]; cs[ai][m][1] = cp[1]; }
        }
#pragma unroll
        for (int ai = 0; ai < 2; ++ai)
#pragma unroll
            for (int m = 0; m < 4; ++m) {
                const int rl = ai * 128 + m * 16 + rowl0;
                f32x4 cs0 = {1.f, 0.f, 1.f, 0.f}, cs1 = cs0;
                if (MODE == 1) { cs0 = cs[ai][m][0]; cs1 = cs[ai][m][1]; }
                bf16_t* rowp = u.out + (size_t)rl * u.ldo + colb;
#pragma unroll
                for (int bj = 0; bj < 2; ++bj) {
                    f32x4 v0 = acc[ai][bj][m][0], v1 = acc[ai][bj][m][1];
                    if (MODE == 1) {
                        const f32x4 a0 = v0, a1 = v1; const float sc = u.scale;
                        v0.x = (a0.x * cs0.x - a0.y * cs0.y) * sc; v0.y = (a0.y * cs0.x + a0.x * cs0.y) * sc;
                        v0.z = (a0.z * cs0.z - a0.w * cs0.w) * sc; v0.w = (a0.w * cs0.z + a0.z * cs0.w) * sc;
                        v1.x = (a1.x * cs1.x - a1.y * cs1.y) * sc; v1.y = (a1.y * cs1.x + a1.x * cs1.y) * sc;
                        v1.z = (a1.z * cs1.z - a1.w * cs1.w) * sc; v1.w = (a1.w * cs1.z + a1.z * cs1.w) * sc;
                    } else if (MODE == 2) {
#pragma unroll
                        for (int e = 0; e < 4; ++e) { v0[e] = v0[e] * sigmoid_f(v0[e]); v1[e] = v1[e] * sigmoid_f(v1[e]); }
                    } else if (MODE == 3) {
#pragma unroll
                        for (int e = 0; e < 4; ++e) { v0[e] = sigmoid_f(v0[e]); v1[e] = sigmoid_f(v1[e]); }
                    }
                    u32x4 w; w.x = pk2(v0.x, v0.y); w.y = pk2(v0.z, v0.w); w.z = pk2(v1.x, v1.y); w.w = pk2(v1.z, v1.w);
                    *(GAS u32x4*)(rowp + bj * 128) = w;
                }
            }
    }
    DI void operator()(const f32x4 (&acc)[2][2][4][2], const Unit1& u, int wr, int wc, int fr, int fq, int wid, int lane) const {
        if (u.mode == 0) emit<0>(acc, u, wr, wc, fr, fq);
        else if (u.mode == 1) emit<1>(acc, u, wr, wc, fr, fq);
        else if (u.mode == 2) emit<2>(acc, u, wr, wc, fr, fq);
        else emit<3>(acc, u, wr, wc, fr, fq);
    }
};

#define MFMA32(a, b, c) __builtin_amdgcn_mfma_f32_32x32x16_bf16((a), (b), (c), 0, 0, 0)
DI int crow(int reg, int h) { return (reg & 3) + 8 * (reg >> 2) + 4 * h; }
DI s16x4 tr4(LAS const unsigned char* p) { return __builtin_bit_cast(s16x4, __builtin_amdgcn_ds_read_tr16_b64_v4i16((LAS v4i16_t*)p)); }
DI bf16x8 frag_tr(LAS const unsigned char* base, int pitch, int k0, int c0, int lane) {
    const int h = lane >> 5, blk = (lane >> 4) & 1, q = (lane & 15) >> 2, p = lane & 3;
    LAS const unsigned char* a = base + (k0 + 8 * h + q) * pitch + (c0 + 16 * blk + 4 * p) * 2;
    const s16x4 lo = tr4(a), hi = tr4(a + 4 * pitch);
    return __builtin_shufflevector(lo, hi, 0, 1, 2, 3, 4, 5, 6, 7);
}
DI bf16x8 frag_nt(LAS const unsigned char* base, int pitch, int r0, int k0, int lane) {
    return *(LAS const bf16x8*)(base + (r0 + (lane & 31)) * pitch + (k0 + 8 * (lane >> 5)) * 2);
}
DI f32x16 zero16() { f32x16 z;
#pragma unroll
    for (int i = 0; i < 16; ++i) z[i] = 0.f; return z; }
DI u32x4 scale_bf16x8(u32x4 v, float s) {
    u32x4 o; o.x = pk2(bf_lo(v.x) * s, bf_hi(v.x) * s); o.y = pk2(bf_lo(v.y) * s, bf_hi(v.y) * s); o.z = pk2(bf_lo(v.z) * s, bf_hi(v.z) * s); o.w = pk2(bf_lo(v.w) * s, bf_hi(v.w) * s); return o;
}
DI float ret_lg2gamma(int h) { return __builtin_log2f(1.0f - __builtin_exp2f(-5.0f - (float)h)); }

DI void ret_kv_item(const Frame& F, int bh, int n) {
    const int b = bh >> 3, h = bh & 7; const float lg = ret_lg2gamma(h);
    LAS unsigned char* VL = F.lds; LAS unsigned char* KL = F.lds + 128 * 320;
    const bf16_t* RK = (const bf16_t*)(F.ws + WS_RK); const bf16_t* RV = (const bf16_t*)(F.ws + WS_RV);
#pragma unroll
    for (int it = 0; it < 8; ++it) {
        const int idx = F.tid + NTHREADS * it, which = idx >> 11, rem = idx & 2047, row = rem >> 4, ch = rem & 15;
        const size_t tok = (size_t)b * SEQ + n * 128 + row;
        u32x4 v = *(const GAS u32x4*)((which ? RK : RV) + tok * 1024 + h * 128 + ch * 8);
        if (which) v = scale_bf16x8(v, fast_exp2(lg * (float)(127 - row)));
        *(LAS u32x4*)((which ? KL : VL) + row * 320 + ch * 16) = v;
    }
    __syncthreads();
    const int w = F.wave, lane = F.lane, eb = w >> 1, db0 = 2 * (w & 1);
    f32x16 acc0 = zero16(), acc1 = zero16();
#pragma unroll
    for (int s = 0; s < 8; ++s) {
        const bf16x8 a = frag_tr(VL, 320, 16 * s, 32 * eb, lane);
        const bf16x8 b0 = frag_tr(KL, 320, 16 * s, 32 * db0, lane), b1 = frag_tr(KL, 320, 16 * s, 32 * (db0 + 1), lane);
        acc0 = MFMA32(a, b0, acc0); acc1 = MFMA32(a, b1, acc1);
    }
    float* dst = (float*)(F.ws + WS_KVST) + ((size_t)(bh * 16 + n) * 128) * 128;
    const int r = lane & 31, hh = lane >> 5;
#pragma unroll
    for (int reg = 0; reg < 16; ++reg) { const int e = 32 * eb + crow(reg, hh);
        dst[(size_t)e * 128 + 32 * db0 + r] = acc0[reg]; dst[(size_t)e * 128 + 32 * (db0 + 1) + r] = acc1[reg]; }
    __syncthreads();
}

struct DilRegs { u32x4 vst[8], kst[8]; bf16x8 qf[8]; };
DI void dil_issue(const Frame& F, int item, DilRegs& R) {
    const int b = item / 192, rem = item % 192, head = rem >> 4, idx16 = rem & 15;
    const int g = head >> 2, r = (g == 0) ? 1 : (g == 1) ? 4 : 16, nbk = 16 / r, c = idx16 / nbk, n = idx16 % nbk;
    const bf16_t* DQ = (const bf16_t*)(F.ws + WS_DQ); const bf16_t* DK = (const bf16_t*)(F.ws + WS_DK); const bf16_t* DV = (const bf16_t*)(F.ws + WS_DV);
    const size_t tb = (size_t)b * SEQ; const int kbmin = (n == 0) ? 4 : 0;
    const int lane = F.lane, rr = lane & 31, hh = lane >> 5, wq = F.wave & 3;
#pragma unroll
    for (int it = 0; it < 8; ++it) {
        const int idx = F.tid + NTHREADS * it, row = idx >> 4, ch = idx & 15; const int rowl = (row >= 32 * kbmin) ? row : 128 + (row & 127);
        const size_t tok = tb + (size_t)((128 * (n - 1) + rowl) * r + c);
        R.vst[it] = *(const GAS u32x4*)(DV + tok * 1536 + head * 128 + ch * 8);
        R.kst[it] = *(const GAS u32x4*)(DK + tok * 1536 + head * 128 + ch * 8);
    }
    const size_t tokq = tb + (size_t)((128 * n + 32 * wq + rr) * r + c);
    const bf16_t* qp = DQ + tokq * 1536 + head * 128 + 8 * hh;
#pragma unroll
    for (int s = 0; s < 8; ++s) R.qf[s] = *(const GAS bf16x8*)(qp + 16 * s);
}
DI void dil_item(const Frame& F, int item, int nxt, DilRegs& R) {
    const int b = item / 192, rem = item % 192, head = rem >> 4, idx16 = rem & 15;
    const int g = head >> 2, r = (g == 0) ? 1 : (g == 1) ? 4 : 16, nbk = 16 / r, c = idx16 / nbk, n = idx16 % nbk;
    LAS unsigned char* VL = F.lds;
    LAS unsigned char* KL = F.lds + 256 * 320;
    LAS unsigned char* PL = F.lds + 256 * 320;
    LAS float* SMAX = (LAS float*)(F.lds + 256 * 320 + 256 * 272);
    LAS float* SSUM = SMAX + 256;
    bf16_t* DQ = (bf16_t*)(F.ws + WS_DQ);
    const size_t tb = (size_t)b * SEQ;
    const int kbmin = (n == 0) ? 4 : 0;
    const int lane = F.lane, rr = lane & 31, hh = lane >> 5, wq = F.wave & 3, wd = F.wave >> 2;
    const int qi = 32 * wq + rr;
    const size_t tokq = tb + (size_t)((128 * n + qi) * r + c);
#pragma unroll
    for (int it = 0; it < 8; ++it) { const int idx = F.tid + NTHREADS * it, row = idx >> 4, ch = idx & 15;
        if (row >= 32 * kbmin) { *(LAS u32x4*)(VL + row * 320 + ch * 16) = R.vst[it]; *(LAS u32x4*)(KL + row * 272 + ch * 16) = R.kst[it]; } }
    bf16x8 qf[8];
#pragma unroll
    for (int s = 0; s < 8; ++s) qf[s] = R.qf[s];
    __syncthreads();
    f32x16 st[3]; bool val[3]; float mloc = -INFINITY;
#pragma unroll
    for (int sl = 0; sl < 3; ++sl) {
        const int kb = wq + wd + 2 * sl; val[sl] = (kb <= wq + 4) && (kb >= kbmin);
        st[sl] = zero16();
        if (val[sl]) {
#pragma unroll
            for (int s = 0; s < 8; ++s) st[sl] = MFMA32(frag_nt(KL, 272, 32 * kb, 16 * s, lane), qf[s], st[sl]);
#pragma unroll
            for (int reg = 0; reg < 16; ++reg) { const int jj = 32 * kb + crow(reg, hh); const bool ok = (jj >= qi) && (jj <= qi + 128);
                st[sl][reg] = ok ? st[sl][reg] : -INFINITY; mloc = fmaxf(mloc, st[sl][reg]); }
        }
    }
    dil_issue(F, nxt, R);
    mloc = fmaxf(mloc, __shfl_xor(mloc, 32));
    if (hh == 0) SMAX[wd * 128 + qi] = mloc;
    __syncthreads();
    const float mx = fmaxf(SMAX[qi], SMAX[128 + qi]);
    float lloc = 0.f;
#pragma unroll
    for (int sl = 0; sl < 3; ++sl) {
        if (val[sl]) { const int kb = wq + wd + 2 * sl;
#pragma unroll
            for (int reg = 0; reg < 16; ++reg) { const float p = fast_exp2(st[sl][reg] - mx); st[sl][reg] = p; lloc += p; }
#pragma unroll
            for (int g4 = 0; g4 < 4; ++g4) { u32x2 w; w.x = pk2(st[sl][4 * g4], st[sl][4 * g4 + 1]); w.y = pk2(st[sl][4 * g4 + 2], st[sl][4 * g4 + 3]);
                *(LAS u32x2*)(PL + qi * 528 + (32 * kb + 8 * g4 + 4 * hh) * 2) = w; }
        }
    }
    lloc += __shfl_xor(lloc, 32);
    if (hh == 0) SSUM[wd * 128 + qi] = lloc;
    __syncthreads();
    const float lsum = SSUM[qi] + SSUM[128 + qi];
    f32x16 o0 = zero16(), o1 = zero16();
    const int kb_lo = (wq > kbmin) ? wq : kbmin;
    for (int kb = kb_lo; kb <= wq + 4; ++kb) {
#pragma unroll
        for (int s = 0; s < 2; ++s) {
            const bf16x8 pb = frag_nt(PL, 528, 32 * wq, 32 * kb + 16 * s, lane);
            const bf16x8 a0 = frag_tr(VL, 320, 32 * kb + 16 * s, 64 * wd, lane), a1 = frag_tr(VL, 320, 32 * kb + 16 * s, 64 * wd + 32, lane);
            o0 = MFMA32(a0, pb, o0); o1 = MFMA32(a1, pb, o1);
        }
    }
    const float inv = 1.0f / lsum;
    bf16_t* op = DQ + tokq * 1536 + head * 128 + 64 * wd + 4 * hh;
#pragma unroll
    for (int g4 = 0; g4 < 4; ++g4) {
        u32x2 w0, w1; w0.x = pk2(o0[4 * g4] * inv, o0[4 * g4 + 1] * inv); w0.y = pk2(o0[4 * g4 + 2] * inv, o0[4 * g4 + 3] * inv);
        w1.x = pk2(o1[4 * g4] * inv, o1[4 * g4 + 1] * inv); w1.y = pk2(o1[4 * g4 + 2] * inv, o1[4 * g4 + 3] * inv);
        *(GAS u32x2*)(op + 8 * g4) = w0; *(GAS u32x2*)(op + 32 + 8 * g4) = w1;
    }
    if (wd == 0 && hh == 0) ((float*)(F.ws + WS_LSE))[(size_t)head * MT + tokq] = mx + __builtin_log2f(lsum);
    __syncthreads();
}

DI void ph2_mixers_a(const Frame& F) {
    const int vb = (F.G % 8 == 0) ? (F.bid % 8) * (F.G / 8) + F.bid / 8 : F.bid;
    for (int it = vb; it < 1024; it += F.G) ret_kv_item(F, it >> 4, it & 15);
    ISTAMP(F, 40);
    { DilRegs R; if (vb < 1536) dil_issue(F, vb, R);
      for (int it = vb; it < 1536; it += F.G) dil_item(F, it, (it + F.G < 1536) ? it + F.G : it, R); }
}

DI void ret_out_item(const Frame& F, int bh, int n) {
    const int b = bh >> 3, h = bh & 7; const float lg = ret_lg2gamma(h);
    LAS unsigned char* VL = F.lds;
    LAS unsigned char* PL = F.lds + 128 * 320;
    LAS unsigned char* PT = PL + 128 * 272;
    LAS float* SQ = (LAS float*)(PT + 128 * 272);
    bf16_t* RQ = (bf16_t*)(F.ws + WS_RQ); const bf16_t* RK = (const bf16_t*)(F.ws + WS_RK); const bf16_t* RV = (const bf16_t*)(F.ws + WS_RV); const bf16_t* SG = (const bf16_t*)(F.ws + WS_SG);
    const size_t tb = (size_t)b * SEQ + n * 128;
    LAS unsigned char* KL = (LAS unsigned char*)(SQ + 256);
    const int lane = F.lane, rr = lane & 31, hh = lane >> 5, wq = F.wave & 3, we = F.wave >> 2;
    const int qi = 32 * wq + rr;
    u32x4 vst[4], kst[4], pst[4];
    { const bf16_t* pv = (const bf16_t*)(F.dout + DO_PREVT) + (size_t)(bh * 16 + n) * 16384;
#pragma unroll
      for (int it = 0; it < 4; ++it) { const int idx = F.tid + NTHREADS * it, row = idx >> 4, ch = idx & 15;
          vst[it] = *(const GAS u32x4*)(RV + (tb + row) * 1024 + h * 128 + ch * 8);
          kst[it] = *(const GAS u32x4*)(RK + (tb + row) * 1024 + h * 128 + ch * 8);
          pst[it] = *(const GAS u32x4*)(pv + row * 128 + ch * 8); } }
    bf16x8 qf[8];
    { const bf16_t* qp = RQ + (tb + qi) * 1024 + h * 128 + 8 * hh;
#pragma unroll
      for (int s = 0; s < 8; ++s) qf[s] = *(const GAS bf16x8*)(qp + 16 * s); }
#pragma unroll
    for (int it = 0; it < 4; ++it) { const int idx = F.tid + NTHREADS * it, row = idx >> 4, ch = idx & 15;
        *(LAS u32x4*)(VL + row * 320 + ch * 16) = vst[it]; *(LAS u32x4*)(KL + row * 272 + ch * 16) = kst[it]; *(LAS u32x4*)(PT + row * 272 + ch * 16) = pst[it]; }
    __syncthreads();
#pragma unroll
    for (int sl = 0; sl < 2; ++sl) {
        const int kb = we + 2 * sl;
        if (kb <= wq) {
            f32x16 st = zero16();
#pragma unroll
            for (int s = 0; s < 8; ++s) st = MFMA32(frag_nt(KL, 272, 32 * kb, 16 * s, lane), qf[s], st);
#pragma unroll
            for (int reg = 0; reg < 16; ++reg) { const int j = 32 * kb + crow(reg, hh); st[reg] = (j <= qi) ? st[reg] * fast_exp2(lg * (float)(qi - j)) : 0.f; }
#pragma unroll
            for (int g4 = 0; g4 < 4; ++g4) { u32x2 w; w.x = pk2(st[4 * g4], st[4 * g4 + 1]); w.y = pk2(st[4 * g4 + 2], st[4 * g4 + 3]);
                *(LAS u32x2*)(PL + qi * 272 + (32 * kb + 8 * g4 + 4 * hh) * 2) = w; }
        }
    }
    __syncthreads();
    f32x16 in0 = zero16(), in1 = zero16(), cr0 = zero16(), cr1 = zero16();
    for (int kb = 0; kb <= wq; ++kb) {
#pragma unroll
        for (int s = 0; s < 2; ++s) {
            const bf16x8 pb = frag_nt(PL, 272, 32 * wq, 32 * kb + 16 * s, lane);
            const bf16x8 a0 = frag_tr(VL, 320, 32 * kb + 16 * s, 64 * we, lane), a1 = frag_tr(VL, 320, 32 * kb + 16 * s, 64 * we + 32, lane);
            in0 = MFMA32(a0, pb, in0); in1 = MFMA32(a1, pb, in1);
        }
    }
#pragma unroll
    for (int s = 0; s < 8; ++s) {
        const bf16x8 a0 = frag_nt(PT, 272, 64 * we, 16 * s, lane), a1 = frag_nt(PT, 272, 64 * we + 32, 16 * s, lane);
        cr0 = MFMA32(a0, qf[s], cr0); cr1 = MFMA32(a1, qf[s], cr1);
    }
    const float qw = fast_exp2(lg * (float)(qi + 1));
    float ss = 0.f;
#pragma unroll
    for (int reg = 0; reg < 16; ++reg) { in0[reg] += qw * cr0[reg]; in1[reg] += qw * cr1[reg]; ss += in0[reg] * in0[reg] + in1[reg] * in1[reg]; }
    ss += __shfl_xor(ss, 32);
    if (hh == 0) SQ[we * 128 + qi] = ss;
    __syncthreads();
    const float rstd = 1.0f / sqrtf((SQ[qi] + SQ[128 + qi]) * (1.0f / 128.0f) + EPS);
    const size_t off = (tb + qi) * 1024 + h * 128 + 64 * we + 4 * hh;
#pragma unroll
    for (int g4 = 0; g4 < 4; ++g4) {
        const u32x2 g0 = *(const GAS u32x2*)(SG + off + 8 * g4), g1 = *(const GAS u32x2*)(SG + off + 32 + 8 * g4);
        u32x2 w0, w1;
        w0.x = pk2(in0[4 * g4] * rstd * bf_lo(g0.x), in0[4 * g4 + 1] * rstd * bf_hi(g0.x)); w0.y = pk2(in0[4 * g4 + 2] * rstd * bf_lo(g0.y), in0[4 * g4 + 3] * rstd * bf_hi(g0.y));
        w1.x = pk2(in1[4 * g4] * rstd * bf_lo(g1.x), in1[4 * g4 + 1] * rstd * bf_hi(g1.x)); w1.y = pk2(in1[4 * g4 + 2] * rstd * bf_lo(g1.y), in1[4 * g4 + 3] * rstd * bf_hi(g1.y));
        *(GAS u32x2*)(RQ + off + 8 * g4) = w0; *(GAS u32x2*)(RQ + off + 32 + 8 * g4) = w1;
    }
    __syncthreads();
}
DI void ph_scan(const Frame& F) {
    const int gt = F.bid * NTHREADS + F.tid, NGT = F.G * NTHREADS;
    for (int i = gt; i < 64 * 4096; i += NGT) {
        const int bh = i >> 12, c4 = i & 4095; const float cd = fast_exp2(ret_lg2gamma(bh & 7) * 128.0f);
        const float* kv = (const float*)(F.ws + WS_KVST) + (size_t)(bh * 16) * 16384 + c4 * 4;
        bf16_t* pv = (bf16_t*)(F.dout + DO_PREVT) + (size_t)(bh * 16) * 16384 + c4 * 4;
        f32x4 v[16];
#pragma unroll
        for (int n = 0; n < 15; ++n) v[n] = *(const GAS f32x4*)(kv + (size_t)n * 16384);
        f32x4 st = {0.f, 0.f, 0.f, 0.f};
#pragma unroll
        for (int n = 0; n < 16; ++n) { u32x2 w; w.x = pk2(st.x, st.y); w.y = pk2(st.z, st.w); *(GAS u32x2*)(pv + (size_t)n * 16384) = w; if (n < 15) st = st * cd + v[n]; }
    }
}
DI void ph3_mixers_b(const Frame& F) {
    const int vb = (F.G % 8 == 0) ? (F.bid % 8) * (F.G / 8) + F.bid / 8 : F.bid;
    for (int it = vb; it < 1024; it += F.G) ret_out_item(F, it >> 4, it & 15);
    bf16_t* DQ = (bf16_t*)(F.ws + WS_DQ); const float* LSE = (const float*)(F.ws + WS_LSE);
    const int gt = F.bid * NTHREADS + F.tid, NGT = F.G * NTHREADS;
    for (int i = gt; i < MT * 64; i += NGT) {
        const int t = i >> 6, hg = (i >> 4) & 3, ch = i & 15;
        const float l0 = LSE[(size_t)hg * MT + t], l1 = LSE[(size_t)(4 + hg) * MT + t], l2 = LSE[(size_t)(8 + hg) * MT + t];
        const float mx = fmaxf(l0, fmaxf(l1, l2)); float w0 = fast_exp2(l0 - mx), w1 = fast_exp2(l1 - mx), w2 = fast_exp2(l2 - mx);
        const float inv = 1.0f / (w0 + w1 + w2); w0 *= inv; w1 *= inv; w2 *= inv;
        bf16_t* p = DQ + (size_t)t * 1536 + hg * 128 + ch * 8;
        const u32x4 a = *(const GAS u32x4*)p, bq = *(const GAS u32x4*)(p + 512), cq = *(const GAS u32x4*)(p + 1024);
        u32x4 o;
        o.x = pk2(w0 * bf_lo(a.x) + w1 * bf_lo(bq.x) + w2 * bf_lo(cq.x), w0 * bf_hi(a.x) + w1 * bf_hi(bq.x) + w2 * bf_hi(cq.x));
        o.y = pk2(w0 * bf_lo(a.y) + w1 * bf_lo(bq.y) + w2 * bf_lo(cq.y), w0 * bf_hi(a.y) + w1 * bf_hi(bq.y) + w2 * bf_hi(cq.y));
        o.z = pk2(w0 * bf_lo(a.z) + w1 * bf_lo(bq.z) + w2 * bf_lo(cq.z), w0 * bf_hi(a.z) + w1 * bf_hi(bq.z) + w2 * bf_hi(cq.z));
        o.w = pk2(w0 * bf_lo(a.w) + w1 * bf_lo(bq.w) + w2 * bf_lo(cq.w), w0 * bf_hi(a.w) + w1 * bf_hi(bq.w) + w2 * bf_hi(cq.w));
        *(GAS u32x4*)p = o;
    }
}

struct UnitG { const char* A; const char* B; int pm, pn; };
struct SchedG {
    typedef UnitG Unit;
    int G, c, nM, nN; const char* Abase; const char* Bbase; size_t astep, bstep;
    DI bool next(int i, Unit& u) const {
        const int L = i * G + c; if (L >= nM * nN) return false;
        int pm, pn; pg8::tile_of<WGM_MID>(L, nM, nN, pm, pn); u.pm = pm; u.pn = pn;
        u.A = Abase + (size_t)pm * astep; u.B = Bbase + (size_t)pn * bstep; return true;
    }
};
#define EPI_ROWS_BEGIN const int rowl0 = wr * 64 + fr, colb = wc * 32 + 8 * fq; _Pragma("unroll") for (int ai = 0; ai < 2; ++ai) _Pragma("unroll") for (int m = 0; m < 4; ++m) { const int rl = ai * 128 + m * 16 + rowl0;
#define EPI_ROWS_END }
DI u32x4 pack8(const f32x4 v0, const f32x4 v1) { u32x4 w; w.x = pk2(v0.x, v0.y); w.y = pk2(v0.z, v0.w); w.z = pk2(v1.x, v1.y); w.w = pk2(v1.z, v1.w); return w; }
DI void unpack8(const u32x4 w, f32x4& v0, f32x4& v1) { v0 = (f32x4){bf_lo(w.x), bf_hi(w.x), bf_lo(w.y), bf_hi(w.y)}; v1 = (f32x4){bf_lo(w.z), bf_hi(w.z), bf_lo(w.w), bf_hi(w.w)}; }

template <int PASS> struct EpiMerge {
    bf16_t* GR; bf16_t* GD;
    DI void operator()(const f32x4 (&acc)[2][2][4][2], const UnitG& u, int wr, int wc, int fr, int fq, int wid, int lane) const {
        const int rowl0 = wr * 64 + fr, colb = wc * 32 + 8 * fq;
        const size_t base = (size_t)(u.pm * 256 + rowl0) * 2048 + u.pn * 256 + colb;
#pragma unroll
        for (int ai = 0; ai < 2; ++ai) {
            u32x4 gr[4][2], gd[4][2];
#pragma unroll
            for (int m = 0; m < 4; ++m)
#pragma unroll
                for (int bj = 0; bj < 2; ++bj) { const size_t off = base + (size_t)(ai * 128 + m * 16) * 2048 + bj * 128;
                    gr[m][bj] = *(const GAS u32x4*)(GR + off); if (PASS == 1) gd[m][bj] = *(const GAS u32x4*)(GD + off); }
#pragma unroll
            for (int m = 0; m < 4; ++m)
#pragma unroll
                for (int bj = 0; bj < 2; ++bj) { const size_t off = base + (size_t)(ai * 128 + m * 16) * 2048 + bj * 128;
                    f32x4 g0, g1; unpack8(gr[m][bj], g0, g1);
                    if (PASS == 0) *(GAS u32x4*)(GR + off) = pack8(g0 * acc[ai][bj][m][0], g1 * acc[ai][bj][m][1]);
                    else { f32x4 d0, d1; unpack8(gd[m][bj], d0, d1); *(GAS u32x4*)(GD + off) = pack8(g0 + d0 * acc[ai][bj][m][0], g1 + d1 * acc[ai][bj][m][1]); } }
        }
    }
};
template <bool F32IN> struct EpiResid {
    const float* xf; bf16_t* XB; float* SSQ;
    DI void operator()(const f32x4 (&acc)[2][2][4][2], const UnitG& u, int wr, int wc, int fr, int fq, int wid, int lane) const {
        const int rowl0 = wr * 64 + fr, colb = wc * 32 + 8 * fq;
        const size_t trow = (size_t)(u.pm * 256 + rowl0); const size_t base = trow * 2048 + u.pn * 256 + colb;
#pragma unroll
        for (int ai = 0; ai < 2; ++ai) {
            f32x4 xo[4][2][2];
#pragma unroll
            for (int m = 0; m < 4; ++m)
#pragma unroll
                for (int bj = 0; bj < 2; ++bj) { const size_t off = base + (size_t)(ai * 128 + m * 16) * 2048 + bj * 128;
                    if (F32IN) { xo[m][bj][0] = *(const GAS f32x4*)(xf + off); xo[m][bj][1] = *(const GAS f32x4*)(xf + off + 4); }
                    else unpack8(*(const GAS u32x4*)(XB + off), xo[m][bj][0], xo[m][bj][1]); }
#pragma unroll
            for (int m = 0; m < 4; ++m) { float ss = 0.f;
#pragma unroll
                for (int bj = 0; bj < 2; ++bj) { const size_t off = base + (size_t)(ai * 128 + m * 16) * 2048 + bj * 128;
                    const f32x4 y0 = xo[m][bj][0] + acc[ai][bj][m][0], y1 = xo[m][bj][1] + acc[ai][bj][m][1];
                    *(GAS u32x4*)(XB + off) = pack8(y0, y1);
                    ss += (y0.x * y0.x + y0.y * y0.y) + (y0.z * y0.z + y0.w * y0.w) + (y1.x * y1.x + y1.y * y1.y) + (y1.z * y1.z + y1.w * y1.w); }
                ss += __shfl_xor(ss, 16); ss += __shfl_xor(ss, 32);
                if (fq == 0) SSQ[(trow + ai * 128 + m * 16) * 32 + u.pn * 4 + wc] = ss; }
        }
    }
};
struct EpiRowScale {
    const float* SSQ; bf16_t* out; float scale;
    DI void operator()(const f32x4 (&acc)[2][2][4][2], const UnitG& u, int wr, int wc, int fr, int fq, int wid, int lane) const {
        const int rowl0 = wr * 64 + fr, colb = wc * 32 + 8 * fq;
        const size_t trow = (size_t)(u.pm * 256 + rowl0);
        f32x4 p[2][4][2];
#pragma unroll
        for (int ai = 0; ai < 2; ++ai)
#pragma unroll
            for (int m = 0; m < 4; ++m) { const float* sp = SSQ + (trow + ai * 128 + m * 16) * 32 + fq * 8; p[ai][m][0] = *(const GAS f32x4*)sp; p[ai][m][1] = *(const GAS f32x4*)(sp + 4); }
#pragma unroll
        for (int ai = 0; ai < 2; ++ai)
#pragma unroll
            for (int m = 0; m < 4; ++m) {
                const f32x4 p0 = p[ai][m][0], p1 = p[ai][m][1];
                float ss = (p0.x + p0.y) + (p0.z + p0.w) + (p1.x + p1.y) + (p1.z + p1.w);
                ss += __shfl_xor(ss, 16); ss += __shfl_xor(ss, 32);
                const float sc = scale / sqrtf(ss * (1.0f / 2048.0f) + EPS);
                bf16_t* rowp = out + (trow + ai * 128 + m * 16) * 2048 + u.pn * 256 + colb;
#pragma unroll
                for (int bj = 0; bj < 2; ++bj) *(GAS u32x4*)(rowp + bj * 128) = pack8(acc[ai][bj][m][0] * sc, acc[ai][bj][m][1] * sc);
            }
    }
};
struct EpiNull {
    DI void operator()(const f32x4 (&acc)[2][2][4][2], const UnitG& u, int wr, int wc, int fr, int fq, int wid, int lane) const {
#pragma unroll
        for (int ai = 0; ai < 2; ++ai)
#pragma unroll
            for (int bj = 0; bj < 2; ++bj)
#pragma unroll
                for (int m = 0; m < 4; ++m) { asm volatile("" :: "v"(acc[ai][bj][m][0]), "v"(acc[ai][bj][m][1])); }
    }
};
struct Sched7 {
    typedef UnitG Unit; int G, c; const char* QM; const char* KM;
    DI bool next(int i, Unit& u) const {
        const int L0 = i * G + c; if (L0 >= 256) return false;
        const int L = (L0 & 7) * 32 + (L0 >> 3);
        const int bh = L >> 3, pm = L & 7, b = bh >> 2, hd = bh & 3; u.pm = L; u.pn = 0;
        u.A = QM + ((size_t)(b * SEQ + pm * 256) * 2048 + hd * 512) * 2; u.B = KM + ((size_t)(b * MEMT) * 2048 + hd * 512) * 2; return true;
    }
};
struct EpiSoftmax {
    bf16_t* P; LAS float* X;
    DI void operator()(f32x4 (&acc)[2][2][4][2], const UnitG& u, int wr, int wc, int fr, int fq, int wid, int lane) const {
        LAS float* MX = X; LAS float* SM = X + 1024;
        EPI_ROWS_BEGIN
            float mx = -INFINITY;
#pragma unroll
            for (int bj = 0; bj < 2; ++bj)
#pragma unroll
                for (int n = 0; n < 2; ++n) { const f32x4 v = acc[ai][bj][m][n]; mx = fmaxf(mx, fmaxf(fmaxf(v.x, v.y), fmaxf(v.z, v.w))); }
            mx = fmaxf(mx, __shfl_xor(mx, 16)); mx = fmaxf(mx, __shfl_xor(mx, 32));
            if (fq == 0) MX[rl * 4 + wc] = mx;
        EPI_ROWS_END
        asm volatile("s_waitcnt lgkmcnt(0)" ::: "memory"); __builtin_amdgcn_s_barrier(); asm volatile("" ::: "memory");
        {
        EPI_ROWS_BEGIN
            const f32x4 q = *(LAS f32x4*)(MX + rl * 4); const float mx = fmaxf(fmaxf(q.x, q.y), fmaxf(q.z, q.w));
            float s = 0.f;
#pragma unroll
            for (int bj = 0; bj < 2; ++bj)
#pragma unroll
                for (int n = 0; n < 2; ++n) { f32x4 v = acc[ai][bj][m][n]; v.x = fast_exp2(v.x - mx); v.y = fast_exp2(v.y - mx); v.z = fast_exp2(v.z - mx); v.w = fast_exp2(v.w - mx);
                    acc[ai][bj][m][n] = v; s += (v.x + v.y) + (v.z + v.w); }
            s += __shfl_xor(s, 16); s += __shfl_xor(s, 32);
            if (fq == 0) SM[rl * 4 + wc] = s;
        EPI_ROWS_END
        }
        asm volatile("s_waitcnt lgkmcnt(0)" ::: "memory"); __builtin_amdgcn_s_barrier(); asm volatile("" ::: "memory");
        {
        EPI_ROWS_BEGIN
            const f32x4 q = *(LAS f32x4*)(SM + rl * 4); const float inv = 1.0f / ((q.x + q.y) + (q.z + q.w));
            bf16_t* rowp = P + (size_t)(u.pm * 256 + rl) * 256 + colb;
#pragma unroll
            for (int bj = 0; bj < 2; ++bj) *(GAS u32x4*)(rowp + bj * 128) = pack8(acc[ai][bj][m][0] * inv, acc[ai][bj][m][1] * inv);
        EPI_ROWS_END
        }
        asm volatile("s_waitcnt lgkmcnt(0)" ::: "memory"); __builtin_amdgcn_s_barrier(); asm volatile("" ::: "memory");
    }
};
struct Sched8 {
    typedef UnitG Unit; int G, c; const char* P; const char* VT;
    DI bool next(int i, Unit& u) const {
        const int L0 = i * G + c; if (L0 >= 512) return false;
        const int L = (L0 & 7) * 64 + (L0 >> 3);
        const int pn = L & 1, l2 = L >> 1, bh = l2 >> 3, pm = l2 & 7, b = bh >> 2, hd = bh & 3;
        u.pm = b * 8 + pm; u.pn = hd * 2 + pn;
        u.A = P + (size_t)(l2 * 256) * 256 * 2; u.B = VT + ((size_t)(hd * 512 + pn * 256) * 2048 + b * MEMT) * 2; return true;
    }
};
struct EpiPlain {
    bf16_t* out; int ldo;
    DI void operator()(const f32x4 (&acc)[2][2][4][2], const UnitG& u, int wr, int wc, int fr, int fq, int wid, int lane) const {
        EPI_ROWS_BEGIN
            bf16_t* rowp = out + (size_t)(u.pm * 256 + rl) * ldo + u.pn * 256 + colb;
#pragma unroll
            for (int bj = 0; bj < 2; ++bj) *(GAS u32x4*)(rowp + bj * 128) = pack8(acc[ai][bj][m][0], acc[ai][bj][m][1]);
        EPI_ROWS_END
    }
};

constexpr float PEER_US = 128.0f, PEER_VS = 16.0f;
DI unsigned sortable(float v) { const unsigned b = __builtin_bit_cast(unsigned, v); return (b & 0x80000000u) ? ~b : (b | 0x80000000u); }
DI float unsortable(unsigned s) { const unsigned b = (s & 0x80000000u) ? (s & 0x7fffffffu) : ~s; return __builtin_bit_cast(float, b); }
#define PEER_CANDS(X) \
    X(0,0) X(0,1) X(0,2) X(0,3) X(0,4) X(0,5) X(0,6) X(0,7) X(0,8) X(0,9) X(0,10) X(0,11) X(0,12) X(0,13) X(0,14) X(0,15) \
    X(1,0) X(1,1) X(1,2) X(1,3) X(1,4) X(1,5) X(1,6) X(1,7) X(2,0) X(2,1) X(2,2) X(2,3) X(2,4) X(3,0) X(3,1) X(3,2) X(3,3) \
    X(4,0) X(4,1) X(4,2) X(5,0) X(5,1) X(6,0) X(6,1) X(7,0) X(7,1) X(8,0) X(9,0) X(10,0) X(11,0) X(12,0) X(13,0) X(14,0) X(15,0)
#define X(a, b) (unsigned char)((a) * 16 + (b)),
static __device__ const unsigned char peer_ab[50] = { PEER_CANDS(X) };
#undef X
DI void cmpex_desc(unsigned& a, unsigned& b) { const unsigned mx = a > b ? a : b, mn = a > b ? b : a; a = mx; b = mn; }
template <int BASE> DI void sort16_desc(unsigned (&k)[64]) {
#pragma unroll
    for (int size = 2; size <= 16; size <<= 1)
#pragma unroll
        for (int stride = size >> 1; stride > 0; stride >>= 1)
#pragma unroll
            for (int i = 0; i < 16; ++i) { const int l = i ^ stride;
                if (l > i) { if ((i & size) == 0) cmpex_desc(k[BASE + i], k[BASE + l]); else cmpex_desc(k[BASE + l], k[BASE + i]); } }
}
template <int A, int B> DI void merge_top16(unsigned (&k)[64]) {
#pragma unroll
    for (int i = 0; i < 16; ++i) k[A + i] = (k[A + i] > k[B + 15 - i]) ? k[A + i] : k[B + 15 - i];
#pragma unroll
    for (int stride = 8; stride > 0; stride >>= 1)
#pragma unroll
        for (int i = 0; i < 16; ++i) { const int l = i ^ stride; if (l > i) cmpex_desc(k[A + i], k[A + l]); }
}
DI void top16_of_64(unsigned (&k)[64]) {
    sort16_desc<0>(k); sort16_desc<16>(k); sort16_desc<32>(k); sort16_desc<48>(k);
    merge_top16<0, 16>(k); merge_top16<32, 48>(k); merge_top16<0, 32>(k);
}
DI void route_pass(const Frame& F, int tg, int h, LAS unsigned* topL  ) {
    const int lane = F.lane, rr = lane & 31, hh = lane >> 5; const size_t tok = (size_t)tg * 32 + rr;
    const bf16_t* PQ = (const bf16_t*)(F.ws + WS_PQ); const bf16_t* SUBK = (const bf16_t*)(F.ws + WS_SUBK);
#pragma unroll 1
    for (int p = 0; p < 2; ++p) {
        bf16x8 qf[8];
        { const bf16_t* qp = PQ + tok * 2048 + (2 * h + p) * 128 + 8 * hh;
#pragma unroll
          for (int s = 0; s < 8; ++s) qf[s] = *(const GAS bf16x8*)(qp + 16 * s); }
        unsigned key[64];
#pragma unroll
        for (int nb = 0; nb < 4; ++nb) {
            const bf16_t* kp = SUBK + ((size_t)((2 * h + p) * 128 + 32 * nb + rr)) * 128 + 8 * hh;
            f32x16 acc = zero16();
#pragma unroll
            for (int s = 0; s < 8; ++s) acc = MFMA32(*(const GAS bf16x8*)(kp + 16 * s), qf[s], acc);
#pragma unroll
            for (int reg = 0; reg < 16; ++reg) { const int n = 32 * nb + crow(reg, hh); key[nb * 16 + reg] = (sortable(acc[reg]) & ~0x7fu) | (unsigned)(127 - n); }
        }
        top16_of_64(key);
        unsigned oth[16];
#pragma unroll
        for (int i = 0; i < 16; ++i) oth[i] = __shfl_xor(key[i], 32);
#pragma unroll
        for (int i = 0; i < 16; ++i) key[i] = (key[i] > oth[15 - i]) ? key[i] : oth[15 - i];
#pragma unroll
        for (int stride = 8; stride > 0; stride >>= 1)
#pragma unroll
            for (int i = 0; i < 16; ++i) { const int l = i ^ stride; if (l > i) cmpex_desc(key[i], key[l]); }
#pragma unroll
        for (int i = 0; i < 16; ++i) topL[(p * 16 + i) * 64 + lane] = key[i];
    }
    LDS_WAIT();
    unsigned ck[64];
    { float v1[16], v2[16];
#pragma unroll
      for (int k = 0; k < 16; ++k) { v1[k] = unsortable(topL[k * 64 + lane] & ~0x7fu); v2[k] = unsortable(topL[(16 + k) * 64 + lane] & ~0x7fu); }
      int k = 0;
#define X(a, b) ck[k] = (sortable(v1[a] + v2[b]) & ~0x3fu) | (unsigned)(63 - k); ++k;
      PEER_CANDS(X)
#undef X
#pragma unroll
      for (int i = 50; i < 64; ++i) ck[i] = 0u;
    }
    top16_of_64(ck);
    LDS_WAIT();
    float cv[16]; unsigned ce[16];
#pragma unroll
    for (int k = 0; k < 16; ++k) {
        const unsigned m = ck[k]; cv[k] = unsortable(m & ~0x3fu);
        const unsigned ab = peer_ab[63u - (m & 63u)];
        const unsigned i1 = 127u - (topL[(ab >> 4) * 64 + lane] & 0x7fu), i2 = 127u - (topL[(16 + (ab & 15u)) * 64 + lane] & 0x7fu);
        ce[k] = i1 * 128u + i2;
    }
    const float cmax = cv[0]; float gs = 0.f;
#pragma unroll
    for (int k = 0; k < 16; ++k) { cv[k] = fast_exp2((cv[k] - cmax) * 1.4426950408889634f); gs += cv[k]; }
    const float ginv = 1.0f / gs;
    if (hh == 0) {
        unsigned* ep = (unsigned*)(F.ws + WS_EIDX) + tok * 128 + h * 16; float* gp = (float*)(F.ws + WS_GATE) + tok * 128 + h * 16;
#pragma unroll
        for (int k = 0; k < 16; k += 4) { *(GAS u32x4*)(ep + k) = (u32x4){ce[k], ce[k + 1], ce[k + 2], ce[k + 3]}; *(GAS f32x4*)(gp + k) = (f32x4){cv[k] * ginv, cv[k + 1] * ginv, cv[k + 2] * ginv, cv[k + 3] * ginv}; }
    }
    LDS_WAIT();
}
DI void ph11_route(const Frame& F, const Args& a) {
    const int gw = F.bid * NWAVES + F.wave, NGW = F.G * NWAVES;
    LAS unsigned* topL = (LAS unsigned*)(F.lds + F.wave * 8192);
    for (int it = gw; it < 512 * 8; it += NGW) route_pass(F, it >> 3, it & 7, topL);
    ISTAMP(F, 41);
    const int gt = F.bid * NTHREADS + F.tid, NGT = F.G * NTHREADS;
    const GAS f32x4* gf = (const GAS f32x4*)a.in[I_GFFN];
    for (int i = gt; i < 16384 * 128; i += NGT) {
        const int e = i >> 7, c = i & 127, sl = c >> 3, j = c & 7;
        const GAS f32x4* su = (const GAS f32x4*)a.in[I_PU] + 4 * (size_t)i; const GAS f32x4* sv = (const GAS f32x4*)a.in[I_PV] + 4 * (size_t)i;
        u32x4 ou, ov;
#pragma unroll
        for (int q = 0; q < 4; ++q) { const f32x4 g = gf[4 * c + q]; const f32x4 u = su[q] * g * PEER_US; const f32x4 v = sv[q] * PEER_VS;
            int pu = __builtin_amdgcn_cvt_pk_fp8_f32(u.x, u.y, 0, false); pu = __builtin_amdgcn_cvt_pk_fp8_f32(u.z, u.w, pu, true);
            int pv = __builtin_amdgcn_cvt_pk_fp8_f32(v.x, v.y, 0, false); pv = __builtin_amdgcn_cvt_pk_fp8_f32(v.z, v.w, pv, true);
            ou[q] = (unsigned)pu; ov[q] = (unsigned)pv; }
        const size_t dst = ((size_t)(sl * 16384 + e) * 128 + 16 * j);
        *(GAS u32x4*)(F.ws + WS_UTAB + dst) = ou; *(GAS u32x4*)(F.ws + WS_VTAB + dst) = ov;
    }
}

DI float gelu_erf(float v) {
    const float av = fabsf(v), t = fast_rcp(av * 0.2316418882f + 1.0f);
    float q = t * 0.5307027145f + (-0.7265760135f); q = q * t + 0.7107068705f; q = q * t + (-0.142248368f); q = q * t + 0.127414796f; q = q * t;
    const float e = fast_exp2((v * v) * (-0.72134752044f)); const float m = v * (q * e);
    return v < 0.f ? m : v - m;
}
template <int CTRL> DI float dpp_f(float v) { return __builtin_bit_cast(float, __builtin_amdgcn_update_dpp(0, __builtin_bit_cast(int, v), CTRL, 0xf, 0xf, false)); }
DI float sum8(float d) { d += dpp_f<0xB1>(d); d += dpp_f<0x4E>(d); d += dpp_f<0x141>(d); return d; }
struct PeerBatch { u32x4 r[8]; };
struct PeerOffs { unsigned o[8]; };
DI void peer_offs(PeerOffs& O, LAS const int* el  , unsigned loff  ) {
#pragma unroll
    for (int ii = 0; ii < 8; ++ii) O.o[ii] = (unsigned)el[8 * ii] + loff;
}
DI void peer_issue(PeerBatch& B, const unsigned char* tb  , const PeerOffs& O) {
#pragma unroll
    for (int ii = 0; ii < 8; ++ii) B.r[ii] = *(const GAS u32x4*)(tb + O.o[ii]);
}

template <int VAR> DI void peer_u_pass(const Frame& F, LAS float* PD, LAS const int* elw, const unsigned char* U8, const bf16_t* XB, size_t tok0, int tl0) {
    const int lane = F.lane, g = lane >> 3, j = lane & 7;
        {
            const unsigned char* ub0 = U8; const unsigned loff = 16u * (unsigned)j; const bf16_t* xb0 = XB + tok0 * 2048 + 16 * j;
            PeerBatch Ba, Bb;
            LAS unsigned char* XS = F.lds + 81920 + F.wave * 4096;
            const bf16_t* xq_src = XB + (tok0 + (lane >> 3)) * 2048 + 16 * (lane & 7);
            u32x4 xq0 = *(const GAS u32x4*)xq_src, xq1 = *(const GAS u32x4*)(xq_src + 8);
#define U_COMPUTE(B, b) do { \
                const u32x4 xc0 = *(LAS const u32x4*)(xs_), xc1 = *(LAS const u32x4*)(xs_ + 16); \
                const unsigned xw_[8] = {xc0.x, xc0.y, xc0.z, xc0.w, xc1.x, xc1.y, xc1.z, xc1.w};        \
                float d_[8]; \
                _Pragma("unroll") for (int ii = 0; ii < 8; ++ii) d_[ii] = 0.f; \
                _Pragma("unroll") for (int q = 0; q < 4; ++q) { \
                    _Pragma("unroll") for (int ii = 0; ii < 8; ++ii) d_[ii] = __builtin_amdgcn_fdot2_f32_bf16(__builtin_amdgcn_cvt_scalef32_pk_bf16_fp8((int)(B).r[ii][q], 1.0f, false), __builtin_bit_cast(bf16x2_t, xw_[2 * q]), d_[ii], false); \
                    _Pragma("unroll") for (int ii = 0; ii < 8; ++ii) d_[ii] = __builtin_amdgcn_fdot2_f32_bf16(__builtin_amdgcn_cvt_scalef32_pk_bf16_fp8((int)(B).r[ii][q], 1.0f, true), __builtin_bit_cast(bf16x2_t, xw_[2 * q + 1]), d_[ii], false); } \
                  \
                float e_[4]; _Pragma("unroll") for (int m = 0; m < 4; ++m) { const float snd = bit0 ? d_[m] : d_[4 + m]; e_[m] = (bit0 ? d_[4 + m] : d_[m]) + dpp_f<0xB1>(snd); } \
                float f_[2]; _Pragma("unroll") for (int m = 0; m < 2; ++m) { const float snd = bit1 ? e_[m] : e_[2 + m]; f_[m] = (bit1 ? e_[2 + m] : e_[m]) + dpp_f<0x4E>(snd); } \
                const float snd_ = bit2 ? f_[0] : f_[1]; const float mine_ = (bit2 ? f_[1] : f_[0]) + __shfl_xor(snd_, 4); \
                if (VAR == 2) { asm volatile("" :: "v"(mine_)); } else PD[tl0 * 128 + 64 * (b) + 8 * jrev + g] += mine_; } while (0)
            const bool bit0 = (lane & 1) != 0, bit1 = (lane & 2) != 0, bit2 = (lane & 4) != 0; const int jrev = ((lane & 1) << 2) | (lane & 2) | ((lane >> 2) & 1);
            PeerBatch Bc, Bd;
            PeerOffs PO;
#define U_OFFS(fb) do { const int fb_ = ((fb) < 255) ? (fb) : 255; peer_offs(PO, elw + 64 * (fb_ & 15), loff); } while (0)
#define U_ISSUE(B, fb) do { const int fb_ = ((fb) < 255) ? (fb) : 255; peer_issue(B, ub0 + (size_t)(fb_ >> 4) * (16384 * 128), PO); U_OFFS((fb) + 1); } while (0)
#define U_STEP(B, fb, Bn, fbn) do { \
                U_ISSUE(Bn, fbn); \
                __builtin_amdgcn_sched_barrier(0); \
                LAS const unsigned char* xs_ = XS + (((fb) >> 4) & 1) * 2048 + ((((fb) >> 1) & 7) * 8 + j) * 32; \
                if (VAR == 3) { _Pragma("unroll") for (int ii = 0; ii < 8; ++ii) asm volatile("" :: "v"((B).r[ii])); } else U_COMPUTE(B, (fb) & 15); \
                __builtin_amdgcn_sched_barrier(0); } while (0)
            U_OFFS(0); U_ISSUE(Ba, 0); U_ISSUE(Bb, 1); U_ISSUE(Bc, 2);
#pragma unroll 1
            for (int fb = 0; fb < 256; fb += 4) {
                if ((fb & 15) == 0) { const int sl = fb >> 4;
                    *(LAS u32x4*)(XS + (sl & 1) * 2048 + lane * 32) = xq0; *(LAS u32x4*)(XS + (sl & 1) * 2048 + lane * 32 + 16) = xq1;
                    if (VAR != 1 && VAR != 3) { const bf16_t* xp = xq_src + 128 * ((sl < 15) ? sl + 1 : 15); xq0 = *(const GAS u32x4*)xp; xq1 = *(const GAS u32x4*)(xp + 8); }
                }
                U_STEP(Ba, fb, Bd, fb + 3);
                U_STEP(Bb, fb + 1, Ba, fb + 4);
                U_STEP(Bc, fb + 2, Bb, fb + 5);
                U_STEP(Bd, fb + 3, Bc, fb + 6);
            }
#undef U_STEP
#undef U_ISSUE
#undef U_OFFS
#undef U_COMPUTE
        }
}
DI void ph12_peer(const Frame& F, const Args& a) {
    LAS int* EL = (LAS int*)F.lds;
    LAS float* PD = (LAS float*)(F.lds + 32768);
    LAS float* SSL = (LAS float*)(F.lds + 65536);
    LAS unsigned* WB = (LAS unsigned*)(F.lds + 114688);
    const int lane = F.lane, g = lane >> 3, j = lane & 7;
    const bf16_t* XB = (const bf16_t*)(F.ws + WS_XB);
    const unsigned char* U8 = F.ws + WS_UTAB; const unsigned char* V8 = F.ws + WS_VTAB;
    for (int blk = F.bid; blk < MT / 64; blk += F.G) {
        const int tl0 = 8 * F.wave; const size_t tok0 = (size_t)blk * 64 + tl0;
        { int e0[8], e1[8];
#pragma unroll
          for (int tk = 0; tk < 8; ++tk) { const int* ep = (const int*)(F.ws + WS_EIDX) + (tok0 + tk) * 128; e0[tk] = ep[lane]; e1[tk] = ep[64 + lane]; }
#pragma unroll
          for (int tk = 0; tk < 8; ++tk) {
            EL[(tl0 + tk) * 128 + lane] = e0[tk] * 128; EL[(tl0 + tk) * 128 + 64 + lane] = e1[tk] * 128;
            PD[(tl0 + tk) * 128 + lane] = 0.f; PD[(tl0 + tk) * 128 + 64 + lane] = 0.f; SSL[(tl0 + tk) * 64 + lane] = 0.f; } }
        LDS_WAIT();
        LAS const int* elw = EL + tl0 * 128 + g;
        peer_u_pass<0>(F, PD, elw, U8, XB, tok0, tl0);
#if PROBE_PHASE >= 30 && PROBE_PHASE <= 33
        LDS_WAIT(); __syncthreads(); ISTAMP(F, 29);
        peer_u_pass<PROBE_PHASE - 30>(F, (LAS float*)(F.lds + 131072), elw, U8, XB, tok0, tl0);
        LDS_WAIT(); __syncthreads(); ISTAMP(F, PROBE_PHASE);
#endif
        LDS_WAIT(); ISTAMP(F, 20);
#pragma unroll 1
        for (int tk = 0; tk < 8; ++tk) {
            const size_t tok = tok0 + tk;
            const float ssq = wave_sum((lane < 32) ? ((const float*)(F.ws + WS_SSQ2))[tok * 32 + lane] : 0.f);
            const float sc = (1.0f / PEER_US) / sqrtf(ssq * (1.0f / 2048.0f) + EPS);
            const float* gp = (const float*)(F.ws + WS_GATE) + tok * 128;
            LAS float* pd = PD + (tl0 + tk) * 128;
            const float w0 = gp[lane] * gelu_erf(pd[lane] * sc), w1 = gp[64 + lane] * gelu_erf(pd[64 + lane] * sc);
            pd[lane] = w0 * (1.0f / PEER_VS); pd[64 + lane] = w1 * (1.0f / PEER_VS);
            LDS_WAIT();
            { const int k1 = 16 * (lane >> 3) + (lane & 7); WB[(tl0 + tk) * 64 + lane] = pk2(pd[k1], pd[k1 + 8]); }
        }
        LDS_WAIT(); ISTAMP(F, 21);
        LAS const unsigned* pww = WB + tl0 * 64 + g;
        {
            const unsigned char* vb0 = V8; const unsigned loff = 16u * (unsigned)j;
            PeerBatch Ba, Bb;
            float y[16];
#define V_COMPUTE(B, b) do { \
                LAS const unsigned* pw_ = pww + 32 * (b); \
                _Pragma("unroll") for (int mm = 0; mm < 4; ++mm) { const bf16x2_t w2_ = __builtin_bit_cast(bf16x2_t, pw_[8 * mm]); \
                    _Pragma("unroll") for (int q = 0; q < 4; ++q) { \
                        const unsigned pa_ = __builtin_amdgcn_perm((B).r[2 * mm + 1][q], (B).r[2 * mm][q], 0x05010400u), pb_ = __builtin_amdgcn_perm((B).r[2 * mm + 1][q], (B).r[2 * mm][q], 0x07030602u); \
                        y[4 * q + 0] = __builtin_amdgcn_fdot2_f32_bf16(__builtin_amdgcn_cvt_scalef32_pk_bf16_fp8((int)pa_, 1.0f, false), w2_, y[4 * q + 0], false); \
                        y[4 * q + 1] = __builtin_amdgcn_fdot2_f32_bf16(__builtin_amdgcn_cvt_scalef32_pk_bf16_fp8((int)pa_, 1.0f, true), w2_, y[4 * q + 1], false); \
                        y[4 * q + 2] = __builtin_amdgcn_fdot2_f32_bf16(__builtin_amdgcn_cvt_scalef32_pk_bf16_fp8((int)pb_, 1.0f, false), w2_, y[4 * q + 2], false); \
                        y[4 * q + 3] = __builtin_amdgcn_fdot2_f32_bf16(__builtin_amdgcn_cvt_scalef32_pk_bf16_fp8((int)pb_, 1.0f, true), w2_, y[4 * q + 3], false); } } } while (0)
            PeerBatch Bc, Bd;
            PeerOffs PO;
#define V_OFFS(fb) do { const int fb_ = ((fb) < 255) ? (fb) : 255; peer_offs(PO, elw + 64 * (fb_ & 15), loff); } while (0)
#define V_ISSUE(B, fb) do { const int fb_ = ((fb) < 255) ? (fb) : 255; peer_issue(B, vb0 + (size_t)(fb_ >> 4) * (16384 * 128), PO); V_OFFS((fb) + 1); } while (0)
#define V_STEP(B, fb, Bn, fbn) do { \
                V_ISSUE(Bn, fbn); \
                __builtin_amdgcn_sched_barrier(0); \
                V_COMPUTE(B, (fb) & 15); \
                __builtin_amdgcn_sched_barrier(0); } while (0)
#define V_FINISH(fb, xw) do { const int tk = ((fb) >> 1) & 7, sl = (fb) >> 4; \
                float z[8]; \
                _Pragma("unroll") for (int q = 0; q < 8; ++q) {            \
                    float a0 = y[q], b0 = y[8 + q]; \
                    asm volatile("v_nop\n\tv_nop\n\tv_permlane32_swap_b32 %0, %1" : "+v"(a0), "+v"(b0)); \
                    z[q] = a0 + b0; } \
                float qq[4]; \
                { const bool up = (lane & 16) != 0; \
                  _Pragma("unroll") for (int q = 0; q < 4; ++q) { const float snd = up ? z[q] : z[4 + q]; qq[q] = (up ? z[4 + q] : z[q]) + __shfl_xor(snd, 16); } } \
                f32x2 p; \
                { const bool up = (lane & 8) != 0; \
                  const float s0 = up ? qq[0] : qq[2], s1 = up ? qq[1] : qq[3]; p.x = (up ? qq[2] : qq[0]) + dpp_f<0x128>(s0); p.y = (up ? qq[3] : qq[1]) + dpp_f<0x128>(s1); } \
                const size_t eo = (tok0 + tk) * 2048 + 128 * sl + 16 * j + 2 * g; \
                const f32x2 x3 = (f32x2){bf_lo(xw), bf_hi(xw)} + p; \
                *(GAS f32x2*)(a.out + eo) = x3; \
                SSL[(tl0 + tk) * 64 + lane] += x3.x * x3.x + x3.y * x3.y; \
                _Pragma("unroll") for (int q = 0; q < 16; ++q) y[q] = 0.f; } while (0)
            V_OFFS(0); V_ISSUE(Ba, 0); V_ISSUE(Bb, 1); V_ISSUE(Bc, 2);
#pragma unroll
            for (int q = 0; q < 16; ++q) y[q] = 0.f;
#pragma unroll 1
            for (int fb = 0; fb < 256; fb += 4) {
                const unsigned xwA = *(const GAS unsigned*)(XB + (tok0 + ((fb >> 1) & 7)) * 2048 + 128 * (fb >> 4) + 16 * j + 2 * g);
                const unsigned xwB = *(const GAS unsigned*)(XB + (tok0 + (((fb + 2) >> 1) & 7)) * 2048 + 128 * (fb >> 4) + 16 * j + 2 * g);
                V_STEP(Ba, fb, Bd, fb + 3);
                V_STEP(Bb, fb + 1, Ba, fb + 4);
                V_FINISH(fb + 1, xwA);
                V_STEP(Bc, fb + 2, Bb, fb + 5);
                V_STEP(Bd, fb + 3, Bc, fb + 6);
                V_FINISH(fb + 3, xwB);
            }
#undef V_FINISH
#undef V_STEP
#undef V_ISSUE
#undef V_OFFS
#undef V_COMPUTE
        }
        LDS_WAIT(); ISTAMP(F, 22);
        const float* gfin = (const float*)a.in[I_GFINAL];
#pragma unroll 1
        for (int tk = 0; tk < 8; ++tk) {
            const float rstd = 1.0f / sqrtf(wave_sum(SSL[(tl0 + tk) * 64 + lane]) * (1.0f / 2048.0f) + EPS);
            float* xr = a.out + (tok0 + tk) * 2048 + 16 * j + 2 * g;
            f32x2 vv[16];
#pragma unroll
            for (int sl = 0; sl < 16; ++sl) vv[sl] = *(const GAS f32x2*)(xr + 128 * sl);
#pragma unroll
            for (int sl = 0; sl < 16; ++sl) { const f32x2 gg = *(const GAS f32x2*)(gfin + 128 * sl + 16 * j + 2 * g);
                *(GAS f32x2*)(xr + 128 * sl) = (f32x2){vv[sl].x * rstd * gg.x, vv[sl].y * rstd * gg.y}; }
        }
        LDS_WAIT();
    }
}

constexpr int NPHASES = 14;
#ifndef MK_ONE_LAUNCH
#define MK_ONE_LAUNCH 1
#endif
__global__ void __launch_bounds__(NTHREADS, 2) hybrid_fwd(Args args) {
    extern __shared__ __attribute__((aligned(16))) unsigned char lds_raw[];
    Frame F;
    F.lds = (LAS unsigned char*)lds_raw;
    F.tid = threadIdx.x; F.lane = F.tid & 63; F.wave = __builtin_amdgcn_readfirstlane(F.tid >> 6);
    F.G = gridDim.x; F.bid = blockIdx.x; F.ws = args.ws; F.dout = (unsigned char*)args.out;
    volatile LAS unsigned* MISC = (volatile LAS unsigned*)(F.lds + LDS_BYTES - 256);
    if (F.tid < 64) MISC[F.tid] = 0u;
    __syncthreads();
    XcdBarrier bar = xcd_barrier_post((unsigned*)(F.ws + WS_CTL) + 4096, MISC + 8);
    const int lo = args.ph_lo, hi = args.ph_hi;
#ifndef PROBE_MULT
#define PROBE_MULT 16
#endif
    if (PROBE_PHASE >= 0 && F.bid == 0 && F.tid == 0) { volatile LAS unsigned long long* ts_ = (volatile LAS unsigned long long*)(F.lds + LDS_BYTES - 64); ts_[0] = __builtin_amdgcn_s_memrealtime(); ts_[1] = 0; }
#define STAMP(k) FSTAMP(F, k)
#define IN(k) (lo <= (k) && (k) < hi && (F.lane = lane_id(), F.tid = F.wave * 64 + F.lane, true))
#define SEAM(k) do { if (IN(k) && IN((k) + 1)) xcd_barrier(bar); } while (0)
    unsigned char* ws = F.ws;
    LAS unsigned char* ring = F.lds;

    if (IN(0)) { ph0_prologue(F, args); } SEAM(0); STAMP(0);
    if (IN(1)) {
        Sched1 S{F.G, F.bid, ws, F.dout}; EpiProj E;
        pg8::gemm_phase<EpiProj, Sched1, true>(ring, F.tid, DM, DM, DM, S, E);
#if PROBE_PHASE == 52
        { __syncthreads(); ISTAMP(F, 51); Sched1 S2{F.G, F.bid, ws, F.dout}; EpiNull1 EN; pg8::gemm_phase<EpiNull1, Sched1, true>(ring, F.tid, DM, DM, DM, S2, EN); __syncthreads(); ISTAMP(F, 52); }
#endif
    } SEAM(1); STAMP(1);
    if (IN(2)) { ph2_mixers_a(F); } SEAM(2); STAMP(2);
    if (IN(3)) { ph_scan(F); } SEAM(3); STAMP(3);
    if (IN(4)) { ph3_mixers_b(F); } SEAM(4); STAMP(4);
    if (IN(5)) {
        { SchedG S{F.G, F.bid, 64, 8, (const char*)(ws + WS_RQ), (const char*)(ws + WS_WBR_T), (size_t)256 * 1024 * 2, (size_t)256 * 1024 * 2};
          EpiMerge<0> E{(bf16_t*)(ws + WS_GR), (bf16_t*)(ws + WS_GD)};
          pg8::gemm_phase<EpiMerge<0>, SchedG, true>(ring, F.tid, 1024, 1024, 1024, S, E); }
        { SchedG S{F.G, F.bid, 64, 8, (const char*)(ws + WS_DQ), (const char*)(ws + WS_WBD_T), (size_t)256 * 1536 * 2, (size_t)256 * 512 * 2};
          EpiMerge<1> E{(bf16_t*)(ws + WS_GR), (bf16_t*)(ws + WS_GD)};
          pg8::gemm_phase<EpiMerge<1>, SchedG, true>(ring, F.tid, 512, 1536, 512, S, E); }
    } SEAM(5); STAMP(5);
    if (IN(6)) {
        SchedG S{F.G, F.bid, 64, 8, (const char*)(ws + WS_GD), (const char*)(ws + WS_WOUT_T), (size_t)256 * 2048 * 2, (size_t)256 * 2048 * 2};
        EpiResid<true> E{(const float*)args.in[I_X], (bf16_t*)(ws + WS_XB), (float*)(ws + WS_SSQ1)};
        pg8::gemm_phase<EpiResid<true>, SchedG, true>(ring, F.tid, 2048, 2048, 2048, S, E);
    } SEAM(6); STAMP(6);
    if (IN(7)) {
        SchedG S{F.G, F.bid, 64, 8, (const char*)(ws + WS_XB), (const char*)(ws + WS_WQ_T), (size_t)256 * 2048 * 2, (size_t)256 * 2048 * 2};
        EpiRowScale E{(const float*)(ws + WS_SSQ1), (bf16_t*)(ws + WS_QM), 0.04419417382415922f * 1.4426950408889634f};
        pg8::gemm_phase<EpiRowScale, SchedG, true>(ring, F.tid, 2048, 2048, 2048, S, E);
#if PROBE_PHASE == 50
        { __syncthreads(); ISTAMP(F, 49); SchedG S2{F.G, F.bid, 64, 8, (const char*)(ws + WS_XB), (const char*)(ws + WS_WQ_T), (size_t)256 * 2048 * 2, (size_t)256 * 2048 * 2};
          EpiNull EN; pg8::gemm_phase<EpiNull, SchedG, true>(ring, F.tid, 2048, 2048, 2048, S2, EN); __syncthreads(); ISTAMP(F, 50); }
#endif
    } SEAM(7); STAMP(7);
    if (IN(8)) {
        Sched7 S{F.G, F.bid, (const char*)(ws + WS_QM), (const char*)(ws + WS_KM)};
        EpiSoftmax E{(bf16_t*)(ws + WS_P), (LAS float*)(F.lds + LDSX_OFF)};
        pg8::gemm_phase<EpiSoftmax, Sched7, true>(ring, F.tid, 512, 2048, 2048, S, E);
    } SEAM(8); STAMP(8);
    if (IN(9)) {
        Sched8 S{F.G, F.bid, (const char*)(ws + WS_P), (const char*)(ws + WS_VT)};
        EpiPlain E{(bf16_t*)(ws + WS_O), 2048};
        pg8::gemm_phase<EpiPlain, Sched8, true>(ring, F.tid, 256, 256, 2048, S, E);
    } SEAM(9); STAMP(9);
    if (IN(10)) {
        SchedG S{F.G, F.bid, 64, 8, (const char*)(ws + WS_O), (const char*)(ws + WS_WO_T), (size_t)256 * 2048 * 2, (size_t)256 * 2048 * 2};
        EpiResid<false> E{nullptr, (bf16_t*)(ws + WS_XB), (float*)(ws + WS_SSQ2)};
        pg8::gemm_phase<EpiResid<false>, SchedG, true>(ring, F.tid, 2048, 2048, 2048, S, E);
    } SEAM(10); STAMP(10);
    if (IN(11)) {
        SchedG S{F.G, F.bid, 64, 8, (const char*)(ws + WS_XB), (const char*)(ws + WS_WPQ_T), (size_t)256 * 2048 * 2, (size_t)256 * 2048 * 2};
        EpiRowScale E{(const float*)(ws + WS_SSQ2), (bf16_t*)(ws + WS_PQ), 1.0f};
        pg8::gemm_phase<EpiRowScale, SchedG, true>(ring, F.tid, 2048, 2048, 2048, S, E);
    } SEAM(11); STAMP(11);
    if (IN(12)) { ph11_route(F, args); } SEAM(12); STAMP(12);
    if (IN(13)) { ph12_peer(F, args); }
    if (PROBE_PHASE >= 0 && F.bid == 0) { __syncthreads(); STAMP(13); __syncthreads(); const unsigned long long t0_ = __builtin_amdgcn_s_memrealtime();
        const unsigned long long tsel_ = ((volatile LAS unsigned long long*)(F.lds + LDS_BYTES - 64))[1];
        while (__builtin_amdgcn_s_memrealtime() - t0_ < (unsigned long long)PROBE_MULT * tsel_) __builtin_amdgcn_s_sleep(8); }
#undef IN
#undef SEAM
}

extern "C" void kernel_launch(void* const* d_in, const int* in_sizes, int n_in, void* d_out, int out_size, void* d_ws, size_t ws_size, hipStream_t stream) {
    static int grid = 0;
    if (grid == 0) {
        if (n_in != 19 || out_size != MT * DM || ws_size < WS_END) { fprintf(stderr, "kernel_launch: unexpected shapes (n_in %d, out %d, ws %zu)\n", n_in, out_size, ws_size); grid = -1; return; }
        int dev = 0, cus = 0;
        if (hipGetDevice(&dev) != hipSuccess || hipDeviceGetAttribute(&cus, hipDeviceAttributeMultiprocessorCount, dev) != hipSuccess) { grid = -1; return; }
        if (hipFuncSetAttribute((const void*)hybrid_fwd, hipFuncAttributeMaxDynamicSharedMemorySize, LDS_BYTES) != hipSuccess) { fprintf(stderr, "kernel_launch: hipFuncSetAttribute failed\n"); grid = -1; return; }
        (void)hipGetLastError();
        grid = cus;
    }
    if (grid < 0) return;
    (void)hipMemsetAsync((char*)d_ws + WS_CTL, 0, CTL_ZERO_BYTES, stream);
    Args a{};
    for (int i = 0; i < 19; ++i) a.in[i] = d_in[i];
    a.out = (float*)d_out; a.ws = (unsigned char*)d_ws;
    for (int i = 0; i < 64; ++i) { a.fret[i] = std::pow(10000.0, -(double)i / 63.0); a.frot[i] = std::pow(10000.0, -(double)i / 64.0); }
#if MK_ONE_LAUNCH
    a.ph_lo = 0; a.ph_hi = NPHASES;
    hipLaunchKernelGGL(hybrid_fwd, dim3(grid), dim3(NTHREADS), LDS_BYTES, stream, a);
#else
    for (int ph = 0; ph < NPHASES; ++ph) {
        a.ph_lo = ph; a.ph_hi = ph + 1;
        hipLaunchKernelGGL(hybrid_fwd, dim3(grid), dim3(NTHREADS), LDS_BYTES, stream, a);
    }
#endif
}
#ifdef PHASE_PROBE
#define PROBE(k) __global__ void __launch_bounds__(NTHREADS, 2) probe_ph##k(Args args) { \
    extern __shared__ __attribute__((aligned(16))) unsigned char lds_raw[]; Frame F; F.lds = (LAS unsigned char*)lds_raw; F.tid = threadIdx.x; F.lane = F.tid & 63; \
    F.wave = __builtin_amdgcn_readfirstlane(F.tid >> 6); F.G = gridDim.x; F.bid = blockIdx.x; F.ws = args.ws; F.dout = (unsigned char*)args.out; unsigned char* ws = F.ws; LAS unsigned char* ring = F.lds;
PROBE(0) ph0_prologue(F, args); }
PROBE(1) Sched1 S{F.G, F.bid, ws, F.dout}; EpiProj E; pg8::gemm_phase<EpiProj, Sched1, true>(ring, F.tid, DM, DM, DM, S, E); }
PROBE(2) ph2_mixers_a(F); }
PROBE(3) ph3_mixers_b(F); }
PROBE(5) SchedG S{F.G, F.bid, 64, 8, (const char*)(ws + WS_GD), (const char*)(ws + WS_WOUT_T), (size_t)256 * 2048 * 2, (size_t)256 * 2048 * 2};
        EpiResid<true> E{(const float*)args.in[I_X], (bf16_t*)(ws + WS_XB), (float*)(ws + WS_SSQ1)};
        pg8::gemm_phase<EpiResid<true>, SchedG, true>(ring, F.tid, 2048, 2048, 2048, S, E); }
PROBE(7) Sched7 S{F.G, F.bid, (const char*)(ws + WS_QM), (const char*)(ws + WS_KM)};
        EpiSoftmax E{(bf16_t*)(ws + WS_P), (LAS float*)(F.lds + LDSX_OFF)};
        pg8::gemm_phase<EpiSoftmax, Sched7, true>(ring, F.tid, 512, 2048, 2048, S, E); }
PROBE(11) ph11_route(F, args); }
PROBE(12) ph12_peer(F, args); }
#endif
```

```cpp
#include <hip/hip_runtime.h>
#include <cstdio>
#include <cstdint>
#include <cmath>

#define LAS __attribute__((address_space(3)))
#define GAS __attribute__((address_space(1)))
#define DI __device__ __forceinline__
typedef unsigned short bf16_t;
typedef short bf16x8 __attribute__((ext_vector_type(8)));
typedef short s16x4 __attribute__((ext_vector_type(4)));
typedef short v4i16_t __attribute__((ext_vector_type(4)));
typedef float f32x2 __attribute__((ext_vector_type(2)));
typedef float f32x4 __attribute__((ext_vector_type(4)));
typedef float f32x16 __attribute__((ext_vector_type(16)));
typedef unsigned u32x2 __attribute__((ext_vector_type(2)));
typedef unsigned u32x4 __attribute__((ext_vector_type(4)));
typedef __bf16 bf16x2_t __attribute__((ext_vector_type(2)));

constexpr int NB = 8, SEQ = 2048, DM = 2048, MT = NB * SEQ;
constexpr int MEMT = 256, MROWS = NB * MEMT;
constexpr int INW = 12800;
constexpr float EPS = 1e-6f;
constexpr int NWAVES = 8, NTHREADS = 512;

constexpr size_t MiB = 1u << 20;
constexpr size_t WS_CTL = 0, CTL_ZERO_BYTES = 1 * MiB;
constexpr size_t WS_SSQ1 = 2 * MiB, WS_SSQ2 = 4 * MiB, WS_LSE = 6 * MiB, WS_EIDX = 8 * MiB, WS_GATE = 16 * MiB;
constexpr size_t WS_WIN_T = 24 * MiB, WS_WKV_T = 74 * MiB, WS_WBR_T = 90 * MiB, WS_WBD_T = 94 * MiB, WS_WOUT_T = 96 * MiB, WS_WQ_T = 104 * MiB, WS_WO_T = 112 * MiB, WS_WPQ_T = 120 * MiB;
constexpr size_t WS_SUBK = 128 * MiB, WS_KM = 130 * MiB, WS_VT = 138 * MiB;
constexpr size_t WS_RQ = 148 * MiB, WS_RK = 180 * MiB, WS_RV = 212 * MiB, WS_SG = 244 * MiB, WS_DQ = 276 * MiB, WS_DK = 324 * MiB, WS_DV = 372 * MiB, WS_GR = 420 * MiB, WS_GD = 484 * MiB;
constexpr size_t WS_END = 548 * MiB;
constexpr size_t WS_KVST = 24 * MiB;
constexpr size_t WS_XB = 24 * MiB;
constexpr size_t WS_QM = 180 * MiB;
constexpr size_t WS_PQ = 180 * MiB;
constexpr size_t WS_P = 244 * MiB;
constexpr size_t WS_O = 324 * MiB;
constexpr size_t WS_UTAB = 276 * MiB;
constexpr size_t WS_VTAB = 404 * MiB;
constexpr size_t DO_H1 = 0, DO_MEMN = 64 * MiB, DO_CSRET = 72 * MiB, DO_CSROT = 80 * MiB;
constexpr size_t DO_PREVT = 0;

DI unsigned f2bf(float f) { unsigned u = __builtin_bit_cast(unsigned, f); return (u + 0x7fffu + ((u >> 16) & 1u)) >> 16; }
DI unsigned pk2(float lo, float hi) { f32x2 v = {lo, hi}; bf16x2_t b = __builtin_convertvector(v, bf16x2_t); return __builtin_bit_cast(unsigned, b); }
DI float bf_lo(unsigned w) { return __builtin_bit_cast(float, w << 16); }
DI float bf_hi(unsigned w) { return __builtin_bit_cast(float, w & 0xffff0000u); }
DI float wave_sum(float v) {
#pragma unroll
    for (int o = 1; o < 64; o <<= 1) v += __shfl_xor(v, o);
    return v;
}
#define LDS_WAIT() asm volatile("s_waitcnt lgkmcnt(0)" ::: "memory")
#define VM_WAIT() asm volatile("s_waitcnt vmcnt(0)" ::: "memory")
DI float fast_exp2(float x) { return __builtin_amdgcn_exp2f(x); }
DI float fast_rcp(float x) { return __builtin_amdgcn_rcpf(x); }
DI float sigmoid_f(float x) { return fast_rcp(1.f + fast_exp2(-1.4426950408889634f * x)); }

namespace pg8 {
constexpr int BM = 256, BK = 64, HALF = 128, HTB = HALF * BK * 2, STAGE_BYTES = 8 * HTB, NXCD = 8, WGM = 8;
__host__ __device__ __forceinline__ int lds_byte(int r, int c) { const int st = (r >> 4) * 2 + (c >> 5), rr = r & 15, cc = c & 31, ob = rr * 64 + cc * 2; return st * 1024 + (ob ^ (((ob >> 9) & 1) << 5)); }
__host__ __device__ __forceinline__ void stage_rc(int b, int& R, int& C) { const int st = b / 1024, sb = b % 1024, swz = sb ^ (((sb >> 9) & 1) << 5); R = (st >> 1) * 16 + swz / 64; C = (st & 1) * 32 + (swz % 64) / 2; }
__host__ __device__ __forceinline__ int perm32(int rho) { const int n = rho >> 4, i = rho & 15; return 8 * (i >> 2) + 4 * n + (i & 3); }

template <int WGM_> __device__ __forceinline__ void tile_of(int L, int nM, int nN, int& pm, int& pn) {
    const int nwg = nM * nN; int wgid = L;
    { const int q = nwg / NXCD, r = nwg % NXCD, xcd = wgid % NXCD, off = wgid / NXCD; wgid = (xcd < r ? xcd * (q + 1) : r * (q + 1) + (xcd - r) * q) + off; }
    const int nig = WGM_ * nN, gid = wgid / nig, fm = gid * WGM_, gsz = (nM - fm) < WGM_ ? (nM - fm) : WGM_;
    pm = fm + ((wgid % nig) % gsz); pn = (wgid % nig) / gsz;
}

template <class Epi, class Sched, bool ALIGN_EPI>
__device__ __forceinline__ void gemm_phase(LAS unsigned char* lds, const int tid, const int K, const int lda, const int ldb, const Sched& S, const Epi& E) {
    typedef typename Sched::Unit Unit;
    const int wid = __builtin_amdgcn_readfirstlane(tid >> 6), lane = tid & 63, wr = wid >> 2, wc = wid & 3, fr = lane & 15, fq = lane >> 4;
    const int nt = K / BK;
    unsigned voffA[2], voffB[2];
#pragma unroll
    for (int i = 0; i < 2; ++i) { int R, C; stage_rc(tid * 16 + i * 8192, R, C); const int Rb = (R & ~31) + perm32(R & 31);
        voffA[i] = (unsigned)(R * lda + C) * 2u; voffB[i] = (unsigned)(Rb * ldb + C) * 2u; }
    const size_t kstep = (size_t)(BK * 2);
    const size_t hstepA = (size_t)HALF * lda * 2, hstepB = (size_t)HALF * ldb * 2;
    const unsigned ldsw = (unsigned)wid * 1024u;
    const int aoff = lds_byte(wr * 64 + fr, fq * 8), boff = lds_byte(wc * 32 + fr, fq * 8);
#define PG8_SA(b, h) (((b) * 2 + (h)) * HTB)
#define PG8_SB(b, h) ((4 + (b) * 2 + (h)) * HTB)
#define PG8_STAGE(bufoff, gbase, voff) do { _Pragma("unroll") for (int _i = 0; _i < 2; ++_i) \
        __builtin_amdgcn_global_load_lds((const unsigned*)((const char*)(gbase) + (voff)[_i]), (LAS unsigned*)(lds + (bufoff) + ldsw + _i * 8192), 16, 0, 0); } while (0)
#define PG8_LDA(dst, b, h) do { _Pragma("unroll") for (int m = 0; m < 4; ++m) _Pragma("unroll") for (int k = 0; k < 2; ++k) dst[m][k] = *(const LAS bf16x8*)(lds + PG8_SA(b, h) + aoff + m * 2048 + k * 1024); } while (0)
#define PG8_LDB(dst, b, h) do { _Pragma("unroll") for (int n = 0; n < 2; ++n) _Pragma("unroll") for (int k = 0; k < 2; ++k) dst[n][k] = *(const LAS bf16x8*)(lds + PG8_SB(b, h) + boff + n * 2048 + k * 1024); } while (0)
#define PG8_MMA(ai, bj, At, Bt) do { __builtin_amdgcn_s_setprio(1); _Pragma("unroll") for (int m = 0; m < 4; ++m) _Pragma("unroll") for (int n = 0; n < 2; ++n) _Pragma("unroll") for (int k = 0; k < 2; ++k) \
        acc[ai][bj][m][n] = __builtin_amdgcn_mfma_f32_16x16x32_bf16(Bt[n][k], At[m][k], acc[ai][bj][m][n], 0, 0, 0); __builtin_amdgcn_s_setprio(0); } while (0)
#define PG8_WAIT_V(n) asm volatile("s_waitcnt vmcnt(" #n ")" ::: "memory")
#define PG8_WAIT_L(n) asm volatile("s_waitcnt lgkmcnt(" #n ")" ::: "memory")
#define PG8_BAR __builtin_amdgcn_s_barrier()
#define PG8_SCHED __builtin_amdgcn_sched_barrier(0)
    Unit cur, nxt; int ui = 0;
    if (!S.next(0, cur)) return;
    f32x4 acc[2][2][4][2];
#pragma unroll
    for (int a = 0; a < 2; ++a)
#pragma unroll
        for (int b = 0; b < 2; ++b)
#pragma unroll
            for (int m = 0; m < 4; ++m)
#pragma unroll
                for (int n = 0; n < 2; ++n) acc[a][b][m][n] = (f32x4){0.f, 0.f, 0.f, 0.f};
    bf16x8 At[4][2], B0[2][2], B1[2][2];
    const char* cA = cur.A; const char* cB = cur.B;
    PG8_STAGE(PG8_SB(0, 0), cB, voffB); PG8_STAGE(PG8_SB(0, 1), cB + hstepB, voffB); PG8_STAGE(PG8_SA(0, 0), cA, voffA); PG8_STAGE(PG8_SA(0, 1), cA + hstepA, voffA);
    if (wr == 1) PG8_BAR;
    PG8_WAIT_V(2); PG8_BAR;
    PG8_STAGE(PG8_SB(1, 0), cB + kstep, voffB); PG8_STAGE(PG8_SA(1, 0), cA + kstep, voffA); PG8_STAGE(PG8_SB(1, 1), cB + hstepB + kstep, voffB);
    PG8_WAIT_V(6); PG8_BAR;
    for (;;) {
        const bool has_next = S.next(ui + 1, nxt);
        const char* nA = has_next ? nxt.A : cA; const char* nB = has_next ? nxt.B : cB;
        for (int t = 0; t < nt; t += 2) {
            const bool last = (t == nt - 2);
            const char* a1 = cA + (size_t)(t + 1) * kstep;
            const char* a2 = last ? nA : cA + (size_t)(t + 2) * kstep; const char* b2 = last ? nB : cB + (size_t)(t + 2) * kstep;
            const char* a3 = a2 + kstep; const char* b3 = b2 + kstep;
            PG8_LDB(B0, 0, 0); PG8_LDB(B1, 0, 1); PG8_SCHED; PG8_LDA(At, 0, 0); PG8_STAGE(PG8_SA(1, 1), a1 + hstepA, voffA);
            PG8_WAIT_V(8); PG8_WAIT_L(0); PG8_BAR; PG8_MMA(0, 0, At, B0); PG8_MMA(0, 1, At, B1); PG8_BAR; PG8_SCHED;
            PG8_LDA(At, 0, 1); PG8_STAGE(PG8_SB(0, 0), b2, voffB); PG8_STAGE(PG8_SB(0, 1), b2 + hstepB, voffB); PG8_STAGE(PG8_SA(0, 0), a2, voffA);
            PG8_WAIT_V(8); PG8_WAIT_L(0); PG8_BAR; PG8_MMA(1, 0, At, B0); PG8_MMA(1, 1, At, B1); PG8_BAR; PG8_SCHED;
            PG8_LDB(B0, 1, 0); PG8_LDB(B1, 1, 1); PG8_SCHED; PG8_LDA(At, 1, 0); PG8_STAGE(PG8_SA(0, 1), a2 + hstepA, voffA);
            PG8_WAIT_V(8); PG8_WAIT_L(0); PG8_BAR; PG8_MMA(0, 0, At, B0); PG8_MMA(0, 1, At, B1); PG8_BAR; PG8_SCHED;
            PG8_LDA(At, 1, 1); PG8_STAGE(PG8_SB(1, 0), b3, voffB); PG8_STAGE(PG8_SB(1, 1), b3 + hstepB, voffB); PG8_STAGE(PG8_SA(1, 0), a3, voffA);
            PG8_WAIT_V(8); PG8_WAIT_L(0); PG8_BAR; PG8_MMA(1, 0, At, B0); PG8_MMA(1, 1, At, B1); PG8_BAR; PG8_SCHED;
        }
        if constexpr (ALIGN_EPI) { if (wr == 0) PG8_BAR; }
        E(acc, cur, wr, wc, fr, fq, wid, lane);
        if (!has_next) break;
#pragma unroll
        for (int a = 0; a < 2; ++a)
#pragma unroll
            for (int b = 0; b < 2; ++b)
#pragma unroll
                for (int m = 0; m < 4; ++m)
#pragma unroll
                    for (int n = 0; n < 2; ++n) acc[a][b][m][n] = (f32x4){0.f, 0.f, 0.f, 0.f};
        cur = nxt; cA = nA; cB = nB; ++ui;
        if constexpr (ALIGN_EPI) { if (wr == 1) PG8_BAR; }
    }
    PG8_WAIT_V(0);
    if constexpr (!ALIGN_EPI) { if (wr == 0) PG8_BAR; }
    PG8_BAR;
#undef PG8_SA
#undef PG8_SB
#undef PG8_STAGE
#undef PG8_LDA
#undef PG8_LDB
#undef PG8_MMA
#undef PG8_WAIT_V
#undef PG8_WAIT_L
#undef PG8_BAR
#undef PG8_SCHED
}
}

constexpr int RING_BYTES = 131072;
constexpr int LDSX_OFF = RING_BYTES;
constexpr int LDSCTL_OFF = RING_BYTES + 16384;
constexpr int LDS_BYTES = 163840;

typedef GAS unsigned gu32;
#define RLX_AGENT __ATOMIC_RELAXED, __HIP_MEMORY_SCOPE_AGENT

#define XB_TMO      128
#define XB_XCNT(j)  (256  + 64 * (j))
#define XB_XSUB(j)  (1280 + 64 * (j))
#define XB_XGEN(j)  (2304 + 64 * (j))
#define XB_TOP      3328
#define XB_TOPGEN   3392
#define XCD_BAR_WORDS 3456
#define XB_SPIN_CAP (1u << 20)
DI unsigned xb_ld(unsigned* p)              { return __hip_atomic_load(p, __ATOMIC_RELAXED, __HIP_MEMORY_SCOPE_AGENT); }
DI unsigned xb_add(unsigned* p, unsigned v) { return __hip_atomic_fetch_add(p, v, __ATOMIC_RELAXED, __HIP_MEMORY_SCOPE_AGENT); }
DI unsigned xb_xcc_id() { return (unsigned)__builtin_amdgcn_s_getreg((3 << 11) | 20) & 0xFu; }
#define XB_SPIN(cond, bar) do { unsigned _sp = 0; while (cond) { __builtin_amdgcn_s_sleep(1); \
    if ((++_sp & 255u) == 0u) { if (xb_ld(&(bar)[XB_TMO])) break; if (_sp > XB_SPIN_CAP) { atomicAdd(&(bar)[XB_TMO], 1u); break; } } } } while (0)
struct XcdBarrier { unsigned* bar; unsigned x; volatile LAS unsigned* st; };
DI XcdBarrier xcd_barrier_post(unsigned* bar, volatile LAS unsigned* st) {
    XcdBarrier b; b.bar = bar; b.x = xb_xcc_id(); b.st = st;
    if (threadIdx.x == 0) (void)xb_add(&bar[XB_XCNT(b.x)], 1u);
    return b;
}
DI void xcd_barrier_complete(unsigned* bar, unsigned x, unsigned& nloc, unsigned& nx) {
    const unsigned G = gridDim.x * gridDim.y * gridDim.z;
    unsigned sum, cnt, mine, sp = 0u;
    for (;;) {
        sum = 0u; cnt = 0u; mine = 0u;
#pragma unroll
        for (unsigned j = 0; j < 16; ++j) { const unsigned c = xb_ld(&bar[XB_XCNT(j)]); sum += c; cnt += (c > 0u) ? 1u : 0u; mine = (j == x) ? c : mine; }
        if (sum == G) break;
        __builtin_amdgcn_s_sleep(1);
        if ((++sp & 255u) == 0u) { if (xb_ld(&bar[XB_TMO])) break; if (sp > XB_SPIN_CAP) { atomicAdd(&bar[XB_TMO], 1u); break; } }
    }
    nloc = mine > 0u ? mine : 1u; nx = cnt > 0u ? cnt : 1u;
}
DI void xcd_barrier(const XcdBarrier& b) {
    asm volatile("s_waitcnt vmcnt(0)" ::: "memory");
    __syncthreads();
    if (threadIdx.x == 0) {
        unsigned* bar = b.bar;
        __builtin_amdgcn_s_waitcnt(0);
        unsigned nloc = b.st[0], nx = b.st[1];
        if (nloc == 0u) { xcd_barrier_complete(bar, b.x, nloc, nx); b.st[0] = nloc; b.st[1] = nx; }
        const unsigned old = xb_add(&bar[XB_XSUB(b.x)], 1u);
        const unsigned gen = old / nloc;
        if (old + 1u == (gen + 1u) * nloc) {
            __builtin_amdgcn_fence(__ATOMIC_RELEASE, "agent");
            asm volatile("s_waitcnt vmcnt(0)" ::: "memory");
            const unsigned og = xb_add(&bar[XB_TOP], 1u);
            const unsigned tg = og / nx;
            if (og + 1u == (tg + 1u) * nx) xb_add(&bar[XB_TOPGEN], 1u);
            else XB_SPIN(xb_ld(&bar[XB_TOPGEN]) == tg, bar);
            __builtin_amdgcn_fence(__ATOMIC_ACQUIRE, "agent");
            xb_add(&bar[XB_XGEN(b.x)], 1u);
            asm volatile("s_waitcnt vmcnt(0)" ::: "memory");
        } else {
            XB_SPIN(xb_ld(&bar[XB_XGEN(b.x)]) == gen, bar);
            __builtin_amdgcn_fence(__ATOMIC_ACQUIRE, "agent");
            asm volatile("s_waitcnt vmcnt(0)" ::: "memory");
        }
    }
    __syncthreads();
}

struct Args {
    const void* in[19]; float* out; unsigned char* ws; int ph_lo, ph_hi;
    double fret[64]; double frot[64];
};
DI int lane_id() { int l; asm volatile("v_mbcnt_lo_u32_b32 %0, -1, 0\n\tv_mbcnt_hi_u32_b32 %0, -1, %0" : "=v"(l)); return l; }
struct Frame {
    LAS unsigned char* lds;
    int tid, lane, wave, G, bid;
    unsigned char* ws; unsigned char* dout;
};
#ifndef PROBE_PHASE
#define PROBE_PHASE -1
#endif
#define ISTAMP(F, k) do { if (PROBE_PHASE >= 20) { __syncthreads(); FSTAMP(F, k); } } while (0)
#define FSTAMP(F, k) do { if (PROBE_PHASE >= 0 && (F).bid == 0 && (F).tid == 0) { volatile LAS unsigned long long* ts_ = (volatile LAS unsigned long long*)((F).lds + LDS_BYTES - 64); \
    const unsigned long long t_ = __builtin_amdgcn_s_memrealtime(); if ((k) == PROBE_PHASE) ts_[1] = t_ - ts_[0]; ts_[0] = t_; } } while (0)
enum { I_X = 0, I_MEM, I_POS, I_GMIX, I_WIN, I_WBR, I_WBD, I_WOUT, I_GCROSS, I_GMEM, I_WQ, I_WKV, I_WO, I_GFFN, I_WPQ, I_SUBK, I_PU, I_PV, I_GFINAL };

DI void tr_item(const float* W, int K, int N, bf16_t* WT, const float* scale, int rot_lo, int rot_hi, LAS float* scr, int item, int lane) {
    const int nblk = N / 64, kb = item / nblk, nb = item % nblk, k0 = 64 * kb, c0 = 64 * nb;
    f32x4 wv[16];
#pragma unroll
    for (int i = 0; i < 16; ++i) { const int kk = 4 * i + (lane >> 4); wv[i] = *(const GAS f32x4*)(W + (size_t)(k0 + kk) * N + c0 + 4 * (lane & 15)); }
    if (scale) {
#pragma unroll
        for (int i = 0; i < 16; ++i) wv[i] = wv[i] * scale[k0 + 4 * i + (lane >> 4)];
    }
#pragma unroll
    for (int i = 0; i < 16; ++i) { const int kk = 4 * i + (lane >> 4); *(LAS f32x4*)(scr + kk * 68 + 4 * (lane & 15)) = wv[i]; }
    LDS_WAIT();
    const bool rot = (c0 >= rot_lo) && (c0 < rot_hi);
    const int hb = c0 & ~127, half = (c0 >> 6) & 1;
    const int c = lane & 7;
#pragma unroll
    for (int j = 0; j < 8; ++j) { const int n = (lane >> 3) + 8 * j; const LAS float* sp = scr + (8 * c) * 68 + n;
        u32x4 o; o.x = pk2(sp[0 * 68], sp[1 * 68]); o.y = pk2(sp[2 * 68], sp[3 * 68]); o.z = pk2(sp[4 * 68], sp[5 * 68]); o.w = pk2(sp[6 * 68], sp[7 * 68]);
        const int drow = rot ? (hb + 2 * n + half) : (c0 + n);
        *(GAS u32x4*)(WT + (size_t)drow * K + k0 + 8 * c) = o; }
    LDS_WAIT();
}
DI void rms_row_bf16(const float* xrow, const float* g, bf16_t* orow, int lane) {
    const GAS f32x4* xr = (const GAS f32x4*)xrow + lane; const GAS f32x4* gr = (const GAS f32x4*)g + lane;
    f32x4 v[8]; float s = 0.f;
#pragma unroll
    for (int j = 0; j < 8; ++j) { v[j] = xr[64 * j]; s += (v[j].x * v[j].x + v[j].y * v[j].y) + (v[j].z * v[j].z + v[j].w * v[j].w); }
    const float rstd = 1.0f / sqrtf(wave_sum(s) * (1.f / DM) + EPS);
    GAS u32x2* o8 = (GAS u32x2*)orow + lane;
#pragma unroll
    for (int j = 0; j < 8; ++j) { const f32x4 gg = gr[64 * j]; u32x2 o; o.x = pk2(v[j].x * rstd * gg.x, v[j].y * rstd * gg.y); o.y = pk2(v[j].z * rstd * gg.z, v[j].w * rstd * gg.w); o8[64 * j] = o; }
}
DI void sincos_d(double a, float& c, float& s) {
    const double x = a * 0.63661977236758134308; const double q = __builtin_rint(x);
    double r = __builtin_fma(-q, 1.57079632679489655800, a); r = __builtin_fma(-q, 6.12323399573676603587e-17, r);
    const int qi = ((int)q) & 3; const double r2 = r * r;
    double sn = 1.0 / 6227020800.0; sn = sn * r2 - 1.0 / 39916800.0; sn = sn * r2 + 1.0 / 362880.0; sn = sn * r2 - 1.0 / 5040.0; sn = sn * r2 + 1.0 / 120.0; sn = sn * r2 - 1.0 / 6.0; sn = sn * r2 + 1.0; sn *= r;
    double cs = -1.0 / 87178291200.0; cs = cs * r2 + 1.0 / 479001600.0; cs = cs * r2 - 1.0 / 3628800.0; cs = cs * r2 + 1.0 / 40320.0; cs = cs * r2 - 1.0 / 720.0; cs = cs * r2 + 1.0 / 24.0; cs = cs * r2 - 0.5; cs = cs * r2 + 1.0;
    const double so = (qi == 0) ? sn : (qi == 1) ? cs : (qi == 2) ? -sn : -cs;
    const double co = (qi == 0) ? cs : (qi == 1) ? -sn : (qi == 2) ? -cs : sn;
    c = (float)co; s = (float)so;
}
DI void ph0_prologue(const Frame& F, const Args& a) {
    LAS float* scr = (LAS float*)(F.lds + F.wave * 17408);
    const int gw = F.bid * NWAVES + F.wave, NGW = F.G * NWAVES;
    unsigned char* ws = F.ws;
    constexpr int I_IN = (DM / 64) * (INW / 64), I_KV = (DM / 64) * (4096 / 64), I_BR = (1024 / 64) * (DM / 64), I_BD = (512 / 64) * (DM / 64), I_SQ = (DM / 64) * (DM / 64);
    constexpr int NITEMS = I_IN + I_KV + I_BR + I_BD + 4 * I_SQ;
    for (int it = gw; it < NITEMS; it += NGW) {
        int r = it;
        if (r < I_IN) { tr_item((const float*)a.in[I_WIN], DM, INW, (bf16_t*)(ws + WS_WIN_T), nullptr, 4096, 7168, scr, r, F.lane); continue; } r -= I_IN;
        if (r < I_KV) { tr_item((const float*)a.in[I_WKV], DM, 4096, (bf16_t*)(ws + WS_WKV_T), nullptr, 0, 0, scr, r, F.lane); continue; } r -= I_KV;
        if (r < I_BR) { tr_item((const float*)a.in[I_WBR], 1024, DM, (bf16_t*)(ws + WS_WBR_T), nullptr, 0, 0, scr, r, F.lane); continue; } r -= I_BR;
        if (r < I_BD) { tr_item((const float*)a.in[I_WBD], 512, DM, (bf16_t*)(ws + WS_WBD_T), nullptr, 0, 0, scr, r, F.lane); continue; } r -= I_BD;
        if (r < I_SQ) { tr_item((const float*)a.in[I_WOUT], DM, DM, (bf16_t*)(ws + WS_WOUT_T), nullptr, 0, 0, scr, r, F.lane); continue; } r -= I_SQ;
        if (r < I_SQ) { tr_item((const float*)a.in[I_WQ], DM, DM, (bf16_t*)(ws + WS_WQ_T), (const float*)a.in[I_GCROSS], 0, 0, scr, r, F.lane); continue; } r -= I_SQ;
        if (r < I_SQ) { tr_item((const float*)a.in[I_WO], DM, DM, (bf16_t*)(ws + WS_WO_T), nullptr, 0, 0, scr, r, F.lane); continue; } r -= I_SQ;
        tr_item((const float*)a.in[I_WPQ], DM, DM, (bf16_t*)(ws + WS_WPQ_T), (const float*)a.in[I_GFFN], 0, 0, scr, r, F.lane);
    }
    ISTAMP(F, 42);
    for (int m = gw; m < MT; m += NGW) rms_row_bf16((const float*)a.in[I_X] + (size_t)m * DM, (const float*)a.in[I_GMIX], (bf16_t*)(F.dout + DO_H1) + (size_t)m * DM, F.lane);
    for (int m = gw; m < MROWS; m += NGW) rms_row_bf16((const float*)a.in[I_MEM] + (size_t)m * DM, (const float*)a.in[I_GMEM], (bf16_t*)(F.dout + DO_MEMN) + (size_t)m * DM, F.lane);
    ISTAMP(F, 43);
    const int gt = F.bid * NTHREADS + F.tid, NGT = F.G * NTHREADS;
    for (int i = gt; i < 16 * 128 * 128 / 8; i += NGT) {
        const GAS f32x4* s = (const GAS f32x4*)a.in[I_SUBK] + 2 * (size_t)i; const f32x4 v0 = s[0], v1 = s[1];
        u32x4 o; o.x = pk2(v0.x, v0.y); o.y = pk2(v0.z, v0.w); o.z = pk2(v1.x, v1.y); o.w = pk2(v1.z, v1.w);
        ((GAS u32x4*)(ws + WS_SUBK))[i] = o;
    }
    for (int i = gt; i < MT * 64; i += NGT) {
        const int t = i >> 6, k = i & 63; const double pos = (double)((const int*)a.in[I_POS])[t];
        { const double rv = pos * a.fret[k] * 0.15915494309189533577; const float fr = (float)(rv - __builtin_floor(rv));
          ((GAS f32x2*)(F.dout + DO_CSRET))[i] = (f32x2){__builtin_amdgcn_cosf(fr), __builtin_amdgcn_sinf(fr)}; }
        { const double rv = pos * a.frot[k] * 0.15915494309189533577; const float fr = (float)(rv - __builtin_floor(rv));
          ((GAS f32x2*)(F.dout + DO_CSROT))[i] = (f32x2){__builtin_amdgcn_cosf(fr), __builtin_amdgcn_sinf(fr)}; }
    }
}

#ifndef WGM_PROJ
#define WGM_PROJ 4
#endif
#ifndef WGM_MID
#define WGM_MID 4
#endif
struct Unit1 { const char* A; const char* B; int pm, pn; int mode; bf16_t* out; int ldo; float scale; const float* cs; };
struct Sched1 {
    typedef Unit1 Unit;
    int G, c; unsigned char* ws; unsigned char* dout;
    DI bool next(int i, Unit& u) const {
        const int L = i * G + c; if (L >= 3328) return false;
        if (L < 3200) {
            int pm, pn; pg8::tile_of<WGM_PROJ>(L, 64, 50, pm, pn); u.pm = pm; u.pn = pn;
            u.A = (const char*)(dout + DO_H1) + (size_t)pm * 256 * DM * 2; u.B = (const char*)(ws + WS_WIN_T) + (size_t)pn * 256 * DM * 2;
            u.scale = 1.f; u.cs = nullptr; u.mode = 0;
            const size_t rowoff = (size_t)pm * 256;
            if (pn < 4)       { u.mode = 1; u.out = (bf16_t*)(ws + WS_RQ) + rowoff * 1024 + (pn - 0) * 256; u.ldo = 1024; u.cs = (const float*)(dout + DO_CSRET); }
            else if (pn < 8)  { u.mode = 1; u.out = (bf16_t*)(ws + WS_RK) + rowoff * 1024 + (pn - 4) * 256; u.ldo = 1024; u.cs = (const float*)(dout + DO_CSRET); u.scale = 0.08838834764831845f; }
            else if (pn < 12) { u.out = (bf16_t*)(ws + WS_RV) + rowoff * 1024 + (pn - 8) * 256; u.ldo = 1024; }
            else if (pn < 16) { u.mode = 2; u.out = (bf16_t*)(ws + WS_SG) + rowoff * 1024 + (pn - 12) * 256; u.ldo = 1024; }
            else if (pn < 22) { u.mode = 1; u.out = (bf16_t*)(ws + WS_DQ) + rowoff * 1536 + (pn - 16) * 256; u.ldo = 1536; u.cs = (const float*)(dout + DO_CSROT); u.scale = 0.08838834764831845f * 1.4426950408889634f; }
            else if (pn < 28) { u.mode = 1; u.out = (bf16_t*)(ws + WS_DK) + rowoff * 1536 + (pn - 22) * 256; u.ldo = 1536; u.cs = (const float*)(dout + DO_CSROT); }
            else if (pn < 34) { u.out = (bf16_t*)(ws + WS_DV) + rowoff * 1536 + (pn - 28) * 256; u.ldo = 1536; }
            else if (pn < 42) { u.mode = 3; u.out = (bf16_t*)(ws + WS_GR) + rowoff * 2048 + (pn - 34) * 256; u.ldo = 2048; }
            else              { u.mode = 3; u.out = (bf16_t*)(ws + WS_GD) + rowoff * 2048 + (pn - 42) * 256; u.ldo = 2048; }
        } else {
            const int l = L - 3200; u.mode = 0; u.scale = 1.f; u.cs = nullptr; u.ldo = 2048;
            if (l < 64) { const int pm = l >> 3, pn = l & 7; u.pm = pm; u.pn = pn;
                u.A = (const char*)(dout + DO_MEMN) + (size_t)pm * 256 * DM * 2; u.B = (const char*)(ws + WS_WKV_T) + (size_t)pn * 256 * DM * 2;
                u.out = (bf16_t*)(ws + WS_KM) + (size_t)pm * 256 * 2048 + pn * 256; }
            else { const int l2 = l - 64, pm = l2 >> 3, pn = l2 & 7; u.pm = pm; u.pn = pn;
                u.A = (const char*)(ws + WS_WKV_T) + (size_t)(2048 + pm * 256) * DM * 2; u.B = (const char*)(dout + DO_MEMN) + (size_t)pn * 256 * DM * 2;
                u.out = (bf16_t*)(ws + WS_VT) + (size_t)pm * 256 * 2048 + pn * 256; }
        }
        return true;
    }
};
struct EpiNull1 {
    DI void operator()(const f32x4 (&acc)[2][2][4][2], const Unit1& u, int wr, int wc, int fr, int fq, int wid, int lane) const {
#pragma unroll
        for (int ai = 0; ai < 2; ++ai)
#pragma unroll
            for (int bj = 0; bj < 2; ++bj)
#pragma unroll
                for (int m = 0; m < 4; ++m) { asm volatile("" :: "v"(acc[ai][bj][m][0]), "v"(acc[ai][bj][m][1])); }
    }
};
struct EpiProj {
    template <int MODE> DI void emit(const f32x4 (&acc)[2][2][4][2], const Unit1& u, int wr, int wc, int fr, int fq) const {
        const int rowl0 = wr * 64 + fr, colb = wc * 32 + 8 * fq;
        f32x4 cs[2][4][2];
        if (MODE == 1) {
#pragma unroll
            for (int ai = 0; ai < 2; ++ai)
#pragma unroll
                for (int m = 0; m < 4; ++m) { const GAS f32x4* cp = (const GAS f32x4*)(u.cs + ((size_t)(u.pm * 256 + ai * 128 + m * 16 + rowl0) * 64 + (colb >> 1)) * 2); cs[ai][m][0] = cp[0]; cs[ai][m][1] = cp[1]; }
        }
#pragma unroll
        for (int ai = 0; ai < 2; ++ai)
#pragma unroll
            for (int m = 0; m < 4; ++m) {
                const int rl = ai * 128 + m * 16 + rowl0;
                f32x4 cs0 = {1.f, 0.f, 1.f, 0.f}, cs1 = cs0;
                if (MODE == 1) { cs0 = cs[ai][m][0]; cs1 = cs[ai][m][1]; }
                bf16_t* rowp = u.out + (size_t)rl * u.ldo + colb;
#pragma unroll
                for (int bj = 0; bj < 2; ++bj) {
                    f32x4 v0 = acc[ai][bj][m][0], v1 = acc[ai][bj][m][1];
                    if (MODE == 1) {
                        const f32x4 a0 = v0, a1 = v1; const float sc = u.scale;
                        v0.x = (a0.x * cs0.x - a0.y * cs0.y) * sc; v0.y = (a0.y * cs0.x + a0.x * cs0.y) * sc;
                        v0.z = (a0.z * cs0.z - a0.w * cs0.w) * sc; v0.w = (a0.w * cs0.z + a0.z * cs0.w) * sc;
                        v1.x = (a1.x * cs1.x - a1.y * cs1.y) * sc; v1.y = (a1.y * cs1.x + a1.x * cs1.y) * sc;
                        v1.z = (a1.z * cs1.z - a1.w * cs1.w) * sc; v1.w = (a1.w * cs1.z + a1.z * cs1.w) * sc;
                    } else if (MODE == 2) {
#pragma unroll
                        for (int e = 0; e < 4; ++e) { v0[e] = v0[e] * sigmoid_f(v0[e]); v1[e] = v1[e] * sigmoid_f(v1[e]); }
                    } else if (MODE == 3) {
#pragma unroll
                        for (int e = 0; e < 4; ++e) { v0[e] = sigmoid_f(v0[e]); v1[e] = sigmoid_f(v1[e]); }
                    }
                    u32x4 w; w.x = pk2(v0.x, v0.y); w.y = pk2(v0.z, v0.w); w.z = pk2(v1.x, v1.y); w.w = pk2(v1.z, v1.w);
                    *(GAS u32x4*)(rowp + bj * 128) = w;
                }
            }
    }
    DI void operator()(const f32x4 (&acc)[2][2][4][2], const Unit1& u, int wr, int wc, int fr, int fq, int wid, int lane) const {
        if (u.mode == 0) emit<0>(acc, u, wr, wc, fr, fq);
        else if (u.mode == 1) emit<1>(acc, u, wr, wc, fr, fq);
        else if (u.mode == 2) emit<2>(acc, u, wr, wc, fr, fq);
        else emit<3>(acc, u, wr, wc, fr, fq);
    }
};

#define MFMA32(a, b, c) __builtin_amdgcn_mfma_f32_32x32x16_bf16((a), (b), (c), 0, 0, 0)
DI int crow(int reg, int h) { return (reg & 3) + 8 * (reg >> 2) + 4 * h; }
DI s16x4 tr4(LAS const unsigned char* p) { return __builtin_bit_cast(s16x4, __builtin_amdgcn_ds_read_tr16_b64_v4i16((LAS v4i16_t*)p)); }
DI bf16x8 frag_tr(LAS const unsigned char* base, int pitch, int k0, int c0, int lane) {
    const int h = lane >> 5, blk = (lane >> 4) & 1, q = (lane & 15) >> 2, p = lane & 3;
    LAS const unsigned char* a = base + (k0 + 8 * h + q) * pitch + (c0 + 16 * blk + 4 * p) * 2;
    const s16x4 lo = tr4(a), hi = tr4(a + 4 * pitch);
    return __builtin_shufflevector(lo, hi, 0, 1, 2, 3, 4, 5, 6, 7);
}
DI bf16x8 frag_nt(LAS const unsigned char* base, int pitch, int r0, int k0, int lane) {
    return *(LAS const bf16x8*)(base + (r0 + (lane & 31)) * pitch + (k0 + 8 * (lane >> 5)) * 2);
}
DI f32x16 zero16() { f32x16 z;
#pragma unroll
    for (int i = 0; i < 16; ++i) z[i] = 0.f; return z; }
DI u32x4 scale_bf16x8(u32x4 v, float s) {
    u32x4 o; o.x = pk2(bf_lo(v.x) * s, bf_hi(v.x) * s); o.y = pk2(bf_lo(v.y) * s, bf_hi(v.y) * s); o.z = pk2(bf_lo(v.z) * s, bf_hi(v.z) * s); o.w = pk2(bf_lo(v.w) * s, bf_hi(v.w) * s); return o;
}
DI float ret_lg2gamma(int h) { return __builtin_log2f(1.0f - __builtin_exp2f(-5.0f - (float)h)); }

DI void ret_kv_item(const Frame& F, int bh, int n) {
    const int b = bh >> 3, h = bh & 7; const float lg = ret_lg2gamma(h);
    LAS unsigned char* VL = F.lds; LAS unsigned char* KL = F.lds + 128 * 320;
    const bf16_t* RK = (const bf16_t*)(F.ws + WS_RK); const bf16_t* RV = (const bf16_t*)(F.ws + WS_RV);
#pragma unroll
    for (int it = 0; it < 8; ++it) {
        const int idx = F.tid + NTHREADS * it, which = idx >> 11, rem = idx & 2047, row = rem >> 4, ch = rem & 15;
        const size_t tok = (size_t)b * SEQ + n * 128 + row;
        u32x4 v = *(const GAS u32x4*)((which ? RK : RV) + tok * 1024 + h * 128 + ch * 8);
        if (which) v = scale_bf16x8(v, fast_exp2(lg * (float)(127 - row)));
        *(LAS u32x4*)((which ? KL : VL) + row * 320 + ch * 16) = v;
    }
    __syncthreads();
    const int w = F.wave, lane = F.lane, eb = w >> 1, db0 = 2 * (w & 1);
    f32x16 acc0 = zero16(), acc1 = zero16();
#pragma unroll
    for (int s = 0; s < 8; ++s) {
        const bf16x8 a = frag_tr(VL, 320, 16 * s, 32 * eb, lane);
        const bf16x8 b0 = frag_tr(KL, 320, 16 * s, 32 * db0, lane), b1 = frag_tr(KL, 320, 16 * s, 32 * (db0 + 1), lane);
        acc0 = MFMA32(a, b0, acc0); acc1 = MFMA32(a, b1, acc1);
    }
    float* dst = (float*)(F.ws + WS_KVST) + ((size_t)(bh * 16 + n) * 128) * 128;
    const int r = lane & 31, hh = lane >> 5;
#pragma unroll
    for (int reg = 0; reg < 16; ++reg) { const int e = 32 * eb + crow(reg, hh);
        dst[(size_t)e * 128 + 32 * db0 + r] = acc0[reg]; dst[(size_t)e * 128 + 32 * (db0 + 1) + r] = acc1[reg]; }
    __syncthreads();
}

struct DilRegs { u32x4 vst[8], kst[8]; bf16x8 qf[8]; };
DI void dil_issue(const Frame& F, int item, DilRegs& R) {
    const int b = item / 192, rem = item % 192, head = rem >> 4, idx16 = rem & 15;
    const int g = head >> 2, r = (g == 0) ? 1 : (g == 1) ? 4 : 16, nbk = 16 / r, c = idx16 / nbk, n = idx16 % nbk;
    const bf16_t* DQ = (const bf16_t*)(F.ws + WS_DQ); const bf16_t* DK = (const bf16_t*)(F.ws + WS_DK); const bf16_t* DV = (const bf16_t*)(F.ws + WS_DV);
    const size_t tb = (size_t)b * SEQ; const int kbmin = (n == 0) ? 4 : 0;
    const int lane = F.lane, rr = lane & 31, hh = lane >> 5, wq = F.wave & 3;
#pragma unroll
    for (int it = 0; it < 8; ++it) {
        const int idx = F.tid + NTHREADS * it, row = idx >> 4, ch = idx & 15; const int rowl = (row >= 32 * kbmin) ? row : 128 + (row & 127);
        const size_t tok = tb + (size_t)((128 * (n - 1) + rowl) * r + c);
        R.vst[it] = *(const GAS u32x4*)(DV + tok * 1536 + head * 128 + ch * 8);
        R.kst[it] = *(const GAS u32x4*)(DK + tok * 1536 + head * 128 + ch * 8);
    }
    const size_t tokq = tb + (size_t)((128 * n + 32 * wq + rr) * r + c);
    const bf16_t* qp = DQ + tokq * 1536 + head * 128 + 8 * hh;
#pragma unroll
    for (int s = 0; s < 8; ++s) R.qf[s] = *(const GAS bf16x8*)(qp + 16 * s);
}
DI void dil_item(const Frame& F, int item, int nxt, DilRegs& R) {
    const int b = item / 192, rem = item % 192, head = rem >> 4, idx16 = rem & 15;
    const int g = head >> 2, r = (g == 0) ? 1 : (g == 1) ? 4 : 16, nbk = 16 / r, c = idx16 / nbk, n = idx16 % nbk;
    LAS unsigned char* VL = F.lds;
    LAS unsigned char* KL = F.lds + 256 * 320;
    LAS unsigned char* PL = F.lds + 256 * 320;
    LAS float* SMAX = (LAS float*)(F.lds + 256 * 320 + 256 * 272);
    LAS float* SSUM = SMAX + 256;
    bf16_t* DQ = (bf16_t*)(F.ws + WS_DQ);
    const size_t tb = (size_t)b * SEQ;
    const int kbmin = (n == 0) ? 4 : 0;
    const int lane = F.lane, rr = lane & 31, hh = lane >> 5, wq = F.wave & 3, wd = F.wave >> 2;
    const int qi = 32 * wq + rr;
    const size_t tokq = tb + (size_t)((128 * n + qi) * r + c);
#pragma unroll
    for (int it = 0; it < 8; ++it) { const int idx = F.tid + NTHREADS * it, row = idx >> 4, ch = idx & 15;
        if (row >= 32 * kbmin) { *(LAS u32x4*)(VL + row * 320 + ch * 16) = R.vst[it]; *(LAS u32x4*)(KL + row * 272 + ch * 16) = R.kst[it]; } }
    bf16x8 qf[8];
#pragma unroll
    for (int s = 0; s < 8; ++s) qf[s] = R.qf[s];
    __syncthreads();
    f32x16 st[3]; bool val[3]; float mloc = -INFINITY;
#pragma unroll
    for (int sl = 0; sl < 3; ++sl) {
        const int kb = wq + wd + 2 * sl; val[sl] = (kb <= wq + 4) && (kb >= kbmin);
        st[sl] = zero16();
        if (val[sl]) {
#pragma unroll
            for (int s = 0; s < 8; ++s) st[sl] = MFMA32(frag_nt(KL, 272, 32 * kb, 16 * s, lane), qf[s], st[sl]);
#pragma unroll
            for (int reg = 0; reg < 16; ++reg) { const int jj = 32 * kb + crow(reg, hh); const bool ok = (jj >= qi) && (jj <= qi + 128);
                st[sl][reg] = ok ? st[sl][reg] : -INFINITY; mloc = fmaxf(mloc, st[sl][reg]); }
        }
    }
    dil_issue(F, nxt, R);
    mloc = fmaxf(mloc, __shfl_xor(mloc, 32));
    if (hh == 0) SMAX[wd * 128 + qi] = mloc;
    __syncthreads();
    const float mx = fmaxf(SMAX[qi], SMAX[128 + qi]);
    float lloc = 0.f;
#pragma unroll
    for (int sl = 0; sl < 3; ++sl) {
        if (val[sl]) { const int kb = wq + wd + 2 * sl;
#pragma unroll
            for (int reg = 0; reg < 16; ++reg) { const float p = fast_exp2(st[sl][reg] - mx); st[sl][reg] = p; lloc += p; }
#pragma unroll
            for (int g4 = 0; g4 < 4; ++g4) { u32x2 w; w.x = pk2(st[sl][4 * g4], st[sl][4 * g4 + 1]); w.y = pk2(st[sl][4 * g4 + 2], st[sl][4 * g4 + 3]);
                *(LAS u32x2*)(PL + qi * 528 + (32 * kb + 8 * g4 + 4 * hh) * 2) = w; }
        }
    }
    lloc += __shfl_xor(lloc, 32);
    if (hh == 0) SSUM[wd * 128 + qi] = lloc;
    __syncthreads();
    const float lsum = SSUM[qi] + SSUM[128 + qi];
    f32x16 o0 = zero16(), o1 = zero16();
    const int kb_lo = (wq > kbmin) ? wq : kbmin;
    for (int kb = kb_lo; kb <= wq + 4; ++kb) {
#pragma unroll
        for (int s = 0; s < 2; ++s) {
            const bf16x8 pb = frag_nt(PL, 528, 32 * wq, 32 * kb + 16 * s, lane);
            const bf16x8 a0 = frag_tr(VL, 320, 32 * kb + 16 * s, 64 * wd, lane), a1 = frag_tr(VL, 320, 32 * kb + 16 * s, 64 * wd + 32, lane);
            o0 = MFMA32(a0, pb, o0); o1 = MFMA32(a1, pb, o1);
        }
    }
    const float inv = 1.0f / lsum;
    bf16_t* op = DQ + tokq * 1536 + head * 128 + 64 * wd + 4 * hh;
#pragma unroll
    for (int g4 = 0; g4 < 4; ++g4) {
        u32x2 w0, w1; w0.x = pk2(o0[4 * g4] * inv, o0[4 * g4 + 1] * inv); w0.y = pk2(o0[4 * g4 + 2] * inv, o0[4 * g4 + 3] * inv);
        w1.x = pk2(o1[4 * g4] * inv, o1[4 * g4 + 1] * inv); w1.y = pk2(o1[4 * g4 + 2] * inv, o1[4 * g4 + 3] * inv);
        *(GAS u32x2*)(op + 8 * g4) = w0; *(GAS u32x2*)(op + 32 + 8 * g4) = w1;
    }
    if (wd == 0 && hh == 0) ((float*)(F.ws + WS_LSE))[(size_t)head * MT + tokq] = mx + __builtin_log2f(lsum);
    __syncthreads();
}

DI void ph2_mixers_a(const Frame& F) {
    const int vb = (F.G % 8 == 0) ? (F.bid % 8) * (F.G / 8) + F.bid / 8 : F.bid;
    for (int it = vb; it < 1024; it += F.G) ret_kv_item(F, it >> 4, it & 15);
    ISTAMP(F, 40);
    { DilRegs R; if (vb < 1536) dil_issue(F, vb, R);
      for (int it = vb; it < 1536; it += F.G) dil_item(F, it, (it + F.G < 1536) ? it + F.G : it, R); }
}

DI void ret_out_item(const Frame& F, int bh, int n) {
    const int b = bh >> 3, h = bh & 7; const float lg = ret_lg2gamma(h);
    LAS unsigned char* VL = F.lds;
    LAS unsigned char* PL = F.lds + 128 * 320;
    LAS unsigned char* PT = PL + 128 * 272;
    LAS float* SQ = (LAS float*)(PT + 128 * 272);
    bf16_t* RQ = (bf16_t*)(F.ws + WS_RQ); const bf16_t* RK = (const bf16_t*)(F.ws + WS_RK); const bf16_t* RV = (const bf16_t*)(F.ws + WS_RV); const bf16_t* SG = (const bf16_t*)(F.ws + WS_SG);
    const size_t tb = (size_t)b * SEQ + n * 128;
    LAS unsigned char* KL = (LAS unsigned char*)(SQ + 256);
    const int lane = F.lane, rr = lane & 31, hh = lane >> 5, wq = F.wave & 3, we = F.wave >> 2;
    const int qi = 32 * wq + rr;
    u32x4 vst[4], kst[4], pst[4];
    { const bf16_t* pv = (const bf16_t*)(F.dout + DO_PREVT) + (size_t)(bh * 16 + n) * 16384;
#pragma unroll
      for (int it = 0; it < 4; ++it) { const int idx = F.tid + NTHREADS * it, row = idx >> 4, ch = idx & 15;
          vst[it] = *(const GAS u32x4*)(RV + (tb + row) * 1024 + h * 128 + ch * 8);
          kst[it] = *(const GAS u32x4*)(RK + (tb + row) * 1024 + h * 128 + ch * 8);
          pst[it] = *(const GAS u32x4*)(pv + row * 128 + ch * 8); } }
    bf16x8 qf[8];
    { const bf16_t* qp = RQ + (tb + qi) * 1024 + h * 128 + 8 * hh;
#pragma unroll
      for (int s = 0; s < 8; ++s) qf[s] = *(const GAS bf16x8*)(qp + 16 * s); }
#pragma unroll
    for (int it = 0; it < 4; ++it) { const int idx = F.tid + NTHREADS * it, row = idx >> 4, ch = idx & 15;
        *(LAS u32x4*)(VL + row * 320 + ch * 16) = vst[it]; *(LAS u32x4*)(KL + row * 272 + ch * 16) = kst[it]; *(LAS u32x4*)(PT + row * 272 + ch * 16) = pst[it]; }
    __syncthreads();
#pragma unroll
    for (int sl = 0; sl < 2; ++sl) {
        const int kb = we + 2 * sl;
        if (kb <= wq) {
            f32x16 st = zero16();
#pragma unroll
            for (int s = 0; s < 8; ++s) st = MFMA32(frag_nt(KL, 272, 32 * kb, 16 * s, lane), qf[s], st);
#pragma unroll
            for (int reg = 0; reg < 16; ++reg) { const int j = 32 * kb + crow(reg, hh); st[reg] = (j <= qi) ? st[reg] * fast_exp2(lg * (float)(qi - j)) : 0.f; }
#pragma unroll
            for (int g4 = 0; g4 < 4; ++g4) { u32x2 w; w.x = pk2(st[4 * g4], st[4 * g4 + 1]); w.y = pk2(st[4 * g4 + 2], st[4 * g4 + 3]);
                *(LAS u32x2*)(PL + qi * 272 + (32 * kb + 8 * g4 + 4 * hh) * 2) = w; }
        }
    }
    __syncthreads();
    f32x16 in0 = zero16(), in1 = zero16(), cr0 = zero16(), cr1 = zero16();
    for (int kb = 0; kb <= wq; ++kb) {
#pragma unroll
        for (int s = 0; s < 2; ++s) {
            const bf16x8 pb = frag_nt(PL, 272, 32 * wq, 32 * kb + 16 * s, lane);
            const bf16x8 a0 = frag_tr(VL, 320, 32 * kb + 16 * s, 64 * we, lane), a1 = frag_tr(VL, 320, 32 * kb + 16 * s, 64 * we + 32, lane);
            in0 = MFMA32(a0, pb, in0); in1 = MFMA32(a1, pb, in1);
        }
    }
#pragma unroll
    for (int s = 0; s < 8; ++s) {
        const bf16x8 a0 = frag_nt(PT, 272, 64 * we, 16 * s, lane), a1 = frag_nt(PT, 272, 64 * we + 32, 16 * s, lane);
        cr0 = MFMA32(a0, qf[s], cr0); cr1 = MFMA32(a1, qf[s], cr1);
    }
    const float qw = fast_exp2(lg * (float)(qi + 1));
    float ss = 0.f;
#pragma unroll
    for (int reg = 0; reg < 16; ++reg) { in0[reg] += qw * cr0[reg]; in1[reg] += qw * cr1[reg]; ss += in0[reg] * in0[reg] + in1[reg] * in1[reg]; }
    ss += __shfl_xor(ss, 32);
    if (hh == 0) SQ[we * 128 + qi] = ss;
    __syncthreads();
    const float rstd = 1.0f / sqrtf((SQ[qi] + SQ[128 + qi]) * (1.0f / 128.0f) + EPS);
    const size_t off = (tb + qi) * 1024 + h * 128 + 64 * we + 4 * hh;
#pragma unroll
    for (int g4 = 0; g4 < 4; ++g4) {
        const u32x2 g0 = *(const GAS u32x2*)(SG + off + 8 * g4), g1 = *(const GAS u32x2*)(SG + off + 32 + 8 * g4);
        u32x2 w0, w1;
        w0.x = pk2(in0[4 * g4] * rstd * bf_lo(g0.x), in0[4 * g4 + 1] * rstd * bf_hi(g0.x)); w0.y = pk2(in0[4 * g4 + 2] * rstd * bf_lo(g0.y), in0[4 * g4 + 3] * rstd * bf_hi(g0.y));
        w1.x = pk2(in1[4 * g4] * rstd * bf_lo(g1.x), in1[4 * g4 + 1] * rstd * bf_hi(g1.x)); w1.y = pk2(in1[4 * g4 + 2] * rstd * bf_lo(g1.y), in1[4 * g4 + 3] * rstd * bf_hi(g1.y));
        *(GAS u32x2*)(RQ + off + 8 * g4) = w0; *(GAS u32x2*)(RQ + off + 32 + 8 * g4) = w1;
    }
    __syncthreads();
}
DI void ph_scan(const Frame& F) {
    const int gt = F.bid * NTHREADS + F.tid, NGT = F.G * NTHREADS;
    for (int i = gt; i < 64 * 4096; i += NGT) {
        const int bh = i >> 12, c4 = i & 4095; const float cd = fast_exp2(ret_lg2gamma(bh & 7) * 128.0f);
        const float* kv = (const float*)(F.ws + WS_KVST) + (size_t)(bh * 16) * 16384 + c4 * 4;
        bf16_t* pv = (bf16_t*)(F.dout + DO_PREVT) + (size_t)(bh * 16) * 16384 + c4 * 4;
        f32x4 v[16];
#pragma unroll
        for (int n = 0; n < 15; ++n) v[n] = *(const GAS f32x4*)(kv + (size_t)n * 16384);
        f32x4 st = {0.f, 0.f, 0.f, 0.f};
#pragma unroll
        for (int n = 0; n < 16; ++n) { u32x2 w; w.x = pk2(st.x, st.y); w.y = pk2(st.z, st.w); *(GAS u32x2*)(pv + (size_t)n * 16384) = w; if (n < 15) st = st * cd + v[n]; }
    }
}
DI void ph3_mixers_b(const Frame& F) {
    const int vb = (F.G % 8 == 0) ? (F.bid % 8) * (F.G / 8) + F.bid / 8 : F.bid;
    for (int it = vb; it < 1024; it += F.G) ret_out_item(F, it >> 4, it & 15);
    bf16_t* DQ = (bf16_t*)(F.ws + WS_DQ); const float* LSE = (const float*)(F.ws + WS_LSE);
    const int gt = F.bid * NTHREADS + F.tid, NGT = F.G * NTHREADS;
    for (int i = gt; i < MT * 64; i += NGT) {
        const int t = i >> 6, hg = (i >> 4) & 3, ch = i & 15;
        const float l0 = LSE[(size_t)hg * MT + t], l1 = LSE[(size_t)(4 + hg) * MT + t], l2 = LSE[(size_t)(8 + hg) * MT + t];
        const float mx = fmaxf(l0, fmaxf(l1, l2)); float w0 = fast_exp2(l0 - mx), w1 = fast_exp2(l1 - mx), w2 = fast_exp2(l2 - mx);
        const float inv = 1.0f / (w0 + w1 + w2); w0 *= inv; w1 *= inv; w2 *= inv;
        bf16_t* p = DQ + (size_t)t * 1536 + hg * 128 + ch * 8;
        const u32x4 a = *(const GAS u32x4*)p, bq = *(const GAS u32x4*)(p + 512), cq = *(const GAS u32x4*)(p + 1024);
        u32x4 o;
        o.x = pk2(w0 * bf_lo(a.x) + w1 * bf_lo(bq.x) + w2 * bf_lo(cq.x), w0 * bf_hi(a.x) + w1 * bf_hi(bq.x) + w2 * bf_hi(cq.x));
        o.y = pk2(w0 * bf_lo(a.y) + w1 * bf_lo(bq.y) + w2 * bf_lo(cq.y), w0 * bf_hi(a.y) + w1 * bf_hi(bq.y) + w2 * bf_hi(cq.y));
        o.z = pk2(w0 * bf_lo(a.z) + w1 * bf_lo(bq.z) + w2 * bf_lo(cq.z), w0 * bf_hi(a.z) + w1 * bf_hi(bq.z) + w2 * bf_hi(cq.z));
        o.w = pk2(w0 * bf_lo(a.w) + w1 * bf_lo(bq.w) + w2 * bf_lo(cq.w), w0 * bf_hi(a.w) + w1 * bf_hi(bq.w) + w2 * bf_hi(cq.w));
        *(GAS u32x4*)p = o;
    }
}

struct UnitG { const char* A; const char* B; int pm, pn; };
struct SchedG {
    typedef UnitG Unit;
    int G, c, nM, nN; const char* Abase; const char* Bbase; size_t astep, bstep;
    DI bool next(int i, Unit& u) const {
        const int L = i * G + c; if (L >= nM * nN) return false;
        int pm, pn; pg8::tile_of<WGM_MID>(L, nM, nN, pm, pn); u.pm = pm; u.pn = pn;
        u.A = Abase + (size_t)pm * astep; u.B = Bbase + (size_t)pn * bstep; return true;
    }
};
#define EPI_ROWS_BEGIN const int rowl0 = wr * 64 + fr, colb = wc * 32 + 8 * fq; _Pragma("unroll") for (int ai = 0; ai < 2; ++ai) _Pragma("unroll") for (int m = 0; m < 4; ++m) { const int rl = ai * 128 + m * 16 + rowl0;
#define EPI_ROWS_END }
DI u32x4 pack8(const f32x4 v0, const f32x4 v1) { u32x4 w; w.x = pk2(v0.x, v0.y); w.y = pk2(v0.z, v0.w); w.z = pk2(v1.x, v1.y); w.w = pk2(v1.z, v1.w); return w; }
DI void unpack8(const u32x4 w, f32x4& v0, f32x4& v1) { v0 = (f32x4){bf_lo(w.x), bf_hi(w.x), bf_lo(w.y), bf_hi(w.y)}; v1 = (f32x4){bf_lo(w.z), bf_hi(w.z), bf_lo(w.w), bf_hi(w.w)}; }

template <int PASS> struct EpiMerge {
    bf16_t* GR; bf16_t* GD;
    DI void operator()(const f32x4 (&acc)[2][2][4][2], const UnitG& u, int wr, int wc, int fr, int fq, int wid, int lane) const {
        const int rowl0 = wr * 64 + fr, colb = wc * 32 + 8 * fq;
        const size_t base = (size_t)(u.pm * 256 + rowl0) * 2048 + u.pn * 256 + colb;
#pragma unroll
        for (int ai = 0; ai < 2; ++ai) {
            u32x4 gr[4][2], gd[4][2];
#pragma unroll
            for (int m = 0; m < 4; ++m)
#pragma unroll
                for (int bj = 0; bj < 2; ++bj) { const size_t off = base + (size_t)(ai * 128 + m * 16) * 2048 + bj * 128;
                    gr[m][bj] = *(const GAS u32x4*)(GR + off); if (PASS == 1) gd[m][bj] = *(const GAS u32x4*)(GD + off); }
#pragma unroll
            for (int m = 0; m < 4; ++m)
#pragma unroll
                for (int bj = 0; bj < 2; ++bj) { const size_t off = base + (size_t)(ai * 128 + m * 16) * 2048 + bj * 128;
                    f32x4 g0, g1; unpack8(gr[m][bj], g0, g1);
                    if (PASS == 0) *(GAS u32x4*)(GR + off) = pack8(g0 * acc[ai][bj][m][0], g1 * acc[ai][bj][m][1]);
                    else { f32x4 d0, d1; unpack8(gd[m][bj], d0, d1); *(GAS u32x4*)(GD + off) = pack8(g0 + d0 * acc[ai][bj][m][0], g1 + d1 * acc[ai][bj][m][1]); } }
        }
    }
};
template <bool F32IN> struct EpiResid {
    const float* xf; bf16_t* XB; float* SSQ;
    DI void operator()(const f32x4 (&acc)[2][2][4][2], const UnitG& u, int wr, int wc, int fr, int fq, int wid, int lane) const {
        const int rowl0 = wr * 64 + fr, colb = wc * 32 + 8 * fq;
        const size_t trow = (size_t)(u.pm * 256 + rowl0); const size_t base = trow * 2048 + u.pn * 256 + colb;
#pragma unroll
        for (int ai = 0; ai < 2; ++ai) {
            f32x4 xo[4][2][2];
#pragma unroll
            for (int m = 0; m < 4; ++m)
#pragma unroll
                for (int bj = 0; bj < 2; ++bj) { const size_t off = base + (size_t)(ai * 128 + m * 16) * 2048 + bj * 128;
                    if (F32IN) { xo[m][bj][0] = *(const GAS f32x4*)(xf + off); xo[m][bj][1] = *(const GAS f32x4*)(xf + off + 4); }
                    else unpack8(*(const GAS u32x4*)(XB + off), xo[m][bj][0], xo[m][bj][1]); }
#pragma unroll
            for (int m = 0; m < 4; ++m) { float ss = 0.f;
#pragma unroll
                for (int bj = 0; bj < 2; ++bj) { const size_t off = base + (size_t)(ai * 128 + m * 16) * 2048 + bj * 128;
                    const f32x4 y0 = xo[m][bj][0] + acc[ai][bj][m][0], y1 = xo[m][bj][1] + acc[ai][bj][m][1];
                    *(GAS u32x4*)(XB + off) = pack8(y0, y1);
                    ss += (y0.x * y0.x + y0.y * y0.y) + (y0.z * y0.z + y0.w * y0.w) + (y1.x * y1.x + y1.y * y1.y) + (y1.z * y1.z + y1.w * y1.w); }
                ss += __shfl_xor(ss, 16); ss += __shfl_xor(ss, 32);
                if (fq == 0) SSQ[(trow + ai * 128 + m * 16) * 32 + u.pn * 4 + wc] = ss; }
        }
    }
};
struct EpiRowScale {
    const float* SSQ; bf16_t* out; float scale;
    DI void operator()(const f32x4 (&acc)[2][2][4][2], const UnitG& u, int wr, int wc, int fr, int fq, int wid, int lane) const {
        const int rowl0 = wr * 64 + fr, colb = wc * 32 + 8 * fq;
        const size_t trow = (size_t)(u.pm * 256 + rowl0);
        f32x4 p[2][4][2];
#pragma unroll
        for (int ai = 0; ai < 2; ++ai)
#pragma unroll
            for (int m = 0; m < 4; ++m) { const float* sp = SSQ + (trow + ai * 128 + m * 16) * 32 + fq * 8; p[ai][m][0] = *(const GAS f32x4*)sp; p[ai][m][1] = *(const GAS f32x4*)(sp + 4); }
#pragma unroll
        for (int ai = 0; ai < 2; ++ai)
#pragma unroll
            for (int m = 0; m < 4; ++m) {
                const f32x4 p0 = p[ai][m][0], p1 = p[ai][m][1];
                float ss = (p0.x + p0.y) + (p0.z + p0.w) + (p1.x + p1.y) + (p1.z + p1.w);
                ss += __shfl_xor(ss, 16); ss += __shfl_xor(ss, 32);
                const float sc = scale / sqrtf(ss * (1.0f / 2048.0f) + EPS);
                bf16_t* rowp = out + (trow + ai * 128 + m * 16) * 2048 + u.pn * 256 + colb;
#pragma unroll
                for (int bj = 0; bj < 2; ++bj) *(GAS u32x4*)(rowp + bj * 128) = pack8(acc[ai][bj][m][0] * sc, acc[ai][bj][m][1] * sc);
            }
    }
};
struct EpiNull {
    DI void operator()(const f32x4 (&acc)[2][2][4][2], const UnitG& u, int wr, int wc, int fr, int fq, int wid, int lane) const {
#pragma unroll
        for (int ai = 0; ai < 2; ++ai)
#pragma unroll
            for (int bj = 0; bj < 2; ++bj)
#pragma unroll
                for (int m = 0; m < 4; ++m) { asm volatile("" :: "v"(acc[ai][bj][m][0]), "v"(acc[ai][bj][m][1])); }
    }
};
struct Sched7 {
    typedef UnitG Unit; int G, c; const char* QM; const char* KM;
    DI bool next(int i, Unit& u) const {
        const int L0 = i * G + c; if (L0 >= 256) return false;
        const int L = (L0 & 7) * 32 + (L0 >> 3);
        const int bh = L >> 3, pm = L & 7, b = bh >> 2, hd = bh & 3; u.pm = L; u.pn = 0;
        u.A = QM + ((size_t)(b * SEQ + pm * 256) * 2048 + hd * 512) * 2; u.B = KM + ((size_t)(b * MEMT) * 2048 + hd * 512) * 2; return true;
    }
};
struct EpiSoftmax {
    bf16_t* P; LAS float* X;
    DI void operator()(f32x4 (&acc)[2][2][4][2], const UnitG& u, int wr, int wc, int fr, int fq, int wid, int lane) const {
        LAS float* MX = X; LAS float* SM = X + 1024;
        EPI_ROWS_BEGIN
            float mx = -INFINITY;
#pragma unroll
            for (int bj = 0; bj < 2; ++bj)
#pragma unroll
                for (int n = 0; n < 2; ++n) { const f32x4 v = acc[ai][bj][m][n]; mx = fmaxf(mx, fmaxf(fmaxf(v.x, v.y), fmaxf(v.z, v.w))); }
            mx = fmaxf(mx, __shfl_xor(mx, 16)); mx = fmaxf(mx, __shfl_xor(mx, 32));
            if (fq == 0) MX[rl * 4 + wc] = mx;
        EPI_ROWS_END
        asm volatile("s_waitcnt lgkmcnt(0)" ::: "memory"); __builtin_amdgcn_s_barrier(); asm volatile("" ::: "memory");
        {
        EPI_ROWS_BEGIN
            const f32x4 q = *(LAS f32x4*)(MX + rl * 4); const float mx = fmaxf(fmaxf(q.x, q.y), fmaxf(q.z, q.w));
            float s = 0.f;
#pragma unroll
            for (int bj = 0; bj < 2; ++bj)
#pragma unroll
                for (int n = 0; n < 2; ++n) { f32x4 v = acc[ai][bj][m][n]; v.x = fast_exp2(v.x - mx); v.y = fast_exp2(v.y - mx); v.z = fast_exp2(v.z - mx); v.w = fast_exp2(v.w - mx);
                    acc[ai][bj][m][n] = v; s += (v.x + v.y) + (v.z + v.w); }
            s += __shfl_xor(s, 16); s += __shfl_xor(s, 32);
            if (fq == 0) SM[rl * 4 + wc] = s;
        EPI_ROWS_END
        }
        asm volatile("s_waitcnt lgkmcnt(0)" ::: "memory"); __builtin_amdgcn_s_barrier(); asm volatile("" ::: "memory");
        {
        EPI_ROWS_BEGIN
            const f32x4 q = *(LAS f32x4*)(SM + rl * 4); const float inv = 1.0f / ((q.x + q.y) + (q.z + q.w));
            bf16_t* rowp = P + (size_t)(u.pm * 256 + rl) * 256 + colb;
#pragma unroll
            for (int bj = 0; bj < 2; ++bj) *(GAS u32x4*)(rowp + bj * 128) = pack8(acc[ai][bj][m][0] * inv, acc[ai][bj][m][1] * inv);
        EPI_ROWS_END
        }
        asm volatile("s_waitcnt lgkmcnt(0)" ::: "memory"); __builtin_amdgcn_s_barrier(); asm volatile("" ::: "memory");
    }
};
struct Sched8 {
    typedef UnitG Unit; int G, c; const char* P; const char* VT;
    DI bool next(int i, Unit& u) const {
        const int L0 = i * G + c; if (L0 >= 512) return false;
        const int L = (L0 & 7) * 64 + (L0 >> 3);
        const int pn = L & 1, l2 = L >> 1, bh = l2 >> 3, pm = l2 & 7, b = bh >> 2, hd = bh & 3;
        u.pm = b * 8 + pm; u.pn = hd * 2 + pn;
        u.A = P + (size_t)(l2 * 256) * 256 * 2; u.B = VT + ((size_t)(hd * 512 + pn * 256) * 2048 + b * MEMT) * 2; return true;
    }
};
struct EpiPlain {
    bf16_t* out; int ldo;
    DI void operator()(const f32x4 (&acc)[2][2][4][2], const UnitG& u, int wr, int wc, int fr, int fq, int wid, int lane) const {
        EPI_ROWS_BEGIN
            bf16_t* rowp = out + (size_t)(u.pm * 256 + rl) * ldo + u.pn * 256 + colb;
#pragma unroll
            for (int bj = 0; bj < 2; ++bj) *(GAS u32x4*)(rowp + bj * 128) = pack8(acc[ai][bj][m][0], acc[ai][bj][m][1]);
        EPI_ROWS_END
    }
};

constexpr float PEER_US = 128.0f, PEER_VS = 16.0f;
DI unsigned sortable(float v) { const unsigned b = __builtin_bit_cast(unsigned, v); return (b & 0x80000000u) ? ~b : (b | 0x80000000u); }
DI float unsortable(unsigned s) { const unsigned b = (s & 0x80000000u) ? (s & 0x7fffffffu) : ~s; return __builtin_bit_cast(float, b); }
#define PEER_CANDS(X) \
    X(0,0) X(0,1) X(0,2) X(0,3) X(0,4) X(0,5) X(0,6) X(0,7) X(0,8) X(0,9) X(0,10) X(0,11) X(0,12) X(0,13) X(0,14) X(0,15) \
    X(1,0) X(1,1) X(1,2) X(1,3) X(1,4) X(1,5) X(1,6) X(1,7) X(2,0) X(2,1) X(2,2) X(2,3) X(2,4) X(3,0) X(3,1) X(3,2) X(3,3) \
    X(4,0) X(4,1) X(4,2) X(5,0) X(5,1) X(6,0) X(6,1) X(7,0) X(7,1) X(8,0) X(9,0) X(10,0) X(11,0) X(12,0) X(13,0) X(14,0) X(15,0)
#define X(a, b) (unsigned char)((a) * 16 + (b)),
static __device__ const unsigned char peer_ab[50] = { PEER_CANDS(X) };
#undef X
DI void cmpex_desc(unsigned& a, unsigned& b) { const unsigned mx = a > b ? a : b, mn = a > b ? b : a; a = mx; b = mn; }
template <int BASE> DI void sort16_desc(unsigned (&k)[64]) {
#pragma unroll
    for (int size = 2; size <= 16; size <<= 1)
#pragma unroll
        for (int stride = size >> 1; stride > 0; stride >>= 1)
#pragma unroll
            for (int i = 0; i < 16; ++i) { const int l = i ^ stride;
                if (l > i) { if ((i & size) == 0) cmpex_desc(k[BASE + i], k[BASE + l]); else cmpex_desc(k[BASE + l], k[BASE + i]); } }
}
template <int A, int B> DI void merge_top16(unsigned (&k)[64]) {
#pragma unroll
    for (int i = 0; i < 16; ++i) k[A + i] = (k[A + i] > k[B + 15 - i]) ? k[A + i] : k[B + 15 - i];
#pragma unroll
    for (int stride = 8; stride > 0; stride >>= 1)
#pragma unroll
        for (int i = 0; i < 16; ++i) { const int l = i ^ stride; if (l > i) cmpex_desc(k[A + i], k[A + l]); }
}
DI void top16_of_64(unsigned (&k)[64]) {
    sort16_desc<0>(k); sort16_desc<16>(k); sort16_desc<32>(k); sort16_desc<48>(k);
    merge_top16<0, 16>(k); merge_top16<32, 48>(k); merge_top16<0, 32>(k);
}
DI void route_pass(const Frame& F, int tg, int h, LAS unsigned* topL  ) {
    const int lane = F.lane, rr = lane & 31, hh = lane >> 5; const size_t tok = (size_t)tg * 32 + rr;
    const bf16_t* PQ = (const bf16_t*)(F.ws + WS_PQ); const bf16_t* SUBK = (const bf16_t*)(F.ws + WS_SUBK);
#pragma unroll 1
    for (int p = 0; p < 2; ++p) {
        bf16x8 qf[8];
        { const bf16_t* qp = PQ + tok * 2048 + (2 * h + p) * 128 + 8 * hh;
#pragma unroll
          for (int s = 0; s < 8; ++s) qf[s] = *(const GAS bf16x8*)(qp + 16 * s); }
        unsigned key[64];
        bf16x8 kfr[4][8];
#pragma unroll
        for (int nb = 0; nb < 4; ++nb) { const bf16_t* kp = SUBK + ((size_t)((2 * h + p) * 128 + 32 * nb + rr)) * 128 + 8 * hh;
#pragma unroll
            for (int s = 0; s < 8; ++s) kfr[nb][s] = *(const GAS bf16x8*)(kp + 16 * s); }
        __builtin_amdgcn_sched_barrier(0);
#pragma unroll
        for (int nb = 0; nb < 4; ++nb) {
            f32x16 acc = zero16();
#pragma unroll
            for (int s = 0; s < 8; ++s) acc = MFMA32(kfr[nb][s], qf[s], acc);
#pragma unroll
            for (int reg = 0; reg < 16; ++reg) { const int n = 32 * nb + crow(reg, hh); key[nb * 16 + reg] = (sortable(acc[reg]) & ~0x7fu) | (unsigned)(127 - n); }
        }
        top16_of_64(key);
        unsigned oth[16];
#pragma unroll
        for (int i = 0; i < 16; ++i) oth[i] = __shfl_xor(key[i], 32);
#pragma unroll
        for (int i = 0; i < 16; ++i) key[i] = (key[i] > oth[15 - i]) ? key[i] : oth[15 - i];
#pragma unroll
        for (int stride = 8; stride > 0; stride >>= 1)
#pragma unroll
            for (int i = 0; i < 16; ++i) { const int l = i ^ stride; if (l > i) cmpex_desc(key[i], key[l]); }
#pragma unroll
        for (int i = 0; i < 16; ++i) topL[(p * 16 + i) * 64 + lane] = key[i];
    }
    LDS_WAIT();
    unsigned ck[64];
    { float v1[16], v2[16];
#pragma unroll
      for (int k = 0; k < 16; ++k) { v1[k] = unsortable(topL[k * 64 + lane] & ~0x7fu); v2[k] = unsortable(topL[(16 + k) * 64 + lane] & ~0x7fu); }
      int k = 0;
#define X(a, b) ck[k] = (sortable(v1[a] + v2[b]) & ~0x3fu) | (unsigned)(63 - k); ++k;
      PEER_CANDS(X)
#undef X
#pragma unroll
      for (int i = 50; i < 64; ++i) ck[i] = 0u;
    }
    top16_of_64(ck);
    LDS_WAIT();
    float cv[16]; unsigned ce[16];
#pragma unroll
    for (int k = 0; k < 16; ++k) {
        const unsigned m = ck[k]; cv[k] = unsortable(m & ~0x3fu);
        const unsigned ab = peer_ab[63u - (m & 63u)];
        const unsigned i1 = 127u - (topL[(ab >> 4) * 64 + lane] & 0x7fu), i2 = 127u - (topL[(16 + (ab & 15u)) * 64 + lane] & 0x7fu);
        ce[k] = i1 * 128u + i2;
    }
    const float cmax = cv[0]; float gs = 0.f;
#pragma unroll
    for (int k = 0; k < 16; ++k) { cv[k] = fast_exp2((cv[k] - cmax) * 1.4426950408889634f); gs += cv[k]; }
    const float ginv = 1.0f / gs;
    if (hh == 0) {
        unsigned* ep = (unsigned*)(F.ws + WS_EIDX) + tok * 128 + h * 16; float* gp = (float*)(F.ws + WS_GATE) + tok * 128 + h * 16;
#pragma unroll
        for (int k = 0; k < 16; k += 4) { *(GAS u32x4*)(ep + k) = (u32x4){ce[k], ce[k + 1], ce[k + 2], ce[k + 3]}; *(GAS f32x4*)(gp + k) = (f32x4){cv[k] * ginv, cv[k + 1] * ginv, cv[k + 2] * ginv, cv[k + 3] * ginv}; }
    }
    LDS_WAIT();
}
DI void ph11_route(const Frame& F, const Args& a) {
    const int gw = F.bid * NWAVES + F.wave, NGW = F.G * NWAVES;
    LAS unsigned* topL = (LAS unsigned*)(F.lds + F.wave * 8192);
    for (int it = gw; it < 512 * 8; it += NGW) route_pass(F, it >> 3, it & 7, topL);
    ISTAMP(F, 41);
    const int gt = F.bid * NTHREADS + F.tid, NGT = F.G * NTHREADS;
    const GAS f32x4* gf = (const GAS f32x4*)a.in[I_GFFN];
    for (int i0 = gt; i0 < 16384 * 128; i0 += 2 * NGT) {
        f32x4 uu[2][4], vv[2][4], gg[2][4];
#pragma unroll
        for (int t = 0; t < 2; ++t) { const int ir = i0 + t * NGT, i = (ir < 16384 * 128) ? ir : i0, c = i & 127;
            const GAS f32x4* su = (const GAS f32x4*)a.in[I_PU] + 4 * (size_t)i; const GAS f32x4* sv = (const GAS f32x4*)a.in[I_PV] + 4 * (size_t)i;
#pragma unroll
            for (int q = 0; q < 4; ++q) { uu[t][q] = su[q]; vv[t][q] = sv[q]; gg[t][q] = gf[4 * c + q]; } }
#pragma unroll
        for (int t = 0; t < 2; ++t) { const int i = i0 + t * NGT, e = i >> 7, c = i & 127, sl = c >> 3, j = c & 7;
            u32x4 ou, ov;
#pragma unroll
            for (int q = 0; q < 4; ++q) { const f32x4 u = uu[t][q] * gg[t][q] * PEER_US; const f32x4 v = vv[t][q] * PEER_VS;
                int pu = __builtin_amdgcn_cvt_pk_fp8_f32(u.x, u.y, 0, false); pu = __builtin_amdgcn_cvt_pk_fp8_f32(u.z, u.w, pu, true);
                int pv = __builtin_amdgcn_cvt_pk_fp8_f32(v.x, v.y, 0, false); pv = __builtin_amdgcn_cvt_pk_fp8_f32(v.z, v.w, pv, true);
                ou[q] = (unsigned)pu; ov[q] = (unsigned)pv; }
            const size_t dst = ((size_t)(sl * 16384 + e) * 128 + 16 * j);
            if (i < 16384 * 128) { *(GAS u32x4*)(F.ws + WS_UTAB + dst) = ou; *(GAS u32x4*)(F.ws + WS_VTAB + dst) = ov; } }
    }
}

DI float gelu_erf(float v) {
    const float av = fabsf(v), t = fast_rcp(av * 0.2316418882f + 1.0f);
    float q = t * 0.5307027145f + (-0.7265760135f); q = q * t + 0.7107068705f; q = q * t + (-0.142248368f); q = q * t + 0.127414796f; q = q * t;
    const float e = fast_exp2((v * v) * (-0.72134752044f)); const float m = v * (q * e);
    return v < 0.f ? m : v - m;
}
template <int CTRL> DI float dpp_f(float v) { return __builtin_bit_cast(float, __builtin_amdgcn_update_dpp(0, __builtin_bit_cast(int, v), CTRL, 0xf, 0xf, false)); }
DI float sum8(float d) { d += dpp_f<0xB1>(d); d += dpp_f<0x4E>(d); d += dpp_f<0x141>(d); return d; }
struct PeerBatch { u32x4 r[8]; };
struct PeerOffs { unsigned o[8]; };
DI void peer_offs(PeerOffs& O, LAS const int* el  , unsigned loff  ) {
#pragma unroll
    for (int ii = 0; ii < 8; ++ii) O.o[ii] = (unsigned)el[8 * ii] + loff;
}
DI void peer_issue(PeerBatch& B, const unsigned char* tb  , const PeerOffs& O) {
#pragma unroll
    for (int ii = 0; ii < 8; ++ii) B.r[ii] = *(const GAS u32x4*)(tb + O.o[ii]);
}

template <int VAR> DI void peer_u_pass(const Frame& F, LAS float* PD, LAS const int* elw, const unsigned char* U8, const bf16_t* XB, size_t tok0, int tl0) {
    const int lane = F.lane, g = lane >> 3, j = lane & 7;
        {
            const unsigned char* ub0 = U8; const unsigned loff = 16u * (unsigned)j; const bf16_t* xb0 = XB + tok0 * 2048 + 16 * j;
            PeerBatch Ba, Bb;
            LAS unsigned char* XS = F.lds + 81920 + F.wave * 4096;
            const bf16_t* xq_src = XB + (tok0 + (lane >> 3)) * 2048 + 16 * (lane & 7);
            u32x4 xq0 = *(const GAS u32x4*)xq_src, xq1 = *(const GAS u32x4*)(xq_src + 8);
#define U_COMPUTE(B, b) do { \
                const u32x4 xc0 = *(LAS const u32x4*)(xs_), xc1 = *(LAS const u32x4*)(xs_ + 16); \
                const unsigned xw_[8] = {xc0.x, xc0.y, xc0.z, xc0.w, xc1.x, xc1.y, xc1.z, xc1.w};        \
                float d_[8]; \
                _Pragma("unroll") for (int ii = 0; ii < 8; ++ii) d_[ii] = 0.f; \
                _Pragma("unroll") for (int q = 0; q < 4; ++q) { \
                    _Pragma("unroll") for (int ii = 0; ii < 8; ++ii) d_[ii] = __builtin_amdgcn_fdot2_f32_bf16(__builtin_amdgcn_cvt_scalef32_pk_bf16_fp8((int)(B).r[ii][q], 1.0f, false), __builtin_bit_cast(bf16x2_t, xw_[2 * q]), d_[ii], false); \
                    _Pragma("unroll") for (int ii = 0; ii < 8; ++ii) d_[ii] = __builtin_amdgcn_fdot2_f32_bf16(__builtin_amdgcn_cvt_scalef32_pk_bf16_fp8((int)(B).r[ii][q], 1.0f, true), __builtin_bit_cast(bf16x2_t, xw_[2 * q + 1]), d_[ii], false); } \
                  \
                float e_[4]; _Pragma("unroll") for (int m = 0; m < 4; ++m) { const float snd = bit0 ? d_[m] : d_[4 + m]; e_[m] = (bit0 ? d_[4 + m] : d_[m]) + dpp_f<0xB1>(snd); } \
                float f_[2]; _Pragma("unroll") for (int m = 0; m < 2; ++m) { const float snd = bit1 ? e_[m] : e_[2 + m]; f_[m] = (bit1 ? e_[2 + m] : e_[m]) + dpp_f<0x4E>(snd); } \
                const float snd_ = bit2 ? f_[0] : f_[1]; const float mine_ = (bit2 ? f_[1] : f_[0]) + __shfl_xor(snd_, 4); \
                if (VAR == 2) { asm volatile("" :: "v"(mine_)); } else PD[tl0 * 128 + 64 * (b) + 8 * jrev + g] += mine_; } while (0)
            const bool bit0 = (lane & 1) != 0, bit1 = (lane & 2) != 0, bit2 = (lane & 4) != 0; const int jrev = ((lane & 1) << 2) | (lane & 2) | ((lane >> 2) & 1);
            PeerBatch Bc, Bd;
            PeerOffs PO;
#define U_OFFS(fb) do { const int fb_ = ((fb) < 255) ? (fb) : 255; peer_offs(PO, elw + 64 * (fb_ & 15), loff); } while (0)
#define U_ISSUE(B, fb) do { const int fb_ = ((fb) < 255) ? (fb) : 255; peer_issue(B, ub0 + (size_t)(fb_ >> 4) * (16384 * 128), PO); U_OFFS((fb) + 1); } while (0)
#define U_STEP(B, fb, Bn, fbn) do { \
                U_ISSUE(Bn, fbn); \
                __builtin_amdgcn_sched_barrier(0); \
                LAS const unsigned char* xs_ = XS + (((fb) >> 4) & 1) * 2048 + ((((fb) >> 1) & 7) * 8 + j) * 32; \
                if (VAR == 3) { _Pragma("unroll") for (int ii = 0; ii < 8; ++ii) asm volatile("" :: "v"((B).r[ii])); } else U_COMPUTE(B, (fb) & 15); \
                __builtin_amdgcn_sched_barrier(0); } while (0)
            U_OFFS(0); U_ISSUE(Ba, 0); U_ISSUE(Bb, 1); U_ISSUE(Bc, 2);
#pragma unroll 1
            for (int fb = 0; fb < 256; fb += 4) {
                if ((fb & 15) == 0) { const int sl = fb >> 4;
                    *(LAS u32x4*)(XS + (sl & 1) * 2048 + lane * 32) = xq0; *(LAS u32x4*)(XS + (sl & 1) * 2048 + lane * 32 + 16) = xq1;
                    if (VAR != 1 && VAR != 3) { const bf16_t* xp = xq_src + 128 * ((sl < 15) ? sl + 1 : 15); xq0 = *(const GAS u32x4*)xp; xq1 = *(const GAS u32x4*)(xp + 8); }
                }
                U_STEP(Ba, fb, Bd, fb + 3);
                U_STEP(Bb, fb + 1, Ba, fb + 4);
                U_STEP(Bc, fb + 2, Bb, fb + 5);
                U_STEP(Bd, fb + 3, Bc, fb + 6);
            }
#undef U_STEP
#undef U_ISSUE
#undef U_OFFS
#undef U_COMPUTE
        }
}
DI void ph12_peer(const Frame& F, const Args& a) {
    LAS int* EL = (LAS int*)F.lds;
    LAS float* PD = (LAS float*)(F.lds + 32768);
    LAS float* SSL = (LAS float*)(F.lds + 65536);
    LAS unsigned* WB = (LAS unsigned*)(F.lds + 114688);
    const int lane = F.lane, g = lane >> 3, j = lane & 7;
    const bf16_t* XB = (const bf16_t*)(F.ws + WS_XB); bf16_t* XBw = (bf16_t*)(F.ws + WS_XB);
    const unsigned char* U8 = F.ws + WS_UTAB; const unsigned char* V8 = F.ws + WS_VTAB;
    for (int blk = F.bid; blk < MT / 64; blk += F.G) {
        const int tl0 = 8 * F.wave; const size_t tok0 = (size_t)blk * 64 + tl0;
        { int e0[8], e1[8];
#pragma unroll
          for (int tk = 0; tk < 8; ++tk) { const int* ep = (const int*)(F.ws + WS_EIDX) + (tok0 + tk) * 128; e0[tk] = ep[lane]; e1[tk] = ep[64 + lane]; }
#pragma unroll
          for (int tk = 0; tk < 8; ++tk) {
            EL[(tl0 + tk) * 128 + lane] = e0[tk] * 128; EL[(tl0 + tk) * 128 + 64 + lane] = e1[tk] * 128;
            PD[(tl0 + tk) * 128 + lane] = 0.f; PD[(tl0 + tk) * 128 + 64 + lane] = 0.f; SSL[(tl0 + tk) * 64 + lane] = 0.f; } }
        LDS_WAIT();
        LAS const int* elw = EL + tl0 * 128 + g;
        peer_u_pass<0>(F, PD, elw, U8, XB, tok0, tl0);
#if PROBE_PHASE >= 30 && PROBE_PHASE <= 33
        LDS_WAIT(); __syncthreads(); ISTAMP(F, 29);
        peer_u_pass<PROBE_PHASE - 30>(F, (LAS float*)(F.lds + 131072), elw, U8, XB, tok0, tl0);
        LDS_WAIT(); __syncthreads(); ISTAMP(F, PROBE_PHASE);
#endif
        LDS_WAIT(); ISTAMP(F, 20);
#pragma unroll 1
        for (int tk = 0; tk < 8; ++tk) {
            const size_t tok = tok0 + tk;
            const float ssq = wave_sum((lane < 32) ? ((const float*)(F.ws + WS_SSQ2))[tok * 32 + lane] : 0.f);
            const float sc = (1.0f / PEER_US) / sqrtf(ssq * (1.0f / 2048.0f) + EPS);
            const float* gp = (const float*)(F.ws + WS_GATE) + tok * 128;
            LAS float* pd = PD + (tl0 + tk) * 128;
            const float w0 = gp[lane] * gelu_erf(pd[lane] * sc), w1 = gp[64 + lane] * gelu_erf(pd[64 + lane] * sc);
            pd[lane] = w0 * (1.0f / PEER_VS); pd[64 + lane] = w1 * (1.0f / PEER_VS);
            LDS_WAIT();
            { const int k1 = 16 * (lane >> 3) + (lane & 7); WB[(tl0 + tk) * 64 + lane] = pk2(pd[k1], pd[k1 + 8]); }
        }
        LDS_WAIT(); ISTAMP(F, 21);
        LAS const unsigned* pww = WB + tl0 * 64 + g;
        {
            const unsigned char* vb0 = V8; const unsigned loff = 16u * (unsigned)j;
            PeerBatch Ba, Bb;
            float y[16];
#define V_COMPUTE(B, b) do { \
                LAS const unsigned* pw_ = pww + 32 * (b); \
                _Pragma("unroll") for (int mm = 0; mm < 4; ++mm) { const bf16x2_t w2_ = __builtin_bit_cast(bf16x2_t, pw_[8 * mm]); \
                    _Pragma("unroll") for (int q = 0; q < 4; ++q) { \
                        const unsigned pa_ = __builtin_amdgcn_perm((B).r[2 * mm + 1][q], (B).r[2 * mm][q], 0x05010400u), pb_ = __builtin_amdgcn_perm((B).r[2 * mm + 1][q], (B).r[2 * mm][q], 0x07030602u); \
                        y[4 * q + 0] = __builtin_amdgcn_fdot2_f32_bf16(__builtin_amdgcn_cvt_scalef32_pk_bf16_fp8((int)pa_, 1.0f, false), w2_, y[4 * q + 0], false); \
                        y[4 * q + 1] = __builtin_amdgcn_fdot2_f32_bf16(__builtin_amdgcn_cvt_scalef32_pk_bf16_fp8((int)pa_, 1.0f, true), w2_, y[4 * q + 1], false); \
                        y[4 * q + 2] = __builtin_amdgcn_fdot2_f32_bf16(__builtin_amdgcn_cvt_scalef32_pk_bf16_fp8((int)pb_, 1.0f, false), w2_, y[4 * q + 2], false); \
                        y[4 * q + 3] = __builtin_amdgcn_fdot2_f32_bf16(__builtin_amdgcn_cvt_scalef32_pk_bf16_fp8((int)pb_, 1.0f, true), w2_, y[4 * q + 3], false); } } } while (0)
            PeerBatch Bc, Bd;
            PeerOffs PO;
#define V_OFFS(fb) do { const int fb_ = ((fb) < 255) ? (fb) : 255; peer_offs(PO, elw + 64 * (fb_ & 15), loff); } while (0)
#define V_ISSUE(B, fb) do { const int fb_ = ((fb) < 255) ? (fb) : 255; peer_issue(B, vb0 + (size_t)(fb_ >> 4) * (16384 * 128), PO); V_OFFS((fb) + 1); } while (0)
#define V_STEP(B, fb, Bn, fbn) do { \
                V_ISSUE(Bn, fbn); \
                __builtin_amdgcn_sched_barrier(0); \
                V_COMPUTE(B, (fb) & 15); \
                __builtin_amdgcn_sched_barrier(0); } while (0)
#define V_FINISH(fb, xw) do { const int tk = ((fb) >> 1) & 7, sl = (fb) >> 4; \
                float z[8]; \
                _Pragma("unroll") for (int q = 0; q < 8; ++q) {            \
                    float a0 = y[q], b0 = y[8 + q]; \
                    asm volatile("v_nop\n\tv_nop\n\tv_permlane32_swap_b32 %0, %1" : "+v"(a0), "+v"(b0)); \
                    z[q] = a0 + b0; } \
                float qq[4]; \
                { const bool up = (lane & 16) != 0; \
                  _Pragma("unroll") for (int q = 0; q < 4; ++q) { const float snd = up ? z[q] : z[4 + q]; qq[q] = (up ? z[4 + q] : z[q]) + __shfl_xor(snd, 16); } } \
                f32x2 p; \
                { const bool up = (lane & 8) != 0; \
                  const float s0 = up ? qq[0] : qq[2], s1 = up ? qq[1] : qq[3]; p.x = (up ? qq[2] : qq[0]) + dpp_f<0x128>(s0); p.y = (up ? qq[3] : qq[1]) + dpp_f<0x128>(s1); } \
                const size_t eo = (tok0 + tk) * 2048 + 128 * sl + 16 * j + 2 * g; \
                const f32x2 x3 = (f32x2){bf_lo(xw), bf_hi(xw)} + p; \
                *(GAS unsigned*)(XBw + eo) = pk2(x3.x, x3.y);        \
                SSL[(tl0 + tk) * 64 + lane] += x3.x * x3.x + x3.y * x3.y; \
                _Pragma("unroll") for (int q = 0; q < 16; ++q) y[q] = 0.f; } while (0)
            V_OFFS(0); V_ISSUE(Ba, 0); V_ISSUE(Bb, 1); V_ISSUE(Bc, 2);
#pragma unroll
            for (int q = 0; q < 16; ++q) y[q] = 0.f;
#pragma unroll 1
            for (int fb = 0; fb < 256; fb += 4) {
                const unsigned xwA = *(const GAS unsigned*)(XB + (tok0 + ((fb >> 1) & 7)) * 2048 + 128 * (fb >> 4) + 16 * j + 2 * g);
                const unsigned xwB = *(const GAS unsigned*)(XB + (tok0 + (((fb + 2) >> 1) & 7)) * 2048 + 128 * (fb >> 4) + 16 * j + 2 * g);
                V_STEP(Ba, fb, Bd, fb + 3);
                V_STEP(Bb, fb + 1, Ba, fb + 4);
                V_FINISH(fb + 1, xwA);
                V_STEP(Bc, fb + 2, Bb, fb + 5);
                V_STEP(Bd, fb + 3, Bc, fb + 6);
                V_FINISH(fb + 3, xwB);
            }
#undef V_FINISH
#undef V_STEP
#undef V_ISSUE
#undef V_OFFS
#undef V_COMPUTE
        }
        LDS_WAIT(); ISTAMP(F, 22);
        const float* gfin = (const float*)a.in[I_GFINAL];
#pragma unroll 1
        for (int tk = 0; tk < 8; ++tk) {
            const float rstd = 1.0f / sqrtf(wave_sum(SSL[(tl0 + tk) * 64 + lane]) * (1.0f / 2048.0f) + EPS);
            float* xr = a.out + (tok0 + tk) * 2048 + 16 * j + 2 * g; const bf16_t* xs = XB + (tok0 + tk) * 2048 + 16 * j + 2 * g;
            unsigned vv[16];
#pragma unroll
            for (int sl = 0; sl < 16; ++sl) vv[sl] = *(const GAS unsigned*)(xs + 128 * sl);
#pragma unroll
            for (int sl = 0; sl < 16; ++sl) { const f32x2 gg = *(const GAS f32x2*)(gfin + 128 * sl + 16 * j + 2 * g);
                *(GAS f32x2*)(xr + 128 * sl) = (f32x2){bf_lo(vv[sl]) * rstd * gg.x, bf_hi(vv[sl]) * rstd * gg.y}; }
        }
        LDS_WAIT();
    }
}

constexpr int NPHASES = 14;
#ifndef MK_ONE_LAUNCH
#define MK_ONE_LAUNCH 1
#endif
__global__ void __launch_bounds__(NTHREADS, 2) hybrid_fwd(Args args) {
    extern __shared__ __attribute__((aligned(16))) unsigned char lds_raw[];
    Frame F;
    F.lds = (LAS unsigned char*)lds_raw;
    F.tid = threadIdx.x; F.lane = F.tid & 63; F.wave = __builtin_amdgcn_readfirstlane(F.tid >> 6);
    F.G = gridDim.x; F.bid = blockIdx.x; F.ws = args.ws; F.dout = (unsigned char*)args.out;
    volatile LAS unsigned* MISC = (volatile LAS unsigned*)(F.lds + LDS_BYTES - 256);
    if (F.tid < 64) MISC[F.tid] = 0u;
    __syncthreads();
    XcdBarrier bar = xcd_barrier_post((unsigned*)(F.ws + WS_CTL) + 4096, MISC + 8);
    const int lo = args.ph_lo, hi = args.ph_hi;
#ifndef PROBE_MULT
#define PROBE_MULT 16
#endif
    if (PROBE_PHASE >= 0 && F.bid == 0 && F.tid == 0) { volatile LAS unsigned long long* ts_ = (volatile LAS unsigned long long*)(F.lds + LDS_BYTES - 64); ts_[0] = __builtin_amdgcn_s_memrealtime(); ts_[1] = 0; }
#define STAMP(k) FSTAMP(F, k)
#define IN(k) (lo <= (k) && (k) < hi && (F.lane = lane_id(), F.tid = F.wave * 64 + F.lane, true))
#define SEAM(k) do { if (IN(k) && IN((k) + 1)) xcd_barrier(bar); } while (0)
    unsigned char* ws = F.ws;
    LAS unsigned char* ring = F.lds;

    if (IN(0)) { ph0_prologue(F, args); } SEAM(0); STAMP(0);
    if (IN(1)) {
        Sched1 S{F.G, F.bid, ws, F.dout}; EpiProj E;
        pg8::gemm_phase<EpiProj, Sched1, true>(ring, F.tid, DM, DM, DM, S, E);
#if PROBE_PHASE == 52
        { __syncthreads(); ISTAMP(F, 51); Sched1 S2{F.G, F.bid, ws, F.dout}; EpiNull1 EN; pg8::gemm_phase<EpiNull1, Sched1, true>(ring, F.tid, DM, DM, DM, S2, EN); __syncthreads(); ISTAMP(F, 52); }
#endif
    } SEAM(1); STAMP(1);
    if (IN(2)) { ph2_mixers_a(F); } SEAM(2); STAMP(2);
    if (IN(3)) { ph_scan(F); } SEAM(3); STAMP(3);
    if (IN(4)) { ph3_mixers_b(F); } SEAM(4); STAMP(4);
    if (IN(5)) {
        { SchedG S{F.G, F.bid, 64, 8, (const char*)(ws + WS_RQ), (const char*)(ws + WS_WBR_T), (size_t)256 * 1024 * 2, (size_t)256 * 1024 * 2};
          EpiMerge<0> E{(bf16_t*)(ws + WS_GR), (bf16_t*)(ws + WS_GD)};
          pg8::gemm_phase<EpiMerge<0>, SchedG, true>(ring, F.tid, 1024, 1024, 1024, S, E); }
        { SchedG S{F.G, F.bid, 64, 8, (const char*)(ws + WS_DQ), (const char*)(ws + WS_WBD_T), (size_t)256 * 1536 * 2, (size_t)256 * 512 * 2};
          EpiMerge<1> E{(bf16_t*)(ws + WS_GR), (bf16_t*)(ws + WS_GD)};
          pg8::gemm_phase<EpiMerge<1>, SchedG, true>(ring, F.tid, 512, 1536, 512, S, E); }
    } SEAM(5); STAMP(5);
    if (IN(6)) {
        SchedG S{F.G, F.bid, 64, 8, (const char*)(ws + WS_GD), (const char*)(ws + WS_WOUT_T), (size_t)256 * 2048 * 2, (size_t)256 * 2048 * 2};
        EpiResid<true> E{(const float*)args.in[I_X], (bf16_t*)(ws + WS_XB), (float*)(ws + WS_SSQ1)};
        pg8::gemm_phase<EpiResid<true>, SchedG, true>(ring, F.tid, 2048, 2048, 2048, S, E);
    } SEAM(6); STAMP(6);
    if (IN(7)) {
        SchedG S{F.G, F.bid, 64, 8, (const char*)(ws + WS_XB), (const char*)(ws + WS_WQ_T), (size_t)256 * 2048 * 2, (size_t)256 * 2048 * 2};
        EpiRowScale E{(const float*)(ws + WS_SSQ1), (bf16_t*)(ws + WS_QM), 0.04419417382415922f * 1.4426950408889634f};
        pg8::gemm_phase<EpiRowScale, SchedG, true>(ring, F.tid, 2048, 2048, 2048, S, E);
#if PROBE_PHASE == 50
        { __syncthreads(); ISTAMP(F, 49); SchedG S2{F.G, F.bid, 64, 8, (const char*)(ws + WS_XB), (const char*)(ws + WS_WQ_T), (size_t)256 * 2048 * 2, (size_t)256 * 2048 * 2};
          EpiNull EN; pg8::gemm_phase<EpiNull, SchedG, true>(ring, F.tid, 2048, 2048, 2048, S2, EN); __syncthreads(); ISTAMP(F, 50); }
#endif
    } SEAM(7); STAMP(7);
    if (IN(8)) {
        Sched7 S{F.G, F.bid, (const char*)(ws + WS_QM), (const char*)(ws + WS_KM)};
        EpiSoftmax E{(bf16_t*)(ws + WS_P), (LAS float*)(F.lds + LDSX_OFF)};
        pg8::gemm_phase<EpiSoftmax, Sched7, true>(ring, F.tid, 512, 2048, 2048, S, E);
    } SEAM(8); STAMP(8);
    if (IN(9)) {
        Sched8 S{F.G, F.bid, (const char*)(ws + WS_P), (const char*)(ws + WS_VT)};
        EpiPlain E{(bf16_t*)(ws + WS_O), 2048};
        pg8::gemm_phase<EpiPlain, Sched8, true>(ring, F.tid, 256, 256, 2048, S, E);
    } SEAM(9); STAMP(9);
    if (IN(10)) {
        SchedG S{F.G, F.bid, 64, 8, (const char*)(ws + WS_O), (const char*)(ws + WS_WO_T), (size_t)256 * 2048 * 2, (size_t)256 * 2048 * 2};
        EpiResid<false> E{nullptr, (bf16_t*)(ws + WS_XB), (float*)(ws + WS_SSQ2)};
        pg8::gemm_phase<EpiResid<false>, SchedG, true>(ring, F.tid, 2048, 2048, 2048, S, E);
    } SEAM(10); STAMP(10);
    if (IN(11)) {
        SchedG S{F.G, F.bid, 64, 8, (const char*)(ws + WS_XB), (const char*)(ws + WS_WPQ_T), (size_t)256 * 2048 * 2, (size_t)256 * 2048 * 2};
        EpiRowScale E{(const float*)(ws + WS_SSQ2), (bf16_t*)(ws + WS_PQ), 1.0f};
        pg8::gemm_phase<EpiRowScale, SchedG, true>(ring, F.tid, 2048, 2048, 2048, S, E);
    } SEAM(11); STAMP(11);
    if (IN(12)) { ph11_route(F, args); } SEAM(12); STAMP(12);
    if (IN(13)) { ph12_peer(F, args); }
    if (PROBE_PHASE >= 0 && F.bid == 0) { __syncthreads(); STAMP(13); __syncthreads(); const unsigned long long t0_ = __builtin_amdgcn_s_memrealtime();
        const unsigned long long tsel_ = ((volatile LAS unsigned long long*)(F.lds + LDS_BYTES - 64))[1];
        while (__builtin_amdgcn_s_memrealtime() - t0_ < (unsigned long long)PROBE_MULT * tsel_) __builtin_amdgcn_s_sleep(8); }
#undef IN
#undef SEAM
}

extern "C" void kernel_launch(void* const* d_in, const int* in_sizes, int n_in, void* d_out, int out_size, void* d_ws, size_t ws_size, hipStream_t stream) {
    static int grid = 0;
    if (grid == 0) {
        if (n_in != 19 || out_size != MT * DM || ws_size < WS_END) { fprintf(stderr, "kernel_launch: unexpected shapes (n_in %d, out %d, ws %zu)\n", n_in, out_size, ws_size); grid = -1; return; }
        int dev = 0, cus = 0;
        if (hipGetDevice(&dev) != hipSuccess || hipDeviceGetAttribute(&cus, hipDeviceAttributeMultiprocessorCount, dev) != hipSuccess) { grid = -1; return; }
        if (hipFuncSetAttribute((const void*)hybrid_fwd, hipFuncAttributeMaxDynamicSharedMemorySize, LDS_BYTES) != hipSuccess) { fprintf(stderr, "kernel_launch: hipFuncSetAttribute failed\n"); grid = -1; return; }
        (void)hipGetLastError();
        grid = cus;
    }
    if (grid < 0) return;
    (void)hipMemsetAsync((char*)d_ws + WS_CTL, 0, CTL_ZERO_BYTES, stream);
    Args a{};
    for (int i = 0; i < 19; ++i) a.in[i] = d_in[i];
    a.out = (float*)d_out; a.ws = (unsigned char*)d_ws;
    for (int i = 0; i < 64; ++i) { a.fret[i] = std::pow(10000.0, -(double)i / 63.0); a.frot[i] = std::pow(10000.0, -(double)i / 64.0); }
#if MK_ONE_LAUNCH
    a.ph_lo = 0; a.ph_hi = NPHASES;
    hipLaunchKernelGGL(hybrid_fwd, dim3(grid), dim3(NTHREADS), LDS_BYTES, stream, a);
#else
    for (int ph = 0; ph < NPHASES; ++ph) {
        a.ph_lo = ph; a.ph_hi = ph + 1;
        hipLaunchKernelGGL(hybrid_fwd, dim3(grid), dim3(NTHREADS), LDS_BYTES, stream, a);
    }
#endif
}
#ifdef PHASE_PROBE
#define PROBE(k) __global__ void __launch_bounds__(NTHREADS, 2) probe_ph##k(Args args) { \
    extern __shared__ __attribute__((aligned(16))) unsigned char lds_raw[]; Frame F; F.lds = (LAS unsigned char*)lds_raw; F.tid = threadIdx.x; F.lane = F.tid & 63; \
    F.wave = __builtin_amdgcn_readfirstlane(F.tid >> 6); F.G = gridDim.x; F.bid = blockIdx.x; F.ws = args.ws; F.dout = (unsigned char*)args.out; unsigned char* ws = F.ws; LAS unsigned char* ring = F.lds;
PROBE(0) ph0_prologue(F, args); }
PROBE(1) Sched1 S{F.G, F.bid, ws, F.dout}; EpiProj E; pg8::gemm_phase<EpiProj, Sched1, true>(ring, F.tid, DM, DM, DM, S, E); }
PROBE(2) ph2_mixers_a(F); }
PROBE(3) ph3_mixers_b(F); }
PROBE(5) SchedG S{F.G, F.bid, 64, 8, (const char*)(ws + WS_GD), (const char*)(ws + WS_WOUT_T), (size_t)256 * 2048 * 2, (size_t)256 * 2048 * 2};
        EpiResid<true> E{(const float*)args.in[I_X], (bf16_t*)(ws + WS_XB), (float*)(ws + WS_SSQ1)};
        pg8::gemm_phase<EpiResid<true>, SchedG, true>(ring, F.tid, 2048, 2048, 2048, S, E); }
PROBE(7) Sched7 S{F.G, F.bid, (const char*)(ws + WS_QM), (const char*)(ws + WS_KM)};
        EpiSoftmax E{(bf16_t*)(ws + WS_P), (LAS float*)(F.lds + LDSX_OFF)};
        pg8::gemm_phase<EpiSoftmax, Sched7, true>(ring, F.tid, 512, 2048, 2048, S, E); }
PROBE(11) ph11_route(F, args); }
PROBE(12) ph12_peer(F, args); }
#endif
```

```cpp
#include <hip/hip_runtime.h>
#include <cstdio>
#include <cstdint>
#include <cmath>

#define LAS __attribute__((address_space(3)))
#define GAS __attribute__((address_space(1)))
#define DI __device__ __forceinline__
typedef unsigned short bf16_t;
typedef short bf16x8 __attribute__((ext_vector_type(8)));
typedef short s16x4 __attribute__((ext_vector_type(4)));
typedef short v4i16_t __attribute__((ext_vector_type(4)));
typedef float f32x2 __attribute__((ext_vector_type(2)));
typedef float f32x4 __attribute__((ext_vector_type(4)));
typedef float f32x16 __attribute__((ext_vector_type(16)));
typedef unsigned u32x2 __attribute__((ext_vector_type(2)));
typedef unsigned u32x4 __attribute__((ext_vector_type(4)));
typedef __bf16 bf16x2_t __attribute__((ext_vector_type(2)));

constexpr int NB = 8, SEQ = 2048, DM = 2048, MT = NB * SEQ;
constexpr int MEMT = 256, MROWS = NB * MEMT;
constexpr int INW = 12800;
constexpr float EPS = 1e-6f;
constexpr int NWAVES = 8, NTHREADS = 512;

constexpr size_t MiB = 1u << 20;
constexpr size_t WS_CTL = 0, CTL_ZERO_BYTES = 1 * MiB;
constexpr size_t WS_SSQ1 = 2 * MiB, WS_SSQ2 = 4 * MiB, WS_LSE = 6 * MiB, WS_EIDX = 8 * MiB, WS_GATE = 16 * MiB;
constexpr size_t WS_CMAX_IN = WS_CTL + 512 * 1024, WS_CMAX_KV = WS_CMAX_IN + 12800 * 4;
constexpr size_t WS_RMAX_GD = WS_CTL + 640 * 1024, WS_RMAX_X1 = WS_RMAX_GD + 65536, WS_RMAX_O = WS_RMAX_X1 + 65536, WS_RMAX_X2 = WS_RMAX_O + 65536;
constexpr size_t WS_W8_OUT = 548 * MiB, WS_W8_Q = 552 * MiB, WS_W8_O = 556 * MiB, WS_W8_PQ = 560 * MiB;
constexpr size_t WS_RQ8 = 32 * MiB, WS_W8_BR = 565 * MiB, WS_RMAX_RQ = WS_RMAX_X2 + 65536;
constexpr size_t WS_DQ8 = 24 * MiB, WS_W8_BD = 564 * MiB;
constexpr size_t WS_A8_0 = 276 * MiB, WS_A8_1 = 308 * MiB;
constexpr size_t WS_SA_H1 = WS_LSE + 1 * MiB, WS_SA_MEM = WS_SA_H1 + 16384 * 4, WS_SB_IN = WS_SA_MEM + 2048 * 4, WS_SB_KV = WS_SB_IN + 12800 * 4, WS_SB_OUT = WS_SB_KV + 4096 * 4, WS_SB_Q = WS_SB_OUT + 8192, WS_SB_O = WS_SB_Q + 8192, WS_SB_PQ = WS_SB_O + 8192, WS_SA8_0 = WS_SB_PQ + 8192, WS_SA8_1 = WS_SA8_0 + 65536, WS_SB_BD = WS_SA8_1 + 65536, WS_SA_DQ = WS_SB_BD + 8192, WS_SB_BR = WS_SA_DQ + 65536, WS_SA_RQ = WS_SB_BR + 8192;
constexpr size_t WS_WIN_T = 24 * MiB, WS_WKV_T = 74 * MiB, WS_WBR_T = 90 * MiB, WS_WBD_T = 94 * MiB, WS_WOUT_T = 96 * MiB, WS_WQ_T = 104 * MiB, WS_WO_T = 112 * MiB, WS_WPQ_T = 120 * MiB;
constexpr size_t WS_SUBK = 128 * MiB, WS_KM = 130 * MiB, WS_VT = 138 * MiB;
constexpr size_t WS_RQ = 148 * MiB, WS_RK = 180 * MiB, WS_RV = 212 * MiB, WS_SG = 244 * MiB, WS_DQ = 276 * MiB, WS_DK = 324 * MiB, WS_DV = 372 * MiB, WS_GR = 420 * MiB, WS_GD = 484 * MiB;
constexpr size_t WS_END = 568 * MiB;
constexpr size_t WS_KVST = 24 * MiB;
constexpr size_t WS_XB = 24 * MiB;
constexpr size_t WS_QM = 180 * MiB;
constexpr size_t WS_PQ = 180 * MiB;
constexpr size_t WS_P = 244 * MiB;
constexpr size_t WS_O = 324 * MiB;
constexpr size_t WS_UTAB = 276 * MiB;
constexpr size_t WS_VTAB = 404 * MiB;
constexpr size_t DO_H1 = 0, DO_MEMN = 64 * MiB, DO_CSRET = 72 * MiB, DO_CSROT = 80 * MiB;
constexpr size_t DO_PREVT = 0;

DI unsigned f2bf(float f) { unsigned u = __builtin_bit_cast(unsigned, f); return (u + 0x7fffu + ((u >> 16) & 1u)) >> 16; }
DI unsigned pk2(float lo, float hi) { f32x2 v = {lo, hi}; bf16x2_t b = __builtin_convertvector(v, bf16x2_t); return __builtin_bit_cast(unsigned, b); }
DI float bf_lo(unsigned w) { return __builtin_bit_cast(float, w << 16); }
DI float bf_hi(unsigned w) { return __builtin_bit_cast(float, w & 0xffff0000u); }
DI float wave_sum(float v) {
#pragma unroll
    for (int o = 1; o < 64; o <<= 1) v += __shfl_xor(v, o);
    return v;
}
DI float wave_max(float v) {
#pragma unroll
    for (int o = 1; o < 64; o <<= 1) v = fmaxf(v, __shfl_xor(v, o));
    return v;
}
DI unsigned q8_pack(const f32x4 v, float inv) {
    const unsigned b0 = __builtin_bit_cast(unsigned, __builtin_fmaf(v.x, inv, 12582912.0f)), b1 = __builtin_bit_cast(unsigned, __builtin_fmaf(v.y, inv, 12582912.0f));
    const unsigned b2 = __builtin_bit_cast(unsigned, __builtin_fmaf(v.z, inv, 12582912.0f)), b3 = __builtin_bit_cast(unsigned, __builtin_fmaf(v.w, inv, 12582912.0f));
    const unsigned lo = __builtin_amdgcn_perm(b1, b0, 0x0c0c0400u), hi = __builtin_amdgcn_perm(b3, b2, 0x04000c0cu);
    return lo | hi;
}
#define LDS_WAIT() asm volatile("s_waitcnt lgkmcnt(0)" ::: "memory")
#define VM_WAIT() asm volatile("s_waitcnt vmcnt(0)" ::: "memory")
DI float fast_exp2(float x) { return __builtin_amdgcn_exp2f(x); }
DI float fast_rcp(float x) { return __builtin_amdgcn_rcpf(x); }
DI float sigmoid_f(float x) { return fast_rcp(1.f + fast_exp2(-1.4426950408889634f * x)); }

namespace pg8 {
constexpr int BM = 256, BK = 64, HALF = 128, HTB = HALF * BK * 2, STAGE_BYTES = 8 * HTB, NXCD = 8, WGM = 8;
__host__ __device__ __forceinline__ int lds_byte(int r, int c) { const int st = (r >> 4) * 2 + (c >> 5), rr = r & 15, cc = c & 31, ob = rr * 64 + cc * 2; return st * 1024 + (ob ^ (((ob >> 9) & 1) << 5)); }
__host__ __device__ __forceinline__ void stage_rc(int b, int& R, int& C) { const int st = b / 1024, sb = b % 1024, swz = sb ^ (((sb >> 9) & 1) << 5); R = (st >> 1) * 16 + swz / 64; C = (st & 1) * 32 + (swz % 64) / 2; }
__host__ __device__ __forceinline__ int perm32(int rho) { const int n = rho >> 4, i = rho & 15; return 8 * (i >> 2) + 4 * n + (i & 3); }

template <int WGM_> __device__ __forceinline__ void tile_of(int L, int nM, int nN, int& pm, int& pn) {
    const int nwg = nM * nN; int wgid = L;
    { const int q = nwg / NXCD, r = nwg % NXCD, xcd = wgid % NXCD, off = wgid / NXCD; wgid = (xcd < r ? xcd * (q + 1) : r * (q + 1) + (xcd - r) * q) + off; }
    const int nig = WGM_ * nN, gid = wgid / nig, fm = gid * WGM_, gsz = (nM - fm) < WGM_ ? (nM - fm) : WGM_;
    pm = fm + ((wgid % nig) % gsz); pn = (wgid % nig) / gsz;
}

typedef int i32x4 __attribute__((ext_vector_type(4)));
template <bool I8> DI f32x4 mma16(const bf16x8 a, const bf16x8 b, const f32x4 c) {
    if constexpr (I8) return __builtin_bit_cast(f32x4, __builtin_amdgcn_mfma_i32_16x16x64_i8(__builtin_bit_cast(i32x4, a), __builtin_bit_cast(i32x4, b), __builtin_bit_cast(i32x4, c), 0, 0, 0));
    else return __builtin_amdgcn_mfma_f32_16x16x32_bf16(a, b, c, 0, 0, 0);
}
template <class Epi, class Sched, bool ALIGN_EPI, bool I8 = false>
__device__ __forceinline__ void gemm_phase(LAS unsigned char* lds, const int tid, const int K, const int lda, const int ldb, const Sched& S, const Epi& E) {
    typedef typename Sched::Unit Unit;
    const int wid = __builtin_amdgcn_readfirstlane(tid >> 6), lane = tid & 63, wr = wid >> 2, wc = wid & 3, fr = lane & 15, fq = lane >> 4;
    const int nt = K / BK;
    unsigned voffA[2], voffB[2];
#pragma unroll
    for (int i = 0; i < 2; ++i) { int R, C; stage_rc(tid * 16 + i * 8192, R, C); const int Rb = (R & ~31) + perm32(R & 31);
        voffA[i] = (unsigned)(R * lda + C) * 2u; voffB[i] = (unsigned)(Rb * ldb + C) * 2u; }
    const size_t kstep = (size_t)(BK * 2);
    const size_t hstepA = (size_t)HALF * lda * 2, hstepB = (size_t)HALF * ldb * 2;
    const unsigned ldsw = (unsigned)wid * 1024u;
    const int aoff = lds_byte(wr * 64 + fr, fq * 8), boff = lds_byte(wc * 32 + fr, fq * 8);
#define PG8_SA(b, h) (((b) * 2 + (h)) * HTB)
#define PG8_SB(b, h) ((4 + (b) * 2 + (h)) * HTB)
#define PG8_STAGE(bufoff, gbase, voff) do { _Pragma("unroll") for (int _i = 0; _i < 2; ++_i) \
        __builtin_amdgcn_global_load_lds((const unsigned*)((const char*)(gbase) + (voff)[_i]), (LAS unsigned*)(lds + (bufoff) + ldsw + _i * 8192), 16, 0, 0); } while (0)
#define PG8_LDA(dst, b, h) do { _Pragma("unroll") for (int m = 0; m < 4; ++m) _Pragma("unroll") for (int k = 0; k < 2; ++k) dst[m][k] = *(const LAS bf16x8*)(lds + PG8_SA(b, h) + aoff + m * 2048 + k * 1024); } while (0)
#define PG8_LDB(dst, b, h) do { _Pragma("unroll") for (int n = 0; n < 2; ++n) _Pragma("unroll") for (int k = 0; k < 2; ++k) dst[n][k] = *(const LAS bf16x8*)(lds + PG8_SB(b, h) + boff + n * 2048 + k * 1024); } while (0)
#define PG8_MMA(ai, bj, At, Bt) do { __builtin_amdgcn_s_setprio(1); _Pragma("unroll") for (int m = 0; m < 4; ++m) _Pragma("unroll") for (int n = 0; n < 2; ++n) _Pragma("unroll") for (int k = 0; k < 2; ++k) \
        acc[ai][bj][m][n] = mma16<I8>(Bt[n][k], At[m][k], acc[ai][bj][m][n]); __builtin_amdgcn_s_setprio(0); } while (0)
#define PG8_WAIT_V(n) asm volatile("s_waitcnt vmcnt(" #n ")" ::: "memory")
#define PG8_WAIT_L(n) asm volatile("s_waitcnt lgkmcnt(" #n ")" ::: "memory")
#define PG8_BAR __builtin_amdgcn_s_barrier()
#define PG8_SCHED __builtin_amdgcn_sched_barrier(0)
    Unit cur, nxt; int ui = 0;
    if (!S.next(0, cur)) return;
    f32x4 acc[2][2][4][2];
#pragma unroll
    for (int a = 0; a < 2; ++a)
#pragma unroll
        for (int b = 0; b < 2; ++b)
#pragma unroll
            for (int m = 0; m < 4; ++m)
#pragma unroll
                for (int n = 0; n < 2; ++n) acc[a][b][m][n] = (f32x4){0.f, 0.f, 0.f, 0.f};
    bf16x8 At[4][2], B0[2][2], B1[2][2];
    const char* cA = cur.A; const char* cB = cur.B;
    PG8_STAGE(PG8_SB(0, 0), cB, voffB); PG8_STAGE(PG8_SB(0, 1), cB + hstepB, voffB); PG8_STAGE(PG8_SA(0, 0), cA, voffA); PG8_STAGE(PG8_SA(0, 1), cA + hstepA, voffA);
    if (wr == 1) PG8_BAR;
    PG8_WAIT_V(2); PG8_BAR;
    PG8_STAGE(PG8_SB(1, 0), cB + kstep, voffB); PG8_STAGE(PG8_SA(1, 0), cA + kstep, voffA); PG8_STAGE(PG8_SB(1, 1), cB + hstepB + kstep, voffB);
    PG8_WAIT_V(6); PG8_BAR;
    for (;;) {
        const bool has_next = S.next(ui + 1, nxt);
        const char* nA = has_next ? nxt.A : cA; const char* nB = has_next ? nxt.B : cB;
        for (int t = 0; t < nt; t += 2) {
            const bool last = (t == nt - 2);
            const char* a1 = cA + (size_t)(t + 1) * kstep;
            const char* a2 = last ? nA : cA + (size_t)(t + 2) * kstep; const char* b2 = last ? nB : cB + (size_t)(t + 2) * kstep;
            const char* a3 = a2 + kstep; const char* b3 = b2 + kstep;
            PG8_LDB(B0, 0, 0); PG8_LDB(B1, 0, 1); PG8_SCHED; PG8_LDA(At, 0, 0); PG8_STAGE(PG8_SA(1, 1), a1 + hstepA, voffA);
            PG8_WAIT_V(8); PG8_WAIT_L(0); PG8_BAR; PG8_MMA(0, 0, At, B0); PG8_MMA(0, 1, At, B1); PG8_BAR; PG8_SCHED;
            PG8_LDA(At, 0, 1); PG8_STAGE(PG8_SB(0, 0), b2, voffB); PG8_STAGE(PG8_SB(0, 1), b2 + hstepB, voffB); PG8_STAGE(PG8_SA(0, 0), a2, voffA);
            PG8_WAIT_V(8); PG8_WAIT_L(0); PG8_BAR; PG8_MMA(1, 0, At, B0); PG8_MMA(1, 1, At, B1); PG8_BAR; PG8_SCHED;
            PG8_LDB(B0, 1, 0); PG8_LDB(B1, 1, 1); PG8_SCHED; PG8_LDA(At, 1, 0); PG8_STAGE(PG8_SA(0, 1), a2 + hstepA, voffA);
            PG8_WAIT_V(8); PG8_WAIT_L(0); PG8_BAR; PG8_MMA(0, 0, At, B0); PG8_MMA(0, 1, At, B1); PG8_BAR; PG8_SCHED;
            PG8_LDA(At, 1, 1); PG8_STAGE(PG8_SB(1, 0), b3, voffB); PG8_STAGE(PG8_SB(1, 1), b3 + hstepB, voffB); PG8_STAGE(PG8_SA(1, 0), a3, voffA);
            PG8_WAIT_V(8); PG8_WAIT_L(0); PG8_BAR; PG8_MMA(1, 0, At, B0); PG8_MMA(1, 1, At, B1); PG8_BAR; PG8_SCHED;
        }
        if constexpr (ALIGN_EPI) { if (wr == 0) PG8_BAR; }
        E(acc, cur, wr, wc, fr, fq, wid, lane);
        if (!has_next) break;
#pragma unroll
        for (int a = 0; a < 2; ++a)
#pragma unroll
            for (int b = 0; b < 2; ++b)
#pragma unroll
                for (int m = 0; m < 4; ++m)
#pragma unroll
                    for (int n = 0; n < 2; ++n) acc[a][b][m][n] = (f32x4){0.f, 0.f, 0.f, 0.f};
        cur = nxt; cA = nA; cB = nB; ++ui;
        if constexpr (ALIGN_EPI) { if (wr == 1) PG8_BAR; }
    }
    PG8_WAIT_V(0);
    if constexpr (!ALIGN_EPI) { if (wr == 0) PG8_BAR; }
    PG8_BAR;
#undef PG8_SA
#undef PG8_SB
#undef PG8_STAGE
#undef PG8_LDA
#undef PG8_LDB
#undef PG8_MMA
#undef PG8_WAIT_V
#undef PG8_WAIT_L
#undef PG8_BAR
#undef PG8_SCHED
}
}

constexpr int RING_BYTES = 131072;
constexpr int LDSX_OFF = RING_BYTES;
constexpr int LDSCTL_OFF = RING_BYTES + 16384;
constexpr int LDS_BYTES = 163840;

typedef GAS unsigned gu32;
#define RLX_AGENT __ATOMIC_RELAXED, __HIP_MEMORY_SCOPE_AGENT

#define XB_TMO      128
#define XB_XCNT(j)  (256  + 64 * (j))
#define XB_XSUB(j)  (1280 + 64 * (j))
#define XB_XGEN(j)  (2304 + 64 * (j))
#define XB_TOP      3328
#define XB_TOPGEN   3392
#define XCD_BAR_WORDS 3456
#define XB_SPIN_CAP (1u << 20)
DI unsigned xb_ld(unsigned* p)              { return __hip_atomic_load(p, __ATOMIC_RELAXED, __HIP_MEMORY_SCOPE_AGENT); }
DI unsigned xb_add(unsigned* p, unsigned v) { return __hip_atomic_fetch_add(p, v, __ATOMIC_RELAXED, __HIP_MEMORY_SCOPE_AGENT); }
DI unsigned xb_xcc_id() { return (unsigned)__builtin_amdgcn_s_getreg((3 << 11) | 20) & 0xFu; }
#define XB_SPIN(cond, bar) do { unsigned _sp = 0; while (cond) { __builtin_amdgcn_s_sleep(1); \
    if ((++_sp & 255u) == 0u) { if (xb_ld(&(bar)[XB_TMO])) break; if (_sp > XB_SPIN_CAP) { atomicAdd(&(bar)[XB_TMO], 1u); break; } } } } while (0)
struct XcdBarrier { unsigned* bar; unsigned x; volatile LAS unsigned* st; };
DI XcdBarrier xcd_barrier_post(unsigned* bar, volatile LAS unsigned* st) {
    XcdBarrier b; b.bar = bar; b.x = xb_xcc_id(); b.st = st;
    if (threadIdx.x == 0) (void)xb_add(&bar[XB_XCNT(b.x)], 1u);
    return b;
}
DI void xcd_barrier_complete(unsigned* bar, unsigned x, unsigned& nloc, unsigned& nx) {
    const unsigned G = gridDim.x * gridDim.y * gridDim.z;
    unsigned sum, cnt, mine, sp = 0u;
    for (;;) {
        sum = 0u; cnt = 0u; mine = 0u;
#pragma unroll
        for (unsigned j = 0; j < 16; ++j) { const unsigned c = xb_ld(&bar[XB_XCNT(j)]); sum += c; cnt += (c > 0u) ? 1u : 0u; mine = (j == x) ? c : mine; }
        if (sum == G) break;
        __builtin_amdgcn_s_sleep(1);
        if ((++sp & 255u) == 0u) { if (xb_ld(&bar[XB_TMO])) break; if (sp > XB_SPIN_CAP) { atomicAdd(&bar[XB_TMO], 1u); break; } }
    }
    nloc = mine > 0u ? mine : 1u; nx = cnt > 0u ? cnt : 1u;
}
DI void xcd_barrier(const XcdBarrier& b) {
    asm volatile("s_waitcnt vmcnt(0)" ::: "memory");
    __syncthreads();
    if (threadIdx.x == 0) {
        unsigned* bar = b.bar;
        __builtin_amdgcn_s_waitcnt(0);
        unsigned nloc = b.st[0], nx = b.st[1];
        if (nloc == 0u) { xcd_barrier_complete(bar, b.x, nloc, nx); b.st[0] = nloc; b.st[1] = nx; }
        const unsigned old = xb_add(&bar[XB_XSUB(b.x)], 1u);
        const unsigned gen = old / nloc;
        if (old + 1u == (gen + 1u) * nloc) {
            __builtin_amdgcn_fence(__ATOMIC_RELEASE, "agent");
            asm volatile("s_waitcnt vmcnt(0)" ::: "memory");
            const unsigned og = xb_add(&bar[XB_TOP], 1u);
            const unsigned tg = og / nx;
            if (og + 1u == (tg + 1u) * nx) xb_add(&bar[XB_TOPGEN], 1u);
            else XB_SPIN(xb_ld(&bar[XB_TOPGEN]) == tg, bar);
            __builtin_amdgcn_fence(__ATOMIC_ACQUIRE, "agent");
            xb_add(&bar[XB_XGEN(b.x)], 1u);
            asm volatile("s_waitcnt vmcnt(0)" ::: "memory");
        } else {
            XB_SPIN(xb_ld(&bar[XB_XGEN(b.x)]) == gen, bar);
            __builtin_amdgcn_fence(__ATOMIC_ACQUIRE, "agent");
            asm volatile("s_waitcnt vmcnt(0)" ::: "memory");
        }
    }
    __syncthreads();
}

struct Args {
    const void* in[19]; float* out; unsigned char* ws; int ph_lo, ph_hi;
    double fret[64]; double frot[64];
};
DI int lane_id() { int l; asm volatile("v_mbcnt_lo_u32_b32 %0, -1, 0\n\tv_mbcnt_hi_u32_b32 %0, -1, %0" : "=v"(l)); return l; }
struct Frame {
    LAS unsigned char* lds;
    int tid, lane, wave, G, bid;
    unsigned char* ws; unsigned char* dout;
};
#ifndef PROBE_PHASE
#define PROBE_PHASE -1
#endif
#define ISTAMP(F, k) do { if (PROBE_PHASE >= 20) { __syncthreads(); FSTAMP(F, k); } } while (0)
#define FSTAMP(F, k) do { if (PROBE_PHASE >= 0 && (F).bid == 0 && (F).tid == 0) { volatile LAS unsigned long long* ts_ = (volatile LAS unsigned long long*)((F).lds + LDS_BYTES - 64); \
    const unsigned long long t_ = __builtin_amdgcn_s_memrealtime(); if ((k) == PROBE_PHASE) ts_[1] = t_ - ts_[0]; ts_[0] = t_; } } while (0)
enum { I_X = 0, I_MEM, I_POS, I_GMIX, I_WIN, I_WBR, I_WBD, I_WOUT, I_GCROSS, I_GMEM, I_WQ, I_WKV, I_WO, I_GFFN, I_WPQ, I_SUBK, I_PU, I_PV, I_GFINAL };

DI void tr_item(const float* W, int K, int N, bf16_t* WT, const float* scale, int rot_lo, int rot_hi, LAS float* scr, int item, int lane) {
    const int nblk = N / 64, kb = item / nblk, nb = item % nblk, k0 = 64 * kb, c0 = 64 * nb;
    f32x4 wv[16];
#pragma unroll
    for (int i = 0; i < 16; ++i) { const int kk = 4 * i + (lane >> 4); wv[i] = __builtin_nontemporal_load((const GAS f32x4*)(W + (size_t)(k0 + kk) * N + c0 + 4 * (lane & 15))); }
    if (scale) {
#pragma unroll
        for (int i = 0; i < 16; ++i) wv[i] = wv[i] * scale[k0 + 4 * i + (lane >> 4)];
    }
#pragma unroll
    for (int i = 0; i < 16; ++i) { const int kk = 4 * i + (lane >> 4); *(LAS f32x4*)(scr + kk * 68 + 4 * (lane & 15)) = wv[i]; }
    LDS_WAIT();
    const bool rot = (c0 >= rot_lo) && (c0 < rot_hi);
    const int hb = c0 & ~127, half = (c0 >> 6) & 1;
    const int c = lane & 7;
#pragma unroll
    for (int j = 0; j < 8; ++j) { const int n = (lane >> 3) + 8 * j; const LAS float* sp = scr + (8 * c) * 68 + n;
        u32x4 o; o.x = pk2(sp[0 * 68], sp[1 * 68]); o.y = pk2(sp[2 * 68], sp[3 * 68]); o.z = pk2(sp[4 * 68], sp[5 * 68]); o.w = pk2(sp[6 * 68], sp[7 * 68]);
        const int drow = rot ? (hb + 2 * n + half) : (c0 + n);
        *(GAS u32x4*)(WT + (size_t)drow * K + k0 + 8 * c) = o; }
    LDS_WAIT();
}
DI void rms_row_bf16(const float* xrow, const float* g, bf16_t* orow, int lane) {
    const GAS f32x4* xr = (const GAS f32x4*)xrow + lane; const GAS f32x4* gr = (const GAS f32x4*)g + lane;
    f32x4 v[8]; float s = 0.f;
#pragma unroll
    for (int j = 0; j < 8; ++j) { v[j] = xr[64 * j]; s += (v[j].x * v[j].x + v[j].y * v[j].y) + (v[j].z * v[j].z + v[j].w * v[j].w); }
    const float rstd = 1.0f / sqrtf(wave_sum(s) * (1.f / DM) + EPS);
    GAS u32x2* o8 = (GAS u32x2*)orow + lane;
#pragma unroll
    for (int j = 0; j < 8; ++j) { const f32x4 gg = gr[64 * j]; u32x2 o; o.x = pk2(v[j].x * rstd * gg.x, v[j].y * rstd * gg.y); o.y = pk2(v[j].z * rstd * gg.z, v[j].w * rstd * gg.w); o8[64 * j] = o; }
}
DI void rms_row_i8(const float* xrow, const float* g, unsigned char* orow, float* sa, int lane) {
    const GAS f32x4* xr = (const GAS f32x4*)xrow + lane; const GAS f32x4* gr = (const GAS f32x4*)g + lane;
    f32x4 v[8]; float s = 0.f;
#pragma unroll
    for (int j = 0; j < 8; ++j) { v[j] = __builtin_nontemporal_load(xr + 64 * j); s += (v[j].x * v[j].x + v[j].y * v[j].y) + (v[j].z * v[j].z + v[j].w * v[j].w); }
    const float rstd = 1.0f / sqrtf(wave_sum(s) * (1.f / DM) + EPS);
    float m = 0.f;
#pragma unroll
    for (int j = 0; j < 8; ++j) { v[j] = v[j] * gr[64 * j] * rstd; m = fmaxf(fmaxf(m, fmaxf(fabsf(v[j].x), fabsf(v[j].y))), fmaxf(fabsf(v[j].z), fabsf(v[j].w))); }
    m = wave_max(m); const float inv = (m > 0.f) ? 127.0f / m : 0.f;
    GAS unsigned* o4 = (GAS unsigned*)orow + lane;
#pragma unroll
    for (int j = 0; j < 8; ++j) o4[64 * j] = q8_pack(v[j], inv);
    if (lane == 0) *sa = m * (1.0f / 127.0f);
}
DI void cmax_item(const float* W, int N, unsigned* cmax, int item, int lane) {
    const int nblk = N / 256, kb = item / nblk, nb = item % nblk;
    const GAS f32x4* p = (const GAS f32x4*)(W + (size_t)(64 * kb) * N + 256 * nb) + lane;
    f32x4 m = {0.f, 0.f, 0.f, 0.f};
#pragma unroll 16
    for (int k = 0; k < 64; ++k) { const f32x4 v = p[(size_t)k * (N / 4)]; m.x = fmaxf(m.x, fabsf(v.x)); m.y = fmaxf(m.y, fabsf(v.y)); m.z = fmaxf(m.z, fabsf(v.z)); m.w = fmaxf(m.w, fabsf(v.w)); }
    unsigned* c = cmax + 256 * nb + 4 * lane;
    const float m0 = m.x, m1 = m.y, m2 = m.z, m3 = m.w;
    atomicMax(c + 0, __builtin_bit_cast(unsigned, m0)); atomicMax(c + 1, __builtin_bit_cast(unsigned, m1)); atomicMax(c + 2, __builtin_bit_cast(unsigned, m2)); atomicMax(c + 3, __builtin_bit_cast(unsigned, m3));
}
DI void tr_item8(const float* W, int K, int N, unsigned char* WT, float* sbt, const unsigned* cmax, int rot_lo, int rot_hi, LAS float* scr, int item, int lane) {
    const int nblk = N / 64, kb = item / nblk, nb = item % nblk, k0 = 64 * kb, c0 = 64 * nb;
    f32x4 wv[16];
#pragma unroll
    for (int i = 0; i < 16; ++i) { const int kk = 4 * i + (lane >> 4); wv[i] = __builtin_nontemporal_load((const GAS f32x4*)(W + (size_t)(k0 + kk) * N + c0 + 4 * (lane & 15))); }
    float cm[8];
#pragma unroll
    for (int j = 0; j < 8; ++j) cm[j] = __builtin_bit_cast(float, cmax[c0 + (lane >> 3) + 8 * j]);
#pragma unroll
    for (int i = 0; i < 16; ++i) { const int kk = 4 * i + (lane >> 4); *(LAS f32x4*)(scr + kk * 68 + 4 * (lane & 15)) = wv[i]; }
    LDS_WAIT();
    const bool rot = (c0 >= rot_lo) && (c0 < rot_hi);
    const int hb = c0 & ~127, half = (c0 >> 6) & 1;
    const int c = lane & 7;
#pragma unroll
    for (int j = 0; j < 8; ++j) { const int n = (lane >> 3) + 8 * j; const LAS float* sp = scr + (8 * c) * 68 + n;
        const float inv = (cm[j] > 0.f) ? 127.0f / cm[j] : 0.f;
        u32x2 o; o.x = q8_pack((f32x4){sp[0 * 68], sp[1 * 68], sp[2 * 68], sp[3 * 68]}, inv); o.y = q8_pack((f32x4){sp[4 * 68], sp[5 * 68], sp[6 * 68], sp[7 * 68]}, inv);
        const int drow = rot ? (hb + 2 * n + half) : (c0 + n);
        *(GAS u32x2*)(WT + (size_t)drow * K + k0 + 8 * c) = o;
        if (kb == 0 && c == 0) sbt[drow] = cm[j] * (1.0f / 127.0f); }
    LDS_WAIT();
}
DI void sincos_d(double a, float& c, float& s) {
    const double x = a * 0.63661977236758134308; const double q = __builtin_rint(x);
    double r = __builtin_fma(-q, 1.57079632679489655800, a); r = __builtin_fma(-q, 6.12323399573676603587e-17, r);
    const int qi = ((int)q) & 3; const double r2 = r * r;
    double sn = 1.0 / 6227020800.0; sn = sn * r2 - 1.0 / 39916800.0; sn = sn * r2 + 1.0 / 362880.0; sn = sn * r2 - 1.0 / 5040.0; sn = sn * r2 + 1.0 / 120.0; sn = sn * r2 - 1.0 / 6.0; sn = sn * r2 + 1.0; sn *= r;
    double cs = -1.0 / 87178291200.0; cs = cs * r2 + 1.0 / 479001600.0; cs = cs * r2 - 1.0 / 3628800.0; cs = cs * r2 + 1.0 / 40320.0; cs = cs * r2 - 1.0 / 720.0; cs = cs * r2 + 1.0 / 24.0; cs = cs * r2 - 0.5; cs = cs * r2 + 1.0;
    const double so = (qi == 0) ? sn : (qi == 1) ? cs : (qi == 2) ? -sn : -cs;
    const double co = (qi == 0) ? cs : (qi == 1) ? -sn : (qi == 2) ? -cs : sn;
    c = (float)co; s = (float)so;
}
DI void ph0_prologue(const Frame& F, const Args& a) {
    LAS float* scr = (LAS float*)(F.lds + F.wave * 17408);
    const int gw = F.bid * NWAVES + F.wave, NGW = F.G * NWAVES;
    unsigned char* ws = F.ws;
    constexpr int I_IN = (DM / 64) * (INW / 64), I_KV = (DM / 64) * (4096 / 64), I_BR = (1024 / 64) * (DM / 64), I_BD = (512 / 64) * (DM / 64), I_SQ = (DM / 64) * (DM / 64);
    constexpr int NITEMS = I_IN + I_KV + I_BR + I_BD + 4 * I_SQ;
    for (int it = gw + I_IN + I_KV; it < NITEMS; it += NGW) {
        int r = it - I_IN - I_KV;
        if (r < I_BR) { tr_item((const float*)a.in[I_WBR], 1024, DM, (bf16_t*)(ws + WS_WBR_T), nullptr, 0, 0, scr, r, F.lane); continue; } r -= I_BR;
        if (r < I_BD) { tr_item((const float*)a.in[I_WBD], 512, DM, (bf16_t*)(ws + WS_WBD_T), nullptr, 0, 0, scr, r, F.lane); continue; } r -= I_BD;
        if (r < I_SQ) { tr_item((const float*)a.in[I_WOUT], DM, DM, (bf16_t*)(ws + WS_WOUT_T), nullptr, 0, 0, scr, r, F.lane); continue; } r -= I_SQ;
        if (r < I_SQ) { tr_item((const float*)a.in[I_WQ], DM, DM, (bf16_t*)(ws + WS_WQ_T), (const float*)a.in[I_GCROSS], 0, 0, scr, r, F.lane); continue; } r -= I_SQ;
        if (r < I_SQ) { tr_item((const float*)a.in[I_WO], DM, DM, (bf16_t*)(ws + WS_WO_T), nullptr, 0, 0, scr, r, F.lane); continue; } r -= I_SQ;
        tr_item((const float*)a.in[I_WPQ], DM, DM, (bf16_t*)(ws + WS_WPQ_T), (const float*)a.in[I_GFFN], 0, 0, scr, r, F.lane);
    }
    ISTAMP(F, 42);
    for (int m = gw; m < MT; m += NGW) rms_row_i8((const float*)a.in[I_X] + (size_t)m * DM, (const float*)a.in[I_GMIX], F.dout + DO_H1 + (size_t)m * DM, (float*)(ws + WS_SA_H1) + m, F.lane);
    for (int m = gw; m < MROWS; m += NGW) rms_row_i8((const float*)a.in[I_MEM] + (size_t)m * DM, (const float*)a.in[I_GMEM], F.dout + DO_MEMN + (size_t)m * DM, (float*)(ws + WS_SA_MEM) + m, F.lane);
    ISTAMP(F, 43);
    const int gt = F.bid * NTHREADS + F.tid, NGT = F.G * NTHREADS;
    for (int i = gt; i < 16 * 128 * 128 / 8; i += NGT) {
        const GAS f32x4* s = (const GAS f32x4*)a.in[I_SUBK] + 2 * (size_t)i; const f32x4 v0 = s[0], v1 = s[1];
        u32x4 o; o.x = pk2(v0.x, v0.y); o.y = pk2(v0.z, v0.w); o.z = pk2(v1.x, v1.y); o.w = pk2(v1.z, v1.w);
        ((GAS u32x4*)(ws + WS_SUBK))[i] = o;
    }
    for (int i = gt; i < MT * 64; i += NGT) {
        const int t = i >> 6, k = i & 63; const double pos = (double)((const int*)a.in[I_POS])[t];
        { const double rv = pos * a.fret[k] * 0.15915494309189533577; const float fr = (float)(rv - __builtin_floor(rv));
          ((GAS f32x2*)(F.dout + DO_CSRET))[i] = (f32x2){__builtin_amdgcn_cosf(fr), __builtin_amdgcn_sinf(fr)}; }
        { const double rv = pos * a.frot[k] * 0.15915494309189533577; const float fr = (float)(rv - __builtin_floor(rv));
          ((GAS f32x2*)(F.dout + DO_CSROT))[i] = (f32x2){__builtin_amdgcn_cosf(fr), __builtin_amdgcn_sinf(fr)}; }
    }
    constexpr int C_IN = (DM / 64) * (INW / 256), C_KV = (DM / 64) * (4096 / 256);
    for (int it = gw; it < C_IN + C_KV; it += NGW) {
        if (it < C_IN) cmax_item((const float*)a.in[I_WIN], INW, (unsigned*)(ws + WS_CMAX_IN), it, F.lane);
        else cmax_item((const float*)a.in[I_WKV], 4096, (unsigned*)(ws + WS_CMAX_KV), it - C_IN, F.lane);
    }
}

DI void row_q8(const bf16_t* src, unsigned char* dst, float* sc, const unsigned* rmax, int lane) {
    const GAS u32x4* sp = (const GAS u32x4*)src + lane; u32x4 w[4];
#pragma unroll
    for (int q = 0; q < 4; ++q) w[q] = __builtin_nontemporal_load(sp + 64 * q);
    float m;
    if (rmax) m = __builtin_bit_cast(float, *rmax);
    else { unsigned mx = 0u;
#pragma unroll
        for (int q = 0; q < 4; ++q)
#pragma unroll
            for (int c = 0; c < 4; ++c) { const unsigned v = w[q][c], lo = (v << 16) & 0x7fffffffu, hi = v & 0x7fff0000u; mx = mx > lo ? mx : lo; mx = mx > hi ? mx : hi; }
        m = wave_max(__builtin_bit_cast(float, mx)); }
    const float inv = (m > 0.f) ? 127.0f / m : 0.f;
    GAS u32x2* dp = (GAS u32x2*)dst + lane;
#pragma unroll
    for (int q = 0; q < 4; ++q) { u32x2 o; o.x = q8_pack((f32x4){bf_lo(w[q].x), bf_hi(w[q].x), bf_lo(w[q].y), bf_hi(w[q].y)}, inv); o.y = q8_pack((f32x4){bf_lo(w[q].z), bf_hi(w[q].z), bf_lo(w[q].w), bf_hi(w[q].w)}, inv); dp[64 * q] = o; }
    if (lane == 0) *sc = m * (1.0f / 127.0f);
}
DI void ph0b_quant(const Frame& F, const Args& a) {
    LAS float* scr = (LAS float*)(F.lds + F.wave * 17408);
    const int gw = F.bid * NWAVES + F.wave, NGW = F.G * NWAVES;
    constexpr int I_IN = (DM / 64) * (INW / 64), I_KV = (DM / 64) * (4096 / 64);
    for (int it = gw; it < I_IN + I_KV; it += NGW) {
        if (it < I_IN) tr_item8((const float*)a.in[I_WIN], DM, INW, F.ws + WS_WIN_T, (float*)(F.ws + WS_SB_IN), (const unsigned*)(F.ws + WS_CMAX_IN), 4096, 7168, scr, it, F.lane);
        else tr_item8((const float*)a.in[I_WKV], DM, 4096, F.ws + WS_WKV_T, (float*)(F.ws + WS_SB_KV), (const unsigned*)(F.ws + WS_CMAX_KV), 0, 0, scr, it - I_IN, F.lane);
    }
    for (int r = gw; r < 4 * DM; r += NGW) { const int w = r >> 11, n = r & 2047;
        const size_t srcs[4] = {WS_WOUT_T, WS_WQ_T, WS_WO_T, WS_WPQ_T}, dsts[4] = {WS_W8_OUT, WS_W8_Q, WS_W8_O, WS_W8_PQ}, scs[4] = {WS_SB_OUT, WS_SB_Q, WS_SB_O, WS_SB_PQ};
        row_q8((const bf16_t*)(F.ws + srcs[w]) + (size_t)n * DM, F.ws + dsts[w] + (size_t)n * DM, (float*)(F.ws + scs[w]) + n, nullptr, F.lane); }
    for (int n = gw; n < DM; n += NGW) { const GAS u32x4* sp = (const GAS u32x4*)((const bf16_t*)(F.ws + WS_WBR_T) + (size_t)n * 1024) + F.lane; const u32x4 w0 = sp[0], w1 = sp[64];
        unsigned mx = 0u;
#pragma unroll
        for (int c = 0; c < 4; ++c) { const unsigned v = w0[c], lo = (v << 16) & 0x7fffffffu, hi = v & 0x7fff0000u, v2 = w1[c], lo2 = (v2 << 16) & 0x7fffffffu, hi2 = v2 & 0x7fff0000u;
            mx = mx > lo ? mx : lo; mx = mx > hi ? mx : hi; mx = mx > lo2 ? mx : lo2; mx = mx > hi2 ? mx : hi2; }
        const float m = wave_max(__builtin_bit_cast(float, mx)), inv = (m > 0.f) ? 127.0f / m : 0.f;
        GAS u32x2* dp = (GAS u32x2*)(F.ws + WS_W8_BR + (size_t)n * 1024) + F.lane;
        dp[0] = (u32x2){q8_pack((f32x4){bf_lo(w0.x), bf_hi(w0.x), bf_lo(w0.y), bf_hi(w0.y)}, inv), q8_pack((f32x4){bf_lo(w0.z), bf_hi(w0.z), bf_lo(w0.w), bf_hi(w0.w)}, inv)};
        dp[64] = (u32x2){q8_pack((f32x4){bf_lo(w1.x), bf_hi(w1.x), bf_lo(w1.y), bf_hi(w1.y)}, inv), q8_pack((f32x4){bf_lo(w1.z), bf_hi(w1.z), bf_lo(w1.w), bf_hi(w1.w)}, inv)};
        if (F.lane == 0) ((float*)(F.ws + WS_SB_BR))[n] = m * (1.0f / 127.0f); }
    for (int n = gw; n < DM; n += NGW) { const u32x4 w = ((const GAS u32x4*)((const bf16_t*)(F.ws + WS_WBD_T) + (size_t)n * 512))[F.lane];
        unsigned mx = 0u;
#pragma unroll
        for (int c = 0; c < 4; ++c) { const unsigned v = w[c], lo = (v << 16) & 0x7fffffffu, hi = v & 0x7fff0000u; mx = mx > lo ? mx : lo; mx = mx > hi ? mx : hi; }
        const float m = wave_max(__builtin_bit_cast(float, mx)), inv = (m > 0.f) ? 127.0f / m : 0.f;
        u32x2 o; o.x = q8_pack((f32x4){bf_lo(w.x), bf_hi(w.x), bf_lo(w.y), bf_hi(w.y)}, inv); o.y = q8_pack((f32x4){bf_lo(w.z), bf_hi(w.z), bf_lo(w.w), bf_hi(w.w)}, inv);
        ((GAS u32x2*)(F.ws + WS_W8_BD + (size_t)n * 512))[F.lane] = o;
        if (F.lane == 0) ((float*)(F.ws + WS_SB_BD))[n] = m * (1.0f / 127.0f); }
}
#ifndef WGM_PROJ
#define WGM_PROJ 4
#endif
#ifndef WGM_MID
#define WGM_MID 2
#endif
struct Unit1 { const char* A; const char* B; int pm, pn; int mode; bf16_t* out; int ldo; float scale; const float* cs; const float* sa; const float* sb; };
struct Sched1 {
    typedef Unit1 Unit;
    int G, c; unsigned char* ws; unsigned char* dout;
    DI bool next(int i, Unit& u) const {
        const int L = i * G + c; if (L >= 3328) return false;
        if (L < 3200) {
            int pm, pn; pg8::tile_of<WGM_PROJ>(L, 64, 50, pm, pn); u.pm = pm; u.pn = pn;
            u.A = (const char*)(dout + DO_H1) + (size_t)pm * 256 * DM; u.B = (const char*)(ws + WS_WIN_T) + (size_t)pn * 256 * DM;
            u.sa = (const float*)(ws + WS_SA_H1) + pm * 256; u.sb = (const float*)(ws + WS_SB_IN) + pn * 256;
            u.scale = 1.f; u.cs = nullptr; u.mode = 0;
            const size_t rowoff = (size_t)pm * 256;
            if (pn < 4)       { u.mode = 1; u.out = (bf16_t*)(ws + WS_RQ) + rowoff * 1024 + (pn - 0) * 256; u.ldo = 1024; u.cs = (const float*)(dout + DO_CSRET); }
            else if (pn < 8)  { u.mode = 1; u.out = (bf16_t*)(ws + WS_RK) + rowoff * 1024 + (pn - 4) * 256; u.ldo = 1024; u.cs = (const float*)(dout + DO_CSRET); u.scale = 0.08838834764831845f; }
            else if (pn < 12) { u.out = (bf16_t*)(ws + WS_RV) + rowoff * 1024 + (pn - 8) * 256; u.ldo = 1024; }
            else if (pn < 16) { u.mode = 2; u.out = (bf16_t*)(ws + WS_SG) + rowoff * 1024 + (pn - 12) * 256; u.ldo = 1024; }
            else if (pn < 22) { u.mode = 1; u.out = (bf16_t*)(ws + WS_DQ) + rowoff * 1536 + (pn - 16) * 256; u.ldo = 1536; u.cs = (const float*)(dout + DO_CSROT); u.scale = 0.08838834764831845f * 1.4426950408889634f; }
            else if (pn < 28) { u.mode = 1; u.out = (bf16_t*)(ws + WS_DK) + rowoff * 1536 + (pn - 22) * 256; u.ldo = 1536; u.cs = (const float*)(dout + DO_CSROT); }
            else if (pn < 34) { u.out = (bf16_t*)(ws + WS_DV) + rowoff * 1536 + (pn - 28) * 256; u.ldo = 1536; }
            else if (pn < 42) { u.mode = 3; u.out = (bf16_t*)(ws + WS_GR) + rowoff * 2048 + (pn - 34) * 256; u.ldo = 2048; }
            else              { u.mode = 3; u.out = (bf16_t*)(ws + WS_GD) + rowoff * 2048 + (pn - 42) * 256; u.ldo = 2048; }
        } else {
            const int l = L - 3200; u.mode = 0; u.scale = 1.f; u.cs = nullptr; u.ldo = 2048;
            if (l < 64) { const int pm = l >> 3, pn = l & 7; u.pm = pm; u.pn = pn;
                u.A = (const char*)(dout + DO_MEMN) + (size_t)pm * 256 * DM; u.B = (const char*)(ws + WS_WKV_T) + (size_t)pn * 256 * DM;
                u.sa = (const float*)(ws + WS_SA_MEM) + pm * 256; u.sb = (const float*)(ws + WS_SB_KV) + pn * 256;
                u.out = (bf16_t*)(ws + WS_KM) + (size_t)pm * 256 * 2048 + pn * 256; }
            else { const int l2 = l - 64, pm = l2 >> 3, pn = l2 & 7; u.pm = pm; u.pn = pn;
                u.A = (const char*)(ws + WS_WKV_T) + (size_t)(2048 + pm * 256) * DM; u.B = (const char*)(dout + DO_MEMN) + (size_t)pn * 256 * DM;
                u.sa = (const float*)(ws + WS_SB_KV) + 2048 + pm * 256; u.sb = (const float*)(ws + WS_SA_MEM) + pn * 256;
                u.out = (bf16_t*)(ws + WS_VT) + (size_t)pm * 256 * 2048 + pn * 256; }
        }
        return true;
    }
};
struct EpiNull1 {
    DI void operator()(const f32x4 (&acc)[2][2][4][2], const Unit1& u, int wr, int wc, int fr, int fq, int wid, int lane) const {
#pragma unroll
        for (int ai = 0; ai < 2; ++ai)
#pragma unroll
            for (int bj = 0; bj < 2; ++bj)
#pragma unroll
                for (int m = 0; m < 4; ++m) { asm volatile("" :: "v"(acc[ai][bj][m][0]), "v"(acc[ai][bj][m][1])); }
    }
};
struct EpiProj {
    template <int MODE> DI void emit(const f32x4 (&acc)[2][2][4][2], const Unit1& u, int wr, int wc, int fr, int fq) const {
        int rowl0 = wr * 64 + fr, colb = wc * 32 + 8 * fq;
        asm volatile("" : "+v"(rowl0), "+v"(colb));
        f32x4 sb[2][2];
#pragma unroll
        for (int bj = 0; bj < 2; ++bj) { const GAS f32x4* sp = (const GAS f32x4*)(u.sb + bj * 128 + colb); sb[bj][0] = sp[0]; sb[bj][1] = sp[1]; }
        float sa2[2][4];
#pragma unroll
        for (int ai = 0; ai < 2; ++ai)
#pragma unroll
            for (int m = 0; m < 4; ++m) sa2[ai][m] = u.sa[ai * 128 + m * 16 + rowl0];
#pragma unroll
        for (int ai = 0; ai < 2; ++ai) {
            f32x4 cs[4][2]; float sa[4];
#pragma unroll
            for (int m = 0; m < 4; ++m) sa[m] = sa2[ai][m];
            if (MODE == 1) {
#pragma unroll
                for (int m = 0; m < 4; ++m) { const GAS f32x4* cp = (const GAS f32x4*)(u.cs + ((size_t)(u.pm * 256 + ai * 128 + m * 16 + rowl0) * 64 + (colb >> 1)) * 2); cs[m][0] = cp[0]; cs[m][1] = cp[1]; }
#pragma unroll
                for (int m = 0; m < 4; ++m) { const float f = sa[m] * u.scale; cs[m][0] = cs[m][0] * f; cs[m][1] = cs[m][1] * f; }
            }
            __builtin_amdgcn_sched_barrier(0);
#pragma unroll
            for (int m = 0; m < 4; ++m) {
                const int rl = ai * 128 + m * 16 + rowl0;
                f32x4 cs0 = {1.f, 0.f, 1.f, 0.f}, cs1 = cs0;
                if (MODE == 1) { cs0 = cs[m][0]; cs1 = cs[m][1]; }
                bf16_t* rowp = u.out + (size_t)rl * u.ldo + colb;
#pragma unroll
                for (int bj = 0; bj < 2; ++bj) {
                    f32x4 v0 = __builtin_convertvector(__builtin_bit_cast(pg8::i32x4, acc[ai][bj][m][0]), f32x4) * sb[bj][0], v1 = __builtin_convertvector(__builtin_bit_cast(pg8::i32x4, acc[ai][bj][m][1]), f32x4) * sb[bj][1];
                    if (MODE != 1) { v0 = v0 * sa[m]; v1 = v1 * sa[m]; }
                    if (MODE == 1) {
                        const f32x4 a0 = v0, a1 = v1;
                        v0.x = a0.x * cs0.x - a0.y * cs0.y; v0.y = a0.y * cs0.x + a0.x * cs0.y;
                        v0.z = a0.z * cs0.z - a0.w * cs0.w; v0.w = a0.w * cs0.z + a0.z * cs0.w;
                        v1.x = a1.x * cs1.x - a1.y * cs1.y; v1.y = a1.y * cs1.x + a1.x * cs1.y;
                        v1.z = a1.z * cs1.z - a1.w * cs1.w; v1.w = a1.w * cs1.z + a1.z * cs1.w;
                    } else if (MODE == 2) {
#pragma unroll
                        for (int e = 0; e < 4; ++e) { v0[e] = v0[e] * sigmoid_f(v0[e]); v1[e] = v1[e] * sigmoid_f(v1[e]); }
                    } else if (MODE == 3) {
#pragma unroll
                        for (int e = 0; e < 4; ++e) { v0[e] = sigmoid_f(v0[e]); v1[e] = sigmoid_f(v1[e]); }
                    }
                    u32x4 w; w.x = pk2(v0.x, v0.y); w.y = pk2(v0.z, v0.w); w.z = pk2(v1.x, v1.y); w.w = pk2(v1.z, v1.w);
                    __builtin_nontemporal_store(w, (GAS u32x4*)(rowp + bj * 128));
                }
            }
        }
    }
    DI void operator()(const f32x4 (&acc)[2][2][4][2], const Unit1& u, int wr, int wc, int fr, int fq, int wid, int lane) const {
        if (u.mode == 0) emit<0>(acc, u, wr, wc, fr, fq);
        else if (u.mode == 1) emit<1>(acc, u, wr, wc, fr, fq);
        else if (u.mode == 2) emit<2>(acc, u, wr, wc, fr, fq);
        else emit<3>(acc, u, wr, wc, fr, fq);
    }
};

#define MFMA32(a, b, c) __builtin_amdgcn_mfma_f32_32x32x16_bf16((a), (b), (c), 0, 0, 0)
DI int crow(int reg, int h) { return (reg & 3) + 8 * (reg >> 2) + 4 * h; }
DI s16x4 tr4(LAS const unsigned char* p) { return __builtin_bit_cast(s16x4, __builtin_amdgcn_ds_read_tr16_b64_v4i16((LAS v4i16_t*)p)); }
DI bf16x8 frag_tr(LAS const unsigned char* base, int pitch, int k0, int c0, int lane) {
    const int h = lane >> 5, blk = (lane >> 4) & 1, q = (lane & 15) >> 2, p = lane & 3;
    LAS const unsigned char* a = base + (k0 + 8 * h + q) * pitch + (c0 + 16 * blk + 4 * p) * 2;
    const s16x4 lo = tr4(a), hi = tr4(a + 4 * pitch);
    return __builtin_shufflevector(lo, hi, 0, 1, 2, 3, 4, 5, 6, 7);
}
DI bf16x8 frag_nt(LAS const unsigned char* base, int pitch, int r0, int k0, int lane) {
    return *(LAS const bf16x8*)(base + (r0 + (lane & 31)) * pitch + (k0 + 8 * (lane >> 5)) * 2);
}
DI f32x16 zero16() { f32x16 z;
#pragma unroll
    for (int i = 0; i < 16; ++i) z[i] = 0.f; return z; }
DI u32x4 scale_bf16x8(u32x4 v, float s) {
    u32x4 o; o.x = pk2(bf_lo(v.x) * s, bf_hi(v.x) * s); o.y = pk2(bf_lo(v.y) * s, bf_hi(v.y) * s); o.z = pk2(bf_lo(v.z) * s, bf_hi(v.z) * s); o.w = pk2(bf_lo(v.w) * s, bf_hi(v.w) * s); return o;
}
DI float ret_lg2gamma(int h) { return __builtin_log2f(1.0f - __builtin_exp2f(-5.0f - (float)h)); }

DI void ret_kv_item(const Frame& F, int bh, int n) {
    const int b = bh >> 3, h = bh & 7; const float lg = ret_lg2gamma(h);
    LAS unsigned char* VL = F.lds; LAS unsigned char* KL = F.lds + 128 * 320;
    const bf16_t* RK = (const bf16_t*)(F.ws + WS_RK); const bf16_t* RV = (const bf16_t*)(F.ws + WS_RV);
#pragma unroll
    for (int it = 0; it < 8; ++it) {
        const int idx = F.tid + NTHREADS * it, which = idx >> 11, rem = idx & 2047, row = rem >> 4, ch = rem & 15;
        const size_t tok = (size_t)b * SEQ + n * 128 + row;
        u32x4 v = *(const GAS u32x4*)((which ? RK : RV) + tok * 1024 + h * 128 + ch * 8);
        if (which) v = scale_bf16x8(v, fast_exp2(lg * (float)(127 - row)));
        *(LAS u32x4*)((which ? KL : VL) + row * 320 + ch * 16) = v;
    }
    __syncthreads();
    const int w = F.wave, lane = F.lane, eb = w >> 1, db0 = 2 * (w & 1);
    f32x16 acc0 = zero16(), acc1 = zero16();
#pragma unroll
    for (int s = 0; s < 8; ++s) {
        const bf16x8 a = frag_tr(VL, 320, 16 * s, 32 * eb, lane);
        const bf16x8 b0 = frag_tr(KL, 320, 16 * s, 32 * db0, lane), b1 = frag_tr(KL, 320, 16 * s, 32 * (db0 + 1), lane);
        acc0 = MFMA32(a, b0, acc0); acc1 = MFMA32(a, b1, acc1);
    }
    float* dst = (float*)(F.ws + WS_KVST) + ((size_t)(bh * 16 + n) * 128) * 128;
    const int r = lane & 31, hh = lane >> 5;
#pragma unroll
    for (int reg = 0; reg < 16; ++reg) { const int e = 32 * eb + crow(reg, hh);
        dst[(size_t)e * 128 + 32 * db0 + r] = acc0[reg]; dst[(size_t)e * 128 + 32 * (db0 + 1) + r] = acc1[reg]; }
    __syncthreads();
}

struct DilRegs { u32x4 vst[8], kst[8]; bf16x8 qf[8]; };
DI void dil_issue(const Frame& F, int item, DilRegs& R) {
    const int b = item / 192, rem = item % 192, head = rem >> 4, idx16 = rem & 15;
    const int g = head >> 2, r = (g == 0) ? 1 : (g == 1) ? 4 : 16, nbk = 16 / r, c = idx16 / nbk, n = idx16 % nbk;
    const bf16_t* DQ = (const bf16_t*)(F.ws + WS_DQ); const bf16_t* DK = (const bf16_t*)(F.ws + WS_DK); const bf16_t* DV = (const bf16_t*)(F.ws + WS_DV);
    const size_t tb = (size_t)b * SEQ; const int kbmin = (n == 0) ? 4 : 0;
    const int lane = F.lane, rr = lane & 31, hh = lane >> 5, wq = F.wave & 3;
#pragma unroll
    for (int it = 0; it < 8; ++it) {
        const int idx = F.tid + NTHREADS * it, row = idx >> 4, ch = idx & 15; const int rowl = (row >= 32 * kbmin) ? row : 128 + (row & 127);
        const size_t tok = tb + (size_t)((128 * (n - 1) + rowl) * r + c);
        R.vst[it] = *(const GAS u32x4*)(DV + tok * 1536 + head * 128 + ch * 8);
        R.kst[it] = *(const GAS u32x4*)(DK + tok * 1536 + head * 128 + ch * 8);
    }
    const size_t tokq = tb + (size_t)((128 * n + 32 * wq + rr) * r + c);
    const bf16_t* qp = DQ + tokq * 1536 + head * 128 + 8 * hh;
#pragma unroll
    for (int s = 0; s < 8; ++s) R.qf[s] = *(const GAS bf16x8*)(qp + 16 * s);
}
DI void dil_item(const Frame& F, int item, int nxt, DilRegs& R) {
    const int b = item / 192, rem = item % 192, head = rem >> 4, idx16 = rem & 15;
    const int g = head >> 2, r = (g == 0) ? 1 : (g == 1) ? 4 : 16, nbk = 16 / r, c = idx16 / nbk, n = idx16 % nbk;
    LAS unsigned char* VL = F.lds;
    LAS unsigned char* KL = F.lds + 256 * 320;
    LAS unsigned char* PL = F.lds + 256 * 320;
    LAS float* SMAX = (LAS float*)(F.lds + 256 * 320 + 256 * 272);
    LAS float* SSUM = SMAX + 256;
    bf16_t* DQ = (bf16_t*)(F.ws + WS_DQ);
    const size_t tb = (size_t)b * SEQ;
    const int kbmin = (n == 0) ? 4 : 0;
    const int lane = F.lane, rr = lane & 31, hh = lane >> 5, wq = F.wave & 3, wd = F.wave >> 2;
    const int qi = 32 * wq + rr;
    const size_t tokq = tb + (size_t)((128 * n + qi) * r + c);
#pragma unroll
    for (int it = 0; it < 8; ++it) { const int idx = F.tid + NTHREADS * it, row = idx >> 4, ch = idx & 15;
        if (row >= 32 * kbmin) { *(LAS u32x4*)(VL + row * 320 + ch * 16) = R.vst[it]; *(LAS u32x4*)(KL + row * 272 + ch * 16) = R.kst[it]; } }
    bf16x8 qf[8];
#pragma unroll
    for (int s = 0; s < 8; ++s) qf[s] = R.qf[s];
    __syncthreads();
    f32x16 st[3]; bool val[3]; float mloc = -INFINITY;
#pragma unroll
    for (int sl = 0; sl < 3; ++sl) {
        const int kb = wq + wd + 2 * sl; val[sl] = (kb <= wq + 4) && (kb >= kbmin);
        st[sl] = zero16();
        if (val[sl]) {
#pragma unroll
            for (int s = 0; s < 8; ++s) st[sl] = MFMA32(frag_nt(KL, 272, 32 * kb, 16 * s, lane), qf[s], st[sl]);
#pragma unroll
            for (int reg = 0; reg < 16; ++reg) { const int jj = 32 * kb + crow(reg, hh); const bool ok = (jj >= qi) && (jj <= qi + 128);
                st[sl][reg] = ok ? st[sl][reg] : -INFINITY; mloc = fmaxf(mloc, st[sl][reg]); }
        }
    }
    dil_issue(F, nxt, R);
    mloc = fmaxf(mloc, __shfl_xor(mloc, 32));
    if (hh == 0) SMAX[wd * 128 + qi] = mloc;
    __syncthreads();
    const float mx = fmaxf(SMAX[qi], SMAX[128 + qi]);
    float lloc = 0.f;
#pragma unroll
    for (int sl = 0; sl < 3; ++sl) {
        if (val[sl]) { const int kb = wq + wd + 2 * sl;
#pragma unroll
            for (int reg = 0; reg < 16; ++reg) { const float p = fast_exp2(st[sl][reg] - mx); st[sl][reg] = p; lloc += p; }
#pragma unroll
            for (int g4 = 0; g4 < 4; ++g4) { u32x2 w; w.x = pk2(st[sl][4 * g4], st[sl][4 * g4 + 1]); w.y = pk2(st[sl][4 * g4 + 2], st[sl][4 * g4 + 3]);
                *(LAS u32x2*)(PL + qi * 528 + (32 * kb + 8 * g4 + 4 * hh) * 2) = w; }
        }
    }
    lloc += __shfl_xor(lloc, 32);
    if (hh == 0) SSUM[wd * 128 + qi] = lloc;
    __syncthreads();
    const float lsum = SSUM[qi] + SSUM[128 + qi];
    f32x16 o0 = zero16(), o1 = zero16();
    const int kb_lo = (wq > kbmin) ? wq : kbmin;
    for (int kb = kb_lo; kb <= wq + 4; ++kb) {
#pragma unroll
        for (int s = 0; s < 2; ++s) {
            const bf16x8 pb = frag_nt(PL, 528, 32 * wq, 32 * kb + 16 * s, lane);
            const bf16x8 a0 = frag_tr(VL, 320, 32 * kb + 16 * s, 64 * wd, lane), a1 = frag_tr(VL, 320, 32 * kb + 16 * s, 64 * wd + 32, lane);
            o0 = MFMA32(a0, pb, o0); o1 = MFMA32(a1, pb, o1);
        }
    }
    const float inv = 1.0f / lsum;
    bf16_t* op = DQ + tokq * 1536 + head * 128 + 64 * wd + 4 * hh;
#pragma unroll
    for (int g4 = 0; g4 < 4; ++g4) {
        u32x2 w0, w1; w0.x = pk2(o0[4 * g4] * inv, o0[4 * g4 + 1] * inv); w0.y = pk2(o0[4 * g4 + 2] * inv, o0[4 * g4 + 3] * inv);
        w1.x = pk2(o1[4 * g4] * inv, o1[4 * g4 + 1] * inv); w1.y = pk2(o1[4 * g4 + 2] * inv, o1[4 * g4 + 3] * inv);
        *(GAS u32x2*)(op + 8 * g4) = w0; *(GAS u32x2*)(op + 32 + 8 * g4) = w1;
    }
    if (wd == 0 && hh == 0) ((float*)(F.ws + WS_LSE))[(size_t)head * MT + tokq] = mx + __builtin_log2f(lsum);
    __syncthreads();
}

DI void ph2_mixers_a(const Frame& F) {
    const int vb = (F.G % 8 == 0) ? (F.bid % 8) * (F.G / 8) + F.bid / 8 : F.bid;
    for (int it = vb; it < 1024; it += F.G) ret_kv_item(F, it >> 4, it & 15);
    ISTAMP(F, 40);
    { DilRegs R; if (vb < 1536) dil_issue(F, vb, R);
      for (int it = vb; it < 1536; it += F.G) dil_item(F, it, (it + F.G < 1536) ? it + F.G : it, R); }
}

DI void ret_out_item(const Frame& F, int bh, int n) {
    const int b = bh >> 3, h = bh & 7; const float lg = ret_lg2gamma(h);
    LAS unsigned char* VL = F.lds;
    LAS unsigned char* PL = F.lds + 128 * 320;
    LAS unsigned char* PT = PL + 128 * 272;
    LAS float* SQ = (LAS float*)(PT + 128 * 272);
    bf16_t* RQ = (bf16_t*)(F.ws + WS_RQ); const bf16_t* RK = (const bf16_t*)(F.ws + WS_RK); const bf16_t* RV = (const bf16_t*)(F.ws + WS_RV); const bf16_t* SG = (const bf16_t*)(F.ws + WS_SG);
    const size_t tb = (size_t)b * SEQ + n * 128;
    LAS unsigned char* KL = (LAS unsigned char*)(SQ + 256);
    const int lane = F.lane, rr = lane & 31, hh = lane >> 5, wq = F.wave & 3, we = F.wave >> 2;
    const int qi = 32 * wq + rr;
    u32x4 vst[4], kst[4], pst[4];
    { const bf16_t* pv = (const bf16_t*)(F.dout + DO_PREVT) + (size_t)(bh * 16 + n) * 16384;
#pragma unroll
      for (int it = 0; it < 4; ++it) { const int idx = F.tid + NTHREADS * it, row = idx >> 4, ch = idx & 15;
          vst[it] = *(const GAS u32x4*)(RV + (tb + row) * 1024 + h * 128 + ch * 8);
          kst[it] = *(const GAS u32x4*)(RK + (tb + row) * 1024 + h * 128 + ch * 8);
          pst[it] = *(const GAS u32x4*)(pv + row * 128 + ch * 8); } }
    bf16x8 qf[8];
    { const bf16_t* qp = RQ + (tb + qi) * 1024 + h * 128 + 8 * hh;
#pragma unroll
      for (int s = 0; s < 8; ++s) qf[s] = *(const GAS bf16x8*)(qp + 16 * s); }
#pragma unroll
    for (int it = 0; it < 4; ++it) { const int idx = F.tid + NTHREADS * it, row = idx >> 4, ch = idx & 15;
        *(LAS u32x4*)(VL + row * 320 + ch * 16) = vst[it]; *(LAS u32x4*)(KL + row * 272 + ch * 16) = kst[it]; *(LAS u32x4*)(PT + row * 272 + ch * 16) = pst[it]; }
    __syncthreads();
#pragma unroll
    for (int sl = 0; sl < 2; ++sl) {
        const int kb = we + 2 * sl;
        if (kb <= wq) {
            f32x16 st = zero16();
#pragma unroll
            for (int s = 0; s < 8; ++s) st = MFMA32(frag_nt(KL, 272, 32 * kb, 16 * s, lane), qf[s], st);
#pragma unroll
            for (int reg = 0; reg < 16; ++reg) { const int j = 32 * kb + crow(reg, hh); st[reg] = (j <= qi) ? st[reg] * fast_exp2(lg * (float)(qi - j)) : 0.f; }
#pragma unroll
            for (int g4 = 0; g4 < 4; ++g4) { u32x2 w; w.x = pk2(st[4 * g4], st[4 * g4 + 1]); w.y = pk2(st[4 * g4 + 2], st[4 * g4 + 3]);
                *(LAS u32x2*)(PL + qi * 272 + (32 * kb + 8 * g4 + 4 * hh) * 2) = w; }
        }
    }
    __syncthreads();
    f32x16 in0 = zero16(), in1 = zero16(), cr0 = zero16(), cr1 = zero16();
    for (int kb = 0; kb <= wq; ++kb) {
#pragma unroll
        for (int s = 0; s < 2; ++s) {
            const bf16x8 pb = frag_nt(PL, 272, 32 * wq, 32 * kb + 16 * s, lane);
            const bf16x8 a0 = frag_tr(VL, 320, 32 * kb + 16 * s, 64 * we, lane), a1 = frag_tr(VL, 320, 32 * kb + 16 * s, 64 * we + 32, lane);
            in0 = MFMA32(a0, pb, in0); in1 = MFMA32(a1, pb, in1);
        }
    }
#pragma unroll
    for (int s = 0; s < 8; ++s) {
        const bf16x8 a0 = frag_nt(PT, 272, 64 * we, 16 * s, lane), a1 = frag_nt(PT, 272, 64 * we + 32, 16 * s, lane);
        cr0 = MFMA32(a0, qf[s], cr0); cr1 = MFMA32(a1, qf[s], cr1);
    }
    const float qw = fast_exp2(lg * (float)(qi + 1));
    float ss = 0.f;
#pragma unroll
    for (int reg = 0; reg < 16; ++reg) { in0[reg] += qw * cr0[reg]; in1[reg] += qw * cr1[reg]; ss += in0[reg] * in0[reg] + in1[reg] * in1[reg]; }
    ss += __shfl_xor(ss, 32);
    if (hh == 0) SQ[we * 128 + qi] = ss;
    __syncthreads();
    const float rstd = 1.0f / sqrtf((SQ[qi] + SQ[128 + qi]) * (1.0f / 128.0f) + EPS);
    const size_t off = (tb + qi) * 1024 + h * 128 + 64 * we + 4 * hh;
    float mxr = 0.f;
#pragma unroll
    for (int g4 = 0; g4 < 4; ++g4) {
        const u32x2 g0 = *(const GAS u32x2*)(SG + off + 8 * g4), g1 = *(const GAS u32x2*)(SG + off + 32 + 8 * g4);
        const f32x4 y0 = {in0[4 * g4] * rstd * bf_lo(g0.x), in0[4 * g4 + 1] * rstd * bf_hi(g0.x), in0[4 * g4 + 2] * rstd * bf_lo(g0.y), in0[4 * g4 + 3] * rstd * bf_hi(g0.y)};
        const f32x4 y1 = {in1[4 * g4] * rstd * bf_lo(g1.x), in1[4 * g4 + 1] * rstd * bf_hi(g1.x), in1[4 * g4 + 2] * rstd * bf_lo(g1.y), in1[4 * g4 + 3] * rstd * bf_hi(g1.y)};
        mxr = fmaxf(mxr, fmaxf(fmaxf(fmaxf(fabsf(y0.x), fabsf(y0.y)), fmaxf(fabsf(y0.z), fabsf(y0.w))), fmaxf(fmaxf(fabsf(y1.x), fabsf(y1.y)), fmaxf(fabsf(y1.z), fabsf(y1.w)))));
        u32x2 w0, w1;
        w0.x = pk2(y0.x, y0.y); w0.y = pk2(y0.z, y0.w); w1.x = pk2(y1.x, y1.y); w1.y = pk2(y1.z, y1.w);
        *(GAS u32x2*)(RQ + off + 8 * g4) = w0; *(GAS u32x2*)(RQ + off + 32 + 8 * g4) = w1;
    }
    atomicMax((unsigned*)(F.ws + WS_RMAX_RQ) + tb + qi, __builtin_bit_cast(unsigned, mxr));
    __syncthreads();
}
DI void ph_scan(const Frame& F) {
    const int gt = F.bid * NTHREADS + F.tid, NGT = F.G * NTHREADS;
    for (int i = gt; i < 64 * 4096; i += NGT) {
        const int bh = i >> 12, c4 = i & 4095; const float cd = fast_exp2(ret_lg2gamma(bh & 7) * 128.0f);
        const float* kv = (const float*)(F.ws + WS_KVST) + (size_t)(bh * 16) * 16384 + c4 * 4;
        bf16_t* pv = (bf16_t*)(F.dout + DO_PREVT) + (size_t)(bh * 16) * 16384 + c4 * 4;
        f32x4 v[16];
#pragma unroll
        for (int n = 0; n < 15; ++n) v[n] = __builtin_nontemporal_load((const GAS f32x4*)(kv + (size_t)n * 16384));
        f32x4 st = {0.f, 0.f, 0.f, 0.f};
#pragma unroll
        for (int n = 0; n < 16; ++n) { u32x2 w; w.x = pk2(st.x, st.y); w.y = pk2(st.z, st.w); *(GAS u32x2*)(pv + (size_t)n * 16384) = w; if (n < 15) st = st * cd + v[n]; }
    }
}
DI void ph3_mixers_b(const Frame& F) {
    const int vb = (F.G % 8 == 0) ? (F.bid % 8) * (F.G / 8) + F.bid / 8 : F.bid;
    for (int it = vb; it < 1024; it += F.G) ret_out_item(F, it >> 4, it & 15);
    bf16_t* DQ = (bf16_t*)(F.ws + WS_DQ); const float* LSE = (const float*)(F.ws + WS_LSE);
    const int gt = F.bid * NTHREADS + F.tid, NGT = F.G * NTHREADS;
    for (int i = gt; i < MT * 64; i += NGT) {
        const int t = i >> 6, hg = (i >> 4) & 3, ch = i & 15;
        const float l0 = LSE[(size_t)hg * MT + t], l1 = LSE[(size_t)(4 + hg) * MT + t], l2 = LSE[(size_t)(8 + hg) * MT + t];
        const float mx = fmaxf(l0, fmaxf(l1, l2)); float w0 = fast_exp2(l0 - mx), w1 = fast_exp2(l1 - mx), w2 = fast_exp2(l2 - mx);
        const float inv = 1.0f / (w0 + w1 + w2); w0 *= inv; w1 *= inv; w2 *= inv;
        bf16_t* p = DQ + (size_t)t * 1536 + hg * 128 + ch * 8;
        const u32x4 a = *(const GAS u32x4*)p, bq = *(const GAS u32x4*)(p + 512), cq = *(const GAS u32x4*)(p + 1024);
        const f32x4 o0 = {w0 * bf_lo(a.x) + w1 * bf_lo(bq.x) + w2 * bf_lo(cq.x), w0 * bf_hi(a.x) + w1 * bf_hi(bq.x) + w2 * bf_hi(cq.x), w0 * bf_lo(a.y) + w1 * bf_lo(bq.y) + w2 * bf_lo(cq.y), w0 * bf_hi(a.y) + w1 * bf_hi(bq.y) + w2 * bf_hi(cq.y)};
        const f32x4 o1 = {w0 * bf_lo(a.z) + w1 * bf_lo(bq.z) + w2 * bf_lo(cq.z), w0 * bf_hi(a.z) + w1 * bf_hi(bq.z) + w2 * bf_hi(cq.z), w0 * bf_lo(a.w) + w1 * bf_lo(bq.w) + w2 * bf_lo(cq.w), w0 * bf_hi(a.w) + w1 * bf_hi(bq.w) + w2 * bf_hi(cq.w)};
        const float mq = wave_max(fmaxf(fmaxf(fmaxf(fabsf(o0.x), fabsf(o0.y)), fmaxf(fabsf(o0.z), fabsf(o0.w))), fmaxf(fmaxf(fabsf(o1.x), fabsf(o1.y)), fmaxf(fabsf(o1.z), fabsf(o1.w)))));
        const float qinv = (mq > 0.f) ? 127.0f / mq : 0.f;
        u32x2 o; o.x = q8_pack(o0, qinv); o.y = q8_pack(o1, qinv);
        *(GAS u32x2*)(F.ws + WS_DQ8 + (size_t)t * 512 + hg * 128 + ch * 8) = o;
        if ((i & 63) == 0) ((float*)(F.ws + WS_SA_DQ))[t] = mq * (1.0f / 127.0f);
    }
}

struct UnitG { const char* A; const char* B; int pm, pn; };
struct SchedG {
    typedef UnitG Unit;
    int G, c, nM, nN; const char* Abase; const char* Bbase; size_t astep, bstep;
    DI bool next(int i, Unit& u) const {
        const int L = i * G + c; if (L >= nM * nN) return false;
        int pm, pn; pg8::tile_of<WGM_MID>(L, nM, nN, pm, pn); u.pm = pm; u.pn = pn;
        u.A = Abase + (size_t)pm * astep; u.B = Bbase + (size_t)pn * bstep; return true;
    }
};
#define EPI_ROWS_BEGIN const int rowl0 = wr * 64 + fr, colb = wc * 32 + 8 * fq; _Pragma("unroll") for (int ai = 0; ai < 2; ++ai) _Pragma("unroll") for (int m = 0; m < 4; ++m) { const int rl = ai * 128 + m * 16 + rowl0;
#define EPI_ROWS_END }
DI u32x4 pack8(const f32x4 v0, const f32x4 v1) { u32x4 w; w.x = pk2(v0.x, v0.y); w.y = pk2(v0.z, v0.w); w.z = pk2(v1.x, v1.y); w.w = pk2(v1.z, v1.w); return w; }
DI void unpack8(const u32x4 w, f32x4& v0, f32x4& v1) { v0 = (f32x4){bf_lo(w.x), bf_hi(w.x), bf_lo(w.y), bf_hi(w.y)}; v1 = (f32x4){bf_lo(w.z), bf_hi(w.z), bf_lo(w.w), bf_hi(w.w)}; }

template <int PASS, bool I8 = false> struct EpiMerge {
    bf16_t* GR; bf16_t* GD; unsigned* rmax; const float* sa; const float* sb;
    DI void operator()(const f32x4 (&acc)[2][2][4][2], const UnitG& u, int wr, int wc, int fr, int fq, int wid, int lane) const {
        int rowl0 = wr * 64 + fr, colb = wc * 32 + 8 * fq;
        if (I8) asm volatile("" : "+v"(rowl0), "+v"(colb));
        const size_t base = (size_t)(u.pm * 256 + rowl0) * 2048 + u.pn * 256 + colb;
        u32x2 cbp[2][2];
        if (I8) {
#pragma unroll
            for (int bj = 0; bj < 2; ++bj) { const GAS f32x4* sp = (const GAS f32x4*)(sb + u.pn * 256 + bj * 128 + colb); const f32x4 c0 = sp[0], c1 = sp[1];
                cbp[bj][0] = (u32x2){pk2(c0.x, c0.y), pk2(c0.z, c0.w)}; cbp[bj][1] = (u32x2){pk2(c1.x, c1.y), pk2(c1.z, c1.w)}; } }
#pragma unroll
        for (int ai = 0; ai < 2; ++ai) {
            u32x4 gr[4][2], gd[4][2]; float ra[4];
            if (I8) {
#pragma unroll
                for (int m = 0; m < 4; ++m) ra[m] = sa[(size_t)(u.pm * 256 + rowl0) + ai * 128 + m * 16]; }
#pragma unroll
            for (int m = 0; m < 4; ++m)
#pragma unroll
                for (int bj = 0; bj < 2; ++bj) { const size_t off = base + (size_t)(ai * 128 + m * 16) * 2048 + bj * 128;
                    gr[m][bj] = *(const GAS u32x4*)(GR + off); if (PASS == 1) gd[m][bj] = *(const GAS u32x4*)(GD + off); }
#pragma unroll
            for (int m = 0; m < 4; ++m) { float mxr = 0.f;
#pragma unroll
                for (int bj = 0; bj < 2; ++bj) { const size_t off = base + (size_t)(ai * 128 + m * 16) * 2048 + bj * 128;
                    f32x4 g0, g1; unpack8(gr[m][bj], g0, g1);
                    f32x4 a0 = acc[ai][bj][m][0], a1 = acc[ai][bj][m][1];
                    if (I8) { const f32x4 c0 = {bf_lo(cbp[bj][0].x), bf_hi(cbp[bj][0].x), bf_lo(cbp[bj][0].y), bf_hi(cbp[bj][0].y)}, c1 = {bf_lo(cbp[bj][1].x), bf_hi(cbp[bj][1].x), bf_lo(cbp[bj][1].y), bf_hi(cbp[bj][1].y)};
                        a0 = __builtin_convertvector(__builtin_bit_cast(pg8::i32x4, a0), f32x4) * (c0 * ra[m]); a1 = __builtin_convertvector(__builtin_bit_cast(pg8::i32x4, a1), f32x4) * (c1 * ra[m]); }
                    if (PASS == 0) *(GAS u32x4*)(GR + off) = pack8(g0 * a0, g1 * a1);
                    else { f32x4 d0, d1; unpack8(gd[m][bj], d0, d1); const f32x4 y0 = g0 + d0 * a0, y1 = g1 + d1 * a1; *(GAS u32x4*)(GD + off) = pack8(y0, y1);
                        mxr = fmaxf(mxr, fmaxf(fmaxf(fmaxf(fabsf(y0.x), fabsf(y0.y)), fmaxf(fabsf(y0.z), fabsf(y0.w))), fmaxf(fmaxf(fabsf(y1.x), fabsf(y1.y)), fmaxf(fabsf(y1.z), fabsf(y1.w))))); } }
                if (PASS == 1) { mxr = fmaxf(mxr, __shfl_xor(mxr, 16)); mxr = fmaxf(mxr, __shfl_xor(mxr, 32));
                    if (fq == 0) atomicMax(rmax + (size_t)(u.pm * 256 + rowl0) + ai * 128 + m * 16, __builtin_bit_cast(unsigned, mxr)); } }
            if (I8) __builtin_amdgcn_sched_barrier(0);
        }
    }
};
DI void quant_rows(const Frame& F, const bf16_t* src, const unsigned* rmax, unsigned char* a8, float* sa8) {
    const int lane = F.lane;
    const int rb = (F.G == 256) ? (F.bid & 7) * 32 + (F.bid >> 3) : F.bid;
#pragma unroll 1
    for (size_t t0 = (size_t)(rb * NWAVES + F.wave) * 8; t0 < MT; t0 += (size_t)F.G * NWAVES * 8) {
        u32x4 w[8][4]; float m[8];
#pragma unroll
        for (int r = 0; r < 8; ++r) { const GAS u32x4* sp = (const GAS u32x4*)(src + (t0 + r) * 2048) + lane;
#pragma unroll
            for (int q = 0; q < 4; ++q) w[r][q] = __builtin_nontemporal_load(sp + 64 * q);
            m[r] = __builtin_bit_cast(float, rmax[t0 + r]); }
#pragma unroll
        for (int r = 0; r < 8; ++r) { const float inv = (m[r] > 0.f) ? 127.0f / m[r] : 0.f;
            GAS u32x2* dp = (GAS u32x2*)(a8 + (t0 + r) * 2048) + lane;
#pragma unroll
            for (int q = 0; q < 4; ++q) { u32x2 o; o.x = q8_pack((f32x4){bf_lo(w[r][q].x), bf_hi(w[r][q].x), bf_lo(w[r][q].y), bf_hi(w[r][q].y)}, inv); o.y = q8_pack((f32x4){bf_lo(w[r][q].z), bf_hi(w[r][q].z), bf_lo(w[r][q].w), bf_hi(w[r][q].w)}, inv); dp[64 * q] = o; }
            if (lane == 0) sa8[t0 + r] = m[r] * (1.0f / 127.0f); }
    }
}
DI void quant_rows1k(const Frame& F, const bf16_t* src, const unsigned* rmax, unsigned char* a8, float* sa8) {
    const int lane = F.lane;
    const int rb = (F.G == 256) ? (F.bid & 7) * 32 + (F.bid >> 3) : F.bid;
#pragma unroll 1
    for (size_t t0 = (size_t)(rb * NWAVES + F.wave) * 8; t0 < MT; t0 += (size_t)F.G * NWAVES * 8) {
        u32x4 w[8][2]; float m[8];
#pragma unroll
        for (int r = 0; r < 8; ++r) { const GAS u32x4* sp = (const GAS u32x4*)(src + (t0 + r) * 1024) + lane;
            w[r][0] = __builtin_nontemporal_load(sp); w[r][1] = __builtin_nontemporal_load(sp + 64);
            m[r] = __builtin_bit_cast(float, rmax[t0 + r]); }
#pragma unroll
        for (int r = 0; r < 8; ++r) { const float inv = (m[r] > 0.f) ? 127.0f / m[r] : 0.f;
            GAS u32x2* dp = (GAS u32x2*)(a8 + (t0 + r) * 1024) + lane;
#pragma unroll
            for (int q = 0; q < 2; ++q) { u32x2 o; o.x = q8_pack((f32x4){bf_lo(w[r][q].x), bf_hi(w[r][q].x), bf_lo(w[r][q].y), bf_hi(w[r][q].y)}, inv); o.y = q8_pack((f32x4){bf_lo(w[r][q].z), bf_hi(w[r][q].z), bf_lo(w[r][q].w), bf_hi(w[r][q].w)}, inv); dp[64 * q] = o; }
            if (lane == 0) sa8[t0 + r] = m[r] * (1.0f / 127.0f); }
    }
}
template <bool F32IN, bool I8 = false> struct EpiResid {
    const float* xf; bf16_t* XB; float* SSQ; unsigned* rmax; const float* sa; const float* sb;
    DI void operator()(const f32x4 (&acc)[2][2][4][2], const UnitG& u, int wr, int wc, int fr, int fq, int wid, int lane) const {
        int rowl0 = wr * 64 + fr, colb = wc * 32 + 8 * fq;
        if (I8) asm volatile("" : "+v"(rowl0), "+v"(colb));
        const size_t trow = (size_t)(u.pm * 256 + rowl0); const size_t base = trow * 2048 + u.pn * 256 + colb;
        f32x4 cb[2][2];
        if (I8) {
#pragma unroll
            for (int bj = 0; bj < 2; ++bj) { const GAS f32x4* sp = (const GAS f32x4*)(sb + u.pn * 256 + bj * 128 + colb); cb[bj][0] = sp[0]; cb[bj][1] = sp[1]; } }
#pragma unroll
        for (int ai = 0; ai < 2; ++ai) {
            f32x4 xo[4][2][2]; float ra[4];
            if (I8) {
#pragma unroll
                for (int m = 0; m < 4; ++m) ra[m] = sa[trow + ai * 128 + m * 16]; }
#pragma unroll
            for (int m = 0; m < 4; ++m)
#pragma unroll
                for (int bj = 0; bj < 2; ++bj) { const size_t off = base + (size_t)(ai * 128 + m * 16) * 2048 + bj * 128;
                    if (F32IN) { xo[m][bj][0] = __builtin_nontemporal_load((const GAS f32x4*)(xf + off)); xo[m][bj][1] = __builtin_nontemporal_load((const GAS f32x4*)(xf + off + 4)); }
                    else unpack8(*(const GAS u32x4*)(XB + off), xo[m][bj][0], xo[m][bj][1]); }
#pragma unroll
            for (int m = 0; m < 4; ++m) { float ss = 0.f, mxr = 0.f;
#pragma unroll
                for (int bj = 0; bj < 2; ++bj) { const size_t off = base + (size_t)(ai * 128 + m * 16) * 2048 + bj * 128;
                    f32x4 a0 = acc[ai][bj][m][0], a1 = acc[ai][bj][m][1];
                    if (I8) { a0 = __builtin_convertvector(__builtin_bit_cast(pg8::i32x4, a0), f32x4) * (cb[bj][0] * ra[m]); a1 = __builtin_convertvector(__builtin_bit_cast(pg8::i32x4, a1), f32x4) * (cb[bj][1] * ra[m]); }
                    const f32x4 y0 = xo[m][bj][0] + a0, y1 = xo[m][bj][1] + a1;
                    *(GAS u32x4*)(XB + off) = pack8(y0, y1);
                    mxr = fmaxf(mxr, fmaxf(fmaxf(fmaxf(fabsf(y0.x), fabsf(y0.y)), fmaxf(fabsf(y0.z), fabsf(y0.w))), fmaxf(fmaxf(fabsf(y1.x), fabsf(y1.y)), fmaxf(fabsf(y1.z), fabsf(y1.w)))));
                    ss += (y0.x * y0.x + y0.y * y0.y) + (y0.z * y0.z + y0.w * y0.w) + (y1.x * y1.x + y1.y * y1.y) + (y1.z * y1.z + y1.w * y1.w); }
                ss += __shfl_xor(ss, 16); ss += __shfl_xor(ss, 32);
                mxr = fmaxf(mxr, __shfl_xor(mxr, 16)); mxr = fmaxf(mxr, __shfl_xor(mxr, 32));
                if (fq == 0) { SSQ[(trow + ai * 128 + m * 16) * 32 + u.pn * 4 + wc] = ss; atomicMax(rmax + trow + ai * 128 + m * 16, __builtin_bit_cast(unsigned, mxr)); } }
        }
    }
};
struct EpiRowScale {
    const float* SSQ; bf16_t* out; float scale;
    DI void operator()(const f32x4 (&acc)[2][2][4][2], const UnitG& u, int wr, int wc, int fr, int fq, int wid, int lane) const {
        const int rowl0 = wr * 64 + fr, colb = wc * 32 + 8 * fq;
        const size_t trow = (size_t)(u.pm * 256 + rowl0);
        f32x4 p[2][4][2];
#pragma unroll
        for (int ai = 0; ai < 2; ++ai)
#pragma unroll
            for (int m = 0; m < 4; ++m) { const float* sp = SSQ + (trow + ai * 128 + m * 16) * 32 + fq * 8; p[ai][m][0] = *(const GAS f32x4*)sp; p[ai][m][1] = *(const GAS f32x4*)(sp + 4); }
#pragma unroll
        for (int ai = 0; ai < 2; ++ai)
#pragma unroll
            for (int m = 0; m < 4; ++m) {
                const f32x4 p0 = p[ai][m][0], p1 = p[ai][m][1];
                float ss = (p0.x + p0.y) + (p0.z + p0.w) + (p1.x + p1.y) + (p1.z + p1.w);
                ss += __shfl_xor(ss, 16); ss += __shfl_xor(ss, 32);
                const float sc = scale / sqrtf(ss * (1.0f / 2048.0f) + EPS);
                bf16_t* rowp = out + (trow + ai * 128 + m * 16) * 2048 + u.pn * 256 + colb;
#pragma unroll
                for (int bj = 0; bj < 2; ++bj) *(GAS u32x4*)(rowp + bj * 128) = pack8(acc[ai][bj][m][0] * sc, acc[ai][bj][m][1] * sc);
            }
    }
};
struct EpiRowScale8 {
    const float* SSQ; bf16_t* out; float scale; const float* sa; const float* sb;
    DI void operator()(const f32x4 (&acc)[2][2][4][2], const UnitG& u, int wr, int wc, int fr, int fq, int wid, int lane) const {
        int rowl0 = wr * 64 + fr, colb = wc * 32 + 8 * fq;
        asm volatile("" : "+v"(rowl0), "+v"(colb));
        const size_t trow = (size_t)(u.pm * 256 + rowl0);
        f32x4 cb[2][2];
#pragma unroll
        for (int bj = 0; bj < 2; ++bj) { const GAS f32x4* sp = (const GAS f32x4*)(sb + u.pn * 256 + bj * 128 + colb); cb[bj][0] = sp[0]; cb[bj][1] = sp[1]; }
#pragma unroll
        for (int ai = 0; ai < 2; ++ai) {
            f32x4 p[4][2]; float ra[4];
#pragma unroll
            for (int m = 0; m < 4; ++m) { const float* sp = SSQ + (trow + ai * 128 + m * 16) * 32 + fq * 8; p[m][0] = *(const GAS f32x4*)sp; p[m][1] = *(const GAS f32x4*)(sp + 4); ra[m] = sa[trow + ai * 128 + m * 16]; }
#pragma unroll
            for (int m = 0; m < 4; ++m) {
                const f32x4 p0 = p[m][0], p1 = p[m][1];
                float ss = (p0.x + p0.y) + (p0.z + p0.w) + (p1.x + p1.y) + (p1.z + p1.w);
                ss += __shfl_xor(ss, 16); ss += __shfl_xor(ss, 32);
                const float sc = scale * ra[m] / sqrtf(ss * (1.0f / 2048.0f) + EPS);
                bf16_t* rowp = out + (trow + ai * 128 + m * 16) * 2048 + u.pn * 256 + colb;
#pragma unroll
                for (int bj = 0; bj < 2; ++bj) *(GAS u32x4*)(rowp + bj * 128) = pack8(__builtin_convertvector(__builtin_bit_cast(pg8::i32x4, acc[ai][bj][m][0]), f32x4) * (cb[bj][0] * sc), __builtin_convertvector(__builtin_bit_cast(pg8::i32x4, acc[ai][bj][m][1]), f32x4) * (cb[bj][1] * sc));
            }
        }
    }
};
struct EpiNull {
    DI void operator()(const f32x4 (&acc)[2][2][4][2], const UnitG& u, int wr, int wc, int fr, int fq, int wid, int lane) const {
#pragma unroll
        for (int ai = 0; ai < 2; ++ai)
#pragma unroll
            for (int bj = 0; bj < 2; ++bj)
#pragma unroll
                for (int m = 0; m < 4; ++m) { asm volatile("" :: "v"(acc[ai][bj][m][0]), "v"(acc[ai][bj][m][1])); }
    }
};
struct Sched7 {
    typedef UnitG Unit; int G, c; const char* QM; const char* KM;
    DI bool next(int i, Unit& u) const {
        const int L0 = i * G + c; if (L0 >= 256) return false;
        const int L = (L0 & 7) * 32 + (L0 >> 3);
        const int bh = L >> 3, pm = L & 7, b = bh >> 2, hd = bh & 3; u.pm = L; u.pn = 0;
        u.A = QM + ((size_t)(b * SEQ + pm * 256) * 2048 + hd * 512) * 2; u.B = KM + ((size_t)(b * MEMT) * 2048 + hd * 512) * 2; return true;
    }
};
struct EpiSoftmax {
    bf16_t* P; LAS float* X;
    DI void operator()(f32x4 (&acc)[2][2][4][2], const UnitG& u, int wr, int wc, int fr, int fq, int wid, int lane) const {
        LAS float* MX = X; LAS float* SM = X + 1024;
        EPI_ROWS_BEGIN
            float mx = -INFINITY;
#pragma unroll
            for (int bj = 0; bj < 2; ++bj)
#pragma unroll
                for (int n = 0; n < 2; ++n) { const f32x4 v = acc[ai][bj][m][n]; mx = fmaxf(mx, fmaxf(fmaxf(v.x, v.y), fmaxf(v.z, v.w))); }
            mx = fmaxf(mx, __shfl_xor(mx, 16)); mx = fmaxf(mx, __shfl_xor(mx, 32));
            if (fq == 0) MX[rl * 4 + wc] = mx;
        EPI_ROWS_END
        asm volatile("s_waitcnt lgkmcnt(0)" ::: "memory"); __builtin_amdgcn_s_barrier(); asm volatile("" ::: "memory");
        {
        EPI_ROWS_BEGIN
            const f32x4 q = *(LAS f32x4*)(MX + rl * 4); const float mx = fmaxf(fmaxf(q.x, q.y), fmaxf(q.z, q.w));
            float s = 0.f;
#pragma unroll
            for (int bj = 0; bj < 2; ++bj)
#pragma unroll
                for (int n = 0; n < 2; ++n) { f32x4 v = acc[ai][bj][m][n]; v.x = fast_exp2(v.x - mx); v.y = fast_exp2(v.y - mx); v.z = fast_exp2(v.z - mx); v.w = fast_exp2(v.w - mx);
                    acc[ai][bj][m][n] = v; s += (v.x + v.y) + (v.z + v.w); }
            s += __shfl_xor(s, 16); s += __shfl_xor(s, 32);
            if (fq == 0) SM[rl * 4 + wc] = s;
        EPI_ROWS_END
        }
        asm volatile("s_waitcnt lgkmcnt(0)" ::: "memory"); __builtin_amdgcn_s_barrier(); asm volatile("" ::: "memory");
        {
        EPI_ROWS_BEGIN
            const f32x4 q = *(LAS f32x4*)(SM + rl * 4); const float inv = 1.0f / ((q.x + q.y) + (q.z + q.w));
            bf16_t* rowp = P + (size_t)(u.pm * 256 + rl) * 256 + colb;
#pragma unroll
            for (int bj = 0; bj < 2; ++bj) *(GAS u32x4*)(rowp + bj * 128) = pack8(acc[ai][bj][m][0] * inv, acc[ai][bj][m][1] * inv);
        EPI_ROWS_END
        }
        asm volatile("s_waitcnt lgkmcnt(0)" ::: "memory"); __builtin_amdgcn_s_barrier(); asm volatile("" ::: "memory");
    }
};
struct Sched8 {
    typedef UnitG Unit; int G, c; const char* P; const char* VT;
    DI bool next(int i, Unit& u) const {
        const int L0 = i * G + c; if (L0 >= 512) return false;
        const int L = (L0 & 7) * 64 + (L0 >> 3);
        const int pn = L & 1, l2 = L >> 1, bh = l2 >> 3, pm = l2 & 7, b = bh >> 2, hd = bh & 3;
        u.pm = b * 8 + pm; u.pn = hd * 2 + pn;
        u.A = P + (size_t)(l2 * 256) * 256 * 2; u.B = VT + ((size_t)(hd * 512 + pn * 256) * 2048 + b * MEMT) * 2; return true;
    }
};
struct EpiPlain {
    bf16_t* out; int ldo; unsigned* rmax;
    DI void operator()(const f32x4 (&acc)[2][2][4][2], const UnitG& u, int wr, int wc, int fr, int fq, int wid, int lane) const {
        EPI_ROWS_BEGIN
            bf16_t* rowp = out + (size_t)(u.pm * 256 + rl) * ldo + u.pn * 256 + colb; float mxr = 0.f;
#pragma unroll
            for (int bj = 0; bj < 2; ++bj) { const f32x4 y0 = acc[ai][bj][m][0], y1 = acc[ai][bj][m][1]; *(GAS u32x4*)(rowp + bj * 128) = pack8(y0, y1);
                mxr = fmaxf(mxr, fmaxf(fmaxf(fmaxf(fabsf(y0.x), fabsf(y0.y)), fmaxf(fabsf(y0.z), fabsf(y0.w))), fmaxf(fmaxf(fabsf(y1.x), fabsf(y1.y)), fmaxf(fabsf(y1.z), fabsf(y1.w))))); }
            mxr = fmaxf(mxr, __shfl_xor(mxr, 16)); mxr = fmaxf(mxr, __shfl_xor(mxr, 32));
            if (fq == 0) atomicMax(rmax + (size_t)(u.pm * 256 + rl), __builtin_bit_cast(unsigned, mxr));
        EPI_ROWS_END
    }
};


DI int fbits(float v) { return __builtin_bit_cast(int, v); }
template <int LOWB> DI int fkey(int b) { return b ^ ((b >> 31) & (0x7fffffff & ~((1 << LOWB) - 1))); }
DI void cmpex_desc(int& a, int& b) { const int mx = a > b ? a : b, mn = a > b ? b : a; a = mx; b = mn; }
template <int BASE, int N> DI void sort16_desc(int (&k)[N]) {
#define CE(a, b) cmpex_desc(k[BASE + a], k[BASE + b]);
    CE(0,13) CE(1,12) CE(2,15) CE(3,14) CE(4,8) CE(5,6) CE(7,11) CE(9,10)
    CE(0,5) CE(1,7) CE(2,9) CE(3,4) CE(6,13) CE(8,14) CE(10,15) CE(11,12)
    CE(0,1) CE(2,3) CE(4,5) CE(6,8) CE(7,9) CE(10,11) CE(12,13) CE(14,15)
    CE(0,2) CE(1,3) CE(4,10) CE(5,11) CE(6,7) CE(8,9) CE(12,14) CE(13,15)
    CE(1,2) CE(3,12) CE(4,6) CE(5,7) CE(8,10) CE(9,11) CE(13,14)
    CE(1,4) CE(2,6) CE(5,8) CE(7,10) CE(9,13) CE(11,14)
    CE(2,4) CE(3,6) CE(9,12) CE(11,13)
    CE(3,5) CE(6,8) CE(7,9) CE(10,12)
    CE(3,4) CE(5,6) CE(7,8) CE(9,10) CE(11,12)
    CE(6,7) CE(8,9)
#undef CE
}
template <int BASE, int N> DI void bitonic16_desc(int (&k)[N]) {
#pragma unroll
    for (int stride = 8; stride > 0; stride >>= 1)
#pragma unroll
        for (int i = 0; i < 16; ++i) { const int l = i ^ stride; if (l > i) cmpex_desc(k[BASE + i], k[BASE + l]); }
}
template <int A, int B, int N> DI void merge_top16(int (&k)[N]) {
#pragma unroll
    for (int i = 0; i < 16; ++i) k[A + i] = (k[A + i] > k[B + 15 - i]) ? k[A + i] : k[B + 15 - i];
    bitonic16_desc<A>(k);
}
constexpr int CONV_ROWS = 2 * 16384, CONV_RING = 3;
constexpr size_t WS_USC = WS_LSE, WS_VSC = WS_LSE + 16384 * 4;
struct ConvCtx { int ci, NGW; };
struct ConvRow { f32x4 r[8]; };
DI void conv_row_issue(ConvRow& R, int ir, const Args& a, int lane) {
    const int i = (ir < CONV_ROWS) ? ir : 0;
    const GAS f32x4* src = ((i < 16384) ? (const GAS f32x4*)a.in[I_PU] : (const GAS f32x4*)a.in[I_PV]) + (size_t)(i & 16383) * 512 + lane;
#pragma unroll
    for (int q = 0; q < 8; ++q) R.r[q] = __builtin_nontemporal_load(src + 64 * q);
}
DI void conv_row_finish(const ConvRow& R, int i, const Frame& F, LAS const f32x4* ggl  ) {
    const int lane = F.lane, e = i & 16383; const bool isU = i < 16384;
    unsigned char* tab = F.ws + (isU ? WS_UTAB : WS_VTAB);
    const unsigned voff = (unsigned)e * 128u + 4u * (unsigned)(lane & 31) + (unsigned)(lane >> 5) * (16384u * 128u);
    f32x4 v[8]; float m = 0.f;
#pragma unroll
    for (int q = 0; q < 8; ++q) { v[q] = isU ? R.r[q] * ggl[q * 64 + lane] : R.r[q]; m = fmaxf(fmaxf(m, fmaxf(fabsf(v[q].x), fabsf(v[q].y))), fmaxf(fabsf(v[q].z), fabsf(v[q].w))); }
    m = wave_max(m); const float inv = (m > 0.f) ? 127.0f / m : 0.f;
    if (i < CONV_ROWS) {
#pragma unroll
        for (int q = 0; q < 8; ++q) *(GAS unsigned*)(tab + (voff + (unsigned)(2 * q) * (16384u * 128u))) = q8_pack(v[q], inv);
        if (lane == 0) ((GAS float*)(F.ws + WS_USC))[i] = m * (1.0f / 127.0f);
    }
}
DI void conv_step(ConvRow& R, ConvCtx& cc, const Frame& F, const Args& a, LAS const f32x4* ggl) {
    conv_row_finish(R, cc.ci, F, ggl);
    conv_row_issue(R, cc.ci + CONV_RING * cc.NGW, a, F.lane);
    cc.ci += cc.NGW;
}
DI void load_qf(bf16x8 (&qf)[8], const Frame& F, size_t tok, int h, int p) {
    const bf16_t* qp = (const bf16_t*)(F.ws + WS_PQ) + tok * 2048 + (2 * h + p) * 128 + 8 * (F.lane >> 5);
#pragma unroll
    for (int s = 0; s < 8; ++s) qf[s] = *(const GAS bf16x8*)(qp + 16 * s);
}
DI void route_pass(const Frame& F, const Args& a, int tg, int tgn, int h, LAS int* topL  , LAS const unsigned char* subL, LAS const f32x4* ggl, ConvCtx& cc, ConvRow (&ring)[CONV_RING]) {
    const int lane = F.lane, rr = lane & 31, hh = lane >> 5; const size_t tok = (size_t)tg * 32 + rr;
    bf16x8 qf[8];
#pragma unroll 1
    for (int p = 0; p < 2; ++p) {
        load_qf(qf, F, tok, h, p);
        __builtin_amdgcn_sched_barrier(0);
        int key[32];
        LAS const unsigned char* kb = subL + (p * 128 + rr) * 272 + 16 * hh;
#pragma unroll
        for (int nb = 0; nb < 4; ++nb) {
            f32x16 acc = zero16();
#pragma unroll
            for (int s = 0; s < 8; ++s) acc = MFMA32(*(LAS const bf16x8*)(kb + nb * 32 * 272 + 32 * s), qf[s], acc);
            if (nb == 0) {
#pragma unroll
                for (int reg = 0; reg < 16; ++reg) key[reg] = (fkey<7>(fbits(acc[reg])) & ~0x7f) | reg;
                sort16_desc<0>(key);
            } else {
#pragma unroll
                for (int reg = 0; reg < 16; ++reg) key[16 + reg] = (fkey<7>(fbits(acc[reg])) & ~0x7f) | (nb * 16 + reg);
                sort16_desc<16>(key); merge_top16<0, 16>(key);
            }
            if (nb < CONV_RING) { __builtin_amdgcn_sched_barrier(0); conv_step(ring[nb], cc, F, a, ggl); __builtin_amdgcn_sched_barrier(0); }
        }
#pragma unroll
        for (int i = 0; i < 16; ++i) key[i] |= hh << 6;
#pragma unroll
        for (int i = 0; i < 16; ++i) key[16 + i] = __shfl_xor(key[i], 32);
        merge_top16<0, 16>(key);
#pragma unroll
        for (int i = 0; i < 16; ++i) topL[(p * 16 + i) * 64 + lane] = key[i];
    }
    LDS_WAIT();
    conv_step(ring[0], cc, F, a, ggl); __builtin_amdgcn_sched_barrier(0);
    float v1[8], v2[8];
#pragma unroll
    for (int k = 0; k < 8; ++k) { v1[k] = __builtin_bit_cast(float, fkey<7>(topL[k * 64 + lane]) & ~0x7f); v2[k] = __builtin_bit_cast(float, fkey<7>(topL[(16 + k) * 64 + lane]) & ~0x7f); }
#define V1(a) (((a) < 8) ? v1[(a) & 7] : __builtin_bit_cast(float, fkey<7>(topL[(a) * 64 + lane]) & ~0x7f))
#define V2(b) (((b) < 8) ? v2[(b) & 7] : __builtin_bit_cast(float, fkey<7>(topL[(16 + (b)) * 64 + lane]) & ~0x7f))
#define CAND(a, b) ((fkey<8>(__builtin_bit_cast(int, V1(a) + V2(b))) & ~0xff) | ((a) * 16 + (b)))
    int m[32];
    const float cmax = __builtin_bit_cast(float, __builtin_bit_cast(int, v1[0] + v2[0]) & ~0xff);
#define COL0(i) m[i] = CAND(i, 0);
    COL0(0) COL0(1) COL0(2) COL0(3) COL0(4) COL0(5) COL0(6) COL0(7) COL0(8) COL0(9) COL0(10) COL0(11) COL0(12) COL0(13) COL0(14) COL0(15)
#undef COL0
#define ROW0(i) { const int r_ = CAND(0, 16 - (i)); m[i] = m[i] > r_ ? m[i] : r_; }
    ROW0(1) ROW0(2) ROW0(3) ROW0(4) ROW0(5) ROW0(6) ROW0(7) ROW0(8) ROW0(9) ROW0(10) ROW0(11) ROW0(12) ROW0(13) ROW0(14) ROW0(15)
#undef ROW0
    bitonic16_desc<0>(m);
    m[16] = CAND(1, 1); m[17] = CAND(1, 2); m[18] = CAND(1, 3); m[19] = CAND(1, 4); m[20] = CAND(1, 5); m[21] = CAND(1, 6); m[22] = CAND(1, 7);
    m[23] = CAND(2, 1); m[24] = CAND(2, 2); m[25] = CAND(2, 3); m[26] = CAND(2, 4); m[27] = CAND(3, 1); m[28] = CAND(3, 2); m[29] = CAND(3, 3); m[30] = CAND(4, 1); m[31] = CAND(4, 2);
    sort16_desc<16>(m);
    { const int t0 = CAND(5, 1), t1 = CAND(6, 1), t2 = CAND(7, 1);
      m[31] = m[31] > t0 ? m[31] : t0; m[30] = m[30] > t1 ? m[30] : t1; m[29] = m[29] > t2 ? m[29] : t2; }
    bitonic16_desc<16>(m);
#undef CAND
#undef V1
#undef V2
#pragma unroll
    for (int i = 0; i < 16; ++i) m[i] = (m[i] > m[31 - i]) ? m[i] : m[31 - i];
    __builtin_amdgcn_sched_barrier(0); conv_step(ring[1], cc, F, a, ggl); __builtin_amdgcn_sched_barrier(0);
    float cv[16]; unsigned ce[16];
#pragma unroll
    for (int k = 0; k < 16; ++k) {
        const int mk = m[k]; cv[k] = __builtin_bit_cast(float, fkey<8>(mk) & ~0xff);
        const int ia = (mk >> 4) & 15, ib = mk & 15;
        const int d1 = topL[ia * 64 + lane], d2 = topL[(16 + ib) * 64 + lane];
        const unsigned i1 = (unsigned)(((d1 & 0x3c) << 1) | ((d1 >> 4) & 4) | (d1 & 3)), i2 = (unsigned)(((d2 & 0x3c) << 1) | ((d2 >> 4) & 4) | (d2 & 3));
        ce[k] = i1 * 128u + i2;
    }
    float gs = 0.f;
#pragma unroll
    for (int k = 0; k < 16; ++k) { cv[k] = fast_exp2((cv[k] - cmax) * 1.4426950408889634f); gs += cv[k]; }
    const float ginv = 1.0f / gs;
    if (hh == 0) {
        unsigned* ep = (unsigned*)(F.ws + WS_EIDX) + tok * 128 + h * 16; float* gp = (float*)(F.ws + WS_GATE) + tok * 128 + h * 16;
#pragma unroll
        for (int k = 0; k < 16; k += 4) { *(GAS u32x4*)(ep + k) = (u32x4){ce[k], ce[k + 1], ce[k + 2], ce[k + 3]}; *(GAS f32x4*)(gp + k) = (f32x4){cv[k] * ginv, cv[k + 1] * ginv, cv[k + 2] * ginv, cv[k + 3] * ginv}; }
    }
    LDS_WAIT();
    __builtin_amdgcn_sched_barrier(0); conv_step(ring[2], cc, F, a, ggl);
}
DI void ph11_route(const Frame& F, const Args& a) {
    LAS int* topL = (LAS int*)(F.lds + F.wave * 8192);
    LAS unsigned char* subL = F.lds + 65536;
    LAS f32x4* ggl = (LAS f32x4*)(F.lds + 65536 + 2 * 128 * 272);
    ConvCtx cc; cc.NGW = F.G * NWAVES; cc.ci = F.bid * NWAVES + F.wave;
    ConvRow ring[CONV_RING];
#pragma unroll
    for (int k = 0; k < CONV_RING; ++k) conv_row_issue(ring[k], cc.ci + k * cc.NGW, a, F.lane);
    ggl[F.tid] = ((const GAS f32x4*)a.in[I_GFFN])[F.tid];
    const int nh = (F.G & 7) ? 8 : 1, first = (nh == 1) ? (F.bid >> 3) : F.bid, stride = (nh == 1) ? (F.G >> 3) : F.G;
#pragma unroll 1
    for (int hi = 0; hi < nh; ++hi) {
        const int h = (nh == 1) ? (F.bid & 7) : hi;
        if (hi) __syncthreads();
        { const GAS u32x4* src = (const GAS u32x4*)((const bf16_t*)(F.ws + WS_SUBK) + (size_t)h * 256 * 128);
#pragma unroll
          for (int r = 0; r < 8; ++r) { const int c = r * NTHREADS + F.tid; *(LAS u32x4*)(subL + (c >> 4) * 272 + (c & 15) * 16) = src[c]; } }
        __syncthreads();
#pragma unroll 1
        for (int tg = first + stride * F.wave; tg < 512; tg += stride * NWAVES) route_pass(F, a, tg, tg, h, topL, subL, ggl, cc, ring);
    }
#pragma unroll 1
    while (cc.ci < CONV_ROWS) {
#pragma unroll
        for (int k = 0; k < CONV_RING; ++k) conv_step(ring[k], cc, F, a, ggl); }
}

DI float gelu_erf(float v) {
    const float av = fabsf(v), t = fast_rcp(av * 0.2316418882f + 1.0f);
    float q = t * 0.5307027145f + (-0.7265760135f); q = q * t + 0.7107068705f; q = q * t + (-0.142248368f); q = q * t + 0.127414796f; q = q * t;
    const float e = fast_exp2((v * v) * (-0.72134752044f)); const float m = v * (q * e);
    return v < 0.f ? m : v - m;
}
template <int CTRL> DI float dpp_f(float v) { return __builtin_bit_cast(float, __builtin_amdgcn_update_dpp(0, __builtin_bit_cast(int, v), CTRL, 0xf, 0xf, false)); }
DI float sum8(float d) { d += dpp_f<0xB1>(d); d += dpp_f<0x4E>(d); d += dpp_f<0x141>(d); return d; }
struct PeerBatch { u32x4 r[8]; };
struct PeerOffs { unsigned o[8]; };
DI void peer_offs(PeerOffs& O, LAS const int* el  , unsigned loff  ) {
#pragma unroll
    for (int ii = 0; ii < 8; ++ii) O.o[ii] = (unsigned)el[8 * ii] + loff;
}
DI void peer_issue(PeerBatch& B, const unsigned char* tb  , const PeerOffs& O) {
#pragma unroll
    for (int ii = 0; ii < 8; ++ii) B.r[ii] = *(const GAS u32x4*)(tb + O.o[ii]);
}

template <int CTRL> DI int dpp_i(int v) { return __builtin_amdgcn_update_dpp(0, v, CTRL, 0xf, 0xf, false); }
template <int VAR> DI void peer_u_pass(const Frame& F, LAS int* PD, LAS const int* elw, const unsigned char* U8, const bf16_t* XB, size_t tok0, int tl0) {
    const int lane = F.lane, g = lane >> 3, j = lane & 7;
        {
            const unsigned char* ub0 = U8; const unsigned loff = 16u * (unsigned)j;
            PeerBatch Ba, Bb;
            LAS unsigned char* XS = F.lds + 81920 + F.wave * 4096;
            const float xinv = ((LAS const float*)(XS + 2048))[lane >> 3];
            const bf16_t* xq_src = XB + (tok0 + (lane >> 3)) * 2048 + 16 * (lane & 7);
            u32x4 xq0 = *(const GAS u32x4*)xq_src, xq1 = *(const GAS u32x4*)(xq_src + 8);
#define U_COMPUTE(B, b) do { \
                const u32x4 xc0 = *(LAS const u32x4*)(xs_); \
                int d_[8]; \
                _Pragma("unroll") for (int ii = 0; ii < 8; ++ii) d_[ii] = 0; \
                _Pragma("unroll") for (int q = 0; q < 4; ++q) { \
                    _Pragma("unroll") for (int ii = 0; ii < 8; ++ii) d_[ii] = __builtin_amdgcn_sdot4((int)(B).r[ii][q], (int)xc0[q], d_[ii], false); } \
                  \
                int e_[4]; _Pragma("unroll") for (int m = 0; m < 4; ++m) { const int snd = bit0 ? d_[m] : d_[4 + m]; e_[m] = (bit0 ? d_[4 + m] : d_[m]) + dpp_i<0xB1>(snd); } \
                int f_[2]; _Pragma("unroll") for (int m = 0; m < 2; ++m) { const int snd = bit1 ? e_[m] : e_[2 + m]; f_[m] = (bit1 ? e_[2 + m] : e_[m]) + dpp_i<0x4E>(snd); } \
                const int snd_ = bit2 ? f_[0] : f_[1]; const int mine_ = (bit2 ? f_[1] : f_[0]) + __shfl_xor(snd_, 4); \
                if (VAR == 2) { asm volatile("" :: "v"(mine_)); } else PD[tl0 * 128 + 64 * (b) + 8 * jrev + g] += mine_; } while (0)
            const bool bit0 = (lane & 1) != 0, bit1 = (lane & 2) != 0, bit2 = (lane & 4) != 0; const int jrev = ((lane & 1) << 2) | (lane & 2) | ((lane >> 2) & 1);
            PeerBatch Bc, Bd;
            if (VAR == 4) { _Pragma("unroll") for (int ii = 0; ii < 8; ++ii) { Ba.r[ii] = (u32x4){0u, 0u, 0u, 0u}; Bb.r[ii] = Ba.r[ii]; Bc.r[ii] = Ba.r[ii]; Bd.r[ii] = Ba.r[ii]; } }
            PeerOffs PO;
#define U_OFFS(fb) do { const int fb_ = ((fb) < 255) ? (fb) : 255; peer_offs(PO, elw + 64 * (fb_ & 15), loff); } while (0)
#define U_ISSUE(B, fb) do { const int fb_ = ((fb) < 255) ? (fb) : 255; if (VAR == 4) { _Pragma("unroll") for (int ii = 0; ii < 8; ++ii) asm volatile("" : "+v"((B).r[ii])); } else peer_issue(B, ub0 + (size_t)(fb_ >> 4) * (16384 * 128), PO); U_OFFS((fb) + 1); } while (0)
#define U_STEP(B, fb, Bn, fbn) do { \
                U_ISSUE(Bn, fbn); \
                __builtin_amdgcn_sched_barrier(0); \
                LAS const unsigned char* xs_ = XS + (((fb) >> 4) & 1) * 1024 + ((((fb) >> 1) & 7) * 8 + j) * 16; \
                if (VAR == 3) { _Pragma("unroll") for (int ii = 0; ii < 8; ++ii) asm volatile("" :: "v"((B).r[ii])); } else U_COMPUTE(B, (fb) & 15); \
                __builtin_amdgcn_sched_barrier(0); } while (0)
            U_OFFS(0); U_ISSUE(Ba, 0); U_ISSUE(Bb, 1); U_ISSUE(Bc, 2);
#pragma unroll 1
            for (int fb = 0; fb < 256; fb += 4) {
                if ((fb & 15) == 0) { const int sl = fb >> 4;
                    u32x4 xo;
                    xo.x = q8_pack((f32x4){bf_lo(xq0.x), bf_hi(xq0.x), bf_lo(xq0.y), bf_hi(xq0.y)}, xinv); xo.y = q8_pack((f32x4){bf_lo(xq0.z), bf_hi(xq0.z), bf_lo(xq0.w), bf_hi(xq0.w)}, xinv);
                    xo.z = q8_pack((f32x4){bf_lo(xq1.x), bf_hi(xq1.x), bf_lo(xq1.y), bf_hi(xq1.y)}, xinv); xo.w = q8_pack((f32x4){bf_lo(xq1.z), bf_hi(xq1.z), bf_lo(xq1.w), bf_hi(xq1.w)}, xinv);
                    *(LAS u32x4*)(XS + (sl & 1) * 1024 + lane * 16) = xo;
                    if (VAR != 1 && VAR != 3 && VAR != 4) { const bf16_t* xp = xq_src + 128 * ((sl < 15) ? sl + 1 : 15); xq0 = *(const GAS u32x4*)xp; xq1 = *(const GAS u32x4*)(xp + 8); }
                }
                U_STEP(Ba, fb, Bd, fb + 3);
                U_STEP(Bb, fb + 1, Ba, fb + 4);
                U_STEP(Bc, fb + 2, Bb, fb + 5);
                U_STEP(Bd, fb + 3, Bc, fb + 6);
            }
#undef U_STEP
#undef U_ISSUE
#undef U_OFFS
#undef U_COMPUTE
        }
}
DI void ph12_peer(const Frame& F, const Args& a) {
    LAS int* EL = (LAS int*)F.lds;
    LAS float* PD = (LAS float*)(F.lds + 32768);
    LAS float* SSL = (LAS float*)(F.lds + 65536);
    LAS unsigned* WB = (LAS unsigned*)(F.lds + 114688);
    const int lane = F.lane, g = lane >> 3, j = lane & 7;
    const bf16_t* XB = (const bf16_t*)(F.ws + WS_XB); bf16_t* XBw = (bf16_t*)(F.ws + WS_XB);
    const unsigned char* U8 = F.ws + WS_UTAB; const unsigned char* V8 = F.ws + WS_VTAB;
    for (int blk = F.bid; blk < MT / 64; blk += F.G) {
        const int tl0 = 8 * F.wave; const size_t tok0 = (size_t)blk * 64 + tl0;
        { int e0[8], e1[8];
#pragma unroll
          for (int tk = 0; tk < 8; ++tk) { const int* ep = (const int*)(F.ws + WS_EIDX) + (tok0 + tk) * 128; e0[tk] = ep[lane]; e1[tk] = ep[64 + lane]; }
#pragma unroll
          for (int tk = 0; tk < 8; ++tk) {
            EL[(tl0 + tk) * 128 + lane] = e0[tk] * 128; EL[(tl0 + tk) * 128 + 64 + lane] = e1[tk] * 128;
            PD[(tl0 + tk) * 128 + lane] = 0.f; PD[(tl0 + tk) * 128 + 64 + lane] = 0.f; SSL[(tl0 + tk) * 64 + lane] = 0.f; } }
        { LAS float* sxl = (LAS float*)(F.lds + 81920 + F.wave * 4096 + 2048);
          u32x4 xr[8][4];
#pragma unroll
          for (int tk = 0; tk < 8; ++tk) { const GAS u32x4* xp = (const GAS u32x4*)(XB + (tok0 + tk) * 2048) + lane;
#pragma unroll
            for (int q = 0; q < 4; ++q) xr[tk][q] = xp[64 * q]; }
#pragma unroll
          for (int tk = 0; tk < 8; ++tk) { unsigned mx = 0u;
#pragma unroll
            for (int q = 0; q < 4; ++q) {
#pragma unroll
                for (int c = 0; c < 4; ++c) { const unsigned w = xr[tk][q][c], lo = (w << 16) & 0x7fffffffu, hi = w & 0x7fff0000u; mx = mx > lo ? mx : lo; mx = mx > hi ? mx : hi; } }
            const float m = wave_max(__builtin_bit_cast(float, mx));
            if (lane == 0) { sxl[tk] = (m > 0.f) ? 127.0f / m : 0.f; sxl[8 + tk] = m * (1.0f / 127.0f); } } }
        LDS_WAIT();
        LAS const int* elw = EL + tl0 * 128 + g;
        peer_u_pass<0>(F, (LAS int*)PD, elw, U8, XB, tok0, tl0);
#if PROBE_PHASE >= 30 && PROBE_PHASE <= 34
        LDS_WAIT(); __syncthreads(); ISTAMP(F, 29);
        peer_u_pass<PROBE_PHASE - 30>(F, (LAS int*)(F.lds + 131072), elw, U8, XB, tok0, tl0);
        LDS_WAIT(); __syncthreads(); ISTAMP(F, PROBE_PHASE);
#endif
        LDS_WAIT(); ISTAMP(F, 20);
#pragma unroll 1
        for (int tk = 0; tk < 8; ++tk) {
            const size_t tok = tok0 + tk;
            const float ssq = wave_sum((lane < 32) ? ((const float*)(F.ws + WS_SSQ2))[tok * 32 + lane] : 0.f);
            const float sc = ((LAS const float*)(F.lds + 81920 + F.wave * 4096 + 2048))[8 + tk] / sqrtf(ssq * (1.0f / 2048.0f) + EPS);
            const float* gp = (const float*)(F.ws + WS_GATE) + tok * 128; const float* usc = (const float*)(F.ws + WS_USC);
            LAS float* pd = PD + (tl0 + tk) * 128; LAS const int* pdi = (LAS const int*)pd; LAS const int* elt = EL + (tl0 + tk) * 128;
            const float su0 = usc[elt[lane] >> 7], su1 = usc[elt[64 + lane] >> 7];
            const float* vsc = (const float*)(F.ws + WS_VSC);
            const float w0 = __builtin_nontemporal_load(gp + lane) * gelu_erf((float)pdi[lane] * (sc * su0)) * vsc[elt[lane] >> 7], w1 = __builtin_nontemporal_load(gp + 64 + lane) * gelu_erf((float)pdi[64 + lane] * (sc * su1)) * vsc[elt[64 + lane] >> 7];
            const float wm = wave_max(fmaxf(fabsf(w0), fabsf(w1))); const float winv = (wm > 0.f) ? 127.0f / wm : 0.f;
            if (lane == 0) ((LAS float*)(F.lds + 81920 + F.wave * 4096 + 2048))[16 + tk] = wm * (1.0f / 127.0f);
            pd[lane] = __builtin_fmaf(w0, winv, 12582912.0f); pd[64 + lane] = __builtin_fmaf(w1, winv, 12582912.0f);
            LDS_WAIT();
            if (lane < 32) { const int k0 = 64 * (lane >> 4) + 32 * ((lane >> 3) & 1) + (lane & 7);
                LAS const unsigned* pu = (LAS const unsigned*)pd + k0;
                WB[(tl0 + tk) * 32 + lane] = __builtin_amdgcn_perm(pu[8], pu[0], 0x0c0c0400u) | __builtin_amdgcn_perm(pu[24], pu[16], 0x04000c0cu); }
        }
        LDS_WAIT(); ISTAMP(F, 21);
        LAS const unsigned* pww = WB + tl0 * 32 + g;
        LAS const float* swl = (LAS const float*)(F.lds + 81920 + F.wave * 4096 + 2048) + 16;
        {
            const unsigned char* vb0 = V8; const unsigned loff = 16u * (unsigned)j;
            PeerBatch Ba, Bb;
            int y[16];
#define V_COMPUTE(B, b) do { \
                LAS const unsigned* pw_ = pww + 16 * (b); \
                _Pragma("unroll") for (int gr = 0; gr < 2; ++gr) { const int w4_ = (int)pw_[8 * gr]; \
                    _Pragma("unroll") for (int q = 0; q < 4; ++q) { \
                        const unsigned l01_ = __builtin_amdgcn_perm((B).r[4 * gr + 1][q], (B).r[4 * gr][q], 0x05010400u), h01_ = __builtin_amdgcn_perm((B).r[4 * gr + 1][q], (B).r[4 * gr][q], 0x07030602u); \
                        const unsigned l23_ = __builtin_amdgcn_perm((B).r[4 * gr + 3][q], (B).r[4 * gr + 2][q], 0x05010400u), h23_ = __builtin_amdgcn_perm((B).r[4 * gr + 3][q], (B).r[4 * gr + 2][q], 0x07030602u); \
                        y[4 * q + 0] = __builtin_amdgcn_sdot4((int)__builtin_amdgcn_perm(l23_, l01_, 0x05040100u), w4_, y[4 * q + 0], false); \
                        y[4 * q + 1] = __builtin_amdgcn_sdot4((int)__builtin_amdgcn_perm(l23_, l01_, 0x07060302u), w4_, y[4 * q + 1], false); \
                        y[4 * q + 2] = __builtin_amdgcn_sdot4((int)__builtin_amdgcn_perm(h23_, h01_, 0x05040100u), w4_, y[4 * q + 2], false); \
                        y[4 * q + 3] = __builtin_amdgcn_sdot4((int)__builtin_amdgcn_perm(h23_, h01_, 0x07060302u), w4_, y[4 * q + 3], false); } } } while (0)
            PeerBatch Bc, Bd;
            PeerOffs PO;
#define V_OFFS(fb) do { const int fb_ = ((fb) < 255) ? (fb) : 255; peer_offs(PO, elw + 64 * (fb_ & 15), loff); } while (0)
#define V_ISSUE(B, fb) do { const int fb_ = ((fb) < 255) ? (fb) : 255; peer_issue(B, vb0 + (size_t)(fb_ >> 4) * (16384 * 128), PO); V_OFFS((fb) + 1); } while (0)
#define V_STEP(B, fb, Bn, fbn) do { \
                V_ISSUE(Bn, fbn); \
                __builtin_amdgcn_sched_barrier(0); \
                V_COMPUTE(B, (fb) & 15); \
                __builtin_amdgcn_sched_barrier(0); } while (0)
#define V_FINISH(fb, xw) do { const int tk = ((fb) >> 1) & 7, sl = (fb) >> 4; \
                int z[8]; \
                _Pragma("unroll") for (int q = 0; q < 8; ++q) {            \
                    int a0 = y[q], b0 = y[8 + q]; \
                    asm volatile("v_nop\n\tv_nop\n\tv_permlane32_swap_b32 %0, %1" : "+v"(a0), "+v"(b0)); \
                    z[q] = a0 + b0; } \
                int qq[4]; \
                { const bool up = (lane & 16) != 0; \
                  _Pragma("unroll") for (int q = 0; q < 4; ++q) { const int snd = up ? z[q] : z[4 + q]; qq[q] = (up ? z[4 + q] : z[q]) + __shfl_xor(snd, 16); } } \
                int p0, p1; \
                { const bool up = (lane & 8) != 0; \
                  const int s0 = up ? qq[0] : qq[2], s1 = up ? qq[1] : qq[3]; p0 = (up ? qq[2] : qq[0]) + dpp_i<0x128>(s0); p1 = (up ? qq[3] : qq[1]) + dpp_i<0x128>(s1); } \
                const size_t eo = (tok0 + tk) * 2048 + 128 * sl + 16 * j + 2 * g; \
                const float sw_ = swl[tk]; \
                const f32x2 x3 = (f32x2){bf_lo(xw) + (float)p0 * sw_, bf_hi(xw) + (float)p1 * sw_}; \
                *(GAS unsigned*)(XBw + eo) = pk2(x3.x, x3.y);        \
                SSL[(tl0 + tk) * 64 + lane] += x3.x * x3.x + x3.y * x3.y; \
                _Pragma("unroll") for (int q = 0; q < 16; ++q) y[q] = 0; } while (0)
            V_OFFS(0); V_ISSUE(Ba, 0); V_ISSUE(Bb, 1); V_ISSUE(Bc, 2);
#pragma unroll
            for (int q = 0; q < 16; ++q) y[q] = 0;
#pragma unroll 1
            for (int fb = 0; fb < 256; fb += 4) {
                const unsigned xwA = *(const GAS unsigned*)(XB + (tok0 + ((fb >> 1) & 7)) * 2048 + 128 * (fb >> 4) + 16 * j + 2 * g);
                const unsigned xwB = *(const GAS unsigned*)(XB + (tok0 + (((fb + 2) >> 1) & 7)) * 2048 + 128 * (fb >> 4) + 16 * j + 2 * g);
                V_STEP(Ba, fb, Bd, fb + 3);
                V_STEP(Bb, fb + 1, Ba, fb + 4);
                V_FINISH(fb + 1, xwA);
                V_STEP(Bc, fb + 2, Bb, fb + 5);
                V_STEP(Bd, fb + 3, Bc, fb + 6);
                V_FINISH(fb + 3, xwB);
            }
#undef V_FINISH
#undef V_STEP
#undef V_ISSUE
#undef V_OFFS
#undef V_COMPUTE
        }
        LDS_WAIT(); ISTAMP(F, 22);
        const float* gfin = (const float*)a.in[I_GFINAL];
#pragma unroll 1
        for (int tk = 0; tk < 8; ++tk) {
            const float rstd = 1.0f / sqrtf(wave_sum(SSL[(tl0 + tk) * 64 + lane]) * (1.0f / 2048.0f) + EPS);
            float* xr = a.out + (tok0 + tk) * 2048 + 16 * j + 2 * g; const bf16_t* xs = XB + (tok0 + tk) * 2048 + 16 * j + 2 * g;
            unsigned vv[16];
#pragma unroll
            for (int sl = 0; sl < 16; ++sl) vv[sl] = __builtin_nontemporal_load((const GAS unsigned*)(xs + 128 * sl));
#pragma unroll
            for (int sl = 0; sl < 16; ++sl) { const f32x2 gg = *(const GAS f32x2*)(gfin + 128 * sl + 16 * j + 2 * g);
                __builtin_nontemporal_store((f32x2){bf_lo(vv[sl]) * rstd * gg.x, bf_hi(vv[sl]) * rstd * gg.y}, (GAS f32x2*)(xr + 128 * sl)); }
        }
        LDS_WAIT();
    }
}

constexpr int NPHASES = 14;
#ifndef MK_ONE_LAUNCH
#define MK_ONE_LAUNCH 1
#endif
__global__ void __launch_bounds__(NTHREADS, 2) hybrid_fwd(Args args) {
    extern __shared__ __attribute__((aligned(16))) unsigned char lds_raw[];
    Frame F;
    F.lds = (LAS unsigned char*)lds_raw;
    F.tid = threadIdx.x; F.lane = F.tid & 63; F.wave = __builtin_amdgcn_readfirstlane(F.tid >> 6);
    F.G = gridDim.x; F.bid = blockIdx.x; F.ws = args.ws; F.dout = (unsigned char*)args.out;
    volatile LAS unsigned* MISC = (volatile LAS unsigned*)(F.lds + LDS_BYTES - 256);
    if (F.tid < 64) MISC[F.tid] = 0u;
    __syncthreads();
    XcdBarrier bar = xcd_barrier_post((unsigned*)(F.ws + WS_CTL) + 4096, MISC + 8);
    const int lo = args.ph_lo, hi = args.ph_hi;
#ifndef PROBE_MULT
#define PROBE_MULT 16
#endif
    if (PROBE_PHASE >= 0 && F.bid == 0 && F.tid == 0) { volatile LAS unsigned long long* ts_ = (volatile LAS unsigned long long*)(F.lds + LDS_BYTES - 64); ts_[0] = __builtin_amdgcn_s_memrealtime(); ts_[1] = 0; }
#define STAMP(k) FSTAMP(F, k)
#define IN(k) (lo <= (k) && (k) < hi && (F.lane = lane_id(), F.tid = F.wave * 64 + F.lane, true))
#define SEAM(k) do { if (IN(k) && IN((k) + 1)) xcd_barrier(bar); } while (0)
    unsigned char* ws = F.ws;
    LAS unsigned char* ring = F.lds;

    if (IN(0)) { ph0_prologue(F, args); xcd_barrier(bar); F.lane = lane_id(); F.tid = F.wave * 64 + F.lane; ph0b_quant(F, args); } SEAM(0); STAMP(0);
    if (IN(1)) {
        Sched1 S{F.G, F.bid, ws, F.dout}; EpiProj E;
        pg8::gemm_phase<EpiProj, Sched1, true, true>(ring, F.tid, DM / 2, DM / 2, DM / 2, S, E);
#if PROBE_PHASE == 52
        { __syncthreads(); ISTAMP(F, 51); Sched1 S2{F.G, F.bid, ws, F.dout}; EpiNull1 EN; pg8::gemm_phase<EpiNull1, Sched1, true>(ring, F.tid, DM, DM, DM, S2, EN); __syncthreads(); ISTAMP(F, 52); }
#endif
    } SEAM(1); STAMP(1);
    if (IN(2)) { ph2_mixers_a(F); } SEAM(2); STAMP(2);
    if (IN(3)) { ph_scan(F); } SEAM(3); STAMP(3);
    if (IN(4)) { ph3_mixers_b(F); } SEAM(4); STAMP(4);
    if (IN(5)) {
        quant_rows1k(F, (const bf16_t*)(ws + WS_RQ), (const unsigned*)(ws + WS_RMAX_RQ), ws + WS_RQ8, (float*)(ws + WS_SA_RQ)); xcd_barrier(bar); F.lane = lane_id(); F.tid = F.wave * 64 + F.lane;
        { SchedG S{F.G, F.bid, 64, 8, (const char*)(ws + WS_RQ8), (const char*)(ws + WS_W8_BR), (size_t)256 * 1024, (size_t)256 * 1024};
          EpiMerge<0, true> E{(bf16_t*)(ws + WS_GR), (bf16_t*)(ws + WS_GD), nullptr, (const float*)(ws + WS_SA_RQ), (const float*)(ws + WS_SB_BR)};
          pg8::gemm_phase<EpiMerge<0, true>, SchedG, true, true>(ring, F.tid, 512, 512, 512, S, E); }
        { SchedG S{F.G, F.bid, 64, 8, (const char*)(ws + WS_DQ8), (const char*)(ws + WS_W8_BD), (size_t)256 * 512, (size_t)256 * 512};
          EpiMerge<1, true> E{(bf16_t*)(ws + WS_GR), (bf16_t*)(ws + WS_GD), (unsigned*)(ws + WS_RMAX_GD), (const float*)(ws + WS_SA_DQ), (const float*)(ws + WS_SB_BD)};
          pg8::gemm_phase<EpiMerge<1, true>, SchedG, true, true>(ring, F.tid, 256, 256, 256, S, E); }
    } SEAM(5); STAMP(5);
    if (IN(6)) {
        quant_rows(F, (const bf16_t*)(ws + WS_GD), (const unsigned*)(ws + WS_RMAX_GD), ws + WS_A8_0, (float*)(ws + WS_SA8_0)); xcd_barrier(bar); F.lane = lane_id(); F.tid = F.wave * 64 + F.lane;
        SchedG S{F.G, F.bid, 64, 8, (const char*)(ws + WS_A8_0), (const char*)(ws + WS_W8_OUT), (size_t)256 * 2048, (size_t)256 * 2048};
        EpiResid<true, true> E{(const float*)args.in[I_X], (bf16_t*)(ws + WS_XB), (float*)(ws + WS_SSQ1), (unsigned*)(ws + WS_RMAX_X1), (const float*)(ws + WS_SA8_0), (const float*)(ws + WS_SB_OUT)};
        pg8::gemm_phase<EpiResid<true, true>, SchedG, true, true>(ring, F.tid, 1024, 1024, 1024, S, E);
    } SEAM(6); STAMP(6);
    if (IN(7)) {
        SchedG S{F.G, F.bid, 64, 8, (const char*)(ws + WS_A8_1), (const char*)(ws + WS_W8_Q), (size_t)256 * 2048, (size_t)256 * 2048};
        quant_rows(F, (const bf16_t*)(ws + WS_XB), (const unsigned*)(ws + WS_RMAX_X1), ws + WS_A8_1, (float*)(ws + WS_SA8_1)); xcd_barrier(bar); F.lane = lane_id(); F.tid = F.wave * 64 + F.lane;
        EpiRowScale8 E{(const float*)(ws + WS_SSQ1), (bf16_t*)(ws + WS_QM), 0.04419417382415922f * 1.4426950408889634f, (const float*)(ws + WS_SA8_1), (const float*)(ws + WS_SB_Q)};
        pg8::gemm_phase<EpiRowScale8, SchedG, true, true>(ring, F.tid, 1024, 1024, 1024, S, E);
#if PROBE_PHASE == 50
        { __syncthreads(); ISTAMP(F, 49); SchedG S2{F.G, F.bid, 64, 8, (const char*)(ws + WS_XB), (const char*)(ws + WS_WQ_T), (size_t)256 * 2048 * 2, (size_t)256 * 2048 * 2};
          EpiNull EN; pg8::gemm_phase<EpiNull, SchedG, true>(ring, F.tid, 2048, 2048, 2048, S2, EN); __syncthreads(); ISTAMP(F, 50); }
#endif
    } SEAM(7); STAMP(7);
    if (IN(8)) {
        Sched7 S{F.G, F.bid, (const char*)(ws + WS_QM), (const char*)(ws + WS_KM)};
        EpiSoftmax E{(bf16_t*)(ws + WS_P), (LAS float*)(F.lds + LDSX_OFF)};
        pg8::gemm_phase<EpiSoftmax, Sched7, true>(ring, F.tid, 512, 2048, 2048, S, E);
    } SEAM(8); STAMP(8);
    if (IN(9)) {
        Sched8 S{F.G, F.bid, (const char*)(ws + WS_P), (const char*)(ws + WS_VT)};
        EpiPlain E{(bf16_t*)(ws + WS_O), 2048, (unsigned*)(ws + WS_RMAX_O)};
        pg8::gemm_phase<EpiPlain, Sched8, true>(ring, F.tid, 256, 256, 2048, S, E);
    } SEAM(9); STAMP(9);
    if (IN(10)) {
        quant_rows(F, (const bf16_t*)(ws + WS_O), (const unsigned*)(ws + WS_RMAX_O), ws + WS_A8_0, (float*)(ws + WS_SA8_0)); xcd_barrier(bar); F.lane = lane_id(); F.tid = F.wave * 64 + F.lane;
        SchedG S{F.G, F.bid, 64, 8, (const char*)(ws + WS_A8_0), (const char*)(ws + WS_W8_O), (size_t)256 * 2048, (size_t)256 * 2048};
        EpiResid<false, true> E{nullptr, (bf16_t*)(ws + WS_XB), (float*)(ws + WS_SSQ2), (unsigned*)(ws + WS_RMAX_X2), (const float*)(ws + WS_SA8_0), (const float*)(ws + WS_SB_O)};
        pg8::gemm_phase<EpiResid<false, true>, SchedG, true, true>(ring, F.tid, 1024, 1024, 1024, S, E);
    } SEAM(10); STAMP(10);
    if (IN(11)) {
        SchedG S{F.G, F.bid, 64, 8, (const char*)(ws + WS_A8_1), (const char*)(ws + WS_W8_PQ), (size_t)256 * 2048, (size_t)256 * 2048};
        quant_rows(F, (const bf16_t*)(ws + WS_XB), (const unsigned*)(ws + WS_RMAX_X2), ws + WS_A8_1, (float*)(ws + WS_SA8_1)); xcd_barrier(bar); F.lane = lane_id(); F.tid = F.wave * 64 + F.lane;
        EpiRowScale8 E{(const float*)(ws + WS_SSQ2), (bf16_t*)(ws + WS_PQ), 1.0f, (const float*)(ws + WS_SA8_1), (const float*)(ws + WS_SB_PQ)};
        pg8::gemm_phase<EpiRowScale8, SchedG, true, true>(ring, F.tid, 1024, 1024, 1024, S, E);
    } SEAM(11); STAMP(11);
    if (IN(12)) { ph11_route(F, args); } SEAM(12); STAMP(12);
    if (IN(13)) { ph12_peer(F, args); }
    if (PROBE_PHASE >= 0 && F.bid == 0) { __syncthreads(); STAMP(13); __syncthreads(); const unsigned long long t0_ = __builtin_amdgcn_s_memrealtime();
        const unsigned long long tsel_ = ((volatile LAS unsigned long long*)(F.lds + LDS_BYTES - 64))[1];
        while (__builtin_amdgcn_s_memrealtime() - t0_ < (unsigned long long)PROBE_MULT * tsel_) __builtin_amdgcn_s_sleep(8); }
#undef IN
#undef SEAM
}

extern "C" void kernel_launch(void* const* d_in, const int* in_sizes, int n_in, void* d_out, int out_size, void* d_ws, size_t ws_size, hipStream_t stream) {
    static int grid = 0;
    if (grid == 0) {
        if (n_in != 19 || out_size != MT * DM || ws_size < WS_END) { fprintf(stderr, "kernel_launch: unexpected shapes (n_in %d, out %d, ws %zu)\n", n_in, out_size, ws_size); grid = -1; return; }
        int dev = 0, cus = 0;
        if (hipGetDevice(&dev) != hipSuccess || hipDeviceGetAttribute(&cus, hipDeviceAttributeMultiprocessorCount, dev) != hipSuccess) { grid = -1; return; }
        if (hipFuncSetAttribute((const void*)hybrid_fwd, hipFuncAttributeMaxDynamicSharedMemorySize, LDS_BYTES) != hipSuccess) { fprintf(stderr, "kernel_launch: hipFuncSetAttribute failed\n"); grid = -1; return; }
        (void)hipGetLastError();
        grid = cus;
    }
    if (grid < 0) return;
    (void)hipMemsetAsync((char*)d_ws + WS_CTL, 0, CTL_ZERO_BYTES, stream);
    Args a{};
    for (int i = 0; i < 19; ++i) a.in[i] = d_in[i];
    a.out = (float*)d_out; a.ws = (unsigned char*)d_ws;
    for (int i = 0; i < 64; ++i) { a.fret[i] = std::pow(10000.0, -(double)i / 63.0); a.frot[i] = std::pow(10000.0, -(double)i / 64.0); }
#if MK_ONE_LAUNCH
    a.ph_lo = 0; a.ph_hi = NPHASES;
    hipLaunchKernelGGL(hybrid_fwd, dim3(grid), dim3(NTHREADS), LDS_BYTES, stream, a);
#else
    for (int ph = 0; ph < NPHASES; ++ph) {
        a.ph_lo = ph; a.ph_hi = ph + 1;
        hipLaunchKernelGGL(hybrid_fwd, dim3(grid), dim3(NTHREADS), LDS_BYTES, stream, a);
    }
#endif
}
#ifdef PHASE_PROBE
#define PROBE(k) __global__ void __launch_bounds__(NTHREADS, 2) probe_ph##k(Args args) { \
    extern __shared__ __attribute__((aligned(16))) unsigned char lds_raw[]; Frame F; F.lds = (LAS unsigned char*)lds_raw; F.tid = threadIdx.x; F.lane = F.tid & 63; \
    F.wave = __builtin_amdgcn_readfirstlane(F.tid >> 6); F.G = gridDim.x; F.bid = blockIdx.x; F.ws = args.ws; F.dout = (unsigned char*)args.out; unsigned char* ws = F.ws; LAS unsigned char* ring = F.lds;
PROBE(0) ph0_prologue(F, args); }
PROBE(1) Sched1 S{F.G, F.bid, ws, F.dout}; EpiProj E; pg8::gemm_phase<EpiProj, Sched1, true, true>(ring, F.tid, DM / 2, DM / 2, DM / 2, S, E); }
PROBE(2) ph2_mixers_a(F); }
PROBE(3) ph3_mixers_b(F); }
PROBE(5) SchedG S{F.G, F.bid, 64, 8, (const char*)(ws + WS_GD), (const char*)(ws + WS_WOUT_T), (size_t)256 * 2048 * 2, (size_t)256 * 2048 * 2};
        EpiResid<true> E{(const float*)args.in[I_X], (bf16_t*)(ws + WS_XB), (float*)(ws + WS_SSQ1), (unsigned*)(ws + WS_RMAX_X1), nullptr, nullptr};
        pg8::gemm_phase<EpiResid<true>, SchedG, true>(ring, F.tid, 2048, 2048, 2048, S, E); }
PROBE(7) Sched7 S{F.G, F.bid, (const char*)(ws + WS_QM), (const char*)(ws + WS_KM)};
        EpiSoftmax E{(bf16_t*)(ws + WS_P), (LAS float*)(F.lds + LDSX_OFF)};
        pg8::gemm_phase<EpiSoftmax, Sched7, true>(ring, F.tid, 512, 2048, 2048, S, E); }
PROBE(11) ph11_route(F, args); }
PROBE(12) ph12_peer(F, args); }
#endif
```
